# Optimizing an MI355X kernel written in HIP

```python
import math
import jax
import jax.numpy as jnp
from jax import lax
import numpy as np

D_MODEL = 1024
BATCH = 16
SEQ = 2048
DEPTH = 2

HEAD_DIM = 64
ATTN_Q_HEADS = 8
ATTN_KV_HEADS = 2
ATTN_GROUP = ATTN_Q_HEADS // ATTN_KV_HEADS
WINDOW = 128
BLOCK = 128
SPAN = BLOCK + 2 * WINDOW
N_BUCKETS = 32
MAX_DISTANCE = 128
DN_HEADS = 8
DN_DK = 64
DN_DV = 64
DN_CONV = 5
DN_CHUNK = 64
POOL_WINDOWS = (2, 4, 8, 16)
N_POOL_GROUPS = 4
POOL_GROUP = 128
ATTN_W = ATTN_Q_HEADS * HEAD_DIM
KV_W = ATTN_KV_HEADS * HEAD_DIM
DN_QK_W = DN_HEADS * DN_DK
DN_V_W = DN_HEADS * DN_DV
DN_CONV_CH = 2 * DN_QK_W + DN_V_W
POOL_W = N_POOL_GROUPS * POOL_GROUP
BRANCH_W = 512
N_BRANCH = 3
SPLIT_SIZES = (ATTN_W, KV_W, KV_W, DN_QK_W, DN_QK_W, DN_V_W, DN_V_W, 4 * DN_HEADS, POOL_W, N_BRANCH * D_MODEL)
IN_COLS = sum(SPLIT_SIZES)
D_FF = 2816
N_EXPERTS = 8
TOP_K = 2
D_FF_EXPERT = 3584
N_DENSE = (DEPTH + 1) // 2
N_MOE = DEPTH // 2
DEEPNORM_ALPHA = (2.0 * DEPTH) ** 0.25
DEEPNORM_BETA = (8.0 * DEPTH) ** -0.25
LN_EPS = 1e-5
RMS_EPS = 1e-6
NEG_INF = -1e30

kernel_name = 'hybrid_gated_attn_deltanet_pool_moe_encoder'

f32 = jnp.float32


def layer_norm(x, g, b):
    xf = x.astype(f32)
    mu = jnp.mean(xf, -1, keepdims=True)
    var = jnp.mean(jnp.square(xf - mu), -1, keepdims=True)
    return ((xf - mu) * lax.rsqrt(var + LN_EPS) * g + b).astype(x.dtype)


def _band_rel():
    q_loc = np.arange(BLOCK)[:, None]
    k_loc = np.arange(SPAN)[None, :]
    return k_loc - WINDOW - q_loc


def _t5_bucket(rel):
    nb = N_BUCKETS // 2
    max_exact = nb // 2
    n = np.abs(rel)
    large = max_exact + (np.log(np.maximum(n, 1) / max_exact) / np.log(MAX_DISTANCE / max_exact)
                         * (nb - max_exact)).astype(np.int32)
    large = np.minimum(large, nb - 1)
    return (np.where(rel > 0, nb, 0) + np.where(n < max_exact, n, large)).astype(np.int32)


def windowed_gqa(q, k, v, sink, bias):
    B, S = q.shape[0], q.shape[1]
    n_blocks = S // BLOCK
    in_window = jnp.asarray(np.abs(_band_rel()) <= WINDOW)
    qg = q.reshape(B, S, ATTN_KV_HEADS, ATTN_GROUP, HEAD_DIM)
    kp = jnp.pad(k, ((0, 0), (WINDOW, WINDOW), (0, 0), (0, 0)))
    vp = jnp.pad(v, ((0, 0), (WINDOW, WINDOW), (0, 0), (0, 0)))
    bias_g = bias.reshape(ATTN_KV_HEADS, ATTN_GROUP, BLOCK, SPAN)
    sink_g = sink.astype(f32).reshape(ATTN_KV_HEADS, ATTN_GROUP, 1, 1)
    scale = HEAD_DIM ** -0.5

    def one_block(i):
        start = i * BLOCK
        qb = lax.dynamic_slice_in_dim(qg, start, BLOCK, axis=1).astype(f32)
        kb = lax.dynamic_slice_in_dim(kp, start, SPAN, axis=1).astype(f32)
        vb = lax.dynamic_slice_in_dim(vp, start, SPAN, axis=1).astype(f32)
        kpos = start - WINDOW + jnp.arange(SPAN)
        valid = in_window & ((kpos >= 0) & (kpos < S))[None, :]
        s = jnp.einsum('bqkgd,bjkd->bkgqj', qb, kb) * scale + bias_g
        s = jnp.where(valid, s, NEG_INF)
        m = jnp.maximum(jnp.max(s, -1, keepdims=True), sink_g)
        p = jnp.exp(s - m)
        denom = jnp.sum(p, -1, keepdims=True) + jnp.exp(sink_g - m)
        o = jnp.einsum('bkgqj,bjkd->bqkgd', p / denom, vb)
        return o.astype(q.dtype)

    o = lax.map(one_block, jnp.arange(n_blocks))
    return jnp.moveaxis(o, 0, 1).reshape(B, S, ATTN_W)


def short_conv(u, w):
    pad = (DN_CONV - 1) // 2
    return lax.conv_general_dilated(u, w[:, None, :].astype(u.dtype), window_strides=(1,),
                                    padding=[(pad, pad)], dimension_numbers=('NWC', 'WIO', 'NWC'),
                                    feature_group_count=u.shape[-1])


def l2norm(t):
    return t * lax.rsqrt(jnp.sum(t * t, -1, keepdims=True) + 1e-6)


def gated_delta_chunked(q, k, v, g, beta):
    R, B, S, H, dk = q.shape
    dv = v.shape[-1]
    C = DN_CHUNK
    N = S // C

    def to_chunks(t):
        t = t.reshape(t.shape[:2] + (N, C) + t.shape[3:])
        return jnp.transpose(t, (2, 0, 1, 4, 3) + tuple(range(5, t.ndim)))

    q = l2norm(q) * (dk ** -0.5)
    k = l2norm(k)
    qc, kc, vc = to_chunks(q), to_chunks(k), to_chunks(v)
    gc, bc = to_chunks(g), to_chunks(beta)
    G = jnp.cumsum(gc, axis=-1)
    lower = jnp.tril(jnp.ones((C, C), bool))
    strict = jnp.tril(jnp.ones((C, C), bool), -1)
    diff = G[..., :, None] - G[..., None, :]
    decay = jnp.where(lower, jnp.exp(jnp.where(lower, diff, 0.0)), 0.0)
    kb = kc * bc[..., None]
    A = jnp.where(strict, jnp.einsum('...id,...jd->...ij', kb, kc) * decay, 0.0)
    rhs = jnp.concatenate([vc * bc[..., None], kb * jnp.exp(G)[..., None]], axis=-1)
    sol = lax.linalg.triangular_solve(A, rhs, left_side=True, lower=True, unit_diagonal=True)
    u_c, w_c = sol[..., :dv], sol[..., dv:]
    qk = jnp.where(lower, jnp.einsum('...id,...jd->...ij', qc, kc) * decay, 0.0)
    q_dec = qc * jnp.exp(G)[..., None]
    G_last = G[..., -1:]
    k_dec = kc * jnp.exp(G_last - G)[..., None]
    chunk_decay = jnp.exp(G_last)[..., None]

    def step(state, xs):
        q_i, k_i, qk_i, u_i, w_i, cd_i = xs
        v_new = u_i - jnp.einsum('rbhcd,rbhde->rbhce', w_i, state)
        o = jnp.einsum('rbhcd,rbhde->rbhce', q_i, state) + jnp.einsum('rbhij,rbhje->rbhie', qk_i, v_new)
        state = state * cd_i + jnp.einsum('rbhcd,rbhce->rbhde', k_i, v_new)
        return state, o

    s0 = jnp.zeros((R, B, H, dk, dv), f32)
    _, o = lax.scan(step, s0, (q_dec, k_dec, qk, u_c, w_c, chunk_decay))
    return jnp.transpose(o, (1, 2, 0, 4, 3, 5)).reshape(R, B, S, H, dv)


def delta_branch(q, k, v, z, a, b, conv_w, a_log, dt_bias, norm_w):
    B, S = q.shape[0], q.shape[1]
    dtype = q.dtype
    qkv = jax.nn.silu(short_conv(jnp.concatenate([q, k, v], -1), conv_w)).astype(f32)
    qh = qkv[..., :DN_QK_W].reshape(B, S, DN_HEADS, DN_DK)
    kh = qkv[..., DN_QK_W:2 * DN_QK_W].reshape(B, S, DN_HEADS, DN_DK)
    vh = qkv[..., 2 * DN_QK_W:].reshape(B, S, DN_HEADS, DN_DV)
    g = -jnp.exp(a_log.astype(f32)) * jax.nn.softplus(a.astype(f32) + dt_bias.astype(f32))
    beta = jax.nn.sigmoid(b.astype(f32))

    def both(t):
        return jnp.stack([t, jnp.flip(t, axis=1)])

    g2 = jnp.stack([g[:, :, 0], jnp.flip(g[:, :, 1], axis=1)])
    beta2 = jnp.stack([beta[:, :, 0], jnp.flip(beta[:, :, 1], axis=1)])
    o = gated_delta_chunked(both(qh), both(kh), both(vh), g2, beta2)
    o = o[0] + jnp.flip(o[1], axis=1)
    zh = z.astype(f32).reshape(B, S, DN_HEADS, DN_DV)
    o = o * lax.rsqrt(jnp.mean(o * o, -1, keepdims=True) + RMS_EPS) * norm_w.astype(f32) * jax.nn.silu(zh)
    return o.reshape(B, S, DN_V_W).astype(dtype)


def pool_branch(u, pool_w, pool_scale):
    B, S = u.shape[0], u.shape[1]
    groups = u.reshape(B, S, N_POOL_GROUPS, POOL_GROUP).astype(f32)
    t = np.arange(S)
    outs = []
    for gi, w in enumerate(POOL_WINDOWS):
        r = w // 2
        ug = groups[:, :, gi]
        cs = jnp.cumsum(jnp.pad(ug, ((0, 0), (r + 1, r), (0, 0))), axis=1)
        win_sum = cs[:, 2 * r + 1:] - cs[:, :S]
        count = (np.minimum(t + r, S - 1) - np.maximum(t - r, 0) + 1).astype(np.float32)
        outs.append(win_sum / jnp.asarray(count)[None, :, None] - ug)
    mixed = jnp.stack(outs, axis=2)
    y = jnp.einsum('bsgc,gcd->bsgd', mixed, pool_w.astype(f32))
    return (y.reshape(B, S, POOL_W) * pool_scale.astype(f32)).astype(u.dtype)


def hybrid_mixer(x, w_in, attn_sink, bias, conv_w, a_log, dt_bias, dn_norm_w, pool_w, pool_scale, w_branch, w_out):
    B, S = x.shape[0], x.shape[1]
    proj = x @ w_in
    points = np.cumsum(SPLIT_SIZES)[:-1].tolist()
    aq, ak, av, dq, dk, dvv, dz, dab, pu, gates = jnp.split(proj, points, axis=-1)
    o_attn = windowed_gqa(aq.reshape(B, S, ATTN_Q_HEADS, HEAD_DIM),
                          ak.reshape(B, S, ATTN_KV_HEADS, HEAD_DIM),
                          av.reshape(B, S, ATTN_KV_HEADS, HEAD_DIM), attn_sink, bias)
    dab = dab.reshape(B, S, 4, DN_HEADS)
    o_delta = delta_branch(dq, dk, dvv, dz, dab[:, :, :2], dab[:, :, 2:], conv_w, a_log, dt_bias, dn_norm_w)
    o_pool = pool_branch(pu, pool_w, pool_scale)
    branches = jnp.stack([o_attn, o_delta, o_pool], axis=2)
    up = jnp.einsum('bsnc,ncd->bsnd', branches, w_branch)
    gate = jax.nn.sigmoid(gates.reshape(B, S, N_BRANCH, D_MODEL))
    merged = jnp.sum(gate * up, axis=2)
    return merged @ w_out


def swiglu(x, w_gate, w_up, w_down):
    return (jax.nn.silu(x @ w_gate) * (x @ w_up)) @ w_down


def moe_swiglu(x, router_w, wg, wu, wd):
    logits = (x @ router_w).astype(f32)
    top_logit, top_idx = lax.top_k(logits, TOP_K)
    top_p = jax.nn.softmax(top_logit, axis=-1)
    combine = jnp.sum(jax.nn.one_hot(top_idx, N_EXPERTS, dtype=f32) * top_p[..., None], axis=-2)
    out = jnp.zeros(x.shape, f32)
    for e in range(N_EXPERTS):
        out = out + combine[..., e:e + 1] * swiglu(x, wg[e], wu[e], wd[e]).astype(f32)
    return out.astype(x.dtype)


def setup_inputs(seed: int = 0) -> dict:
    key = jax.random.key(seed)
    ks = jax.random.split(key, 24)
    L = DEPTH
    D = D_MODEL

    def nrm(k, shape, scale):
        return jax.random.normal(k, shape, f32) * scale

    x = nrm(ks[0], (BATCH, SEQ, D), 1.0)
    w_in = nrm(ks[1], (L, D, IN_COLS), D ** -0.5)
    attn_sink = nrm(ks[2], (L, ATTN_Q_HEADS), 0.5)
    rel_bias = nrm(ks[3], (N_BUCKETS, ATTN_Q_HEADS), 0.5)
    conv_w = nrm(ks[4], (L, DN_CONV, DN_CONV_CH), DN_CONV ** -0.5)
    a_log = jnp.log(jax.random.uniform(ks[5], (L, 2, DN_HEADS), f32, 1.0, 16.0))
    dt = jnp.exp(jax.random.uniform(ks[6], (L, 2, DN_HEADS), f32, math.log(1e-3), math.log(1e-1)))
    dt_bias = dt + jnp.log(-jnp.expm1(-dt))
    dn_norm_w = 1.0 + nrm(ks[7], (L, DN_DV), 0.1)
    pool_w = nrm(ks[8], (L, N_POOL_GROUPS, POOL_GROUP, POOL_GROUP), POOL_GROUP ** -0.5)
    pool_scale = 1.0 + nrm(ks[9], (L, POOL_W), 0.1)
    w_branch = nrm(ks[10], (L, N_BRANCH, BRANCH_W, D), BRANCH_W ** -0.5)
    w_out = nrm(ks[11], (L, D, D), DEEPNORM_BETA * D ** -0.5)
    ln1_g = 1.0 + nrm(ks[12], (L, D), 0.1)
    ln1_b = nrm(ks[13], (L, D), 0.02)
    ln2_g = 1.0 + nrm(ks[14], (L, D), 0.1)
    ln2_b = nrm(ks[15], (L, D), 0.02)
    ffn_w1 = nrm(ks[16], (N_DENSE, D, D_FF), D ** -0.5)
    ffn_w3 = nrm(ks[17], (N_DENSE, D, D_FF), D ** -0.5)
    ffn_w2 = nrm(ks[18], (N_DENSE, D_FF, D), DEEPNORM_BETA * D_FF ** -0.5)
    router_w = nrm(ks[19], (N_MOE, D, N_EXPERTS), D ** -0.5)
    moe_wg = nrm(ks[20], (N_MOE, N_EXPERTS, D, D_FF_EXPERT), D ** -0.5)
    moe_wu = nrm(ks[21], (N_MOE, N_EXPERTS, D, D_FF_EXPERT), D ** -0.5)
    moe_wd = nrm(ks[22], (N_MOE, N_EXPERTS, D_FF_EXPERT, D), DEEPNORM_BETA * D_FF_EXPERT ** -0.5)
    return {'x': x, 'w_in': w_in, 'attn_sink': attn_sink, 'rel_bias': rel_bias, 'conv_w': conv_w,
            'a_log': a_log, 'dt_bias': dt_bias, 'dn_norm_w': dn_norm_w, 'pool_w': pool_w,
            'pool_scale': pool_scale, 'w_branch': w_branch, 'w_out': w_out, 'ln1_g': ln1_g,
            'ln1_b': ln1_b, 'ln2_g': ln2_g, 'ln2_b': ln2_b, 'ffn_w1': ffn_w1, 'ffn_w3': ffn_w3,
            'ffn_w2': ffn_w2, 'router_w': router_w, 'moe_wg': moe_wg, 'moe_wu': moe_wu, 'moe_wd': moe_wd}


def reference(x, w_in, attn_sink, rel_bias, conv_w, a_log, dt_bias, dn_norm_w, pool_w, pool_scale,
              w_branch, w_out, ln1_g, ln1_b, ln2_g, ln2_b, ffn_w1, ffn_w3, ffn_w2,
              router_w, moe_wg, moe_wu, moe_wd):
    bias = jnp.transpose(rel_bias[_t5_bucket(_band_rel())], (2, 0, 1)).astype(f32)
    h = x
    for layer in range(DEPTH):
        y = hybrid_mixer(h, w_in[layer], attn_sink[layer], bias, conv_w[layer], a_log[layer], dt_bias[layer],
                         dn_norm_w[layer], pool_w[layer], pool_scale[layer], w_branch[layer], w_out[layer])
        h = layer_norm(DEEPNORM_ALPHA * h + y, ln1_g[layer], ln1_b[layer])
        i = layer // 2
        if layer % 2 == 0:
            y = swiglu(h, ffn_w1[i], ffn_w3[i], ffn_w2[i])
        else:
            y = moe_swiglu(h, router_w[i], moe_wg[i], moe_wu[i], moe_wd[i])
        h = layer_norm(DEEPNORM_ALPHA * h + y, ln2_g[layer], ln2_b[layer])
    return h
```

```cpp
#include <hip/hip_runtime.h>
#include <cstdio>
#include <cstdint>

#define GAS __attribute__((address_space(1)))
#define LAS __attribute__((address_space(3)))
typedef unsigned short bf16;
typedef unsigned v4u __attribute__((ext_vector_type(4)));
typedef unsigned v2u __attribute__((ext_vector_type(2)));
typedef float f32x2 __attribute__((ext_vector_type(2)));
typedef float f32x4 __attribute__((ext_vector_type(4)));
typedef float f32x16 __attribute__((ext_vector_type(16)));
typedef short bf16x8 __attribute__((ext_vector_type(8)));
typedef short bf16x4 __attribute__((ext_vector_type(4)));

#ifndef ABL
#define ABL 0
#endif
#ifndef LN_FUSE
#define LN_FUSE 3
#endif
#ifndef MK_PER_PHASE
#define MK_PER_PHASE 0
#endif

#ifndef WGM_K
#define WGM_K 8
#endif
namespace pg8 {
#define PG8_LAS __attribute__((address_space(3)))
typedef unsigned short bf16_t;
typedef unsigned u32x4 __attribute__((ext_vector_type(4)));
constexpr int BM = 256, BK = 64, HALF = 128, HTB = HALF * BK * 2  , STAGE_BYTES = 8 * HTB, NXCD = 8, WGM = WGM_K;

__host__ __device__ __forceinline__ int lds_byte(int r, int c) { const int st = (r >> 4) * 2 + (c >> 5), rr = r & 15, cc = c & 31, ob = rr * 64 + cc * 2; return st * 1024 + (ob ^ (((ob >> 9) & 1) << 5)); }
__host__ __device__ __forceinline__ void stage_rc(int b, int& R, int& C) { const int st = b / 1024, sb = b % 1024, swz = sb ^ (((sb >> 9) & 1) << 5); R = (st >> 1) * 16 + swz / 64; C = (st & 1) * 32 + (swz % 64) / 2; }
__host__ __device__ __forceinline__ int perm32(int rho) { const int n = rho >> 4, i = rho & 15; return 8 * (i >> 2) + 4 * n + (i & 3); }

struct Unit { int pm, pn, aux; };

struct StaticOrder {
    int nM, nN, nwg, G, c;
    __host__ __device__ __forceinline__ void init(int nM_, int nN_, int G_, int c_) { nM = nM_; nN = nN_; nwg = nM * nN; G = G_; c = c_; }
    __host__ __device__ __forceinline__ bool map(long L, int& pm, int& pn) const {
        if (L >= nwg) return false;
        int wgid = (int)L; { const int q = nwg / NXCD, r = nwg % NXCD, xcd = wgid % NXCD, off = wgid / NXCD; wgid = (xcd < r ? xcd * (q + 1) : r * (q + 1) + (xcd - r) * q) + off; }
        const int nig = WGM * nN, gid = wgid / nig, fm = gid * WGM, gsz = (nM - fm) < WGM ? (nM - fm) : WGM;
        pm = fm + ((wgid % nig) % gsz); pn = (wgid % nig) / gsz; return true;
    }
};
struct StdSched {
    StaticOrder o; const char* A; const char* Bt; size_t tstep;
    __device__ __forceinline__ void init(const void* A_, const void* Bt_, int M, int N, int K, int G, int c) { o.init(M / BM, N / BM, G, c); A = (const char*)A_; Bt = (const char*)Bt_; tstep = (size_t)BM * K * 2; }
    __device__ __forceinline__ bool next(int i, Unit& u) const { u.aux = 0; return o.map((long)i * o.G + o.c, u.pm, u.pn); }
    __device__ __forceinline__ const char* abase(const Unit& u) const { return A + (size_t)u.pm * tstep; }
    __device__ __forceinline__ const char* bbase(const Unit& u) const { return Bt + (size_t)u.pn * tstep; }
};

typedef __bf16 bf16x2_t __attribute__((ext_vector_type(2)));
__device__ __forceinline__ unsigned cvt_pk_bf16(float lo, float hi) { const f32x2 v = {lo, hi}; const bf16x2_t b = __builtin_convertvector(v, bf16x2_t); return __builtin_bit_cast(unsigned, b); }

typedef f32x4 acc_t[2][2][4][2];
__device__ __forceinline__ void zero_acc(acc_t& acc) {
    float z = 0.f; asm volatile("" : "+v"(z));
#pragma unroll
    for (int a = 0; a < 2; ++a)
#pragma unroll
        for (int b = 0; b < 2; ++b)
#pragma unroll
            for (int m = 0; m < 4; ++m)
#pragma unroll
                for (int n = 0; n < 2; ++n) acc[a][b][m][n] = (f32x4){z, z, z, z};
}

typedef int v8i_t __attribute__((ext_vector_type(8)));
typedef int v4i_t __attribute__((ext_vector_type(4)));
__device__ __forceinline__ f32x4 mfma_fp8(const bf16x8& b0, const bf16x8& b1, const bf16x8& a0, const bf16x8& a1, const f32x4& c) {
    const v4i_t x0 = __builtin_bit_cast(v4i_t, b0), x1 = __builtin_bit_cast(v4i_t, b1), y0 = __builtin_bit_cast(v4i_t, a0), y1 = __builtin_bit_cast(v4i_t, a1);
    const v8i_t X = __builtin_shufflevector(x0, x1, 0, 1, 2, 3, 4, 5, 6, 7), Y = __builtin_shufflevector(y0, y1, 0, 1, 2, 3, 4, 5, 6, 7);
    return __builtin_amdgcn_mfma_scale_f32_16x16x128_f8f6f4(X, Y, c, 0, 0, 0, 0x7f7f7f7f, 0, 0x7f7f7f7f);
}
template <class Epi, class Sched, bool ALIGN_EPI = false, bool SP2 = false, bool FP8 = false>
__device__ __forceinline__ void gemm_phase(PG8_LAS unsigned char* lds, const int K, const Sched& S, const Epi& E, const int wid_in) {
    int lane = (int)__builtin_amdgcn_mbcnt_hi(~0u, __builtin_amdgcn_mbcnt_lo(~0u, 0u)); asm volatile("" : "+v"(lane));
    const int wid = wid_in, tid = wid * 64 + lane, wr = wid >> 2, wc = wid & 3, fr = lane & 15, fq = lane >> 4;
    const int nt = K / BK;
    unsigned voffA[2], voffB[2];
#pragma unroll
    for (int i = 0; i < 2; ++i) { int R, C; stage_rc(tid * 16 + i * 8192, R, C); const int Rb = Epi::PERM ? ((R & ~31) + perm32(R & 31)) : R;
        voffA[i] = (unsigned)(R * K + C) * 2u; voffB[i] = (unsigned)(Rb * K + C) * 2u; }
    const size_t kstep = (size_t)(BK * 2);
    const size_t hstep = (size_t)HALF * K * 2;
    const unsigned ldsw = (unsigned)wid * 1024u;
    const int aoff = lds_byte(wr * 64 + fr, fq * 8), boff = lds_byte(wc * 32 + fr, fq * 8);
#define PG8_SA(b, h) (((b) * 2 + (h)) * HTB)
#define PG8_SB(b, h) ((4 + (b) * 2 + (h)) * HTB)
#define PG8_STAGE(bufoff, gbase, voff) do { _Pragma("unroll") for (int _i = 0; _i < 2; ++_i) \
        __builtin_amdgcn_global_load_lds((const unsigned*)((const char*)(gbase) + (voff)[_i]), (PG8_LAS unsigned*)(lds + (bufoff) + ldsw + _i * 8192), 16, 0, 0); } while (0)
#define PG8_LDA(dst, b, h) do { if constexpr (FP8) { _Pragma("unroll") for (int m = 0; m < 4; ++m) { const v4i_t lo_ = *(const PG8_LAS v4i_t*)(lds + PG8_SA(b, h) + aoff + m * 2048), hi_ = *(const PG8_LAS v4i_t*)(lds + PG8_SA(b, h) + aoff + m * 2048 + 1024); \
            dst##8[m] = __builtin_shufflevector(lo_, hi_, 0, 1, 2, 3, 4, 5, 6, 7); } } \
        else { _Pragma("unroll") for (int m = 0; m < 4; ++m) _Pragma("unroll") for (int k = 0; k < 2; ++k) dst[m][k] = *(const PG8_LAS bf16x8*)(lds + PG8_SA(b, h) + aoff + m * 2048 + k * 1024); } } while (0)
#define PG8_LDB(dst, b, h) do { if constexpr (FP8) { _Pragma("unroll") for (int n = 0; n < 2; ++n) { const v4i_t lo_ = *(const PG8_LAS v4i_t*)(lds + PG8_SB(b, h) + boff + n * 2048), hi_ = *(const PG8_LAS v4i_t*)(lds + PG8_SB(b, h) + boff + n * 2048 + 1024); \
            dst##8[n] = __builtin_shufflevector(lo_, hi_, 0, 1, 2, 3, 4, 5, 6, 7); } } \
        else { _Pragma("unroll") for (int n = 0; n < 2; ++n) _Pragma("unroll") for (int k = 0; k < 2; ++k) dst[n][k] = *(const PG8_LAS bf16x8*)(lds + PG8_SB(b, h) + boff + n * 2048 + k * 1024); } } while (0)
#define PG8_MMA(ai, bj, At, Bt) do { __builtin_amdgcn_s_setprio(1); _Pragma("unroll") for (int m = 0; m < 4; ++m) _Pragma("unroll") for (int n = 0; n < 2; ++n) { \
        if constexpr (FP8) asm volatile("v_mfma_scale_f32_16x16x128_f8f6f4 %0, %1, %2, %0, %3, %3 op_sel_hi:[0,0,0]" : "+v"(acc[ai][bj][m][n]) : "v"(Bt##8[n]), "v"(At##8[m]), "v"(sc127));   \
        else { _Pragma("unroll") for (int k = 0; k < 2; ++k) acc[ai][bj][m][n] = __builtin_amdgcn_mfma_f32_16x16x32_bf16(Bt[n][k], At[m][k], acc[ai][bj][m][n], 0, 0, 0); } } \
        __builtin_amdgcn_s_setprio(0); } while (0)
#define PG8_WAIT_V(n) asm volatile("s_waitcnt vmcnt(" #n ")" ::: "memory")
#define PG8_WAIT_L(n) asm volatile("s_waitcnt lgkmcnt(" #n ")" ::: "memory")
#define PG8_BAR __builtin_amdgcn_s_barrier()
#define PG8_SCHED __builtin_amdgcn_sched_barrier(0)
    Unit cur, nxt; int ui = 0;
    if (!S.next(0, cur)) return;
    acc_t acc; zero_acc(acc);
    bf16x8 At[4][2], B0[2][2], B1[2][2];
    v8i_t At8[4], B08[2], B18[2];
    int sc127 = 0x7f7f7f7f; asm volatile("" : "+v"(sc127));
    const char* cA = S.abase(cur); const char* cB = S.bbase(cur);
    if constexpr (SP2) {
        PG8_STAGE(PG8_SB(0, 0), cB, voffB); PG8_STAGE(PG8_SB(0, 1), cB + hstep, voffB); PG8_STAGE(PG8_SA(0, 0), cA, voffA); PG8_STAGE(PG8_SA(0, 1), cA + hstep, voffA);
        if (wr == 1) PG8_BAR;
        PG8_WAIT_V(2); PG8_BAR;
        PG8_STAGE(PG8_SB(1, 0), cB + kstep, voffB); PG8_STAGE(PG8_SA(1, 0), cA + kstep, voffA); PG8_STAGE(PG8_SB(1, 1), cB + hstep + kstep, voffB);
        PG8_WAIT_V(6); PG8_BAR;
    } else {
        PG8_STAGE(PG8_SB(0, 0), cB, voffB); PG8_STAGE(PG8_SA(0, 0), cA, voffA); PG8_STAGE(PG8_SB(0, 1), cB + hstep, voffB); PG8_STAGE(PG8_SA(0, 1), cA + hstep, voffA);
        if (wr == 1) PG8_BAR;
        PG8_WAIT_V(4); PG8_BAR;
        PG8_STAGE(PG8_SB(1, 0), cB + kstep, voffB); PG8_STAGE(PG8_SA(1, 0), cA + kstep, voffA); PG8_STAGE(PG8_SB(1, 1), cB + hstep + kstep, voffB);
        PG8_WAIT_V(6); PG8_BAR;
    }
    for (;;) {
        const bool has_next = S.next(ui + 1, nxt);
        const char* nA = has_next ? S.abase(nxt) : cA; const char* nB = has_next ? S.bbase(nxt) : cB;
#pragma nounroll
        for (int t = 0; t < nt; t += 2) {
            const bool last = (t == nt - 2);
            const char* a1 = cA + (size_t)(t + 1) * kstep;
            const char* a2 = last ? nA : cA + (size_t)(t + 2) * kstep; const char* b2 = last ? nB : cB + (size_t)(t + 2) * kstep;
            const char* a3 = a2 + kstep; const char* b3 = b2 + kstep;
            if constexpr (SP2) {
            PG8_LDB(B0, 0, 0); PG8_LDB(B1, 0, 1); PG8_SCHED; PG8_LDA(At, 0, 0); PG8_STAGE(PG8_SA(1, 1), a1 + hstep, voffA);
            PG8_WAIT_V(8); PG8_WAIT_L(0); PG8_BAR; PG8_MMA(0, 0, At, B0); PG8_MMA(0, 1, At, B1); PG8_BAR; PG8_SCHED;
            PG8_LDA(At, 0, 1); PG8_STAGE(PG8_SB(0, 0), b2, voffB); PG8_STAGE(PG8_SB(0, 1), b2 + hstep, voffB); PG8_STAGE(PG8_SA(0, 0), a2, voffA);
            PG8_WAIT_V(8); PG8_WAIT_L(0); PG8_BAR; PG8_MMA(1, 0, At, B0); PG8_MMA(1, 1, At, B1); PG8_BAR; PG8_SCHED;
            PG8_LDB(B0, 1, 0); PG8_LDB(B1, 1, 1); PG8_SCHED; PG8_LDA(At, 1, 0); PG8_STAGE(PG8_SA(0, 1), a2 + hstep, voffA);
            PG8_WAIT_V(8); PG8_WAIT_L(0); PG8_BAR; PG8_MMA(0, 0, At, B0); PG8_MMA(0, 1, At, B1); PG8_BAR; PG8_SCHED;
            PG8_LDA(At, 1, 1); PG8_STAGE(PG8_SB(1, 0), b3, voffB); PG8_STAGE(PG8_SB(1, 1), b3 + hstep, voffB); PG8_STAGE(PG8_SA(1, 0), a3, voffA);
            PG8_WAIT_V(8); PG8_WAIT_L(0); PG8_BAR; PG8_MMA(1, 0, At, B0); PG8_MMA(1, 1, At, B1); PG8_BAR; PG8_SCHED;
            } else {
            PG8_LDB(B0, 0, 0); PG8_SCHED; PG8_LDA(At, 0, 0); PG8_STAGE(PG8_SA(1, 1), a1 + hstep, voffA);
            PG8_WAIT_L(8); PG8_BAR; PG8_WAIT_L(0); PG8_MMA(0, 0, At, B0); PG8_BAR; PG8_SCHED;
            PG8_LDB(B1, 0, 1); PG8_STAGE(PG8_SB(0, 0), b2, voffB);
            PG8_BAR; PG8_WAIT_L(0); PG8_MMA(0, 1, At, B1); PG8_BAR;
            PG8_LDA(At, 0, 1); PG8_STAGE(PG8_SA(0, 0), a2, voffA);
            PG8_BAR; PG8_WAIT_L(0); PG8_MMA(1, 0, At, B0); PG8_BAR; PG8_SCHED;
            PG8_STAGE(PG8_SB(0, 1), b2 + hstep, voffB);
            PG8_WAIT_V(6); PG8_BAR; PG8_MMA(1, 1, At, B1); PG8_BAR;
            PG8_LDB(B0, 1, 0); PG8_SCHED; PG8_LDA(At, 1, 0); PG8_STAGE(PG8_SA(0, 1), a2 + hstep, voffA);
            PG8_WAIT_L(8); PG8_BAR; PG8_WAIT_L(0); PG8_MMA(0, 0, At, B0); PG8_BAR; PG8_SCHED;
            PG8_LDB(B1, 1, 1); PG8_STAGE(PG8_SB(1, 0), b3, voffB);
            PG8_BAR; PG8_WAIT_L(0); PG8_MMA(0, 1, At, B1); PG8_BAR;
            PG8_LDA(At, 1, 1); PG8_STAGE(PG8_SA(1, 0), a3, voffA);
            PG8_BAR; PG8_WAIT_L(0); PG8_MMA(1, 0, At, B0); PG8_BAR; PG8_SCHED;
            PG8_STAGE(PG8_SB(1, 1), b3 + hstep, voffB);
            PG8_WAIT_V(6); PG8_BAR; PG8_MMA(1, 1, At, B1); PG8_BAR;
            }
        }
        if constexpr (ALIGN_EPI) { if (wr == 0) PG8_BAR; }
        if constexpr (FP8) asm volatile("s_nop 15\n\ts_nop 15" ::: "memory");
        E(acc, cur, wr, wc, fr, fq);
        if (!has_next) break;
        cur = nxt; cA = nA; cB = nB; ++ui;
        if constexpr (ALIGN_EPI) { if (wr == 1) PG8_BAR; }
    }
    PG8_WAIT_V(0);
    if constexpr (!ALIGN_EPI) { if (wr == 0) PG8_BAR; }
    PG8_BAR;
#undef PG8_SA
#undef PG8_SB
#undef PG8_STAGE
#undef PG8_LDA
#undef PG8_LDB
#undef PG8_MMA
#undef PG8_WAIT_V
#undef PG8_WAIT_L
#undef PG8_BAR
#undef PG8_SCHED
}
}

#ifndef GATES_FP8
#define GATES_FP8 1
#endif
#ifndef FFN_FP8
#define FFN_FP8 3
#endif
#ifndef MOE_FP8
#define MOE_FP8 1
#endif
constexpr int NWAVES = 8, NTHR = 512;
constexpr int BATCH = 16, SEQ = 2048, D = 1024, M = BATCH * SEQ;
constexpr int IN_COLS = 6432;
constexpr int NA = 3584;
constexpr int NG = 3072;
constexpr int WIN_ROWS = NA + NG;
constexpr int FF = 2816, FFE = 3584, NE = 8;
constexpr int NCH = 2, CHT = 256 / NCH, CH_TOK = M / NCH, CH_ROWS = (CHT + 8) * 256;
static_assert(MOE_FP8 || NCH == 4, "bf16 MoE buffers are sized for 4 chunks");
constexpr float LN_EPS = 1e-5f, RMS_EPS = 1e-6f;
constexpr float ALPHA = 1.4142135623730951f;

constexpr size_t MiB = 1u << 20;
constexpr size_t WS_CTL = 0, CTL_ZERO_BYTES = 1 * MiB;
constexpr size_t WS_HB = 1 * MiB;
constexpr size_t WS_META = 65 * MiB;
constexpr size_t WS_WIN = 67 * MiB;
constexpr size_t WS_WBR = 93 * MiB;
constexpr size_t WS_WOUT = 99 * MiB;
constexpr size_t WS_W13 = 103 * MiB;
constexpr size_t WS_W2 = 114 * MiB;
constexpr size_t WS_POOLW = 120 * MiB;
constexpr size_t WS_LNSTAT = 120 * MiB;
constexpr size_t WS_BIG = 121 * MiB;
constexpr size_t WS_AQ = WS_BIG + 0 * MiB;
constexpr size_t WS_DZ = WS_BIG + 32 * MiB;
constexpr size_t WS_OP = WS_BIG + 64 * MiB;
constexpr size_t WS_AK = WS_BIG + 96 * MiB;
constexpr size_t WS_AV = WS_BIG + 104 * MiB;
constexpr size_t WS_DAB = WS_BIG + 112 * MiB;
constexpr size_t WS_PU = WS_BIG + 128 * MiB;
constexpr size_t WS_DQKV = WS_BIG + 160 * MiB;
constexpr size_t WS_OF = WS_BIG + 288 * MiB;
constexpr size_t WS_OB = WS_BIG + 320 * MiB;
constexpr size_t WS_GT = WS_BIG + 96 * MiB;
static_assert(WS_GT + 192 * MiB <= WS_OF && WS_GT >= WS_OP + 32 * MiB, "gate planes");
constexpr size_t WS_MERGED = WS_BIG + 352 * MiB;
constexpr size_t WS_FACT = WS_BIG + 0 * MiB;
constexpr size_t WS_HBG8 = WS_BIG + 384 * MiB;
constexpr size_t WS_HB8 = WS_BIG + 200 * MiB;
constexpr size_t WS_END_L = WS_BIG + 416 * MiB;
constexpr size_t WS_MWGU = 67 * MiB;
constexpr size_t WS_MWD = 179 * MiB;
constexpr size_t WS_XG = 235 * MiB;
constexpr size_t WS_MACT = 271 * MiB;
constexpr size_t WS_YS = 397 * MiB;
constexpr size_t WS_END = 537 * MiB;
static_assert(WS_YS + (size_t)M * 2 * 1024 * 2 <= WS_END && WS_END_L <= WS_END, "ws map");
static_assert(WS_MACT + (size_t)CH_ROWS * FFE * (MOE_FP8 ? 1 : 2) <= WS_YS && WS_XG + (size_t)CH_ROWS * 1024 * (MOE_FP8 ? 1 : 2) <= WS_MACT, "ws map");
constexpr size_t MT_TOKE = 0;
constexpr size_t MT_TOKP = 256 * 1024;
constexpr size_t MT_RANK = 512 * 1024;
constexpr size_t MT_DEFER = 640 * 1024;
constexpr size_t MT_CNT = 768 * 1024;
constexpr size_t MT_ROWMAP = 1024 * 1024;
constexpr int CW_BAR = 4096;
constexpr int CW_LNX = 16384;
constexpr int LNX_LDS_OFF = 131072;

constexpr int RING_OFF = 0, RING_BYTES = 147456;
constexpr int LDSCTL_OFF = RING_BYTES, MISC_OFF = LDSCTL_OFF + 320;
constexpr int MOE_LDS_OFF = LDSCTL_OFF + 1024;
constexpr int LDS_BYTES = 163840;

#define RLX_AGENT __ATOMIC_RELAXED, __HIP_MEMORY_SCOPE_AGENT
#define LDS_WAIT() asm volatile("s_waitcnt lgkmcnt(0)" ::: "memory")
#define VM_WAIT() asm volatile("s_waitcnt vmcnt(0)" ::: "memory")
__device__ __forceinline__ unsigned f2bf(float f) { unsigned u = __builtin_bit_cast(unsigned, f); return (u + 0x7fffu + ((u >> 16) & 1u)) >> 16; }
__device__ __forceinline__ unsigned pk2(float lo, float hi) { return f2bf(lo) | (f2bf(hi) << 16); }
__device__ __forceinline__ float bf2f(unsigned short b) { return __builtin_bit_cast(float, ((unsigned)b) << 16); }
__device__ __forceinline__ float bflo(unsigned w) { return __builtin_bit_cast(float, w << 16); }
__device__ __forceinline__ float bfhi(unsigned w) { return __builtin_bit_cast(float, w & 0xffff0000u); }
__device__ __forceinline__ v4u ld_or_zero(const bf16* p, const bf16* safe, bool ok) { const v4u v = *(const v4u*)(ok ? p : safe); const unsigned mk = ok ? 0xffffffffu : 0u; return (v4u){v.x & mk, v.y & mk, v.z & mk, v.w & mk}; }
__device__ __forceinline__ float sigmoidf_(float x) { return __builtin_amdgcn_rcpf(1.0f + __expf(-x)); }
__device__ __forceinline__ float siluf_(float x) { return x * sigmoidf_(x); }

#define XB_TMO      128
#define XB_XCNT(j)  (256  + 64 * (j))
#define XB_XSUB(j)  (1280 + 64 * (j))
#define XB_XGEN(j)  (2304 + 64 * (j))
#define XB_TOP      3328
#define XB_TOPGEN   3392
#define XCD_BAR_WORDS 3456
#define XB_SPIN_CAP (1u << 22)
#ifndef XB_RELAY
#define XB_RELAY 0
#endif

__device__ __forceinline__ unsigned xb_ld(unsigned* p)              { return __hip_atomic_load(p, __ATOMIC_RELAXED, __HIP_MEMORY_SCOPE_AGENT); }
__device__ __forceinline__ unsigned xb_add(unsigned* p, unsigned v) { return __hip_atomic_fetch_add(p, v, __ATOMIC_RELAXED, __HIP_MEMORY_SCOPE_AGENT); }
__device__ __forceinline__ unsigned xb_xcc_id() { return (unsigned)__builtin_amdgcn_s_getreg((3 << 11) | 20) & 0xFu; }
#define XB_SPIN(cond, bar) do { unsigned _sp = 0; while (cond) { __builtin_amdgcn_s_sleep(1); \
    if ((++_sp & 255u) == 0u) { if (xb_ld(&(bar)[XB_TMO])) break; if (_sp > XB_SPIN_CAP) { atomicAdd(&(bar)[XB_TMO], 1u); break; } } } } while (0)

struct XcdBarrier {
    unsigned* bar; unsigned x; unsigned w0;
    volatile LAS unsigned* st;
};
__device__ __forceinline__ XcdBarrier xcd_barrier_post(unsigned* bar, volatile LAS unsigned* st) {
    XcdBarrier b; b.bar = bar; b.x = xb_xcc_id(); b.st = st; b.w0 = (__builtin_amdgcn_readfirstlane(threadIdx.x >> 6) == 0) ? 1u : 0u;
    if (threadIdx.x == 0) (void)xb_add(&bar[XB_XCNT(b.x)], 1u);
    return b;
}
__device__ __forceinline__ void xcd_barrier_complete(unsigned* bar, unsigned x, unsigned& nloc, unsigned& nx) {
    const unsigned G = gridDim.x * gridDim.y * gridDim.z;
    unsigned sum, cnt, mine, sp = 0u;
    for (;;) {
        sum = 0u; cnt = 0u; mine = 0u;
#pragma unroll
        for (unsigned j = 0; j < 16; ++j) { const unsigned c = xb_ld(&bar[XB_XCNT(j)]); sum += c; cnt += (c > 0u) ? 1u : 0u; mine = (j == x) ? c : mine; }
        if (sum == G) break;
        __builtin_amdgcn_s_sleep(1);
        if ((++sp & 255u) == 0u) { if (xb_ld(&bar[XB_TMO])) break; if (sp > XB_SPIN_CAP) { atomicAdd(&bar[XB_TMO], 1u); break; } }
    }
    nloc = mine > 0u ? mine : 1u; nx = cnt > 0u ? cnt : 1u;
}
__device__ __forceinline__ void xcd_barrier(const XcdBarrier& b) {
    asm volatile("s_waitcnt vmcnt(0)" ::: "memory");
    __syncthreads();
    if (b.w0 && __builtin_amdgcn_mbcnt_hi(~0u, __builtin_amdgcn_mbcnt_lo(~0u, 0u)) == 0u) {
        unsigned* bar = b.bar;
        __builtin_amdgcn_s_waitcnt(0);
        unsigned nloc = b.st[0], nx = b.st[1];
        if (nloc == 0u) { xcd_barrier_complete(bar, b.x, nloc, nx); b.st[0] = nloc; b.st[1] = nx; }
        const unsigned old = xb_add(&bar[XB_XSUB(b.x)], 1u);
        const unsigned gen = old / nloc;
#if XB_RELAY
        if (old + 1u == (gen + 1u) * nloc) {
            __builtin_amdgcn_fence(__ATOMIC_RELEASE, "agent");
            asm volatile("s_waitcnt vmcnt(0)" ::: "memory");
            const unsigned og = xb_add(&bar[XB_TOP], 1u);
            const unsigned tg = og / nx;
            if (og + 1u == (tg + 1u) * nx) xb_add(&bar[XB_TOPGEN], 1u);
            else XB_SPIN(xb_ld(&bar[XB_TOPGEN]) == tg, bar);
            __builtin_amdgcn_fence(__ATOMIC_ACQUIRE, "agent");
#if XB_RELAY
            xb_add(&bar[XB_XGEN(b.x)], 1u);
            asm volatile("s_waitcnt vmcnt(0)" ::: "memory");
#endif
        } else {
#if XB_RELAY
            XB_SPIN(xb_ld(&bar[XB_XGEN(b.x)]) == gen, bar);
#else
            XB_SPIN(xb_ld(&bar[XB_TOPGEN]) == gen, bar);
#endif
            __builtin_amdgcn_fence(__ATOMIC_ACQUIRE, "agent");
            asm volatile("s_waitcnt vmcnt(0)" ::: "memory");
        }
#else
        if (old + 1u == (gen + 1u) * nloc) {
            __builtin_amdgcn_fence(__ATOMIC_RELEASE, "agent");
            asm volatile("s_waitcnt vmcnt(0)" ::: "memory");
            (void)xb_add(&bar[XB_TOP], 1u);
        }
        { const unsigned want = nx * (gen + 1u); XB_SPIN(xb_ld(&bar[XB_TOP]) < want, bar); }
        __builtin_amdgcn_fence(__ATOMIC_ACQUIRE, "agent");
        asm volatile("s_waitcnt vmcnt(0)" ::: "memory");
#endif
    }
    __syncthreads();
}

struct Args { const float* in[23]; float* out; unsigned char* ws; int ph_lo, ph_hi; };
struct Frame {
    unsigned char* lds;
    int tid, lane, wave;
    int G, bx;
    unsigned char* ws;
    float* out;
    const Args* a;
};
#define IN_x(F)          ((F).a->in[0])
#define IN_w_in(F)       ((F).a->in[1])
#define IN_attn_sink(F)  ((F).a->in[2])
#define IN_rel_bias(F)   ((F).a->in[3])
#define IN_conv_w(F)     ((F).a->in[4])
#define IN_a_log(F)      ((F).a->in[5])
#define IN_dt_bias(F)    ((F).a->in[6])
#define IN_dn_norm_w(F)  ((F).a->in[7])
#define IN_pool_w(F)     ((F).a->in[8])
#define IN_pool_scale(F) ((F).a->in[9])
#define IN_w_branch(F)   ((F).a->in[10])
#define IN_w_out(F)      ((F).a->in[11])
#define IN_ln1_g(F)      ((F).a->in[12])
#define IN_ln1_b(F)      ((F).a->in[13])
#define IN_ln2_g(F)      ((F).a->in[14])
#define IN_ln2_b(F)      ((F).a->in[15])
#define IN_ffn_w1(F)     ((F).a->in[16])
#define IN_ffn_w3(F)     ((F).a->in[17])
#define IN_ffn_w2(F)     ((F).a->in[18])
#define IN_router_w(F)   ((F).a->in[19])
#define IN_moe_wg(F)     ((F).a->in[20])
#define IN_moe_wu(F)     ((F).a->in[21])
#define IN_moe_wd(F)     ((F).a->in[22])
__device__ __forceinline__ float wave_sum(float v) {
#pragma unroll
    for (int o = 1; o < 64; o <<= 1) v += __shfl_xor(v, o);
    return v;
}
template <int CTRL> __device__ __forceinline__ float dppf(float x) { return __builtin_bit_cast(float, __builtin_amdgcn_mov_dpp(__builtin_bit_cast(int, x), CTRL, 0xF, 0xF, true)); }
__device__ __forceinline__ float red4(float x) { x += dppf<0xB1>(x); x += dppf<0x4E>(x); return x; }
__device__ __forceinline__ float red8(float x) { x = red4(x); x += dppf<0x141>(x); return x; }
__device__ __forceinline__ float red16(float x) { x = red8(x); x += dppf<0x140>(x); return x; }

__device__ __forceinline__ float q8(float x) { const int p = __builtin_amdgcn_cvt_pk_fp8_f32(x, x, 0, false); return __builtin_amdgcn_cvt_f32_fp8(p, 0); }
#ifndef FP8_EMU
#define FP8_EMU 0
#endif
__device__ __forceinline__ unsigned pk4_fp8(float a, float b, float c, float d) { int w = __builtin_amdgcn_cvt_pk_fp8_f32(a, b, 0, false); w = __builtin_amdgcn_cvt_pk_fp8_f32(c, d, w, true); return (unsigned)w; }
template <bool Q8 = false>
__device__ __forceinline__ void tr_item(const float* W, int ldw, int k0, int n0, bf16* WT, int ldt, int drow0, float* scr, int lane) {
    f32x4 ld[8];
#pragma unroll
    for (int i = 0; i < 8; ++i) ld[i] = __builtin_nontemporal_load((const f32x4*)(W + (size_t)(k0 + 8 * i + (lane >> 3)) * ldw + n0 + 4 * (lane & 7)));
#pragma unroll
    for (int i = 0; i < 8; ++i) { float* d = scr + (8 * i + (lane >> 3)) * 33 + 4 * (lane & 7); d[0] = ld[i][0]; d[1] = ld[i][1]; d[2] = ld[i][2]; d[3] = ld[i][3]; }
    LDS_WAIT(); asm volatile("" ::: "memory");
    const int c = lane & 7;
#pragma unroll
    for (int j = 0; j < 4; ++j) { const int n = (lane >> 3) + 8 * j; const float* s = scr + (8 * c) * 33 + n;
        v4u o;
        if (Q8) { o.x = pk2(q8(32.f * s[0 * 33]), q8(32.f * s[1 * 33])); o.y = pk2(q8(32.f * s[2 * 33]), q8(32.f * s[3 * 33])); o.z = pk2(q8(32.f * s[4 * 33]), q8(32.f * s[5 * 33])); o.w = pk2(q8(32.f * s[6 * 33]), q8(32.f * s[7 * 33])); }
        else { o.x = pk2(s[0 * 33], s[1 * 33]); o.y = pk2(s[2 * 33], s[3 * 33]); o.z = pk2(s[4 * 33], s[5 * 33]); o.w = pk2(s[6 * 33], s[7 * 33]); }
        *(v4u*)(WT + (size_t)(drow0 + n) * ldt + k0 + 8 * c) = o; }
    LDS_WAIT(); asm volatile("" ::: "memory");
}

__device__ __forceinline__ void tr_item_fp8(const float* W, int ldw, int k0, int n0, unsigned char* WT8, int ldt, int drow0, float* scr, int lane) {
    f32x4 ld[8];
#pragma unroll
    for (int i = 0; i < 8; ++i) ld[i] = __builtin_nontemporal_load((const f32x4*)(W + (size_t)(k0 + 8 * i + (lane >> 3)) * ldw + n0 + 4 * (lane & 7)));
#pragma unroll
    for (int i = 0; i < 8; ++i) { float* d = scr + (8 * i + (lane >> 3)) * 33 + 4 * (lane & 7); d[0] = ld[i][0]; d[1] = ld[i][1]; d[2] = ld[i][2]; d[3] = ld[i][3]; }
    LDS_WAIT(); asm volatile("" ::: "memory");
    const int c = lane & 7;
#pragma unroll
    for (int j = 0; j < 4; ++j) { const int n = (lane >> 3) + 8 * j; const float* s = scr + (8 * c) * 33 + n;
        v2u o; o.x = pk4_fp8(32.f * s[0 * 33], 32.f * s[1 * 33], 32.f * s[2 * 33], 32.f * s[3 * 33]); o.y = pk4_fp8(32.f * s[4 * 33], 32.f * s[5 * 33], 32.f * s[6 * 33], 32.f * s[7 * 33]);
        *(v2u*)(WT8 + (size_t)(drow0 + n) * ldt + k0 + 8 * c) = o; }
    LDS_WAIT(); asm volatile("" ::: "memory");
}

struct TrItem { const float* W; int ldw, k0, n0; unsigned char* dst; int ldt, drow, kind; };
__device__ __forceinline__ void tr_load(f32x4 (&ld)[8], const TrItem& t, int lane) {
    if (t.kind == 0) return;
#pragma unroll
    for (int i = 0; i < 8; ++i) ld[i] = __builtin_nontemporal_load((const f32x4*)(t.W + (size_t)(t.k0 + 8 * i + (lane >> 3)) * t.ldw + t.n0 + 4 * (lane & 7)));
}
__device__ __forceinline__ void tr_store(const f32x4 (&ld)[8], const TrItem& t, float* scr, int lane) {
    if (t.kind == 0) return;
#pragma unroll
    for (int i = 0; i < 8; ++i) { float* d = scr + (8 * i + (lane >> 3)) * 33 + 4 * (lane & 7); d[0] = ld[i][0]; d[1] = ld[i][1]; d[2] = ld[i][2]; d[3] = ld[i][3]; }
    LDS_WAIT(); asm volatile("" ::: "memory");
    const int c = lane & 7;
    if (t.kind == 2) {
#pragma unroll
        for (int j = 0; j < 4; ++j) { const int n = (lane >> 3) + 8 * j; const float* s = scr + (8 * c) * 33 + n;
            v2u o; o.x = pk4_fp8(32.f * s[0 * 33], 32.f * s[1 * 33], 32.f * s[2 * 33], 32.f * s[3 * 33]); o.y = pk4_fp8(32.f * s[4 * 33], 32.f * s[5 * 33], 32.f * s[6 * 33], 32.f * s[7 * 33]);
            *(v2u*)(t.dst + (size_t)(t.drow + n) * t.ldt + t.k0 + 8 * c) = o; }
    } else {
#pragma unroll
        for (int j = 0; j < 4; ++j) { const int n = (lane >> 3) + 8 * j; const float* s = scr + (8 * c) * 33 + n;
            v4u o; o.x = pk2(s[0 * 33], s[1 * 33]); o.y = pk2(s[2 * 33], s[3 * 33]); o.z = pk2(s[4 * 33], s[5 * 33]); o.w = pk2(s[6 * 33], s[7 * 33]);
            *(v4u*)((bf16*)t.dst + (size_t)(t.drow + n) * t.ldt + t.k0 + 8 * c) = o; }
    }
    LDS_WAIT(); asm volatile("" ::: "memory");
}
#define TR_PIPELINE(FIRST, COUNT, STRIDE, DEC, scr, lane) do { f32x4 la_[8], lb_[8]; TrItem ta_, tb_; int it_ = (FIRST); \
        if (it_ < (COUNT)) { DEC(it_, ta_); tr_load(la_, ta_, lane); } \
        while (it_ < (COUNT)) { \
            int nx_ = it_ + (STRIDE); if (nx_ < (COUNT)) { DEC(nx_, tb_); tr_load(lb_, tb_, lane); } \
            tr_store(la_, ta_, scr, lane); it_ = nx_; if (it_ >= (COUNT)) break; \
            nx_ = it_ + (STRIDE); if (nx_ < (COUNT)) { DEC(nx_, ta_); tr_load(la_, ta_, lane); } \
            tr_store(lb_, tb_, scr, lane); it_ = nx_; } } while (0)

__device__ __forceinline__ void p0_prologue(Frame& F) {
    float* scr = (float*)(F.lds + F.wave * 16384);
    const int gw = F.bx * NWAVES + F.wave, NGW = F.G * NWAVES;
    constexpr int I_WIN = 16 * 201, I_WBR = 8 * 32, I_WOUT = 16 * 32, I_W1 = 16 * 88, I_W2 = 44 * 32, I_PW = 2 * 4;
    constexpr int NITEMS = 2 * I_WIN + 6 * I_WBR + 2 * I_WOUT + 2 * I_W1 + I_W2 + 8 * I_PW;
    bf16* WIN = (bf16*)(F.ws + WS_WIN); bf16* WBR = (bf16*)(F.ws + WS_WBR); bf16* WOUT = (bf16*)(F.ws + WS_WOUT);
    bf16* W13 = (bf16*)(F.ws + WS_W13); bf16* W2 = (bf16*)(F.ws + WS_W2); bf16* PW = (bf16*)(F.ws + WS_POOLW);
#define P0_DEC(it, t) do { int r = (it); t.kind = 0; \
        if (r < 2 * I_WIN) { const int l = r / I_WIN, q = r % I_WIN, kb = q / 201, n0 = (q % 201) * 32; \
            const int drow = n0 < 2816 ? n0 : (n0 < 2848 ? 3328 + (n0 - 2816) : (n0 < 3360 ? n0 - 32 : 3584 + (n0 - 3360))); \
            t.W = IN_w_in(F) + (size_t)l * 1024 * IN_COLS; t.ldw = IN_COLS; t.k0 = kb * 64; t.n0 = n0; t.ldt = 1024; \
            if (GATES_FP8 && n0 >= 3360) { t.dst = (unsigned char*)(WIN + (size_t)l * WIN_ROWS * 1024 + (size_t)NA * 1024); t.drow = n0 - 3360; t.kind = 2; } \
            else { t.dst = (unsigned char*)(WIN + (size_t)l * WIN_ROWS * 1024); t.drow = drow; t.kind = 1; } } \
        else if ((r -= 2 * I_WIN) < 6 * I_WBR) { const int ln = r / I_WBR, q = r % I_WBR, kb = q / 32, n0 = (q % 32) * 32;        \
            if (ln % 3 != 2) { t.W = IN_w_branch(F) + (size_t)ln * 512 * 1024; t.ldw = 1024; t.k0 = kb * 64; t.n0 = n0; t.dst = (unsigned char*)(WBR + (size_t)ln * 1024 * 512); t.ldt = 512; t.drow = n0; t.kind = 1; } } \
        else if ((r -= 6 * I_WBR) < 2 * I_WOUT) { const int l = r / I_WOUT, q = r % I_WOUT, kb = q / 32, n0 = (q % 32) * 32; \
            t.W = IN_w_out(F) + (size_t)l * 1024 * 1024; t.ldw = 1024; t.k0 = kb * 64; t.n0 = n0; t.dst = (unsigned char*)(WOUT + (size_t)l * 1024 * 1024); t.ldt = 1024; t.drow = n0; t.kind = 1; } \
        else if ((r -= 2 * I_WOUT) < 2 * I_W1) { const int w = r / I_W1, q = r % I_W1, kb = q / 88, n0 = (q % 88) * 32; \
            t.W = w ? IN_ffn_w3(F) : IN_ffn_w1(F); t.ldw = FF; t.k0 = kb * 64; t.n0 = n0; t.dst = (unsigned char*)W13; t.ldt = 1024; t.drow = (n0 >> 7) * 256 + (n0 & 127) + w * 128; t.kind = (FFN_FP8 == 1 || FFN_FP8 == 2) ? 2 : 1; } \
        else if ((r -= 2 * I_W1) < I_W2) { const int kb = r / 32, n0 = (r % 32) * 32; \
            t.W = IN_ffn_w2(F); t.ldw = 1024; t.k0 = kb * 64; t.n0 = n0; t.dst = (unsigned char*)W2; t.ldt = FF; t.drow = n0; t.kind = (FFN_FP8 == 1 || FFN_FP8 == 3) ? 2 : 1; } } while (0)
    (void)PW;
    TR_PIPELINE(gw, NITEMS, NGW, P0_DEC, scr, F.lane);
#undef P0_DEC
    for (int it = gw; it < 2 * 64 * 16; it += NGW) { const int l = it >> 10, cg = (it >> 4) & 63, db = it & 15, g = cg >> 4, c0 = (cg & 15) * 8, d = db * 64 + F.lane;
        const float* pw = IN_pool_w(F) + (((size_t)l * 4 + g) * 128 + c0) * 128; const float* ps = IN_pool_scale(F) + l * 512 + g * 128;
        const float* wb = IN_w_branch(F) + (((size_t)l * 3 + 2) * 512 + g * 128) * 1024 + d;
        float acc[8];
#pragma unroll
        for (int j = 0; j < 8; ++j) acc[j] = 0.f;
#pragma unroll 4
        for (int k = 0; k < 128; ++k) { const float sv = ps[k] * wb[(size_t)k * 1024];
#pragma unroll
            for (int j = 0; j < 8; ++j) acc[j] += pw[j * 128 + k] * sv; }
        v4u o; o.x = pk2(acc[0], acc[1]); o.y = pk2(acc[2], acc[3]); o.z = pk2(acc[4], acc[5]); o.w = pk2(acc[6], acc[7]);
        *(v4u*)(WBR + (((size_t)l * 3 + 2) * 1024 + d) * 512 + g * 128 + c0) = o; }
    bf16* HB = (bf16*)(F.ws + WS_HB);
    const size_t gt = (size_t)F.bx * NTHR + F.tid, NT = (size_t)F.G * NTHR;
    const f32x4* xp = (const f32x4*)IN_x(F);
    for (size_t i0 = gt; i0 < (size_t)M * D / 8; i0 += 4 * NT) {
        f32x4 a[4], b[4];
#pragma unroll
        for (int u = 0; u < 4; ++u) { const size_t i = i0 + u * NT; a[u] = __builtin_nontemporal_load(xp + 2 * i); b[u] = __builtin_nontemporal_load(xp + 2 * i + 1); }
#pragma unroll
        for (int u = 0; u < 4; ++u) { const size_t i = i0 + u * NT; v4u o; o.x = pk2(a[u].x, a[u].y); o.y = pk2(a[u].z, a[u].w); o.z = pk2(b[u].x, b[u].y); o.w = pk2(b[u].z, b[u].w); ((v4u*)HB)[i] = o;
            if (GATES_FP8) { v2u o8; o8.x = pk4_fp8(a[u].x, a[u].y, a[u].z, a[u].w); o8.y = pk4_fp8(b[u].x, b[u].y, b[u].z, b[u].w); ((v2u*)(F.ws + WS_HBG8))[i] = o8; } }
    }
}
__device__ __forceinline__ void moe_weight_convert(Frame& F) {
    float* scr = (float*)(F.lds + F.wave * 16384);
    const int gw = F.bx * NWAVES + F.wave, NGW = F.G * NWAVES;
    constexpr int I_GU = 16 * 112, I_D = 56 * 32;
    constexpr int NITEMS = NE * (2 * I_GU + I_D);
    bf16* MWGU = (bf16*)(F.ws + WS_MWGU); bf16* MWD = (bf16*)(F.ws + WS_MWD);
#if MOE_FP8
#define MOE_DEC(it, t) do { int r = (it); \
        if (r < NE * 2 * I_GU) { const int e = r / (2 * I_GU), q2 = r % (2 * I_GU), w = q2 / I_GU, q = q2 % I_GU, kb = q / 112, n0 = (q % 112) * 32; \
            t.W = (w ? IN_moe_wu(F) : IN_moe_wg(F)) + (size_t)e * 1024 * FFE; t.ldw = FFE; t.k0 = kb * 64; t.n0 = n0; t.dst = (unsigned char*)MWGU; t.ldt = 1024; t.drow = e * 2 * FFE + (n0 >> 7) * 256 + (n0 & 127) + w * 128; t.kind = 2; } \
        else { r -= NE * 2 * I_GU; const int e = r / I_D, q = r % I_D, kb = q / 32, n0 = (q % 32) * 32; \
            t.W = IN_moe_wd(F) + (size_t)e * FFE * 1024; t.ldw = 1024; t.k0 = kb * 64; t.n0 = n0; t.dst = (unsigned char*)MWD + (size_t)e * 1024 * FFE; t.ldt = FFE; t.drow = n0; t.kind = 2; } } while (0)
    TR_PIPELINE(gw, NITEMS, NGW, MOE_DEC, scr, F.lane);
#undef MOE_DEC
#else
    for (int it = gw; it < NITEMS; it += NGW) {
        int r = it;
        if (r < NE * 2 * I_GU) { const int e = r / (2 * I_GU), q2 = r % (2 * I_GU), w = q2 / I_GU, q = q2 % I_GU, kb = q / 112, n0 = (q % 112) * 32;
            const int drow = e * 2 * FFE + (n0 >> 7) * 256 + (n0 & 127) + w * 128;
            tr_item<FP8_EMU != 0>((w ? IN_moe_wu(F) : IN_moe_wg(F)) + (size_t)e * 1024 * FFE, FFE, kb * 64, n0, MWGU, 1024, drow, scr, F.lane);
            continue; }
        r -= NE * 2 * I_GU;
        { const int e = r / I_D, q = r % I_D, kb = q / 32, n0 = (q % 32) * 32;
            tr_item<FP8_EMU != 0>(IN_moe_wd(F) + (size_t)e * FFE * 1024, 1024, kb * 64, n0, MWD + (size_t)e * 1024 * FFE, FFE, n0, scr, F.lane); }
    }
#endif
}

using pg8::acc_t; using pg8::Unit; using pg8::cvt_pk_bf16; using pg8::zero_acc;
__device__ __forceinline__ v4u pack8(const f32x4& v0, const f32x4& v1) { v4u w; w.x = cvt_pk_bf16(v0[0], v0[1]); w.y = cvt_pk_bf16(v0[2], v0[3]); w.z = cvt_pk_bf16(v1[0], v1[1]); w.w = cvt_pk_bf16(v1[2], v1[3]); return w; }

struct EpiInA {
    static constexpr bool PERM = true;
    unsigned char* ws;
    __device__ __forceinline__ void operator()(acc_t& acc, const Unit& u, int wr, int wc, int fr, int fq) const {
        const int pn = u.pn; const size_t row0 = (size_t)u.pm * 256 + wr * 64 + fr;
        if (pn == 13) {
            if (wc == 0) { float* dab = (float*)(ws + WS_DAB);
#pragma unroll
                for (int ai = 0; ai < 2; ++ai)
#pragma unroll
                    for (int m = 0; m < 4; ++m) { float* p = dab + (row0 + ai * 128 + m * 16) * 32 + 8 * fq; *(f32x4*)p = acc[ai][0][m][0]; *(f32x4*)(p + 4) = acc[ai][0][m][1]; } }
        } else {
            bf16* b0; bf16* b1; int ldc;
            if (pn < 2) { ldc = 512; b0 = (bf16*)(ws + WS_AQ) + pn * 256; b1 = b0 + 128; }
            else if (pn == 2) { ldc = 128; b0 = (bf16*)(ws + WS_AK); b1 = (bf16*)(ws + WS_AV); }
            else if (pn < 9) { ldc = 1536; b0 = (bf16*)(ws + WS_DQKV) + (pn - 3) * 256; b1 = b0 + 128; }
            else if (pn < 11) { ldc = 512; b0 = (bf16*)(ws + WS_DZ) + (pn - 9) * 256; b1 = b0 + 128; }
            else { ldc = 512; b0 = (bf16*)(ws + WS_PU) + (pn - 11) * 256; b1 = b0 + 128; }
            const int cl = wc * 32 + 8 * fq;
#pragma unroll
            for (int ai = 0; ai < 2; ++ai)
#pragma unroll
                for (int m = 0; m < 4; ++m) { const size_t ro = (row0 + ai * 128 + m * 16) * ldc + cl;
                    *(v4u*)(b0 + ro) = pack8(acc[ai][0][m][0], acc[ai][0][m][1]);
                    *(v4u*)(b1 + ro) = pack8(acc[ai][1][m][0], acc[ai][1][m][1]); }
        }
        zero_acc(acc);
    }
};
struct EpiGates {
    static constexpr bool PERM = true;
    bf16* GT; float asc;
    __device__ __forceinline__ void operator()(acc_t& acc, const Unit& u, int wr, int wc, int fr, int fq) const {
        const size_t row0 = (size_t)u.pm * 256 + wr * 64 + fr;
        bf16* base = GT + (size_t)(u.pn >> 2) * M * 1024 + (u.pn & 3) * 256 + wc * 32 + 8 * fq;
#pragma unroll
        for (int ai = 0; ai < 2; ++ai)
#pragma unroll
            for (int m = 0; m < 4; ++m)
#pragma unroll
                for (int bj = 0; bj < 2; ++bj) { f32x4 v0 = acc[ai][bj][m][0], v1 = acc[ai][bj][m][1];
#pragma unroll
                    for (int j = 0; j < 4; ++j) { v0[j] = sigmoidf_(v0[j] * asc); v1[j] = sigmoidf_(v1[j] * asc); }
                    *(v4u*)(base + (row0 + ai * 128 + m * 16) * 1024 + bj * 128) = pack8(v0, v1); }
        zero_acc(acc);
    }
};
struct BrSched {
    pg8::StaticOrder o; const char *A0, *B0; size_t tstep;
    __device__ __forceinline__ bool next(int i, Unit& u) const { const int t = i / 3; u.aux = i - 3 * t; return o.map((long)t * o.G + o.c, u.pm, u.pn); }
    __device__ __forceinline__ const char* abase(const Unit& u) const { return A0 + (size_t)u.aux * (32 * MiB) + (size_t)u.pm * tstep; }
    __device__ __forceinline__ const char* bbase(const Unit& u) const { return B0 + (size_t)u.aux * (1024 * 512 * 2) + (size_t)u.pn * tstep; }
};
__device__ __forceinline__ void unpack8(const v4u& w, f32x4& a, f32x4& b) { a[0] = bflo(w.x); a[1] = bfhi(w.x); a[2] = bflo(w.y); a[3] = bfhi(w.y); b[0] = bflo(w.z); b[1] = bfhi(w.z); b[2] = bflo(w.w); b[3] = bfhi(w.w); }
#ifndef GNT
#define GNT 1
#endif
struct EpiBranch {
    static constexpr bool PERM = true;
    const bf16* GT; bf16* MG;
    __device__ __forceinline__ void operator()(acc_t& acc, const Unit& u, int wr, int wc, int fr, int fq) const {
        const unsigned eoff = ((unsigned)u.pm * 256u + (unsigned)(wr * 64 + fr)) * 1024u + (unsigned)(u.pn * 256 + wc * 32 + 8 * fq); const int seg = u.aux;
        const char* gn = (const char*)(GT + (size_t)seg * M * 1024);
        const char* gd = (const char*)(GT + (size_t)(seg < 2 ? seg + 1 : 2) * M * 1024);
#pragma unroll
        for (int ai = 0; ai < 2; ++ai)
#pragma unroll
          for (int mh = 0; mh < 2; ++mh) {
            v4u nb[4], db[4];
#pragma unroll
            for (int mm = 0; mm < 2; ++mm)
#pragma unroll
                for (int bj = 0; bj < 2; ++bj) { const int m = 2 * mh + mm; const size_t off = (size_t)((eoff + (unsigned)((ai * 128 + m * 16) * 1024 + bj * 128)) * 2u);
                    nb[mm * 2 + bj] = GNT ? __builtin_nontemporal_load((const v4u*)(gn + off)) : *(const v4u*)(gn + off);
                    if (seg < 2) db[mm * 2 + bj] = *(const v4u*)(gd + off); }
            __builtin_amdgcn_sched_barrier(0);
#pragma unroll
            for (int mm = 0; mm < 2; ++mm)
#pragma unroll
                for (int bj = 0; bj < 2; ++bj) { const int m = 2 * mh + mm; const size_t off = (size_t)((eoff + (unsigned)((ai * 128 + m * 16) * 1024 + bj * 128)) * 2u);
                    f32x4 n0, n1; unpack8(nb[mm * 2 + bj], n0, n1);
                    if (seg < 2) { f32x4 d0, d1; unpack8(db[mm * 2 + bj], d0, d1);
#pragma unroll
                        for (int j = 0; j < 4; ++j) { n0[j] *= __builtin_amdgcn_rcpf(fmaxf(d0[j], 1e-30f)); n1[j] *= __builtin_amdgcn_rcpf(fmaxf(d1[j], 1e-30f)); } }
                    acc[ai][bj][m][0] *= n0; acc[ai][bj][m][1] *= n1;
                    if (seg == 2) *(v4u*)((char*)MG + off) = pack8(acc[ai][bj][m][0], acc[ai][bj][m][1]); }
            __builtin_amdgcn_sched_barrier(0);
          }
        if (seg == 2) zero_acc(acc);
    }
};
struct EpiBranchRMW {
    static constexpr bool PERM = true;
    const bf16* GT; bf16* MG;
    __device__ __forceinline__ void operator()(acc_t& acc, const Unit& u, int wr, int wc, int fr, int fq) const {
        const size_t row0 = (size_t)u.pm * 256 + wr * 64 + fr; const int col = u.pn * 256 + wc * 32 + 8 * fq; const int seg = u.aux;
        const bf16* gn = GT + (size_t)seg * M * 1024;
#pragma unroll
        for (int ai = 0; ai < 2; ++ai)
#pragma unroll
            for (int m = 0; m < 4; ++m)
#pragma unroll
                for (int bj = 0; bj < 2; ++bj) { const size_t off = (row0 + ai * 128 + m * 16) * 1024 + col + bj * 128;
                    f32x4 n0, n1; unpack8(*(const v4u*)(gn + off), n0, n1);
                    f32x4 r0 = acc[ai][bj][m][0] * n0, r1 = acc[ai][bj][m][1] * n1;
                    if (seg > 0) { f32x4 p0, p1; unpack8(*(const v4u*)(MG + off), p0, p1); r0 += p0; r1 += p1; }
                    *(v4u*)(MG + off) = pack8(r0, r1); }
        zero_acc(acc);
    }
};
struct EpiResid {
    static constexpr bool PERM = true;
    bf16* HBp; float ys;
    __device__ __forceinline__ void operator()(acc_t& acc, const Unit& u, int wr, int wc, int fr, int fq) const {
        const size_t row0 = (size_t)u.pm * 256 + wr * 64 + fr; const int col0 = u.pn * 256 + wc * 32 + 8 * fq;
#pragma unroll
        for (int ai = 0; ai < 2; ++ai)
#pragma unroll
            for (int m = 0; m < 4; ++m) { bf16* rp = HBp + (row0 + ai * 128 + m * 16) * 1024 + col0;
#pragma unroll
                for (int bj = 0; bj < 2; ++bj) { f32x4 h0, h1; unpack8(*(const v4u*)(rp + bj * 128), h0, h1);
                    *(v4u*)(rp + bj * 128) = pack8(h0 * ALPHA + acc[ai][bj][m][0] * ys, h1 * ALPHA + acc[ai][bj][m][1] * ys); } }
        zero_acc(acc);
    }
};
template <int use, bool g8, int LNI  >
struct EpiResidLN {
    static constexpr bool PERM = true;
    unsigned char* ws; const Args* a; LAS unsigned char* ldsl; float ys;
    __device__ __forceinline__ void operator()(acc_t& acc, const Unit& u, int wr, int wc, int fr_in, int fq_in) const {
        int fr = fr_in, fq = fq_in; asm volatile("" : "+v"(fr), "+v"(fq));
        const int tid = (wr * 4 + wc) * 64 + fq * 16 + fr;
        LAS float* part = (LAS float*)(ldsl + LNX_LDS_OFF); LAS float* mr = part + 2048;
        const int rloc = wr * 64 + fr; const int col0 = u.pn * 256 + wc * 32 + 8 * fq;
        const unsigned eoff = ((unsigned)u.pm * 256u + (unsigned)rloc) * 1024u + (unsigned)col0;
        const char* hb = (const char*)(ws + WS_HB);
#pragma unroll
        for (int ai = 0; ai < 2; ++ai) {
            v4u rb[8];
#pragma unroll
            for (int m = 0; m < 4; ++m)
#pragma unroll
                for (int bj = 0; bj < 2; ++bj) rb[m * 2 + bj] = *(const v4u*)(hb + (size_t)((eoff + (unsigned)(ai * 128 + m * 16) * 1024u) * 2u + bj * 256u));
            __builtin_amdgcn_sched_barrier(0);
#pragma unroll
            for (int m = 0; m < 4; ++m) { float a = 0.f, q = 0.f;
#pragma unroll
                for (int bj = 0; bj < 2; ++bj) { f32x4 h0, h1; unpack8(rb[m * 2 + bj], h0, h1);
                    const f32x4 z0 = h0 * ALPHA + acc[ai][bj][m][0] * ys, z1 = h1 * ALPHA + acc[ai][bj][m][1] * ys; acc[ai][bj][m][0] = z0; acc[ai][bj][m][1] = z1;
                    a += ((z0[0] + z0[1]) + (z0[2] + z0[3])) + ((z1[0] + z1[1]) + (z1[2] + z1[3]));
                    q += ((z0[0] * z0[0] + z0[1] * z0[1]) + (z0[2] * z0[2] + z0[3] * z0[3])) + ((z1[0] * z1[0] + z1[1] * z1[1]) + (z1[2] * z1[2] + z1[3] * z1[3])); }
                a += __shfl_xor(a, 16); a += __shfl_xor(a, 32); q += __shfl_xor(q, 16); q += __shfl_xor(q, 32);
                if (fq == 0) { LAS float* d = part + (wc * 256 + rloc + ai * 128 + m * 16) * 2; d[0] = a; d[1] = q; } }
            __builtin_amdgcn_sched_barrier(0);
        }
        __syncthreads();
        float S1 = 0.f, S2 = 0.f;
        float* stat = (float*)(ws + WS_LNSTAT) + (size_t)u.pm * 4 * 512;
        if (tid < 256) {
#pragma unroll
            for (int w = 0; w < 4; ++w) { S1 += part[(w * 256 + tid) * 2]; S2 += part[(w * 256 + tid) * 2 + 1]; }
            __hip_atomic_store(stat + (u.pn * 256 + tid) * 2, S1, RLX_AGENT); __hip_atomic_store(stat + (u.pn * 256 + tid) * 2 + 1, S2, RLX_AGENT); }
        asm volatile("s_waitcnt vmcnt(0)" ::: "memory");
        __syncthreads();
        if (tid == 0) { unsigned* flag = (unsigned*)(ws + WS_CTL) + CW_LNX + use * 128 + u.pm;
            (void)__hip_atomic_fetch_add(flag, 1u, RLX_AGENT);
            unsigned sp = 0u; while (__hip_atomic_load(flag, RLX_AGENT) < 4u && ++sp < (1u << 20)) __builtin_amdgcn_s_sleep(1); }
        __syncthreads();
        if (tid < 256) {
#pragma unroll
            for (int p = 1; p < 4; ++p) { const int pn2 = (u.pn + p) & 3; S1 += __hip_atomic_load(stat + (pn2 * 256 + tid) * 2, RLX_AGENT); S2 += __hip_atomic_load(stat + (pn2 * 256 + tid) * 2 + 1, RLX_AGENT); }
            const float mean = S1 * (1.0f / 1024.0f), var = S2 * (1.0f / 1024.0f) - mean * mean;
            mr[tid * 2] = mean; mr[tid * 2 + 1] = __builtin_amdgcn_rsqf((var > 0.f ? var : 0.f) + LN_EPS); }
        __syncthreads();
        asm volatile("" : "+v"(fr), "+v"(fq));
        const int rloc2 = wr * 64 + fr; const int col2 = u.pn * 256 + wc * 32 + 8 * fq;
        const unsigned eoff2 = ((unsigned)u.pm * 256u + (unsigned)rloc2) * 1024u + (unsigned)col2;
        char* hbw = (char*)(ws + WS_HB); unsigned char* h8 = ws + WS_HBG8; const float* gam = a->in[12 + 2 * LNI]; const float* bet = a->in[13 + 2 * LNI];
#pragma unroll
        for (int bj = 0; bj < 2; ++bj) {
            const f32x4 g0 = *(const f32x4*)(gam + col2 + bj * 128), g1 = *(const f32x4*)(gam + col2 + bj * 128 + 4), b0 = *(const f32x4*)(bet + col2 + bj * 128), b1 = *(const f32x4*)(bet + col2 + bj * 128 + 4);
#pragma unroll
            for (int ai = 0; ai < 2; ++ai)
#pragma unroll
                for (int m = 0; m < 4; ++m) { const int rl = rloc2 + ai * 128 + m * 16; const float mean = mr[rl * 2], rstd = mr[rl * 2 + 1];
                    const unsigned eo = eoff2 + (unsigned)(ai * 128 + m * 16) * 1024u + bj * 128u;
                    const f32x4 v0 = (acc[ai][bj][m][0] - mean) * rstd * g0 + b0, v1 = (acc[ai][bj][m][1] - mean) * rstd * g1 + b1;
                    *(v4u*)(hbw + (size_t)(eo * 2u)) = pack8(v0, v1);
                    if (g8) { v2u o; o.x = pk4_fp8(v0[0], v0[1], v0[2], v0[3]); o.y = pk4_fp8(v1[0], v1[1], v1[2], v1[3]); *(v2u*)(h8 + (size_t)eo) = o; } } }
        zero_acc(acc);
    }
};
struct EpiSwiglu {
    static constexpr bool PERM = true;
    bf16* ACT; int ldc; float asc; int q;
    __device__ __forceinline__ void operator()(acc_t& acc, const Unit& u, int wr, int wc, int fr, int fq) const {
        const size_t row0 = (size_t)u.pm * 256 + wr * 64 + fr; const int col = u.aux * 128 + wc * 32 + 8 * fq;
#pragma unroll
        for (int ai = 0; ai < 2; ++ai)
#pragma unroll
            for (int m = 0; m < 4; ++m) { f32x4 v0, v1;
#pragma unroll
                for (int j = 0; j < 4; ++j) { v0[j] = siluf_(acc[ai][0][m][0][j] * asc) * (acc[ai][1][m][0][j] * asc); v1[j] = siluf_(acc[ai][0][m][1][j] * asc) * (acc[ai][1][m][1][j] * asc); if (q) { v0[j] = q8(v0[j]); v1[j] = q8(v1[j]); } }
                *(v4u*)(ACT + (row0 + ai * 128 + m * 16) * ldc + col) = pack8(v0, v1); }
        zero_acc(acc);
    }
};
struct EpiSwiglu8 {
    static constexpr bool PERM = true;
    unsigned char* ACT; int ldc; float asc;
    __device__ __forceinline__ void operator()(acc_t& acc, const Unit& u, int wr, int wc, int fr, int fq) const {
        const size_t row0 = (size_t)u.pm * 256 + wr * 64 + fr; const int col = u.aux * 128 + wc * 32 + 8 * fq;
#pragma unroll
        for (int ai = 0; ai < 2; ++ai)
#pragma unroll
            for (int m = 0; m < 4; ++m) { float v[8];
#pragma unroll
                for (int j = 0; j < 4; ++j) { v[j] = siluf_(acc[ai][0][m][0][j] * asc) * (acc[ai][1][m][0][j] * asc); v[4 + j] = siluf_(acc[ai][0][m][1][j] * asc) * (acc[ai][1][m][1][j] * asc); }
                v2u o; o.x = pk4_fp8(v[0], v[1], v[2], v[3]); o.y = pk4_fp8(v[4], v[5], v[6], v[7]);
                *(v2u*)(ACT + (row0 + ai * 128 + m * 16) * ldc + col) = o;
                __builtin_amdgcn_sched_barrier(0); }
        zero_acc(acc);
    }
};
struct FfnUpSched {
    pg8::StaticOrder o; const char* A; const char* Bt; size_t tstep;
    __device__ __forceinline__ bool next(int i, Unit& u) const { const bool ok = o.map((long)i * o.G + o.c, u.pm, u.pn); u.aux = u.pn; return ok; }
    __device__ __forceinline__ const char* abase(const Unit& u) const { return A + (size_t)u.pm * tstep; }
    __device__ __forceinline__ const char* bbase(const Unit& u) const { return Bt + (size_t)u.pn * tstep; }
};

constexpr int DN_RAW_OFF = 0;
constexpr int DN_XS_OFF = 26624;
constexpr int DN_OB_OFF = DN_XS_OFF + 49152;
constexpr int DN_AB_OFF = DN_OB_OFF + 16384;
constexpr int DN_CW_OFF = DN_AB_OFF + 512;
static_assert(DN_CW_OFF + 3840 <= RING_BYTES, "delta LDS");
__device__ __forceinline__ void delta_seq(Frame& F, int layer, int seq) {
    const int dir = seq >> 7, b = (seq >> 3) & 15, h = seq & 7;
    bf16* raw = (bf16*)(F.lds + DN_RAW_OFF); float* xs = (float*)(F.lds + DN_XS_OFF); float* ob = (float*)(F.lds + DN_OB_OFF);
    float* ab = (float*)(F.lds + DN_AB_OFF); float* cw = (float*)(F.lds + DN_CW_OFF);
    const bf16* DQKV = (const bf16*)(F.ws + WS_DQKV); const float* DAB = (const float*)(F.ws + WS_DAB);
    float* OUT = (float*)(F.ws + (dir ? WS_OB : WS_OF));
    const int tid = F.tid, lane = F.lane, wave = F.wave, p = lane & 7, j = wave * 8 + (lane >> 3);
    __syncthreads();
    for (int i = tid; i < 5 * 192; i += NTHR) { const int jj = i / 192, ch = i % 192; cw[i] = IN_conv_w(F)[((size_t)layer * 5 + jj) * 1536 + (ch >> 6) * 512 + h * 64 + (ch & 63)]; }
    const float nA = -__expf(IN_a_log(F)[layer * 16 + dir * 8 + h]), dtb = IN_dt_bias(F)[layer * 16 + dir * 8 + h];
    float S[8];
#pragma unroll
    for (int i = 0; i < 8; ++i) S[i] = 0.f;
    for (int blk = 0; blk < SEQ / 64; ++blk) {
        const int tb = dir ? (SEQ / 64 - 1 - blk) : blk, t0 = tb * 64;
        __syncthreads();
        for (int idx = tid; idx < 68 * 24; idx += NTHR) { const int r = idx / 24, pc = idx % 24, sec = pc >> 3, c8 = pc & 7, t = t0 - 2 + r;
            const v4u v = ld_or_zero(DQKV + ((size_t)b * SEQ + t) * 1536 + sec * 512 + h * 64 + c8 * 8, DQKV, t >= 0 && t < SEQ);
            *(v4u*)(raw + r * 192 + sec * 64 + c8 * 8) = v; }
        if (tid < 64) { const size_t m = (size_t)b * SEQ + t0 + tid; const float a = DAB[m * 32 + dir * 8 + h], bq = DAB[m * 32 + 16 + dir * 8 + h];
            const float xx = a + dtb; const float sp = xx > 20.f ? xx : log1pf(__expf(xx));
            ab[tid * 2] = __expf(nA * sp); ab[tid * 2 + 1] = sigmoidf_(bq); }
        __syncthreads();
        for (int idx = tid; idx < 64 * 192; idx += NTHR) { const int tt = idx / 192, ch = idx % 192; float x = 0.f;
#pragma unroll
            for (int jj = 0; jj < 5; ++jj) x += cw[jj * 192 + ch] * bf2f(raw[(tt + jj) * 192 + ch]);
            xs[idx] = siluf_(x); }
        __syncthreads();
        { const int row = tid >> 2, part = tid & 3, tt = row >> 1, sec = row & 1; float* xp = xs + tt * 192 + sec * 64 + part * 16; float ss = 0.f; float v[16];
#pragma unroll
            for (int i = 0; i < 16; ++i) { v[i] = xp[i]; ss += v[i] * v[i]; }
            ss = red4(ss);
            const float sc = __builtin_amdgcn_rsqf(ss + 1e-6f) * (sec == 0 ? 0.125f : 1.0f);
#pragma unroll
            for (int i = 0; i < 16; ++i) xp[i] = v[i] * sc; }
        __syncthreads();
        for (int s = 0; s < 64; ++s) {
            const int tt = dir ? 63 - s : s; const float* xr = xs + tt * 192;
            const f32x4 q0 = *(const f32x4*)(xr + 8 * p), q1 = *(const f32x4*)(xr + 8 * p + 4);
            const f32x4 k0 = *(const f32x4*)(xr + 64 + 8 * p), k1 = *(const f32x4*)(xr + 64 + 8 * p + 4);
            const float v = xr[128 + j], al = ab[tt * 2], be = ab[tt * 2 + 1];
            float part = (S[0] * k0[0] + S[1] * k0[1]) + (S[2] * k0[2] + S[3] * k0[3]) + (S[4] * k1[0] + S[5] * k1[1]) + (S[6] * k1[2] + S[7] * k1[3]);
            part = red8(part);
            const float c = be * (v - al * part);
            S[0] = al * S[0] + k0[0] * c; S[1] = al * S[1] + k0[1] * c; S[2] = al * S[2] + k0[2] * c; S[3] = al * S[3] + k0[3] * c;
            S[4] = al * S[4] + k1[0] * c; S[5] = al * S[5] + k1[1] * c; S[6] = al * S[6] + k1[2] * c; S[7] = al * S[7] + k1[3] * c;
            float op = (S[0] * q0[0] + S[1] * q0[1]) + (S[2] * q0[2] + S[3] * q0[3]) + (S[4] * q1[0] + S[5] * q1[1]) + (S[6] * q1[2] + S[7] * q1[3]);
            op = red8(op);
            if (p == 0) ob[tt * 64 + j] = op;
        }
        __syncthreads();
        for (int idx = tid; idx < 64 * 16; idx += NTHR) { const int tt = idx >> 4, c4 = idx & 15;
            *(f32x4*)(OUT + ((size_t)b * SEQ + t0 + tt) * 512 + h * 64 + c4 * 4) = *(const f32x4*)(ob + tt * 64 + c4 * 4); }
    }
}
__device__ __forceinline__ void delta_post(Frame& F, int layer) {
    const bf16* OFp = (const bf16*)(F.ws + WS_OF); const bf16* OBp = (const bf16*)(F.ws + WS_OB); bf16* DZ = (bf16*)(F.ws + WS_DZ);
    const int d4 = (F.lane & 15) * 4; const f32x4 nw = *(const f32x4*)(IN_dn_norm_w(F) + layer * 64 + d4);
    const size_t gq = ((size_t)F.bx * NTHR + F.tid) >> 4, NQ = ((size_t)F.G * NTHR) >> 4;
    for (size_t pr0 = gq; pr0 < (size_t)M * 8; pr0 += 4 * NQ) {
        v2u ofw[4], obw[4], zw[4];
#pragma unroll
        for (int u = 0; u < 4; ++u) { const size_t off = (pr0 + u * NQ) * 64 + d4; ofw[u] = *(const v2u*)(OFp + off); obw[u] = *(const v2u*)(OBp + off); zw[u] = *(const v2u*)(DZ + off); }
#pragma unroll
        for (int u = 0; u < 4; ++u) { const size_t off = (pr0 + u * NQ) * 64 + d4;
            const f32x4 o = (f32x4){bflo(ofw[u].x) + bflo(obw[u].x), bfhi(ofw[u].x) + bfhi(obw[u].x), bflo(ofw[u].y) + bflo(obw[u].y), bfhi(ofw[u].y) + bfhi(obw[u].y)};
            float ss = (o[0] * o[0] + o[1] * o[1]) + (o[2] * o[2] + o[3] * o[3]); ss = red16(ss);
            const float rs = (ABL == 2) ? 0.f : __builtin_amdgcn_rsqf(ss * (1.0f / 64.0f) + RMS_EPS);
            const float z0 = bflo(zw[u].x), z1 = bfhi(zw[u].x), z2 = bflo(zw[u].y), z3 = bfhi(zw[u].y);
            v2u w; w.x = pk2(o[0] * rs * nw[0] * siluf_(z0), o[1] * rs * nw[1] * siluf_(z1)); w.y = pk2(o[2] * rs * nw[2] * siluf_(z2), o[3] * rs * nw[3] * siluf_(z3));
            *(v2u*)(DZ + off) = w; }
    }
}

typedef short v4i16_t __attribute__((ext_vector_type(4)));
constexpr int AT_K_OFF = 0;
constexpr int AT_V_OFF = 46080;
constexpr int AT_BIAS_OFF = 92160;
static_assert(AT_V_OFF + 46080 <= AT_BIAS_OFF && AT_BIAS_OFF + 8320 <= RING_BYTES, "attn LDS");
__device__ __forceinline__ int t5_bucket(int rel) {
    const int n = rel < 0 ? -rel : rel;
    const int large = 8 + (n >= 12) + (n >= 16) + (n >= 23) + (n >= 32) + (n >= 46) + (n >= 64) + (n >= 91);
    return (rel > 0 ? 16 : 0) + (n < 8 ? n : large);
}
__device__ __forceinline__ void attn_bias_setup(Frame& F) {
    float* bl = (float*)(F.lds + AT_BIAS_OFF);
    for (int i = F.tid; i < 8 * 257; i += NTHR) { const int h = i / 257, r = i % 257; bl[h * 260 + r] = IN_rel_bias(F)[t5_bucket(r - 128) * 8 + h] * 1.44269504f; }
}
__device__ __forceinline__ void attn_load(Frame& F, int unit, v4u (&kr)[5], v4u (&vr)[5], bf16x8 (&qn)[4]) {
    const int b = unit >> 6, kvh = (unit >> 5) & 1, q0 = (unit & 31) * 64;
    const bf16* AK = (const bf16*)(F.ws + WS_AK); const bf16* AV = (const bf16*)(F.ws + WS_AV);
    { const int hq = kvh * 4 + (F.wave & 3), qw = q0 + 32 * (F.wave >> 2), qi = F.lane & 31, hl = F.lane >> 5;
        const bf16* qp = (const bf16*)(F.ws + WS_AQ) + ((size_t)b * SEQ + qw + qi) * 512 + hq * 64 + 8 * hl;
#pragma unroll
        for (int s = 0; s < 4; ++s) qn[s] = *(const bf16x8*)(qp + 16 * s); }
#pragma unroll
    for (int it = 0; it < 5; ++it) { const int idx = F.tid + it * NTHR, i = idx >> 3, d8 = idx & 7, kp = q0 - 128 + i; const bool ok = kp >= 0 && kp < SEQ;
        const size_t off = ((size_t)b * SEQ + kp) * 128 + kvh * 64 + d8 * 8;
        kr[it] = ld_or_zero(AK + off, AK, ok); vr[it] = ld_or_zero(AV + off, AV, ok); }
}
__device__ __forceinline__ void attn_store(Frame& F, const v4u (&kr)[5], const v4u (&vr)[5]) {
    bf16* Kl = (bf16*)(F.lds + AT_K_OFF); bf16* Vl = (bf16*)(F.lds + AT_V_OFF);
#pragma unroll
    for (int it = 0; it < 5; ++it) { const int idx = F.tid + it * NTHR, i = idx >> 3, d8 = idx & 7;
        *(v4u*)(Kl + i * 72 + d8 * 8) = kr[it]; *(v4u*)(Vl + i * 72 + d8 * 8) = vr[it]; }
}
__device__ __forceinline__ void attn_compute(Frame& F, int layer, int unit, bf16* OUT, const bf16x8 (&qf)[4]) {
    const int b = unit >> 6, kvh = (unit >> 5) & 1, qb = unit & 31, q0 = qb * 64;
    const bf16* Kl = (const bf16*)(F.lds + AT_K_OFF); const bf16* Vl = (const bf16*)(F.lds + AT_V_OFF); const float* bl = (const float*)(F.lds + AT_BIAS_OFF);
    bf16* AQ = (bf16*)(F.ws + WS_AQ);
    const int lane = F.lane, wave = F.wave;
    const int hq = kvh * 4 + (wave & 3), half = wave >> 2, qw = q0 + 32 * half, qi = lane & 31, hl = lane >> 5;
    const size_t qrow = ((size_t)b * SEQ + qw + qi) * 512 + hq * 64;
    f32x16 o0, o1;
#pragma unroll
    for (int i = 0; i < 16; ++i) { o0[i] = 0.f; o1[i] = 0.f; }
    float mrun = IN_attn_sink(F)[layer * 8 + hq] * 1.44269504f, lrun = hl == 0 ? 1.0f : 0.0f;
    const bool interior = (qb >= 2) && (qb <= 29);
    const float qsc = 0.125f * 1.44269504f;
    const float* bh = bl + hq * 260;
    for (int kt = 0; kt < 9; ++kt) {
        const int kb = 32 * half + 32 * kt;
        f32x16 sc;
#pragma unroll
        for (int i = 0; i < 16; ++i) sc[i] = 0.f;
#pragma unroll
        for (int s = 0; s < 4; ++s) { const bf16x8 a = *(const bf16x8*)(Kl + (kb + qi) * 72 + 16 * s + 8 * hl); sc = __builtin_amdgcn_mfma_f32_32x32x16_bf16(a, qf[s], sc, 0, 0, 0); }
        float mt = -1e30f;
        if (interior && kt >= 1 && kt <= 7) {
            const float* bp = bh + 32 * kt + 4 * hl - qi;
#pragma unroll
            for (int i = 0; i < 16; ++i) { const float sv = sc[i] * qsc + bp[(i & 3) + 8 * (i >> 2)]; sc[i] = sv; mt = fmaxf(mt, sv); }
        } else {
#pragma unroll
            for (int i = 0; i < 16; ++i) { const int krow = (i & 3) + 8 * (i >> 2) + 4 * hl, kp = q0 - 128 + kb + krow, rel = kp - (qw + qi);
                const bool valid = (kp >= 0) && (kp < SEQ) && (rel >= -128) && (rel <= 128);
                const int ri = rel < -128 ? 0 : (rel > 128 ? 256 : rel + 128);
                const float sv = valid ? sc[i] * qsc + bh[ri] : -1e30f; sc[i] = sv; mt = fmaxf(mt, sv); }
        }
        mt = fmaxf(mt, __shfl_xor(mt, 32));
        const float mnew = fmaxf(mrun, mt), corr = __builtin_amdgcn_exp2f(mrun - mnew); mrun = mnew;
        float ls = 0.f;
#pragma unroll
        for (int i = 0; i < 16; ++i) { const float pv = __builtin_amdgcn_exp2f(sc[i] - mnew); sc[i] = pv; ls += pv; }
        lrun = lrun * corr + ls;
#pragma unroll
        for (int i = 0; i < 16; ++i) { o0[i] *= corr; o1[i] *= corr; }
#pragma unroll
        for (int s2 = 0; s2 < 2; ++s2) {
            v4u pw; pw.x = cvt_pk_bf16(sc[8 * s2 + 0], sc[8 * s2 + 1]); pw.y = cvt_pk_bf16(sc[8 * s2 + 2], sc[8 * s2 + 3]); pw.z = cvt_pk_bf16(sc[8 * s2 + 4], sc[8 * s2 + 5]); pw.w = cvt_pk_bf16(sc[8 * s2 + 6], sc[8 * s2 + 7]);
            const bf16x8 pb = __builtin_bit_cast(bf16x8, pw);
            const bf16* v0p = Vl + (size_t)(kb + 16 * s2 + 4 * hl + ((lane & 15) >> 2)) * 72 + 16 * ((lane >> 4) & 1) + 4 * (lane & 3);
            const v4i16_t a0 = __builtin_amdgcn_ds_read_tr16_b64_v4i16((LAS v4i16_t*)v0p), a1 = __builtin_amdgcn_ds_read_tr16_b64_v4i16((LAS v4i16_t*)(v0p + 8 * 72));
            const v4i16_t c0 = __builtin_amdgcn_ds_read_tr16_b64_v4i16((LAS v4i16_t*)(v0p + 32)), c1 = __builtin_amdgcn_ds_read_tr16_b64_v4i16((LAS v4i16_t*)(v0p + 32 + 8 * 72));
            const bf16x8 va = __builtin_shufflevector(a0, a1, 0, 1, 2, 3, 4, 5, 6, 7), vc = __builtin_shufflevector(c0, c1, 0, 1, 2, 3, 4, 5, 6, 7);
            o0 = __builtin_amdgcn_mfma_f32_32x32x16_bf16(va, pb, o0, 0, 0, 0);
            o1 = __builtin_amdgcn_mfma_f32_32x32x16_bf16(vc, pb, o1, 0, 0, 0);
        }
    }
    const float inv = (ABL == 1) ? 0.f : 1.0f / (lrun + __shfl_xor(lrun, 32));
#pragma unroll
    for (int g = 0; g < 4; ++g) {
        v2u w0, w1; w0.x = cvt_pk_bf16(o0[4 * g] * inv, o0[4 * g + 1] * inv); w0.y = cvt_pk_bf16(o0[4 * g + 2] * inv, o0[4 * g + 3] * inv);
        w1.x = cvt_pk_bf16(o1[4 * g] * inv, o1[4 * g + 1] * inv); w1.y = cvt_pk_bf16(o1[4 * g + 2] * inv, o1[4 * g + 3] * inv);
        bf16* OQ = OUT ? OUT : AQ; *(v2u*)(OQ + qrow + 8 * g + 4 * hl) = w0; *(v2u*)(OQ + qrow + 32 + 8 * g + 4 * hl) = w1; }
}

__device__ __forceinline__ void attn_phase(Frame& F, int layer, bf16* OUT) {
    v4u kr[5], vr[5]; bf16x8 qn[4];
    int u = F.bx;
    if (u < 1024) attn_load(F, u, kr, vr, qn);
    for (; u < 1024; u += F.G) {
        __syncthreads();
        attn_store(F, kr, vr);
        bf16x8 qf[4];
#pragma unroll
        for (int s = 0; s < 4; ++s) qf[s] = qn[s];
        __syncthreads();
        if (u + F.G < 1024) attn_load(F, u + F.G, kr, vr, qn);
        attn_compute(F, layer, u, OUT, qf);
    }
}

constexpr int PL_U_OFF = 0;
constexpr int PL_MX_OFF = 49152;
static_assert(PL_MX_OFF + 32768 <= RING_BYTES, "pool LDS");
__device__ __forceinline__ void pool_unit(Frame& F, int layer, int unit) {
    const int b = unit >> 6, t0 = (unit & 63) * 32;
    bf16* U = (bf16*)(F.lds + PL_U_OFF); bf16* MX = (bf16*)(F.lds + PL_MX_OFF);
    const bf16* PU = (const bf16*)(F.ws + WS_PU); bf16* OP = (bf16*)(F.ws + WS_OP);
    const int tid = F.tid;
    __syncthreads();
    for (int idx = tid; idx < 48 * 64; idx += NTHR) { const int r = idx >> 6, c8 = idx & 63, t = t0 - 8 + r;
        const v4u v = ld_or_zero(PU + ((size_t)b * SEQ + t) * 512 + c8 * 8, PU, t >= 0 && t < SEQ);
        *(v4u*)(U + r * 512 + c8 * 8) = v; }
    __syncthreads();
    { const int chp = tid & 255, tt0 = (tid >> 8) * 16, g = chp >> 6, r = 1 << g;
        const unsigned* Uw = (const unsigned*)U + chp;
        float s0 = 0.f, s1 = 0.f;
        for (int d = -r; d <= r; ++d) { const unsigned w = Uw[(8 + tt0 + d) * 256]; s0 += bflo(w); s1 += bfhi(w); }
        for (int i = 0; i < 16; ++i) { const int tt = tt0 + i, t = t0 + tt; const int lo = t - r < 0 ? 0 : t - r, hi = t + r > SEQ - 1 ? SEQ - 1 : t + r;
            const float rc = __builtin_amdgcn_rcpf((float)(hi - lo + 1)); const unsigned c = Uw[(8 + tt) * 256];
            ((unsigned*)MX)[tt * 256 + chp] = (ABL == 3) ? 0u : pk2(s0 * rc - bflo(c), s1 * rc - bfhi(c));
            if (i < 15) { const unsigned a = Uw[(8 + tt + 1 + r) * 256], sb = Uw[(8 + tt - r) * 256]; s0 += bflo(a) - bflo(sb); s1 += bfhi(a) - bfhi(sb); } } }
    __syncthreads();
    for (int idx = tid; idx < 32 * 64; idx += NTHR) { const int tt = idx >> 6, c8 = idx & 63;
        *(v4u*)(OP + ((size_t)b * SEQ + t0 + tt) * 512 + c8 * 8) = *(const v4u*)(MX + tt * 512 + c8 * 8); }
}

constexpr int DC_QN = 0, DC_KN = 9216, DC_KBT = 18432, DC_KDT = 27648, DC_VBT = 36864;
constexpr int DC_ST = 46080, DC_VNT = 55296, DC_T = 64512, DC_QKM = 73728;
constexpr int DC_AF = 82944;
constexpr int DC_AB = 100352;
constexpr int DC_DT1 = 109568;
constexpr int DC_DTS = 112128;
constexpr int DC_OB = 113664;
constexpr int DC_RAW = 55296;
static_assert(DC_RAW + 52224 <= DC_DT1 && DC_OB + 16384 <= RING_BYTES, "delta chunk LDS");
constexpr int DC_CW = LDSCTL_OFF + 2048;
constexpr int DC_VEC = DC_CW + 3840;
static_assert(DC_VEC + 7 * 256 <= LDS_BYTES, "delta chunk LDS (vectors)");
#ifndef DCREP
#define DCREP 0
#endif
__device__ __forceinline__ f32x4 mfma16(const bf16x8& a, const bf16x8& b, const f32x4& c) { return __builtin_amdgcn_mfma_f32_16x16x32_bf16(a, b, c, 0, 0, 0); }
__device__ __forceinline__ bf16x8 ld8(const bf16* p) { return *(const bf16x8*)p; }
__device__ __forceinline__ int tsw(int row, int col) { return row * 72 + ((((col >> 3) ^ (row >> 3)) & 7) << 3) + (col & 7); }
__device__ __forceinline__ int tswc(int row, int chunk) { return row * 72 + (((chunk ^ (row >> 3)) & 7) << 3); }
__device__ __forceinline__ bf16x8 ld44(const bf16* p0, const bf16* p1) { const v2u a = *(const v2u*)p0, b = *(const v2u*)p1; return __builtin_bit_cast(bf16x8, (v4u){a.x, a.y, b.x, b.y}); }
__device__ __forceinline__ void st4(bf16* p, float a, float b, float c, float d) { v2u w; w.x = cvt_pk_bf16(a, b); w.y = cvt_pk_bf16(c, d); *(v2u*)p = w; }

__device__ __forceinline__ void delta_seq_chunked(Frame& F, int layer, int seq) {
    const int dir = seq >> 7, b = (seq >> 3) & 15, h = seq & 7;
    unsigned char* L = F.lds;
    bf16* Qn = (bf16*)(L + DC_QN); bf16* Kn = (bf16*)(L + DC_KN); bf16* KbT = (bf16*)(L + DC_KBT); bf16* KdT = (bf16*)(L + DC_KDT); bf16* VbT = (bf16*)(L + DC_VBT);
    bf16* St = (bf16*)(L + DC_ST); bf16* VnT = (bf16*)(L + DC_VNT); bf16* T = (bf16*)(L + DC_T); bf16* QKm = (bf16*)(L + DC_QKM);
    float* Af = (float*)(L + DC_AF); bf16* Ab = (bf16*)(L + DC_AB); bf16* DT1 = (bf16*)(L + DC_DT1); bf16* DTs = (bf16*)(L + DC_DTS); float* ob = (float*)(L + DC_OB);
    float* raw = (float*)(L + DC_RAW); float* cw = (float*)(L + DC_CW);
    float* Gs = (float*)(L + DC_VEC); float* gam = Gs + 64; float* del = Gs + 128; float* bet = Gs + 192; float* rq = Gs + 256; float* rk = Gs + 320; float* cdp = Gs + 384;
    const bf16* DQKV = (const bf16*)(F.ws + WS_DQKV); const float* DAB = (const float*)(F.ws + WS_DAB);
    float* OUT = (float*)(F.ws + (dir ? WS_OB : WS_OF));
    const int tid0 = F.tid, wave = F.wave; int tid = tid0, lane = tid0 & 63;
    const int tr = wave >> 1, tc0 = 2 * (wave & 1); int l15 = 0, q4 = 0;
    __syncthreads();
    for (int i = tid; i < 5 * 192; i += NTHR) { const int jj = i / 192, ch = i % 192; cw[i] = IN_conv_w(F)[((size_t)layer * 5 + jj) * 1536 + (ch >> 6) * 512 + h * 64 + (ch & 63)]; }
    for (int i = tid; i < 64 * 72 / 2; i += NTHR) { ((unsigned*)St)[i] = 0u; ((unsigned*)T)[i] = 0u; }
    const float nA = -__expf(IN_a_log(F)[layer * 16 + dir * 8 + h]), dtb = IN_dt_bias(F)[layer * 16 + dir * 8 + h];
    f32x4 Sacc[2];
    Sacc[0] = (f32x4){0.f, 0.f, 0.f, 0.f}; Sacc[1] = Sacc[0];
    v4u pre[4]; float pa = 0.f, pb = 0.f;
    { const int t0n = dir ? SEQ - 64 : 0;
#pragma unroll
        for (int it = 0; it < 4; ++it) { const int idx = tid + it * NTHR; const int r = idx / 24, pc = idx % 24, t = t0n - 2 + r;
            pre[it] = ld_or_zero(DQKV + ((size_t)b * SEQ + t) * 1536 + (pc >> 3) * 512 + h * 64 + (pc & 7) * 8, DQKV, idx < 68 * 24 && t >= 0 && t < SEQ); }
        if (wave == 0) { const size_t m = (size_t)b * SEQ + t0n + (dir ? 63 - lane : lane); pa = DAB[m * 32 + dir * 8 + h]; pb = DAB[m * 32 + 16 + dir * 8 + h]; } }
    for (int blk = 0; blk < SEQ / 64; ++blk) {
        const int tb = dir ? (SEQ / 64 - 1 - blk) : blk, t0 = tb * 64;
        tid = tid0; asm volatile("" : "+v"(tid)); lane = tid & 63;
        __syncthreads();
#pragma unroll
        for (int it = 0; it < 4; ++it) { const int idx = tid + it * NTHR; if (idx < 68 * 24) { const int r = idx / 24, pc = idx % 24; float* rp = raw + r * 192 + (pc >> 3) * 64 + (pc & 7) * 8;
                f32x4 lo, hi; unpack8(pre[it], lo, hi); *(f32x4*)rp = lo; *(f32x4*)(rp + 4) = hi; } }
        if (wave == 0) { const float xx = pa + dtb; const float sp = xx > 20.f ? xx : log1pf(__expf(xx));
            float g = nA * sp;
#pragma unroll
            for (int o = 1; o < 64; o <<= 1) { const float u = __shfl_up(g, o); if (lane >= o) g += u; }
            const float gl = __shfl(g, 63);
            Gs[lane] = g; gam[lane] = __expf(g); del[lane] = __expf(gl - g); bet[lane] = sigmoidf_(pb); if (lane == 63) cdp[0] = __expf(g); }
        if (blk + 1 < SEQ / 64) { const int tbn = dir ? (SEQ / 64 - 2 - blk) : blk + 1, t0n = tbn * 64;
#pragma unroll
            for (int it = 0; it < 4; ++it) { const int idx = tid + it * NTHR; const int r = idx / 24, pc = idx % 24, t = t0n - 2 + r;
                pre[it] = ld_or_zero(DQKV + ((size_t)b * SEQ + t) * 1536 + (pc >> 3) * 512 + h * 64 + (pc & 7) * 8, DQKV, idx < 68 * 24 && t >= 0 && t < SEQ); }
            if (wave == 0) { const size_t m = (size_t)b * SEQ + t0n + (dir ? 63 - lane : lane); pa = DAB[m * 32 + dir * 8 + h]; pb = DAB[m * 32 + 16 + dir * 8 + h]; } }
        __syncthreads();
        for (int rep1 = 0; rep1 < (DCREP == 1 ? 2 : 1); ++rep1)
        { const int tt = tid >> 3, d0 = (tid & 7) * 8, s = dir ? 63 - tt : tt;
            float xv[3][8];
#pragma unroll
            for (int sec = 0; sec < 3; ++sec) {
                f32x2 a2[4];
#pragma unroll
                for (int pq = 0; pq < 4; ++pq) a2[pq] = (f32x2){0.f, 0.f};
#pragma unroll
                for (int jj = 0; jj < 5; ++jj) { const float* rp = raw + (tt + jj) * 192 + sec * 64 + d0; const float* cp = cw + jj * 192 + sec * 64 + d0;
                    const f32x4 r0 = *(const f32x4*)rp, r1 = *(const f32x4*)(rp + 4), c0 = *(const f32x4*)cp, c1 = *(const f32x4*)(cp + 4);
                    a2[0] += (f32x2){c0[0], c0[1]} * (f32x2){r0[0], r0[1]}; a2[1] += (f32x2){c0[2], c0[3]} * (f32x2){r0[2], r0[3]};
                    a2[2] += (f32x2){c1[0], c1[1]} * (f32x2){r1[0], r1[1]}; a2[3] += (f32x2){c1[2], c1[3]} * (f32x2){r1[2], r1[3]}; }
#pragma unroll
                for (int e = 0; e < 8; ++e) xv[sec][e] = siluf_(a2[e >> 1][e & 1]);
                __builtin_amdgcn_sched_barrier(0); }
            float sq = 0.f, sk = 0.f;
#pragma unroll
            for (int e = 0; e < 8; ++e) { sq += xv[0][e] * xv[0][e]; sk += xv[1][e] * xv[1][e]; }
            sq = __builtin_amdgcn_rsqf(red8(sq) + 1e-6f) * 0.125f; sk = __builtin_amdgcn_rsqf(red8(sk) + 1e-6f);
            const float be = bet[s], bg = be * gam[s], dl = del[s];
#pragma unroll
            for (int e = 0; e < 8; ++e) { xv[0][e] *= sq; xv[1][e] *= sk; }
            v4u w; w.x = cvt_pk_bf16(xv[0][0], xv[0][1]); w.y = cvt_pk_bf16(xv[0][2], xv[0][3]); w.z = cvt_pk_bf16(xv[0][4], xv[0][5]); w.w = cvt_pk_bf16(xv[0][6], xv[0][7]); *(v4u*)(Qn + s * 72 + d0) = w;
            w.x = cvt_pk_bf16(xv[1][0], xv[1][1]); w.y = cvt_pk_bf16(xv[1][2], xv[1][3]); w.z = cvt_pk_bf16(xv[1][4], xv[1][5]); w.w = cvt_pk_bf16(xv[1][6], xv[1][7]); *(v4u*)(Kn + s * 72 + d0) = w;
#pragma unroll
            for (int e = 0; e < 8; e += 2) { const int o0 = tsw(d0 + e, s), o1 = tsw(d0 + e + 1, s);
                const unsigned wb = cvt_pk_bf16(xv[1][e] * bg, xv[1][e + 1] * bg), wd = cvt_pk_bf16(xv[1][e] * dl, xv[1][e + 1] * dl), wv = cvt_pk_bf16(xv[2][e] * be, xv[2][e + 1] * be);
                KbT[o0] = (bf16)(wb & 0xffffu); KbT[o1] = (bf16)(wb >> 16); KdT[o0] = (bf16)(wd & 0xffffu); KdT[o1] = (bf16)(wd >> 16); VbT[o0] = (bf16)(wv & 0xffffu); VbT[o1] = (bf16)(wv >> 16); } }
        __syncthreads();
        { int lv = lane; asm volatile("" : "+v"(lv)); l15 = lv & 15; q4 = lv >> 4; }
        for (int rep4 = 0; rep4 < (DCREP == 4 ? 2 : 1); ++rep4)
        { const bf16x8 a0 = ld8(Kn + (16 * tr + l15) * 72 + 8 * q4), a1 = ld8(Kn + (16 * tr + l15) * 72 + 32 + 8 * q4);
            float Gj[4];
#pragma unroll
            for (int r = 0; r < 4; ++r) Gj[r] = Gs[16 * tr + 4 * q4 + r];
#pragma unroll
            for (int tcx = 0; tcx < 2; ++tcx) { const int tc = tc0 + tcx, i = 16 * tc + l15, j0 = 16 * tr + 4 * q4;
                f32x4 ckk = (f32x4){0.f, 0.f, 0.f, 0.f}, cqk = ckk;
                if (tc >= tr) {
                    const bf16x8 bk0 = ld8(Kn + i * 72 + 8 * q4), bk1 = ld8(Kn + i * 72 + 32 + 8 * q4), bq0 = ld8(Qn + i * 72 + 8 * q4), bq1 = ld8(Qn + i * 72 + 32 + 8 * q4);
                    ckk = mfma16(a0, bk0, ckk); ckk = mfma16(a1, bk1, ckk); cqk = mfma16(a0, bq0, cqk); cqk = mfma16(a1, bq1, cqk);
                    const float Gi = Gs[i], bi = bet[i];
#pragma unroll
                    for (int r = 0; r < 4; ++r) { const int j = j0 + r; const float dec = __expf(Gi - Gj[r]); ckk[r] = (i > j) ? ckk[r] * dec * bi : 0.f; cqk[r] = (i >= j) ? cqk[r] * dec : 0.f; } }
#pragma unroll
                for (int r = 0; r < 4; ++r) Af[(j0 + r) * 68 + i] = ckk[r];
                st4(QKm + i * 72 + j0, cqk[0], cqk[1], cqk[2], cqk[3]);
                st4(Ab + i * 72 + j0, ckk[0], ckk[1], ckk[2], ckk[3]); } }
        __syncthreads();
        for (int rep5 = 0; rep5 < (DCREP == 5 ? 2 : 1); ++rep5)
        if (wave == 0) { const int b4 = lane >> 4, c = lane & 15; const float* Ar = Af + (16 * b4) * 68 + 16 * b4;
            float t[16];
#pragma unroll
            for (int i = 0; i < 16; ++i) t[i] = (i == c) ? 1.f : 0.f;
#pragma unroll
            for (int j = 0; j < 15; ++j) {
#pragma unroll
                for (int i4 = (j + 1) / 4; i4 < 4; ++i4) { const f32x4 a = *(const f32x4*)(Ar + j * 68 + 4 * i4);
#pragma unroll
                    for (int e = 0; e < 4; ++e) if (4 * i4 + e > j) t[4 * i4 + e] -= a[e] * t[j]; } }
#pragma unroll
            for (int i = 0; i < 16; ++i) T[(16 * b4 + i) * 72 + 16 * b4 + c] = (bf16)f2bf(t[i]);
            { v4u w0, w1; w0.x = cvt_pk_bf16(t[0], t[1]); w0.y = cvt_pk_bf16(t[2], t[3]); w0.z = cvt_pk_bf16(t[4], t[5]); w0.w = cvt_pk_bf16(t[6], t[7]);
                w1.x = cvt_pk_bf16(t[8], t[9]); w1.y = cvt_pk_bf16(t[10], t[11]); w1.z = cvt_pk_bf16(t[12], t[13]); w1.w = cvt_pk_bf16(t[14], t[15]);
                const v4u z = (v4u){0u, 0u, 0u, 0u};
                if ((b4 & 1) == 0) { *(v4u*)(DTs + ((b4 >> 1) * 16 + c) * 24) = w0; *(v4u*)(DTs + ((b4 >> 1) * 16 + c) * 24 + 8) = w1; }
                if (b4 == 0) { *(v4u*)(DT1 + c * 40) = w0; *(v4u*)(DT1 + c * 40 + 8) = w1; }
                if (b4 == 1) { *(v4u*)(DT1 + (16 + c) * 40 + 16) = w0; *(v4u*)(DT1 + (16 + c) * 40 + 24) = w1; *(v4u*)(DT1 + (16 + c) * 40) = z; *(v4u*)(DT1 + (16 + c) * 40 + 8) = z; }
                if (lane < 32) { *(v4u*)(T + lane * 72 + 32) = z; *(v4u*)(T + lane * 72 + 40) = z; *(v4u*)(T + lane * 72 + 48) = z; *(v4u*)(T + lane * 72 + 56) = z; }
                if (lane < 16) { *(v4u*)(T + lane * 72 + 16) = z; *(v4u*)(T + lane * 72 + 24) = z; }
                if (lane >= 32 && lane < 48) { *(v4u*)(T + lane * 72 + 48) = z; *(v4u*)(T + lane * 72 + 56) = z; } }
            LDS_WAIT(); asm volatile("" ::: "memory");
            const int m15 = lane & 15, qq = lane >> 4;
#pragma unroll
            for (int p = 0; p < 2; ++p) { const int b0 = 2 * p, b1 = 2 * p + 1;
                const v4u zz = (v4u){0u, 0u, 0u, 0u};
                v4u av = zz, bv = zz;
                if (qq < 2) { av = *(const v4u*)(Ab + (16 * b1 + m15) * 72 + 16 * b0 + 8 * qq); bv = *(const v4u*)(DTs + (p * 16 + m15) * 24 + 8 * qq); }
                f32x4 X4 = (f32x4){0.f, 0.f, 0.f, 0.f};
                X4 = mfma16(__builtin_bit_cast(bf16x8, av), __builtin_bit_cast(bf16x8, bv), X4);
                v4u xa = zz; xa.x = cvt_pk_bf16(X4[0], X4[1]); xa.y = cvt_pk_bf16(X4[2], X4[3]);
                const v2u dr = *(const v2u*)(T + (16 * b1 + m15) * 72 + 16 * b1 + 4 * qq);
                v4u db = zz; db.x = dr.x; db.y = dr.y;
                f32x4 Z4 = (f32x4){0.f, 0.f, 0.f, 0.f};
                Z4 = mfma16(__builtin_bit_cast(bf16x8, xa), __builtin_bit_cast(bf16x8, db), Z4);
                st4(T + (16 * b1 + m15) * 72 + 16 * b0 + 4 * qq, -Z4[0], -Z4[1], -Z4[2], -Z4[3]);
                if (p == 0) {
#pragma unroll
                    for (int r = 0; r < 4; ++r) DT1[(4 * qq + r) * 40 + 16 + m15] = (bf16)f2bf(-Z4[r]); } }
            LDS_WAIT(); asm volatile("" ::: "memory");
            const int r31 = lane & 31, hh = lane >> 5;
            f32x16 X;
#pragma unroll
            for (int i = 0; i < 16; ++i) X[i] = 0.f;
#pragma unroll
            for (int ks = 0; ks < 2; ++ks) X = __builtin_amdgcn_mfma_f32_32x32x16_bf16(ld8(Ab + (32 + r31) * 72 + 16 * ks + 8 * hh), ld8(DT1 + r31 * 40 + 16 * ks + 8 * hh), X, 0, 0, 0);
            f32x16 Z;
#pragma unroll
            for (int i = 0; i < 16; ++i) Z[i] = 0.f;
#pragma unroll
            for (int ks = 0; ks < 2; ++ks) { v4u pw; pw.x = cvt_pk_bf16(X[8 * ks + 0], X[8 * ks + 1]); pw.y = cvt_pk_bf16(X[8 * ks + 2], X[8 * ks + 3]); pw.z = cvt_pk_bf16(X[8 * ks + 4], X[8 * ks + 5]); pw.w = cvt_pk_bf16(X[8 * ks + 6], X[8 * ks + 7]);
                const bf16* d2 = T + (32 + r31) * 72 + 32 + 16 * ks + 4 * hh;
                Z = __builtin_amdgcn_mfma_f32_32x32x16_bf16(__builtin_bit_cast(bf16x8, pw), ld44(d2, d2 + 8), Z, 0, 0, 0); }
#pragma unroll
            for (int g = 0; g < 4; ++g) st4(T + (32 + r31) * 72 + 8 * g + 4 * hh, -Z[4 * g], -Z[4 * g + 1], -Z[4 * g + 2], -Z[4 * g + 3]); }
        __syncthreads();
        { int lv = lane; asm volatile("" : "+v"(lv)); l15 = lv & 15; q4 = lv >> 4; }
        for (int rep7 = 0; rep7 < (DCREP == 7 ? 2 : 1); ++rep7)
        { const bf16x8 ti0 = ld8(T + (16 * tr + l15) * 72 + 8 * q4), ti1 = ld8(T + (16 * tr + l15) * 72 + 32 + 8 * q4);
            f32x4 wt[4];
#pragma unroll
            for (int dt = 0; dt < 4; ++dt) { wt[dt] = (f32x4){0.f, 0.f, 0.f, 0.f};
                wt[dt] = mfma16(ld8(KbT + tswc(16 * dt + l15, q4)), ti0, wt[dt]); wt[dt] = mfma16(ld8(KbT + tswc(16 * dt + l15, 4 + q4)), ti1, wt[dt]); }
            v4u wa0, wa1;
            wa0.x = cvt_pk_bf16(-wt[0][0], -wt[0][1]); wa0.y = cvt_pk_bf16(-wt[0][2], -wt[0][3]); wa0.z = cvt_pk_bf16(-wt[1][0], -wt[1][1]); wa0.w = cvt_pk_bf16(-wt[1][2], -wt[1][3]);
            wa1.x = cvt_pk_bf16(-wt[2][0], -wt[2][1]); wa1.y = cvt_pk_bf16(-wt[2][2], -wt[2][3]); wa1.z = cvt_pk_bf16(-wt[3][0], -wt[3][1]); wa1.w = cvt_pk_bf16(-wt[3][2], -wt[3][3]);
#pragma unroll
            for (int tcx = 0; tcx < 2; ++tcx) { const int e = 16 * (tc0 + tcx) + l15;
                f32x4 u = (f32x4){0.f, 0.f, 0.f, 0.f};
                u = mfma16(ti0, ld8(VbT + tswc(e, q4)), u); u = mfma16(ti1, ld8(VbT + tswc(e, 4 + q4)), u);
                const bf16* sp = St + e * 72 + 4 * q4;
                u = mfma16(__builtin_bit_cast(bf16x8, wa0), ld44(sp, sp + 16), u); u = mfma16(__builtin_bit_cast(bf16x8, wa1), ld44(sp + 32, sp + 48), u);
                st4(VnT + e * 72 + 16 * tr + 4 * q4, u[0], u[1], u[2], u[3]); } }
        __syncthreads();
        { int lv = lane; asm volatile("" : "+v"(lv)); l15 = lv & 15; q4 = lv >> 4; }
        { const bf16x8 qa0 = ld8(Qn + (16 * tr + l15) * 72 + 8 * q4), qa1 = ld8(Qn + (16 * tr + l15) * 72 + 32 + 8 * q4);
            const bf16x8 ma0 = ld8(QKm + (16 * tr + l15) * 72 + 8 * q4), ma1 = ld8(QKm + (16 * tr + l15) * 72 + 32 + 8 * q4);
            const bf16x8 ka0 = ld8(KdT + tswc(16 * tr + l15, q4)), ka1 = ld8(KdT + tswc(16 * tr + l15, 4 + q4));
            const float cd = cdp[0]; float gi[4];
#pragma unroll
            for (int r = 0; r < 4; ++r) gi[r] = gam[16 * tr + 4 * q4 + r];
#pragma unroll
            for (int tcx = 0; tcx < 2; ++tcx) { const int e = 16 * (tc0 + tcx) + l15;
                const bf16x8 s0 = ld8(St + e * 72 + 8 * q4), s1 = ld8(St + e * 72 + 32 + 8 * q4), n0 = ld8(VnT + e * 72 + 8 * q4), n1 = ld8(VnT + e * 72 + 32 + 8 * q4);
                f32x4 o = (f32x4){0.f, 0.f, 0.f, 0.f};
                o = mfma16(qa0, s0, o); o = mfma16(qa1, s1, o);
#pragma unroll
                for (int r = 0; r < 4; ++r) o[r] *= gi[r];
                o = mfma16(ma0, n0, o); o = mfma16(ma1, n1, o);
#pragma unroll
                for (int r = 0; r < 4; ++r) ob[(16 * tr + 4 * q4 + r) * 64 + e] = o[r];
                Sacc[tcx] = Sacc[tcx] * cd; Sacc[tcx] = mfma16(ka0, n0, Sacc[tcx]); Sacc[tcx] = mfma16(ka1, n1, Sacc[tcx]); } }
        __syncthreads();
#pragma unroll
        for (int tcx = 0; tcx < 2; ++tcx) { const int e = 16 * (tc0 + tcx) + l15; st4(St + e * 72 + 16 * tr + 4 * q4, Sacc[tcx][0], Sacc[tcx][1], Sacc[tcx][2], Sacc[tcx][3]); }
        for (int idx = tid; idx < 64 * 16; idx += NTHR) { const int s = idx >> 4, c4 = idx & 15; const int t = t0 + (dir ? 63 - s : s);
            const f32x4 ov = *(const f32x4*)(ob + s * 64 + c4 * 4); v2u ow; ow.x = cvt_pk_bf16(ov[0], ov[1]); ow.y = cvt_pk_bf16(ov[2], ov[3]);
            *(v2u*)((bf16*)OUT + ((size_t)b * SEQ + t) * 512 + h * 64 + c4 * 4) = ow; }
    }
}

#ifndef DPREP
#define DPREP 0
#endif
constexpr int DP_QN = 0, DP_KD = 18432;
constexpr int DP_KN = 36864, DP_KBT = 46080, DP_VBT = 55296, DP_ST = 64512, DP_VNT = 73728, DP_T = 82944, DP_QKM = 92160, DP_AB = 101376;
constexpr int DP_AF4 = 110592;
constexpr int DP_DT1 = 115712, DP_DTS = 118272;
constexpr int DP_RAW = 119808;
static_assert(DP_RAW + 26112 <= RING_BYTES, "pipelined delta LDS");

__device__ __forceinline__ bf16x8 ldtr8(const bf16* img, int ks, int c, int lane) {
    const int q = lane >> 4, qq = (lane & 15) >> 2, p = lane & 3;
    const bf16* a0 = img + (32 * ks + 8 * q + qq) * 72 + 16 * c + 4 * p;
    const v4i16_t lo = __builtin_amdgcn_ds_read_tr16_b64_v4i16((LAS v4i16_t*)a0), hi = __builtin_amdgcn_ds_read_tr16_b64_v4i16((LAS v4i16_t*)(a0 + 4 * 72));
    return __builtin_shufflevector(lo, hi, 0, 1, 2, 3, 4, 5, 6, 7);
}
typedef __bf16 bf16x2v_t __attribute__((ext_vector_type(2)));
__device__ __forceinline__ float dot2bf(unsigned a, unsigned b, float c) { return __builtin_amdgcn_fdot2_f32_bf16(__builtin_bit_cast(bf16x2v_t, a), __builtin_bit_cast(bf16x2v_t, b), c, false); }
__device__ __forceinline__ void delta_seq_pipe(Frame& F, int layer, int seq) {
    const int dir = seq >> 7, b = (seq >> 3) & 15, h = seq & 7;
    unsigned char* L = F.lds;
    bf16* Qn2 = (bf16*)(L + DP_QN); bf16* Kd2 = (bf16*)(L + DP_KD); bf16* Kn = (bf16*)(L + DP_KN); bf16* KbT = (bf16*)(L + DP_KBT); bf16* VbT = (bf16*)(L + DP_VBT);
    bf16* St = (bf16*)(L + DP_ST); bf16* VnT = (bf16*)(L + DP_VNT); bf16* T = (bf16*)(L + DP_T); bf16* QKm = (bf16*)(L + DP_QKM); bf16* Ab = (bf16*)(L + DP_AB);
    float* Af4 = (float*)(L + DP_AF4); bf16* DT1 = (bf16*)(L + DP_DT1); bf16* DTs = (bf16*)(L + DP_DTS); bf16* raw = (bf16*)(L + DP_RAW);
    float* cw = (float*)(L + DC_CW); float* vec0 = (float*)(L + DC_VEC);
    const bf16* DQKV = (const bf16*)(F.ws + WS_DQKV); const float* DAB = (const float*)(F.ws + WS_DAB);
    bf16* OUT = (bf16*)(F.ws + (dir ? WS_OB : WS_OF));
    const int tid0 = F.tid, wave = F.wave; int tid = tid0, lane = tid0 & 63, l15 = 0, q4 = 0;
    const int tr = wave >> 1, tc0 = 2 * (wave & 1);
    __syncthreads();
    for (int i = tid; i < 5 * 192; i += NTHR) { const int jj = i / 192, ch = i % 192; const unsigned wb = f2bf(IN_conv_w(F)[((size_t)layer * 5 + jj) * 1536 + (ch >> 6) * 512 + h * 64 + (ch & 63)]); ((unsigned*)cw)[i] = (ch & 1) ? (wb << 16) : wb; }
    for (int i = tid; i < 64 * 72 / 2; i += NTHR) ((unsigned*)St)[i] = 0u;
    const float nA = -__expf(IN_a_log(F)[layer * 16 + dir * 8 + h]), dtb = IN_dt_bias(F)[layer * 16 + dir * 8 + h];
    f32x4 Sacc[2];
    Sacc[0] = (f32x4){0.f, 0.f, 0.f, 0.f}; Sacc[1] = Sacc[0];
    v4u pre[4]; float pa = 0.f, pb = 0.f;
    v4u kbw = (v4u){0u, 0u, 0u, 0u}, vbw = kbw;

#define DP_LANE() do { tid = tid0; asm volatile("" : "+v"(tid)); lane = tid & 63; l15 = lane & 15; q4 = lane >> 4; } while (0)
#define DP_T0(NB) ((dir ? (SEQ / 64 - 1 - (NB)) : (NB)) * 64)
#define DP_PREFETCH(NB) do { const int t0n_ = DP_T0(NB); \
        _Pragma("unroll") for (int it = 0; it < 4; ++it) { const int idx = tid + it * NTHR; const int r = idx / 24, pc = idx % 24, t = t0n_ - 2 + r; \
            pre[it] = ld_or_zero(DQKV + ((size_t)b * SEQ + t) * 1536 + (pc >> 3) * 512 + h * 64 + (pc & 7) * 8, DQKV, idx < 68 * 24 && t >= 0 && t < SEQ); } \
        if (wave == 0) { const size_t m_ = (size_t)b * SEQ + t0n_ + (dir ? 63 - lane : lane); pa = DAB[m_ * 32 + dir * 8 + h]; pb = DAB[m_ * 32 + 16 + dir * 8 + h]; } } while (0)
#define DP_S0(NB) do { const int nb_ = (NB); \
        _Pragma("unroll") for (int it = 0; it < 4; ++it) { const int idx = tid + it * NTHR; if (idx < 68 * 24) { const int r = idx / 24, pc = idx % 24; *(v4u*)(raw + r * 192 + (pc >> 3) * 64 + (pc & 7) * 8) = pre[it]; } } \
        if (wave == 0) { float* vd_ = vec0 + (nb_ & 1) * 448; const float xx_ = pa + dtb; const float sp_ = xx_ > 20.f ? xx_ : log1pf(__expf(xx_)); float g_ = nA * sp_; \
            _Pragma("unroll") for (int o_ = 1; o_ < 64; o_ <<= 1) { const float u_ = __shfl_up(g_, o_); if (lane >= o_) g_ += u_; } \
            const float gl_ = __shfl(g_, 63); vd_[lane] = g_; vd_[64 + lane] = __expf(g_); vd_[128 + lane] = __expf(gl_ - g_); vd_[192 + lane] = sigmoidf_(pb); if (lane == 63) vd_[256] = __expf(g_); } \
        if (nb_ + 1 < SEQ / 64) DP_PREFETCH(nb_ + 1); } while (0)
#define DP_S1A(NB) do { const int nb_ = (NB); const float* vd_ = vec0 + (nb_ & 1) * 448; bf16* Qn_ = Qn2 + (nb_ & 1) * 4608; bf16* Kd_ = Kd2 + (nb_ & 1) * 4608; \
        const int tt = tid >> 3, d0 = (tid & 7) * 8, s = dir ? 63 - tt : tt; \
        float xv[3][8]; \
        _Pragma("unroll") for (int sec = 0; sec < 3; ++sec) { float a1[8]; \
            _Pragma("unroll") for (int e = 0; e < 8; ++e) a1[e] = 0.f; \
            _Pragma("unroll") for (int jj = 0; jj < 5; ++jj) { const v4u rw = *(const v4u*)(raw + (tt + jj) * 192 + sec * 64 + d0); const float* cp = cw + jj * 192 + sec * 64 + d0; \
                const v4u c0 = *(const v4u*)cp, c1 = *(const v4u*)(cp + 4); \
                a1[0] = dot2bf(rw.x, c0.x, a1[0]); a1[1] = dot2bf(rw.x, c0.y, a1[1]); a1[2] = dot2bf(rw.y, c0.z, a1[2]); a1[3] = dot2bf(rw.y, c0.w, a1[3]); \
                a1[4] = dot2bf(rw.z, c1.x, a1[4]); a1[5] = dot2bf(rw.z, c1.y, a1[5]); a1[6] = dot2bf(rw.w, c1.z, a1[6]); a1[7] = dot2bf(rw.w, c1.w, a1[7]); } \
            _Pragma("unroll") for (int e = 0; e < 8; ++e) xv[sec][e] = siluf_(a1[e]); \
            __builtin_amdgcn_sched_barrier(0); } \
        float sq = 0.f, sk = 0.f; \
        _Pragma("unroll") for (int e = 0; e < 8; ++e) { sq += xv[0][e] * xv[0][e]; sk += xv[1][e] * xv[1][e]; } \
        sq = __builtin_amdgcn_rsqf(red8(sq) + 1e-6f) * 0.125f; sk = __builtin_amdgcn_rsqf(red8(sk) + 1e-6f); \
        const float be = vd_[192 + s], bg = be * vd_[64 + s], dl = vd_[128 + s]; \
        _Pragma("unroll") for (int e = 0; e < 8; ++e) { xv[0][e] *= sq; xv[1][e] *= sk; } \
        v4u w; w.x = cvt_pk_bf16(xv[0][0], xv[0][1]); w.y = cvt_pk_bf16(xv[0][2], xv[0][3]); w.z = cvt_pk_bf16(xv[0][4], xv[0][5]); w.w = cvt_pk_bf16(xv[0][6], xv[0][7]); *(v4u*)(Qn_ + s * 72 + d0) = w; \
        w.x = cvt_pk_bf16(xv[1][0], xv[1][1]); w.y = cvt_pk_bf16(xv[1][2], xv[1][3]); w.z = cvt_pk_bf16(xv[1][4], xv[1][5]); w.w = cvt_pk_bf16(xv[1][6], xv[1][7]); *(v4u*)(Kn + s * 72 + d0) = w; \
        w.x = cvt_pk_bf16(xv[1][0] * bg, xv[1][1] * bg); w.y = cvt_pk_bf16(xv[1][2] * bg, xv[1][3] * bg); w.z = cvt_pk_bf16(xv[1][4] * bg, xv[1][5] * bg); w.w = cvt_pk_bf16(xv[1][6] * bg, xv[1][7] * bg); kbw = w; \
        w.x = cvt_pk_bf16(xv[1][0] * dl, xv[1][1] * dl); w.y = cvt_pk_bf16(xv[1][2] * dl, xv[1][3] * dl); w.z = cvt_pk_bf16(xv[1][4] * dl, xv[1][5] * dl); w.w = cvt_pk_bf16(xv[1][6] * dl, xv[1][7] * dl); *(v4u*)(Kd_ + s * 72 + d0) = w; \
        w.x = cvt_pk_bf16(xv[2][0] * be, xv[2][1] * be); w.y = cvt_pk_bf16(xv[2][2] * be, xv[2][3] * be); w.z = cvt_pk_bf16(xv[2][4] * be, xv[2][5] * be); w.w = cvt_pk_bf16(xv[2][6] * be, xv[2][7] * be); vbw = w; } while (0)
#define DP_S1B() do { const int tt = tid >> 3, d0 = (tid & 7) * 8, s = dir ? 63 - tt : tt; *(v4u*)(KbT + s * 72 + d0) = kbw; *(v4u*)(VbT + s * 72 + d0) = vbw; } while (0)
#define DP_S4(NB) do { const int nb_ = (NB); const float* vd_ = vec0 + (nb_ & 1) * 448; const bf16* Qn_ = Qn2 + (nb_ & 1) * 4608; \
        const bf16x8 a0 = ld8(Kn + (16 * tr + l15) * 72 + 8 * q4), a1 = ld8(Kn + (16 * tr + l15) * 72 + 32 + 8 * q4); \
        float Gj[4]; \
        _Pragma("unroll") for (int r = 0; r < 4; ++r) Gj[r] = vd_[16 * tr + 4 * q4 + r]; \
        _Pragma("unroll") for (int tcx = 0; tcx < 2; ++tcx) { const int tc = tc0 + tcx, i = 16 * tc + l15, j0 = 16 * tr + 4 * q4; \
            f32x4 ckk = (f32x4){0.f, 0.f, 0.f, 0.f}, cqk = ckk; \
            if (tc >= tr) { \
                const bf16x8 bk0 = ld8(Kn + i * 72 + 8 * q4), bk1 = ld8(Kn + i * 72 + 32 + 8 * q4), bq0 = ld8(Qn_ + i * 72 + 8 * q4), bq1 = ld8(Qn_ + i * 72 + 32 + 8 * q4); \
                ckk = mfma16(a0, bk0, ckk); ckk = mfma16(a1, bk1, ckk); cqk = mfma16(a0, bq0, cqk); cqk = mfma16(a1, bq1, cqk); \
                const float Gi = vd_[i], bi = vd_[192 + i]; \
                _Pragma("unroll") for (int r = 0; r < 4; ++r) { const int j = j0 + r; const float dec = __expf(Gi - Gj[r]); ckk[r] = (i > j) ? ckk[r] * dec * bi : 0.f; cqk[r] = (i >= j) ? cqk[r] * dec : 0.f; } } \
            if (tc == tr) { _Pragma("unroll") for (int r = 0; r < 4; ++r) Af4[tr * 320 + (4 * q4 + r) * 20 + l15] = ckk[r]; } \
            st4(QKm + i * 72 + j0, cqk[0], cqk[1], cqk[2], cqk[3]); \
            st4(Ab + i * 72 + j0, ckk[0], ckk[1], ckk[2], ckk[3]); } } while (0)
#define DP_S5() do { if (wave == 0) { const int b4 = lane >> 4, c = lane & 15; const float* Ar = Af4 + b4 * 320; \
        f32x4 ar[15][4];                                            \
        _Pragma("unroll") for (int j = 0; j < 15; ++j) { _Pragma("unroll") for (int i4 = (j + 1) / 4; i4 < 4; ++i4) ar[j][i4] = *(const f32x4*)(Ar + j * 20 + 4 * i4); } \
        float t[16]; \
        _Pragma("unroll") for (int i = 0; i < 16; ++i) t[i] = (i == c) ? 1.f : 0.f; \
        _Pragma("unroll") for (int j = 0; j < 15; ++j) { \
            _Pragma("unroll") for (int i4 = (j + 1) / 4; i4 < 4; ++i4) { \
                _Pragma("unroll") for (int e = 0; e < 4; ++e) if (4 * i4 + e > j) t[4 * i4 + e] -= ar[j][i4][e] * t[j]; } } \
        _Pragma("unroll") for (int i = 0; i < 16; ++i) T[(16 * b4 + i) * 72 + 16 * b4 + c] = (bf16)f2bf(t[i]); \
        { v4u w0, w1; w0.x = cvt_pk_bf16(t[0], t[1]); w0.y = cvt_pk_bf16(t[2], t[3]); w0.z = cvt_pk_bf16(t[4], t[5]); w0.w = cvt_pk_bf16(t[6], t[7]); \
            w1.x = cvt_pk_bf16(t[8], t[9]); w1.y = cvt_pk_bf16(t[10], t[11]); w1.z = cvt_pk_bf16(t[12], t[13]); w1.w = cvt_pk_bf16(t[14], t[15]); \
            const v4u z = (v4u){0u, 0u, 0u, 0u}; \
            if ((b4 & 1) == 0) { *(v4u*)(DTs + ((b4 >> 1) * 16 + c) * 24) = w0; *(v4u*)(DTs + ((b4 >> 1) * 16 + c) * 24 + 8) = w1; } \
            if (b4 == 0) { *(v4u*)(DT1 + c * 40) = w0; *(v4u*)(DT1 + c * 40 + 8) = w1; } \
            if (b4 == 1) { *(v4u*)(DT1 + (16 + c) * 40 + 16) = w0; *(v4u*)(DT1 + (16 + c) * 40 + 24) = w1; *(v4u*)(DT1 + (16 + c) * 40) = z; *(v4u*)(DT1 + (16 + c) * 40 + 8) = z; } \
            if (lane < 32) { *(v4u*)(T + lane * 72 + 32) = z; *(v4u*)(T + lane * 72 + 40) = z; *(v4u*)(T + lane * 72 + 48) = z; *(v4u*)(T + lane * 72 + 56) = z; } \
            if (lane < 16) { *(v4u*)(T + lane * 72 + 16) = z; *(v4u*)(T + lane * 72 + 24) = z; } \
            if (lane >= 32 && lane < 48) { *(v4u*)(T + lane * 72 + 48) = z; *(v4u*)(T + lane * 72 + 56) = z; } } \
        asm volatile("" ::: "memory");                              \
        const int m15 = lane & 15, qq = lane >> 4; \
        { const v4u zz = (v4u){0u, 0u, 0u, 0u}; v4u av[2], bv[2]; v2u dr[2]; \
            _Pragma("unroll") for (int p = 0; p < 2; ++p) { const int b0 = 2 * p, b1 = 2 * p + 1; av[p] = zz; bv[p] = zz; \
                if (qq < 2) { av[p] = *(const v4u*)(Ab + (16 * b1 + m15) * 72 + 16 * b0 + 8 * qq); bv[p] = *(const v4u*)(DTs + (p * 16 + m15) * 24 + 8 * qq); } \
                dr[p] = *(const v2u*)(T + (16 * b1 + m15) * 72 + 16 * b1 + 4 * qq); } \
            f32x4 Z4[2]; \
            _Pragma("unroll") for (int p = 0; p < 2; ++p) { \
                f32x4 X4 = (f32x4){0.f, 0.f, 0.f, 0.f}; X4 = mfma16(__builtin_bit_cast(bf16x8, av[p]), __builtin_bit_cast(bf16x8, bv[p]), X4); \
                v4u xa = zz; xa.x = cvt_pk_bf16(X4[0], X4[1]); xa.y = cvt_pk_bf16(X4[2], X4[3]); \
                v4u db = zz; db.x = dr[p].x; db.y = dr[p].y; \
                Z4[p] = (f32x4){0.f, 0.f, 0.f, 0.f}; Z4[p] = mfma16(__builtin_bit_cast(bf16x8, xa), __builtin_bit_cast(bf16x8, db), Z4[p]); } \
            _Pragma("unroll") for (int p = 0; p < 2; ++p) { const int b0 = 2 * p, b1 = 2 * p + 1; \
                st4(T + (16 * b1 + m15) * 72 + 16 * b0 + 4 * qq, -Z4[p][0], -Z4[p][1], -Z4[p][2], -Z4[p][3]); \
                if (p == 0) { _Pragma("unroll") for (int r = 0; r < 4; ++r) DT1[(4 * qq + r) * 40 + 16 + m15] = (bf16)f2bf(-Z4[p][r]); } } } \
        asm volatile("" ::: "memory"); \
        const int r31 = lane & 31, hh = lane >> 5; \
        f32x16 X; _Pragma("unroll") for (int i = 0; i < 16; ++i) X[i] = 0.f; \
        _Pragma("unroll") for (int ks = 0; ks < 2; ++ks) X = __builtin_amdgcn_mfma_f32_32x32x16_bf16(ld8(Ab + (32 + r31) * 72 + 16 * ks + 8 * hh), ld8(DT1 + r31 * 40 + 16 * ks + 8 * hh), X, 0, 0, 0); \
        f32x16 Z; _Pragma("unroll") for (int i = 0; i < 16; ++i) Z[i] = 0.f; \
        _Pragma("unroll") for (int ks = 0; ks < 2; ++ks) { v4u pw; pw.x = cvt_pk_bf16(X[8 * ks + 0], X[8 * ks + 1]); pw.y = cvt_pk_bf16(X[8 * ks + 2], X[8 * ks + 3]); pw.z = cvt_pk_bf16(X[8 * ks + 4], X[8 * ks + 5]); pw.w = cvt_pk_bf16(X[8 * ks + 6], X[8 * ks + 7]); \
            const bf16* d2 = T + (32 + r31) * 72 + 32 + 16 * ks + 4 * hh; \
            Z = __builtin_amdgcn_mfma_f32_32x32x16_bf16(__builtin_bit_cast(bf16x8, pw), ld44(d2, d2 + 8), Z, 0, 0, 0); } \
        _Pragma("unroll") for (int g = 0; g < 4; ++g) st4(T + (32 + r31) * 72 + 8 * g + 4 * hh, -Z[4 * g], -Z[4 * g + 1], -Z[4 * g + 2], -Z[4 * g + 3]); } } while (0)
#define DP_S7() do { const bf16x8 ti0 = ld8(T + (16 * tr + l15) * 72 + 8 * q4), ti1 = ld8(T + (16 * tr + l15) * 72 + 32 + 8 * q4); \
        f32x4 wt[4]; \
        _Pragma("unroll") for (int dt = 0; dt < 4; ++dt) { wt[dt] = (f32x4){0.f, 0.f, 0.f, 0.f}; \
            wt[dt] = mfma16(ldtr8(KbT, 0, dt, lane), ti0, wt[dt]); wt[dt] = mfma16(ldtr8(KbT, 1, dt, lane), ti1, wt[dt]); } \
        v4u wa0, wa1; \
        wa0.x = cvt_pk_bf16(-wt[0][0], -wt[0][1]); wa0.y = cvt_pk_bf16(-wt[0][2], -wt[0][3]); wa0.z = cvt_pk_bf16(-wt[1][0], -wt[1][1]); wa0.w = cvt_pk_bf16(-wt[1][2], -wt[1][3]); \
        wa1.x = cvt_pk_bf16(-wt[2][0], -wt[2][1]); wa1.y = cvt_pk_bf16(-wt[2][2], -wt[2][3]); wa1.z = cvt_pk_bf16(-wt[3][0], -wt[3][1]); wa1.w = cvt_pk_bf16(-wt[3][2], -wt[3][3]); \
        _Pragma("unroll") for (int tcx = 0; tcx < 2; ++tcx) { const int e = 16 * (tc0 + tcx) + l15; \
            f32x4 u = (f32x4){0.f, 0.f, 0.f, 0.f}; \
            u = mfma16(ti0, ldtr8(VbT, 0, tc0 + tcx, lane), u); u = mfma16(ti1, ldtr8(VbT, 1, tc0 + tcx, lane), u); \
            const bf16* sp = St + e * 72 + 4 * q4; \
            u = mfma16(__builtin_bit_cast(bf16x8, wa0), ld44(sp, sp + 16), u); u = mfma16(__builtin_bit_cast(bf16x8, wa1), ld44(sp + 32, sp + 48), u); \
            st4(VnT + e * 72 + 16 * tr + 4 * q4, u[0], u[1], u[2], u[3]); } } while (0)
#define DP_S8(NB) do { const int nb_ = (NB); const float* vd_ = vec0 + (nb_ & 1) * 448; const bf16* Qn_ = Qn2 + (nb_ & 1) * 4608; const bf16* Kd_ = Kd2 + (nb_ & 1) * 4608; const int t0_ = DP_T0(nb_); \
        const bf16x8 sa0 = ld8(St + (16 * tr + l15) * 72 + 8 * q4), sa1 = ld8(St + (16 * tr + l15) * 72 + 32 + 8 * q4); \
        const bf16x8 va0 = ld8(VnT + (16 * tr + l15) * 72 + 8 * q4), va1 = ld8(VnT + (16 * tr + l15) * 72 + 32 + 8 * q4); \
        const bf16x8 ka0 = ldtr8(Kd_, 0, tr, lane), ka1 = ldtr8(Kd_, 1, tr, lane); \
        const float cd = vd_[256]; \
        _Pragma("unroll") for (int tcx = 0; tcx < 2; ++tcx) { const int i = 16 * (tc0 + tcx) + l15; \
            f32x4 o = (f32x4){0.f, 0.f, 0.f, 0.f}; \
            o = mfma16(sa0, ld8(Qn_ + i * 72 + 8 * q4), o); o = mfma16(sa1, ld8(Qn_ + i * 72 + 32 + 8 * q4), o); \
            o = o * vd_[64 + i]; \
            o = mfma16(va0, ld8(QKm + i * 72 + 8 * q4), o); o = mfma16(va1, ld8(QKm + i * 72 + 32 + 8 * q4), o); \
            const int t = t0_ + (dir ? 63 - i : i); \
            st4(OUT + ((size_t)b * SEQ + t) * 512 + h * 64 + 16 * tr + 4 * q4, o[0], o[1], o[2], o[3]); \
            const int e = 16 * (tc0 + tcx) + l15; \
            Sacc[tcx] = Sacc[tcx] * cd; Sacc[tcx] = mfma16(ka0, ld8(VnT + e * 72 + 8 * q4), Sacc[tcx]); Sacc[tcx] = mfma16(ka1, ld8(VnT + e * 72 + 32 + 8 * q4), Sacc[tcx]); } } while (0)
#define DP_STW() do { _Pragma("unroll") for (int tcx = 0; tcx < 2; ++tcx) { const int e = 16 * (tc0 + tcx) + l15; st4(St + e * 72 + 16 * tr + 4 * q4, Sacc[tcx][0], Sacc[tcx][1], Sacc[tcx][2], Sacc[tcx][3]); } } while (0)

    constexpr int NCK = SEQ / 64;
    DP_LANE(); DP_PREFETCH(0);
    __syncthreads();
    DP_S0(0);
    __syncthreads();
    DP_S1A(0); DP_S1B();
    __syncthreads();
    DP_LANE(); DP_S4(0); DP_S0(1);
    __syncthreads();
    DP_LANE(); DP_S5(); DP_S1A(1);
    __syncthreads();
#pragma nounroll
    for (int n = 0; n < NCK; ++n) {
        const bool has1 = n + 1 < NCK, has2 = n + 2 < NCK;
        DP_LANE(); DP_S7();
        __syncthreads();
        DP_LANE(); DP_S8(n); if (has1) DP_S1B();
        __syncthreads();
        DP_LANE(); DP_STW(); if (has1) DP_S4(n + 1); if (has2) DP_S0(n + 2);
        __syncthreads();
        DP_LANE(); if (has1) DP_S5(); if (has2) DP_S1A(n + 2);
        __syncthreads();
    }
#undef DP_LANE
#undef DP_T0
#undef DP_PREFETCH
#undef DP_S0
#undef DP_S1A
#undef DP_S1B
#undef DP_S4
#undef DP_S5
#undef DP_S7
#undef DP_S8
#undef DP_STW
}

constexpr int LN_CNT_OFF = LDSCTL_OFF + 512;
template <int MODE, bool W8 = false, bool G8 = false>
__device__ __forceinline__ void ln_phase(Frame& F, const float* gam, const float* bet) {
    float* out = F.out; bf16* HB = (bf16*)(F.ws + WS_HB);
    unsigned* lcnt = (unsigned*)(F.lds + LN_CNT_OFF);
    unsigned* TOKE = (unsigned*)(F.ws + WS_META + MT_TOKE); float* TOKP = (float*)(F.ws + WS_META + MT_TOKP); unsigned short* RANK = (unsigned short*)(F.ws + WS_META + MT_RANK);
    unsigned* CNT = (unsigned*)(F.ws + WS_META + MT_CNT); const bf16* YS = (const bf16*)(F.ws + WS_YS);
    const int lane = F.lane;
    if (MODE == 1) { if (F.tid < 8) lcnt[F.tid] = 0u; __syncthreads(); }
    f32x4 gv[4], bv[4];
#pragma unroll
    for (int j = 0; j < 4; ++j) { gv[j] = *(const f32x4*)(gam + lane * 4 + 256 * j); bv[j] = *(const f32x4*)(bet + lane * 4 + 256 * j); }
    v2u nx[2][4];
    { const bf16* h0 = HB + ((size_t)F.bx * 128 + F.wave * 16) * 1024 + lane * 4;
#pragma unroll
        for (int u = 0; u < 2; ++u)
#pragma unroll
            for (int j = 0; j < 4; ++j) nx[u][j] = *(const v2u*)(h0 + u * 1024 + 256 * j); }
    for (int i2 = 0; i2 < 16; i2 += 2) {
      v2u cur[2][4];
#pragma unroll
      for (int u = 0; u < 2; ++u)
#pragma unroll
          for (int j = 0; j < 4; ++j) cur[u][j] = nx[u][j];
      if (i2 + 2 < 16) { const bf16* h0 = HB + ((size_t)F.bx * 128 + F.wave * 16 + i2 + 2) * 1024 + lane * 4;
#pragma unroll
          for (int u = 0; u < 2; ++u)
#pragma unroll
              for (int j = 0; j < 4; ++j) nx[u][j] = *(const v2u*)(h0 + u * 1024 + 256 * j); }
#pragma unroll
      for (int u = 0; u < 2; ++u) {
        const int i = i2 + u;
        const size_t m = (size_t)F.bx * 128 + F.wave * 16 + i;
        float* zr = out + m * 1024 + lane * 4; bf16* hr = HB + m * 1024 + lane * 4;
        f32x4 v[4];
#pragma unroll
        for (int j = 0; j < 4; ++j) v[j] = (f32x4){bflo(cur[u][j].x), bfhi(cur[u][j].x), bflo(cur[u][j].y), bfhi(cur[u][j].y)};
        if (MODE == 2) {
            const float p1 = (ABL == 5) ? 0.f : TOKP[m * 2], p2 = (ABL == 5) ? 0.f : TOKP[m * 2 + 1];
            const bf16* y1 = YS + m * 2048 + lane * 4; const bf16* y2 = y1 + 1024;
#pragma unroll
            for (int j = 0; j < 4; ++j) { const v2u a = *(const v2u*)(y1 + 256 * j), b = *(const v2u*)(y2 + 256 * j);
                v[j][0] = v[j][0] * ALPHA + p1 * bflo(a.x) + p2 * bflo(b.x); v[j][1] = v[j][1] * ALPHA + p1 * bfhi(a.x) + p2 * bfhi(b.x);
                v[j][2] = v[j][2] * ALPHA + p1 * bflo(a.y) + p2 * bflo(b.y); v[j][3] = v[j][3] * ALPHA + p1 * bfhi(a.y) + p2 * bfhi(b.y); }
        }
        float s = 0.f;
#pragma unroll
        for (int j = 0; j < 4; ++j) s += (v[j][0] + v[j][1]) + (v[j][2] + v[j][3]);
        const float mean = wave_sum(s) * (1.0f / 1024.0f);
        float q = 0.f;
#pragma unroll
        for (int j = 0; j < 4; ++j) { v[j] = v[j] - mean; q += (v[j][0] * v[j][0] + v[j][1] * v[j][1]) + (v[j][2] * v[j][2] + v[j][3] * v[j][3]); }
        const float rstd = __builtin_amdgcn_rsqf(wave_sum(q) * (1.0f / 1024.0f) + LN_EPS);
#pragma unroll
        for (int j = 0; j < 4; ++j) { v[j] = v[j] * rstd * gv[j] + bv[j]; if (MODE == 2) *(f32x4*)(zr + 256 * j) = v[j]; }
        if (MODE != 2) {
#pragma unroll
            for (int j = 0; j < 4; ++j) { v2u w; w.x = pk2(v[j][0], v[j][1]); w.y = pk2(v[j][2], v[j][3]); *(v2u*)(hr + 256 * j) = w; }
        }
        if (G8) { unsigned char* h8 = F.ws + WS_HBG8 + m * 1024 + lane * 4;
#pragma unroll
            for (int j = 0; j < 4; ++j) *(unsigned*)(h8 + 256 * j) = pk4_fp8(v[j][0], v[j][1], v[j][2], v[j][3]); }
        if (W8) { unsigned char* h8 = F.ws + WS_HB8 + m * 1024 + lane * 4;
#pragma unroll
            for (int j = 0; j < 4; ++j) *(unsigned*)(h8 + 256 * j) = pk4_fp8(v[j][0], v[j][1], v[j][2], v[j][3]); }
        if (MODE == 1) {
            float lg[8];
#pragma unroll
            for (int e = 0; e < 8; ++e) lg[e] = 0.f;
#pragma unroll
            for (int j = 0; j < 4; ++j)
#pragma unroll
                for (int c = 0; c < 4; ++c) { const float* rw = IN_router_w(F) + (size_t)(lane * 4 + 256 * j + c) * 8; const f32x4 r0 = *(const f32x4*)rw, r1 = *(const f32x4*)(rw + 4); const float hv = v[j][c];
                    lg[0] += hv * r0[0]; lg[1] += hv * r0[1]; lg[2] += hv * r0[2]; lg[3] += hv * r0[3]; lg[4] += hv * r1[0]; lg[5] += hv * r1[1]; lg[6] += hv * r1[2]; lg[7] += hv * r1[3]; }
#pragma unroll
            for (int e = 0; e < 8; ++e) lg[e] = wave_sum(lg[e]);
            int e1 = 0; float l1 = lg[0];
#pragma unroll
            for (int e = 1; e < 8; ++e) if (lg[e] > l1) { l1 = lg[e]; e1 = e; }
            int e2 = -1; float l2 = -3.0e38f;
#pragma unroll
            for (int e = 0; e < 8; ++e) if (e != e1 && lg[e] > l2) { l2 = lg[e]; e2 = e; }
            if (lane == 0) {
                const float p1 = 1.0f / (1.0f + __expf(l2 - l1));
                TOKE[m] = (unsigned)e1 | ((unsigned)e2 << 8); TOKP[m * 2] = p1; TOKP[m * 2 + 1] = 1.0f - p1; (F.ws + WS_META + MT_DEFER)[m] = 0;
                RANK[m * 2] = (unsigned short)atomicAdd(&lcnt[e1], 1u); RANK[m * 2 + 1] = (unsigned short)atomicAdd(&lcnt[e2], 1u);
            }
        }
      }
    }
    if (MODE == 1) { __syncthreads(); if (F.tid < 8) CNT[F.bx * 8 + F.tid] = lcnt[F.tid]; }
}

constexpr int MT_BASE = 288, MT_TOT = 304, MT_NT = 312, MT_PRE = 320;
constexpr int TAIL_U0 = 512, TAIL_ROW0 = (CHT * (NCH - 1) + TAIL_U0 / 4) * 256;
__device__ __forceinline__ void moe_meta(Frame& F, int ln_wg  ) {
    int* mt = (int*)(F.lds + MOE_LDS_OFF); const unsigned* CNT = (const unsigned*)(F.ws + WS_META + MT_CNT);
    __syncthreads();
    { const int e = F.wave; int tot = 0, pre = 0;
#pragma unroll
        for (int k = 0; k < 4; ++k) { const int w = F.lane + 64 * k; const int v = (int)CNT[w * 8 + e]; tot += v; if (w < ln_wg) pre += v; }
#pragma unroll
        for (int o = 1; o < 64; o <<= 1) { tot += __shfl_xor(tot, o); pre += __shfl_xor(pre, o); }
        if (F.lane == 0) { mt[MT_TOT + e] = tot; mt[MT_PRE + e] = pre; } }
    __syncthreads();
    if (F.tid == 0) { int base = 0;
        for (int e = 0; e < 8; ++e) { mt[MT_BASE + e] = base; const int nt = (mt[MT_TOT + e] + 255) >> 8; for (int t = 0; t < nt; ++t) mt[(base >> 8) + t] = e; base += nt << 8; }
        mt[MT_BASE + 8] = base; mt[MT_NT] = base >> 8; }
    __syncthreads();
}
__device__ __forceinline__ int moe_chunk_tiles(const int* mt, int c) { return c < NCH - 1 ? CHT : mt[MT_NT] - CHT * (NCH - 1); }
__device__ __forceinline__ void moe_gather(Frame& F, int c) {
    if (MK_PER_PHASE || c == 0) moe_meta(F, F.bx);
    const int* mt = (const int*)(F.lds + MOE_LDS_OFF);
    const unsigned* TOKE = (const unsigned*)(F.ws + WS_META + MT_TOKE); const unsigned short* RANK = (const unsigned short*)(F.ws + WS_META + MT_RANK);
    unsigned* ROWMAP = (unsigned*)(F.ws + WS_META + MT_ROWMAP);
    const bf16* HB = (const bf16*)(F.ws + WS_HB); bf16* XG = (bf16*)(F.ws + WS_XG);
    const int lane = F.lane, li = lane & 31; const size_t mbase = (size_t)F.bx * 128 + F.wave * 16;
    int pos; bool mine;
    { const size_t m = mbase + (li >> 1); const int slot = li & 1;
        const int e = (int)((TOKE[m] >> (8 * slot)) & 0xffu);
        pos = mt[MT_BASE + e] + mt[MT_PRE + e] + (int)RANK[m * 2 + slot];
        int cc = pos / (CHT * 256); if (cc > NCH - 1) cc = NCH - 1;
        mine = lane < 32 && cc == c;
        if (mine) { ROWMAP[pos] = (unsigned)(m * 2 + slot); if (c == NCH - 1 && pos >= TAIL_ROW0) (F.ws + WS_META + MT_DEFER)[m] = 1; } }
    unsigned mask = (unsigned)__ballot(mine);
    while (mask) {
        int id[4];
#pragma unroll
        for (int k = 0; k < 4; ++k) { if (mask) { id[k] = __builtin_ctz(mask); mask &= mask - 1u; } else id[k] = -1; }
        v4u a[4], b[4];
#pragma unroll
        for (int k = 0; k < 4; ++k) if (id[k] >= 0) { const bf16* src = HB + (mbase + (id[k] >> 1)) * 1024 + lane * 16; a[k] = *(const v4u*)src; b[k] = *(const v4u*)(src + 8); }
#pragma unroll
        for (int k = 0; k < 4; ++k) if (id[k] >= 0) {
            const size_t lr = (size_t)(__builtin_amdgcn_readlane(pos, id[k]) - CHT * 256 * c);
            if (MOE_FP8) { f32x4 t0, t1, t2, t3; unpack8(a[k], t0, t1); unpack8(b[k], t2, t3);
                v4u o; o.x = pk4_fp8(t0[0], t0[1], t0[2], t0[3]); o.y = pk4_fp8(t1[0], t1[1], t1[2], t1[3]); o.z = pk4_fp8(t2[0], t2[1], t2[2], t2[3]); o.w = pk4_fp8(t3[0], t3[1], t3[2], t3[3]);
                *(v4u*)((unsigned char*)XG + lr * 1024 + lane * 16) = o; }
            else { *(v4u*)(XG + lr * 1024 + lane * 16) = a[k]; *(v4u*)(XG + lr * 1024 + lane * 16 + 8) = b[k]; }
        }
    }
}
template <int PASS>
__device__ __forceinline__ void ln_final(Frame& F, const float* gam, const float* bet, int nskip) {
    float* out = F.out; const bf16* HB = (const bf16*)(F.ws + WS_HB);
    const float* TOKP = (const float*)(F.ws + WS_META + MT_TOKP); const bf16* YS = (const bf16*)(F.ws + WS_YS); const unsigned char* DEFER = F.ws + WS_META + MT_DEFER;
    const int lane = F.lane;
    f32x4 gv[4], bv[4];
#pragma unroll
    for (int j = 0; j < 4; ++j) { gv[j] = *(const f32x4*)(gam + lane * 4 + 256 * j); bv[j] = *(const f32x4*)(bet + lane * 4 + 256 * j); }
    int r0, r1; unsigned long long dmask = 0ull;
    if (PASS == 1) { const int nw = (F.G - nskip) * NWAVES, wv = (F.bx - nskip) * NWAVES + F.wave; r0 = (int)(((long)wv * M) / nw); r1 = (int)(((long)(wv + 1) * M) / nw); }
    else { r0 = F.bx * 128 + F.wave * 16; r1 = r0 + 16; dmask = __ballot(lane < 16 && DEFER[r0 + (lane & 15)] != 0); }
    v2u nx[4], ny1[4], ny2[4]; unsigned nfl = 0u; float np1 = 0.f, np2 = 0.f;
    if (PASS == 1 && r0 < r1) { const bf16* h0 = HB + (size_t)r0 * 1024 + lane * 4; const bf16* y0 = YS + (size_t)r0 * 2048 + lane * 4; nfl = DEFER[r0]; np1 = TOKP[(size_t)r0 * 2]; np2 = TOKP[(size_t)r0 * 2 + 1];
#pragma unroll
        for (int j = 0; j < 4; ++j) { nx[j] = *(const v2u*)(h0 + 256 * j); ny1[j] = *(const v2u*)(y0 + 256 * j); ny2[j] = *(const v2u*)(y0 + 1024 + 256 * j); } }
    for (int m_ = r0; m_ < r1; ++m_) {
        const size_t m = (size_t)m_;
        float* zr = out + m * 1024 + lane * 4; const bf16* hr = HB + m * 1024 + lane * 4;
        const bf16* y1 = YS + m * 2048 + lane * 4; const bf16* y2 = y1 + 1024;
        f32x4 v[4]; v2u ya[4], yb[4]; float p1, p2; bool skip;
        if (PASS == 1) {
#pragma unroll
            for (int j = 0; j < 4; ++j) { v[j] = (f32x4){bflo(nx[j].x), bfhi(nx[j].x), bflo(nx[j].y), bfhi(nx[j].y)}; ya[j] = ny1[j]; yb[j] = ny2[j]; }
            p1 = np1; p2 = np2;
            skip = __builtin_amdgcn_readfirstlane(nfl) != 0u;
            if (m_ + 1 < r1) { nfl = DEFER[m + 1]; np1 = TOKP[m * 2 + 2]; np2 = TOKP[m * 2 + 3];
#pragma unroll
                for (int j = 0; j < 4; ++j) { nx[j] = *(const v2u*)(hr + 1024 + 256 * j); ny1[j] = *(const v2u*)(y1 + 2048 + 256 * j); ny2[j] = *(const v2u*)(y2 + 2048 + 256 * j); } }
        } else {
            skip = ((dmask >> (m_ - r0)) & 1ull) == 0ull;
            if (!skip) { p1 = TOKP[m * 2]; p2 = TOKP[m * 2 + 1];
#pragma unroll
                for (int j = 0; j < 4; ++j) { const v2u w = *(const v2u*)(hr + 256 * j); v[j] = (f32x4){bflo(w.x), bfhi(w.x), bflo(w.y), bfhi(w.y)}; ya[j] = *(const v2u*)(y1 + 256 * j); yb[j] = *(const v2u*)(y2 + 256 * j); } }
        }
        if (skip) continue;
        if (ABL == 5) { p1 = 0.f; p2 = 0.f; }
#pragma unroll
        for (int j = 0; j < 4; ++j) { const v2u a = ya[j], b = yb[j];
            v[j][0] = v[j][0] * ALPHA + p1 * bflo(a.x) + p2 * bflo(b.x); v[j][1] = v[j][1] * ALPHA + p1 * bfhi(a.x) + p2 * bfhi(b.x);
            v[j][2] = v[j][2] * ALPHA + p1 * bflo(a.y) + p2 * bflo(b.y); v[j][3] = v[j][3] * ALPHA + p1 * bfhi(a.y) + p2 * bfhi(b.y); }
        float s = 0.f;
#pragma unroll
        for (int j = 0; j < 4; ++j) s += (v[j][0] + v[j][1]) + (v[j][2] + v[j][3]);
        const float mean = wave_sum(s) * (1.0f / 1024.0f);
        float q = 0.f;
#pragma unroll
        for (int j = 0; j < 4; ++j) { v[j] = v[j] - mean; q += (v[j][0] * v[j][0] + v[j][1] * v[j][1]) + (v[j][2] * v[j][2] + v[j][3] * v[j][3]); }
        const float rstd = __builtin_amdgcn_rsqf(wave_sum(q) * (1.0f / 1024.0f) + LN_EPS);
#pragma unroll
        for (int j = 0; j < 4; ++j) { v[j] = v[j] * rstd * gv[j] + bv[j]; *(f32x4*)(zr + 256 * j) = v[j]; }
    }
}
struct MoeSched {
    int G, c, NJ, nunits, t0; const int* mt; const char* A; const char* B; size_t tsA, tsB; int off = 0;
    __device__ __forceinline__ bool next(int i, Unit& u) const { const int L = i * G + c + off; if (L >= nunits) return false; u.pm = L / NJ; u.aux = L - u.pm * NJ; u.pn = mt[t0 + u.pm] * NJ + u.aux; return true; }
    __device__ __forceinline__ const char* abase(const Unit& u) const { return A + (size_t)u.pm * tsA; }
    __device__ __forceinline__ const char* bbase(const Unit& u) const { return B + (size_t)u.pn * tsB; }
};
struct EpiMoeDown {
    static constexpr bool PERM = true;
    bf16* YS; const unsigned* rowmap; const int* mt; int t0;
    __device__ __forceinline__ void operator()(acc_t& acc, const Unit& u, int wr, int wc, int fr, int fq) const {
        const int tg = t0 + u.pm, e = mt[tg], lim = mt[MT_BASE + e] + mt[MT_TOT + e]; const int row0 = tg * 256 + wr * 64 + fr; const int col = u.aux * 256 + wc * 32 + 8 * fq;
#pragma unroll
        for (int ai = 0; ai < 2; ++ai)
#pragma unroll
            for (int m = 0; m < 4; ++m) { const int r = row0 + ai * 128 + m * 16;
                if (r < lim) { const size_t pr = rowmap[r]; bf16* dst = YS + pr * 1024 + col;
                    const float ds = (FP8_EMU || MOE_FP8) ? (1.0f / 32.0f) : 1.0f;
                    *(v4u*)(dst) = pack8(acc[ai][0][m][0] * ds, acc[ai][0][m][1] * ds); *(v4u*)(dst + 128) = pack8(acc[ai][1][m][0] * ds, acc[ai][1][m][1] * ds); } }
        zero_acc(acc);
    }
};

__global__ void __launch_bounds__(NTHR, 2) fwd_kernel(Args args) {
    extern __shared__ __attribute__((aligned(16))) unsigned char lds[];
    Frame F0;
    F0.lds = lds;
    F0.tid = threadIdx.x; F0.lane = F0.tid & 63; F0.wave = __builtin_amdgcn_readfirstlane(F0.tid >> 6);
    F0.G = gridDim.x; F0.bx = blockIdx.x;
    F0.ws = args.ws; F0.out = args.out;
    F0.a = &args;
    { LAS unsigned char* ldsl0 = (LAS unsigned char*)lds;
    for (int u = F0.tid; u < (LDS_BYTES - LDSCTL_OFF) / 4; u += NTHR) ((LAS unsigned*)(ldsl0 + LDSCTL_OFF))[u] = 0u; }
    __syncthreads();
    unsigned* ctl = (unsigned*)(F0.ws + WS_CTL);
    XcdBarrier bar; bar.bar = ctl + CW_BAR; bar.x = 0; bar.st = nullptr; bar.w0 = 0;
    if (!MK_PER_PHASE) bar = xcd_barrier_post(ctl + CW_BAR, (volatile LAS unsigned*)((LAS unsigned char*)lds + MISC_OFF) + 8);
    const int lo = args.ph_lo, hi = args.ph_hi;
#ifndef PHASE_MASK
#define PHASE_MASK 0xFFFFFFFFu
#endif
#define EN(b) (((PHASE_MASK) >> (b)) & 1u)
#ifndef SP2K
#define SP2K 0
#endif
#ifndef ALN
#define ALN 14
#endif
#ifndef DBL
#define DBL 0
#endif
#define REP(k) for (int rep_ = 0; rep_ < ((DBL) == (k) ? 2 : 1); ++rep_)
#define IN(k) (lo <= (k) && (k) < hi)
#define GRID_BAR() do { if (!MK_PER_PHASE) xcd_barrier(bar); } while (0)
#define PH_BEGIN() Frame P = F0; asm volatile("" : "+s"(P.ws), "+s"(P.out), "+s"(P.G), "+s"(P.bx)); P.lane = (int)__builtin_amdgcn_mbcnt_hi(~0u, __builtin_amdgcn_mbcnt_lo(~0u, 0u)); asm volatile("" : "+v"(P.lane)); P.tid = P.wave * 64 + P.lane; Frame& F = P; LAS unsigned char* ldsl = (LAS unsigned char*)P.lds;

    if (EN(0) && IN(0)) { PH_BEGIN(); REP(100) p0_prologue(F); }
    GRID_BAR();
#if defined(XBAR)
    for (int xb_ = 0; xb_ < XBAR; ++xb_) GRID_BAR();
#endif

#pragma nounroll
    for (int layer = 0; layer < 2; ++layer) {
        const int pb = 1 + 40 * layer;
        if (EN(1) && IN(pb + 0)) { PH_BEGIN(); const bf16* HB = (const bf16*)(F.ws + WS_HB); const bf16* WIN = (const bf16*)(F.ws + WS_WIN) + (size_t)layer * WIN_ROWS * 1024;
            pg8::StdSched S; S.init(HB, WIN, M, NA, 1024, F.G, F.bx);
            EpiInA E{F.ws};
            REP(1) pg8::gemm_phase<EpiInA, pg8::StdSched, (ALN & 8) == 0, true>(ldsl + RING_OFF, 1024, S, E, F.wave);
        }
        GRID_BAR();
        if (EN(2) && IN(pb + 1)) { PH_BEGIN();
#if defined(DELTA_RECURRENT)
            REP(21) for (int s = F.bx; s < 256; s += F.G) delta_seq(F, layer, s);
#else
#if defined(DELTA_NOPIPE)
            REP(21) for (int s = F.bx; s < 256; s += F.G) delta_seq_chunked(F, layer, s);
#else
            REP(21) for (int s = F.bx; s < 256; s += F.G) delta_seq_pipe(F, layer, s);
#endif
#endif
            __syncthreads();
            attn_bias_setup(F);
            if (DBL == 22) attn_phase(F, layer, (bf16*)(F.ws + WS_OP));
            attn_phase(F, layer, nullptr);
            REP(23) for (int u = F.bx; u < 1024; u += F.G) pool_unit(F, layer, u);
        }
        GRID_BAR();
        if (EN(3) && IN(pb + 20)) { PH_BEGIN(); delta_post(F, layer); }
        if (EN(3) && IN(pb + 2)) { PH_BEGIN(); const bf16* HB = (const bf16*)(F.ws + WS_HB); const bf16* WIN = (const bf16*)(F.ws + WS_WIN) + (size_t)layer * WIN_ROWS * 1024;
#if GATES_FP8
            pg8::StdSched S; S.init(F.ws + WS_HBG8, WIN + (size_t)NA * 1024, M, NG, 512, F.G, F.bx); (void)HB;
            EpiGates E{(bf16*)(F.ws + WS_GT), 1.0f / 32.0f};
            REP(3) pg8::gemm_phase<EpiGates, pg8::StdSched, (ALN & 2) == 0, (SP2K & 2) == 0, true>(ldsl + RING_OFF, 512, S, E, F.wave);
#else
            pg8::StdSched S; S.init(HB, WIN + (size_t)NA * 1024, M, NG, 1024, F.G, F.bx);
            EpiGates E{(bf16*)(F.ws + WS_GT), 1.0f};
            REP(3) pg8::gemm_phase<EpiGates, pg8::StdSched, true, true>(ldsl + RING_OFF, 1024, S, E, F.wave);
#endif
        }
        GRID_BAR();
        if (EN(4) && IN(pb + 3)) { PH_BEGIN();
#if defined(BRSKEW)
            if (F.bx & 1) { for (int i_ = 0; i_ < BRSKEW; ++i_) __builtin_amdgcn_s_sleep(127); }
#endif
            BrSched S; S.o.init(M / 256, 4, F.G, F.bx); S.A0 = (const char*)(F.ws + WS_AQ); static_assert(WS_DZ == WS_AQ + 32 * MiB && WS_OP == WS_AQ + 64 * MiB, "branch planes");
            S.B0 = (const char*)(F.ws + WS_WBR) + (size_t)layer * 3 * 1024 * 512 * 2; S.tstep = (size_t)256 * 512 * 2;
#if defined(BR_RMW)
            EpiBranchRMW E{(const bf16*)(F.ws + WS_GT), (bf16*)(F.ws + WS_MERGED)};
            pg8::gemm_phase<EpiBranchRMW, BrSched, false, true>(ldsl + RING_OFF, 512, S, E, F.wave);
#else
            EpiBranch E{(const bf16*)(F.ws + WS_GT), (bf16*)(F.ws + WS_MERGED)};
            REP(4) pg8::gemm_phase<EpiBranch, BrSched, (ALN & 16) == 0, true>(ldsl + RING_OFF, 512, S, E, F.wave);
#endif
        }
        GRID_BAR();
        if (EN(5) && IN(pb + 4)) { PH_BEGIN();
            pg8::StdSched S; S.init(F.ws + WS_MERGED, (const bf16*)(F.ws + WS_WOUT) + (size_t)layer * 1024 * 1024, M, 1024, 1024, F.G, F.bx);
#if (LN_FUSE & 1)
            if (layer == 0) { EpiResidLN<0, false, 0> E{F.ws, F.a, ldsl, 1.0f};
                pg8::gemm_phase<EpiResidLN<0, false, 0>, pg8::StdSched, true, true>(ldsl + RING_OFF, 1024, S, E, F.wave); }
            else
#endif
            { EpiResid E{(bf16*)(F.ws + WS_HB), 1.0f};
            pg8::gemm_phase<EpiResid, pg8::StdSched, (ALN & 32) == 0, true>(ldsl + RING_OFF, 1024, S, E, F.wave); }
        }
        GRID_BAR();
        if (EN(6) && IN(pb + 5) && !((LN_FUSE & 1) && layer == 0)) { PH_BEGIN();
            if (layer == 0) ln_phase<0, FFN_FP8 == 1 || FFN_FP8 == 2>(F, IN_ln1_g(F), IN_ln1_b(F));
            else { ln_phase<1>(F, IN_ln1_g(F) + 1024, IN_ln1_b(F) + 1024); REP(101) moe_weight_convert(F); }
        }
        if (!((LN_FUSE & 1) && layer == 0)) GRID_BAR();
        if (layer == 0) {
            if (EN(7) && IN(pb + 6)) { PH_BEGIN(); const bf16* HB = (const bf16*)(F.ws + WS_HB);
#if FFN_FP8 == 2
                FfnUpSched S; S.o.init(M / 256, FF / 128, F.G, F.bx); S.A = (const char*)(F.ws + WS_HB8); S.Bt = (const char*)(F.ws + WS_W13); S.tstep = (size_t)256 * 1024; (void)HB;
                EpiSwiglu E{(bf16*)(F.ws + WS_FACT), FF, 1.0f / 32.0f, 0};
                REP(7) pg8::gemm_phase<EpiSwiglu, FfnUpSched, true, true, true>(ldsl + RING_OFF, 512, S, E, F.wave);
#elif FFN_FP8 == 1
                FfnUpSched S; S.o.init(M / 256, FF / 128, F.G, F.bx); S.A = (const char*)(F.ws + WS_HB8); S.Bt = (const char*)(F.ws + WS_W13); S.tstep = (size_t)256 * 1024; (void)HB;
                EpiSwiglu8 E{(unsigned char*)(F.ws + WS_FACT), FF, 1.0f / 32.0f};
                REP(7) pg8::gemm_phase<EpiSwiglu8, FfnUpSched, true, true, true>(ldsl + RING_OFF, 512, S, E, F.wave);
#elif FFN_FP8 == 3
                FfnUpSched S; S.o.init(M / 256, FF / 128, F.G, F.bx); S.A = (const char*)HB; S.Bt = (const char*)(F.ws + WS_W13); S.tstep = (size_t)256 * 1024 * 2;
                EpiSwiglu8 E{(unsigned char*)(F.ws + WS_FACT), FF, 1.0f};
                REP(7) pg8::gemm_phase<EpiSwiglu8, FfnUpSched, (ALN & 4) == 0, true>(ldsl + RING_OFF, 1024, S, E, F.wave);
#else
                FfnUpSched S; S.o.init(M / 256, FF / 128, F.G, F.bx); S.A = (const char*)HB; S.Bt = (const char*)(F.ws + WS_W13); S.tstep = (size_t)256 * 1024 * 2;
                EpiSwiglu E{(bf16*)(F.ws + WS_FACT), FF, 1.0f, 0};
                REP(7) pg8::gemm_phase<EpiSwiglu, FfnUpSched, (ALN & 4) == 0, true>(ldsl + RING_OFF, 1024, S, E, F.wave);
#endif
            }
            GRID_BAR();
            if (EN(8) && IN(pb + 7)) { PH_BEGIN();
#if FFN_FP8 == 1 || FFN_FP8 == 3
                pg8::StdSched S; S.init(F.ws + WS_FACT, F.ws + WS_W2, M, 1024, FF / 2, F.G, F.bx);
#if (LN_FUSE & 2)
                EpiResidLN<1, GATES_FP8 != 0, 1> E{F.ws, F.a, ldsl, (ABL == 4) ? 0.f : (1.0f / 32.0f)};
                pg8::gemm_phase<EpiResidLN<1, GATES_FP8 != 0, 1>, pg8::StdSched, true, true, true>(ldsl + RING_OFF, FF / 2, S, E, F.wave);
#else
                EpiResid E{(bf16*)(F.ws + WS_HB), (ABL == 4) ? 0.f : (1.0f / 32.0f)};
                pg8::gemm_phase<EpiResid, pg8::StdSched, true, true, true>(ldsl + RING_OFF, FF / 2, S, E, F.wave);
#endif
#else
                pg8::StdSched S; S.init(F.ws + WS_FACT, F.ws + WS_W2, M, 1024, FF, F.G, F.bx);
                EpiResid E{(bf16*)(F.ws + WS_HB), (ABL == 4) ? 0.f : 1.0f};
                pg8::gemm_phase<EpiResid, pg8::StdSched, (ALN & 64) == 0, true>(ldsl + RING_OFF, FF, S, E, F.wave);
#endif
            }
            GRID_BAR();
#if !((LN_FUSE & 2) && (FFN_FP8 == 1 || FFN_FP8 == 3))
            if (EN(9) && IN(pb + 8)) { PH_BEGIN(); ln_phase<0, false, GATES_FP8 != 0>(F, IN_ln2_g(F), IN_ln2_b(F)); }
            GRID_BAR();
#endif
        } else {
            if (EN(10) && IN(pb + 6)) { PH_BEGIN(); moe_gather(F, 0); }
            GRID_BAR();
#pragma nounroll
            for (int c = 0; c < NCH; ++c) {
                if (EN(11) && IN(pb + 7 + 2 * c)) { PH_BEGIN(); const int* mt = (const int*)(F.lds + MOE_LDS_OFF);
                    if (MK_PER_PHASE) moe_meta(F, -1);
                    MoeSched S; S.G = F.G; S.c = F.bx; S.NJ = FFE / 128; S.t0 = CHT * c; S.nunits = moe_chunk_tiles(mt, c) * S.NJ; S.mt = mt; S.A = (const char*)(F.ws + WS_XG); S.B = (const char*)(F.ws + WS_MWGU);
                    S.tsA = (size_t)256 * 1024 * (MOE_FP8 ? 1 : 2); S.tsB = S.tsA;
#if MOE_FP8
                    EpiSwiglu8 E{(unsigned char*)(F.ws + WS_MACT), FFE, 1.0f / 32.0f};
                    REP(11) pg8::gemm_phase<EpiSwiglu8, MoeSched, (ALN & 1) == 0, (SP2K & 1) == 0, true>(ldsl + RING_OFF, 512, S, E, F.wave);
#else
                    EpiSwiglu E{(bf16*)(F.ws + WS_MACT), FFE, FP8_EMU ? (1.0f / 32.0f) : 1.0f, FP8_EMU};
                    REP(11) pg8::gemm_phase<EpiSwiglu, MoeSched, true, true>(ldsl + RING_OFF, 1024, S, E, F.wave);
#endif
                }
                GRID_BAR();
                if (EN(12) && IN(pb + 8 + 2 * c)) { PH_BEGIN(); const int* mt = (const int*)(F.lds + MOE_LDS_OFF);
                    if (MK_PER_PHASE) moe_meta(F, -1);
                    MoeSched S; S.G = F.G; S.c = F.bx; S.NJ = 4; S.t0 = CHT * c; S.nunits = moe_chunk_tiles(mt, c) * 4; if (c == NCH - 1 && S.nunits > TAIL_U0) S.nunits = TAIL_U0; S.mt = mt; S.A = (const char*)(F.ws + WS_MACT); S.B = (const char*)(F.ws + WS_MWD);
                    S.tsA = (size_t)256 * FFE * (MOE_FP8 ? 1 : 2); S.tsB = S.tsA;
                    EpiMoeDown E{(bf16*)(F.ws + WS_YS), (const unsigned*)(F.ws + WS_META + MT_ROWMAP), mt, CHT * c};
#if MOE_FP8
                    REP(12) pg8::gemm_phase<EpiMoeDown, MoeSched, (ALN & 128) == 0, (SP2K & 4) == 0, true>(ldsl + RING_OFF, FFE / 2, S, E, F.wave);
#else
                    REP(12) pg8::gemm_phase<EpiMoeDown, MoeSched, true, true>(ldsl + RING_OFF, FFE, S, E, F.wave);
#endif
                }
                if (EN(12) && IN(pb + 8 + 2 * c) && c + 1 < NCH) { PH_BEGIN(); moe_gather(F, c + 1); }
                GRID_BAR();
            }
            if (EN(13) && IN(pb + 13)) { PH_BEGIN(); const int* mt = (const int*)(F.lds + MOE_LDS_OFF);
                if (MK_PER_PHASE) moe_meta(F, -1);
                const int total = moe_chunk_tiles(mt, NCH - 1) * 4, ntail = total > TAIL_U0 ? total - TAIL_U0 : 0;
                if (F.bx < ntail) {
                    MoeSched S; S.G = F.G; S.c = F.bx; S.NJ = 4; S.t0 = CHT * (NCH - 1); S.nunits = total; S.off = TAIL_U0; S.mt = mt; S.A = (const char*)(F.ws + WS_MACT); S.B = (const char*)(F.ws + WS_MWD);
                    S.tsA = (size_t)256 * FFE * (MOE_FP8 ? 1 : 2); S.tsB = S.tsA;
                    EpiMoeDown E{(bf16*)(F.ws + WS_YS), (const unsigned*)(F.ws + WS_META + MT_ROWMAP), mt, CHT * (NCH - 1)};
#if MOE_FP8
                    pg8::gemm_phase<EpiMoeDown, MoeSched, true, true, true>(ldsl + RING_OFF, FFE / 2, S, E, F.wave);
#else
                    pg8::gemm_phase<EpiMoeDown, MoeSched, true, true>(ldsl + RING_OFF, FFE, S, E, F.wave);
#endif
                } else ln_final<1>(F, IN_ln2_g(F) + 1024, IN_ln2_b(F) + 1024, ntail);
            }
            GRID_BAR();
            if (EN(13) && IN(pb + 15)) { PH_BEGIN(); ln_final<2>(F, IN_ln2_g(F) + 1024, IN_ln2_b(F) + 1024, 0); }
        }
    }
#undef IN
#undef GRID_BAR
}


#if defined(DBG_CHECK)
constexpr int CK_BASE = 512;
__device__ __forceinline__ unsigned ck_hash(unsigned x) { x ^= x >> 16; x *= 0x7feb352du; x ^= x >> 15; x *= 0x846ca68bu; x ^= x >> 16; return x; }
__device__ __forceinline__ void ck_record(unsigned* ctl, int stage, float mine, float ref) {
    const float e = fabsf(mine - ref), r = fabsf(ref);
    atomicMax(ctl + CK_BASE + 2 * stage, __float_as_uint(e == e ? e : 1e30f)); atomicMax(ctl + CK_BASE + 2 * stage + 1, __float_as_uint(r));
}
__device__ __forceinline__ float ck_dot(const bf16* a, int K, const float* w, int ldw) { float s = 0.f; for (int k = 0; k < K; ++k) s += bf2f(a[k]) * w[(size_t)k * ldw]; return s; }
__global__ void __launch_bounds__(256) check_kernel(Args args, int stage, int layer) {
    unsigned char* ws = args.ws; unsigned* ctl = (unsigned*)(ws + WS_CTL);
    const bf16* HB = (const bf16*)(ws + WS_HB);
    const int gt = blockIdx.x * 256 + threadIdx.x;
    const unsigned hsh = ck_hash((unsigned)gt * 2654435761u + 12345u * stage);
    if (stage == 1) {
        const int r = hsh % M; int c = (hsh >> 15) % 3328; if (c >= 2816) c += 32;
        const float ref = ck_dot(HB + (size_t)r * 1024, 1024, args.in[1] + (size_t)layer * 1024 * IN_COLS + c, IN_COLS);
        float mine;
        if (c < 512) mine = bf2f(((const bf16*)(ws + WS_AQ))[(size_t)r * 512 + c]);
        else if (c < 640) mine = bf2f(((const bf16*)(ws + WS_AK))[(size_t)r * 128 + c - 512]);
        else if (c < 768) mine = bf2f(((const bf16*)(ws + WS_AV))[(size_t)r * 128 + c - 640]);
        else if (c < 2304) mine = bf2f(((const bf16*)(ws + WS_DQKV))[(size_t)r * 1536 + c - 768]);
        else if (c < 2816) mine = bf2f(((const bf16*)(ws + WS_DZ))[(size_t)r * 512 + c - 2304]);
        else mine = bf2f(((const bf16*)(ws + WS_PU))[(size_t)r * 512 + c - 2848]);
        ck_record(ctl, 1, mine, ref);
    } else if (stage == 2) {
        const int r = hsh % M, c = (hsh >> 15) % 32;
        const float ref = ck_dot(HB + (size_t)r * 1024, 1024, args.in[1] + (size_t)layer * 1024 * IN_COLS + 2816 + c, IN_COLS);
        ck_record(ctl, 2, ((const float*)(ws + WS_DAB))[(size_t)r * 32 + c], ref);
    } else if (stage == 3) {
        const int r = hsh % M, c = (hsh >> 15) % 3072;
        const float ref = 1.0f / (1.0f + expf(-ck_dot(HB + (size_t)r * 1024, 1024, args.in[1] + (size_t)layer * 1024 * IN_COLS + 3360 + c, IN_COLS)));
        const float mine3 = bf2f(((const bf16*)(ws + WS_GT))[(size_t)(c >> 10) * M * 1024 + (size_t)r * 1024 + (c & 1023)]);
        ck_record(ctl, 3, mine3, ref);
        ck_record(ctl, 14 + (c >> 10), mine3, ref);
        ck_record(ctl, 17 + (r >> 13), mine3, ref);
        ck_record(ctl, 21 + ((c >> 8) & 3), mine3, ref);
        if (fabsf(mine3 - ref) > 0.04f) { const unsigned ix = atomicAdd(ctl + CK_BASE + 100, 1u); if (ix < 256) { ctl[1024 + 2 * ix] = (unsigned)c; ctl[1025 + 2 * ix] = (unsigned)r; } atomicMax(ctl + 2048, __float_as_uint(mine3)); atomicMax(ctl + 2049, __float_as_uint(1.0f - mine3)); atomicMax(ctl + 2050, __float_as_uint(ref)); atomicMax(ctl + 2051, __float_as_uint(1.0f - ref)); }
    } else if (stage == 4) {
        __shared__ float q_s[64]; __shared__ float sc_s[260];
        const unsigned hb_ = ck_hash((unsigned)blockIdx.x * 2654435761u + 777u);
        const int m = hb_ % M, hq = (hb_ >> 15) & 7, d = (hb_ >> 18) & 63, b = m / SEQ, t = m % SEQ, kvh = hq >> 2;
        if (threadIdx.x < 64) q_s[threadIdx.x] = ck_dot(HB + (size_t)m * 1024, 1024, args.in[1] + (size_t)layer * 1024 * IN_COLS + hq * 64 + threadIdx.x, IN_COLS);
        __syncthreads();
        const bf16* AK = (const bf16*)(ws + WS_AK); const bf16* AV = (const bf16*)(ws + WS_AV);
        const float sink = args.in[2][layer * 8 + hq];
        for (int j = threadIdx.x; j < 257; j += 256) { const int kp = t - 128 + j; float s = -1e30f;
            if (kp >= 0 && kp < SEQ) { s = 0.f; for (int i = 0; i < 64; ++i) s += q_s[i] * bf2f(AK[((size_t)b * SEQ + kp) * 128 + kvh * 64 + i]);
                const int rel = kp - t, n = rel < 0 ? -rel : rel;
                int bk; if (n < 8) bk = n; else { bk = 8 + (int)(logf((float)n / 8.f) / logf(16.f) * 8.f + 1e-4f); if (bk > 15) bk = 15; } if (rel > 0) bk += 16;
                s = s * 0.125f + args.in[3][bk * 8 + hq]; }
            sc_s[j] = s; }
        __syncthreads();
        if (threadIdx.x == 0) { float mx = sink; for (int j = 0; j < 257; ++j) mx = fmaxf(mx, sc_s[j]);
            float den = expf(sink - mx), o = 0.f;
            for (int j = 0; j < 257; ++j) { if (sc_s[j] < -1e29f) continue; const int kp = t - 128 + j; const float p = expf(sc_s[j] - mx); den += p; o += p * bf2f(AV[((size_t)b * SEQ + kp) * 128 + kvh * 64 + d]); }
            ck_record(ctl, 4, bf2f(((const bf16*)(ws + WS_AQ))[(size_t)m * 512 + hq * 64 + d]), o / den); }
    } else if (stage == 5) {
        const int m = hsh % M, g = (hsh >> 15) & 3, d = (hsh >> 17) & 127, b = m / SEQ, t = m % SEQ, r = 1 << g;
        const bf16* PU = (const bf16*)(ws + WS_PU); const float* pw = args.in[8] + ((size_t)layer * 4 + g) * 128 * 128;
        const int lo = t - r < 0 ? 0 : t - r, hi = t + r > SEQ - 1 ? SEQ - 1 : t + r; float y = 0.f;
        for (int c = 0; c < 128; ++c) { float s = 0.f; for (int tt = lo; tt <= hi; ++tt) s += bf2f(PU[((size_t)b * SEQ + tt) * 512 + g * 128 + c]);
            const float mxv = s / (float)(hi - lo + 1) - bf2f(PU[(size_t)m * 512 + g * 128 + c]); y += mxv * pw[c * 128 + d]; }
        y *= args.in[9][layer * 512 + g * 128 + d];
        ck_record(ctl, 5, bf2f(((const bf16*)(ws + WS_OP))[(size_t)m * 512 + g * 128 + d]), y);
    } else if (stage == 6) {
        constexpr int TCK = 192;
        __shared__ float q_s[64]; __shared__ float k_s[64];
        const int j = threadIdx.x & 63; if (threadIdx.x >= 64) return;
        const int seq = (blockIdx.x * 17 + 3) & 255;
        const int dir = seq >> 7, b = (seq >> 3) & 15, h = seq & 7;
        const bf16* DQKV = (const bf16*)(ws + WS_DQKV); const float* DAB = (const float*)(ws + WS_DAB); const float* cwp = args.in[4] + (size_t)layer * 5 * 1536;
        const float nA = -expf(args.in[5][layer * 16 + dir * 8 + h]), dtb = args.in[6][layer * 16 + dir * 8 + h];
        float S[64];
#pragma unroll
        for (int i = 0; i < 64; ++i) S[i] = 0.f;
        float maxe = 0.f, maxr = 0.f;
        for (int s2 = 0; s2 < TCK; ++s2) { const int t = dir ? SEQ - 1 - s2 : s2; const size_t m = (size_t)b * SEQ + t;
            float xq = 0.f, xk = 0.f, v = 0.f;
            for (int jj = 0; jj < 5; ++jj) { const int tt = t + jj - 2; if (tt < 0 || tt >= SEQ) continue; const size_t mm = (size_t)b * SEQ + tt;
                xq += cwp[jj * 1536 + h * 64 + j] * bf2f(DQKV[mm * 1536 + h * 64 + j]); xk += cwp[jj * 1536 + 512 + h * 64 + j] * bf2f(DQKV[mm * 1536 + 512 + h * 64 + j]);
                v += cwp[jj * 1536 + 1024 + h * 64 + j] * bf2f(DQKV[mm * 1536 + 1024 + h * 64 + j]); }
            xq = xq / (1.f + expf(-xq)); xk = xk / (1.f + expf(-xk)); v = v / (1.f + expf(-v));
            __syncthreads(); q_s[j] = xq; k_s[j] = xk; __syncthreads();
            float qs = 0.f, ks = 0.f;
            for (int i = 0; i < 64; ++i) { qs += q_s[i] * q_s[i]; ks += k_s[i] * k_s[i]; }
            const float qn = 0.125f / sqrtf(qs + 1e-6f), kn = 1.0f / sqrtf(ks + 1e-6f);
            const float a = DAB[m * 32 + dir * 8 + h] + dtb, sp = a > 20.f ? a : log1pf(expf(a)), al = expf(nA * sp), be = 1.f / (1.f + expf(-DAB[m * 32 + 16 + dir * 8 + h]));
            float part = 0.f;
#pragma unroll
            for (int i = 0; i < 64; ++i) part += S[i] * k_s[i];
            const float c = be * (v - al * part * kn); float o = 0.f;
#pragma unroll
            for (int i = 0; i < 64; ++i) { S[i] = al * S[i] + k_s[i] * kn * c; o += S[i] * q_s[i]; }
            o *= qn;
            const float mine = ((const float*)(ws + (dir ? WS_OB : WS_OF)))[m * 512 + h * 64 + j];
            maxe = fmaxf(maxe, fabsf(mine - o)); maxr = fmaxf(maxr, fabsf(o)); }
        atomicMax(ctl + CK_BASE + 12, __float_as_uint(maxe == maxe ? maxe : 1e30f)); atomicMax(ctl + CK_BASE + 13, __float_as_uint(maxr));
    } else if (stage == 8) {
        const int r = hsh % M, d = (hsh >> 15) & 1023; float mg = 0.f;
        for (int n = 0; n < 3; ++n) { const bf16* O = (const bf16*)(ws + WS_AQ + (size_t)n * 32 * MiB) + (size_t)r * 512;
            mg += bf2f(((const bf16*)(ws + WS_GT))[(size_t)n * M * 1024 + (size_t)r * 1024 + d]) * ck_dot(O, 512, args.in[10] + ((size_t)layer * 3 + n) * 512 * 1024 + d, 1024); }
        ck_record(ctl, 8, bf2f(((const bf16*)(ws + WS_MERGED))[(size_t)r * 1024 + d]), mg);
    } else if (stage == 9) {
        const int r = hsh % M, c = (hsh >> 15) & 1023;
        const float ref = ALPHA * bf2f(HB[(size_t)r * 1024 + c]) + ck_dot((const bf16*)(ws + WS_MERGED) + (size_t)r * 1024, 1024, args.in[11] + (size_t)layer * 1024 * 1024 + c, 1024);
        ck_record(ctl, 9, args.out[(size_t)r * 1024 + c], ref);
    } else if (stage == 10 || stage == 13) {
        const int r = hsh % M; const float* g = args.in[stage == 10 ? 12 : 14] + layer * 1024; const float* bb = args.in[stage == 10 ? 13 : 15] + layer * 1024;
        float s = 0.f, s2 = 0.f, de = 0.f; for (int c = 0; c < 1024; ++c) { const float hv = args.out[(size_t)r * 1024 + c]; const float u = (hv - bb[c]) / g[c]; s += u; s2 += u * u; de = fmaxf(de, fabsf(hv - bf2f(HB[(size_t)r * 1024 + c]))); }
        const float mean = s / 1024.f, var = s2 / 1024.f - mean * mean;
        ck_record(ctl, stage, fabsf(mean) + fabsf(var - 1.0f) + de * 0.1f, 0.0f); atomicMax(ctl + CK_BASE + 2 * stage + 1, __float_as_uint(1.0f));
    } else if (stage == 11) {
        const int r = hsh % M, c = (hsh >> 15) % FF;
        const float g = ck_dot(HB + (size_t)r * 1024, 1024, args.in[16] + c, FF), u = ck_dot(HB + (size_t)r * 1024, 1024, args.in[17] + c, FF);
        ck_record(ctl, 11, bf2f(((const bf16*)(ws + WS_FACT))[(size_t)r * FF + c]), g / (1.f + expf(-g)) * u);
    } else if (stage == 12) {
        const int r = hsh % M, c = (hsh >> 15) & 1023;
        const float ref = ALPHA * bf2f(HB[(size_t)r * 1024 + c]) + ck_dot((const bf16*)(ws + WS_FACT) + (size_t)r * FF, FF, args.in[18] + c, 1024);
        ck_record(ctl, 12, args.out[(size_t)r * 1024 + c], ref);
    } else if (stage == 30) {
        const int rr = 3584 + (int)(hsh % 3072), k = (hsh >> 15) & 1023;
        const float mine = bf2f(((const bf16*)(ws + WS_WIN))[((size_t)layer * WIN_ROWS + rr) * 1024 + k]), ref = args.in[1][(size_t)layer * 1024 * IN_COLS + (size_t)k * IN_COLS + 3360 + rr - 3584];
        ck_record(ctl, 30, mine, ref); if (fabsf(mine - ref) > 0.01f * fabsf(ref) + 1e-4f) atomicAdd(ctl + CK_BASE + 101, 1u);
    } else if (stage == 7) {
        const int m = hsh % M, h = (hsh >> 15) & 7; const float* OFp = (const float*)(ws + WS_OF) + (size_t)m * 512 + h * 64; const float* OBp = (const float*)(ws + WS_OB) + (size_t)m * 512 + h * 64;
        float ss = 0.f; for (int d = 0; d < 64; ++d) { const float o = OFp[d] + OBp[d]; ss += o * o; }
        const int d = (hsh >> 18) & 63; const float z = ck_dot(HB + (size_t)m * 1024, 1024, args.in[1] + (size_t)layer * 1024 * IN_COLS + 2304 + h * 64 + d, IN_COLS);
        const float ref = (OFp[d] + OBp[d]) / sqrtf(ss / 64.f + RMS_EPS) * args.in[7][layer * 64 + d] * z / (1.f + expf(-z));
        ck_record(ctl, 7, bf2f(((const bf16*)(ws + WS_DZ))[(size_t)m * 512 + h * 64 + d]), ref);
    }
}
__global__ void check_verdict(Args args) {
    unsigned* ctl = (unsigned*)(args.ws + WS_CTL);
    float code = 3.0f;
#if defined(CK_VAL)
    code = 3.0f + 40.0f * __uint_as_float(ctl[2048 + CK_VAL]);
#elif defined(CK_WCNT)
    { unsigned cnt = ctl[CK_BASE + 101]; int lg = 0; while (cnt) { ++lg; cnt >>= 1; } code += (float)lg; }
#elif defined(CK_COUNT)
    { unsigned cnt = ctl[CK_BASE + 100]; if (cnt > 256) cnt = 256; int distinct = 0;
        for (unsigned i = 0; i < cnt; ++i) { const unsigned ci = ctl[1024 + 2 * i], ri = ctl[1025 + 2 * i];
            const unsigned key = CK_COUNT == 1 ? (ci >> 5) : (CK_COUNT == 2 ? (ri >> 8) : (CK_COUNT == 3 ? (ci & 31) : (ri & 255)));
            bool seen = false; for (unsigned j = 0; j < i; ++j) { const unsigned cj = ctl[1024 + 2 * j], rj = ctl[1025 + 2 * j];
                const unsigned kj = CK_COUNT == 1 ? (cj >> 5) : (CK_COUNT == 2 ? (rj >> 8) : (CK_COUNT == 3 ? (cj & 31) : (rj & 255))); if (kj == key) { seen = true; break; } }
            if (!seen) ++distinct; }
        code += (float)(distinct > 15 ? 15 : distinct); }
#else
#ifndef CK_LIST
#define CK_LIST {14, 15, 16, 3}
#endif
    const int lst[4] = CK_LIST;
    for (int i = 0; i < 4; ++i) { const float e = __uint_as_float(ctl[CK_BASE + 2 * lst[i]]), r = __uint_as_float(ctl[CK_BASE + 2 * lst[i] + 1]); if (r == 0.f || e > 0.04f * r) code += (float)(1 << i); }
#endif
    for (size_t i = (size_t)blockIdx.x * blockDim.x + threadIdx.x; i < (size_t)M * D; i += (size_t)gridDim.x * blockDim.x) args.out[i] = code;
}
#endif
extern "C" void kernel_launch(void* const* d_in, const int* in_sizes, int n_in, void* d_out, int out_size, void* d_ws, size_t ws_size, hipStream_t stream) {
    static int grid = 0;
    if (grid == 0) {
        if (n_in != 23 || out_size != M * D || ws_size < WS_END) { fprintf(stderr, "kernel_launch: unexpected problem (n_in %d, out %d, ws %zu < %zu); nothing launched\n", n_in, out_size, ws_size, (size_t)WS_END); grid = -1; return; }
        int dev = 0, cus = 0, per_cu = 0;
        if (hipGetDevice(&dev) != hipSuccess || hipDeviceGetAttribute(&cus, hipDeviceAttributeMultiprocessorCount, dev) != hipSuccess) { grid = -1; return; }
        if (hipFuncSetAttribute((const void*)fwd_kernel, hipFuncAttributeMaxDynamicSharedMemorySize, LDS_BYTES) != hipSuccess) { fprintf(stderr, "kernel_launch: hipFuncSetAttribute failed\n"); grid = -1; return; }
        if (hipOccupancyMaxActiveBlocksPerMultiprocessor(&per_cu, (const void*)fwd_kernel, NTHR, LDS_BYTES) != hipSuccess || per_cu < 1) { fprintf(stderr, "kernel_launch: occupancy query says %d\n", per_cu); }
        (void)hipGetLastError();
        if (cus != 256 || per_cu < 1) { fprintf(stderr, "kernel_launch: needs 256 CUs with one resident workgroup each (cus %d, per_cu %d)\n", cus, per_cu); grid = -1; return; }
        grid = 256;
    }
    if (grid < 0) return;
    (void)hipMemsetAsync((char*)d_ws + WS_CTL, 0, CTL_ZERO_BYTES, stream);
    Args a{};
    for (int i = 0; i < 23; ++i) a.in[i] = (const float*)d_in[i];
    a.out = (float*)d_out; a.ws = (unsigned char*)d_ws;
#if MK_PER_PHASE
    static const int phases[] = {0, 1, 2, 21, 3, 4, 5, 6, 7, 8, 9, 41, 42, 61, 43, 44, 45, 46, 47, 48, 49, 50, 51, 52, 53, 54, 55, 56};
    for (int p : phases) { a.ph_lo = p; a.ph_hi = p + 1; hipLaunchKernelGGL(fwd_kernel, dim3(grid), dim3(NTHR), LDS_BYTES, stream, a);
#if defined(DBG_CHECK)
        const int L = DBG_CHECK - 1, pb = 1 + 40 * L;
        if (p == pb + 0) { hipLaunchKernelGGL(check_kernel, dim3(64), dim3(256), 0, stream, a, 1, L); hipLaunchKernelGGL(check_kernel, dim3(64), dim3(256), 0, stream, a, 2, L); }
        if (p == pb + 1) { hipLaunchKernelGGL(check_kernel, dim3(512), dim3(256), 0, stream, a, 4, L); hipLaunchKernelGGL(check_kernel, dim3(64), dim3(256), 0, stream, a, 5, L); hipLaunchKernelGGL(check_kernel, dim3(16), dim3(64), 0, stream, a, 6, L); }
        if (p == pb + 20) hipLaunchKernelGGL(check_kernel, dim3(64), dim3(256), 0, stream, a, 7, L);
        if (p == pb + 2) { hipLaunchKernelGGL(check_kernel, dim3(64), dim3(256), 0, stream, a, 3, L); hipLaunchKernelGGL(check_kernel, dim3(256), dim3(256), 0, stream, a, 30, L); }
        if (p == pb + 3) hipLaunchKernelGGL(check_kernel, dim3(64), dim3(256), 0, stream, a, 8, L);
        if (p == pb + 4) hipLaunchKernelGGL(check_kernel, dim3(64), dim3(256), 0, stream, a, 9, L);
        if (p == pb + 5) hipLaunchKernelGGL(check_kernel, dim3(16), dim3(256), 0, stream, a, 10, L);
        if (L == 0 && p == pb + 6) hipLaunchKernelGGL(check_kernel, dim3(64), dim3(256), 0, stream, a, 11, L);
        if (L == 0 && p == pb + 7) hipLaunchKernelGGL(check_kernel, dim3(64), dim3(256), 0, stream, a, 12, L);
        if (L == 0 && p == pb + 8) hipLaunchKernelGGL(check_kernel, dim3(16), dim3(256), 0, stream, a, 13, L);
#endif
    }
#if defined(DBG_CHECK)
    hipLaunchKernelGGL(check_verdict, dim3(1024), dim3(256), 0, stream, a);
#endif
#else
    a.ph_lo = 0; a.ph_hi = 1000;
    hipLaunchKernelGGL(fwd_kernel, dim3(grid), dim3(NTHR), LDS_BYTES, stream, a);
#endif
}
```

```cpp
#include <hip/hip_runtime.h>
#include <cstdio>
#include <cstdint>

#define GAS __attribute__((address_space(1)))
#define LAS __attribute__((address_space(3)))
typedef unsigned short bf16;
typedef unsigned v4u __attribute__((ext_vector_type(4)));
typedef unsigned v2u __attribute__((ext_vector_type(2)));
typedef float f32x2 __attribute__((ext_vector_type(2)));
typedef float f32x4 __attribute__((ext_vector_type(4)));
typedef float f32x16 __attribute__((ext_vector_type(16)));
typedef short bf16x8 __attribute__((ext_vector_type(8)));
typedef short bf16x4 __attribute__((ext_vector_type(4)));

#ifndef ABL
#define ABL 0
#endif
#ifndef LN_FUSE
#define LN_FUSE 3
#endif
#ifndef MK_PER_PHASE
#define MK_PER_PHASE 0
#endif

#ifndef WGM_K
#define WGM_K 8
#endif
namespace pg8 {
#define PG8_LAS __attribute__((address_space(3)))
typedef unsigned short bf16_t;
typedef unsigned u32x4 __attribute__((ext_vector_type(4)));
constexpr int BM = 256, BK = 64, HALF = 128, HTB = HALF * BK * 2  , STAGE_BYTES = 8 * HTB, NXCD = 8, WGM = WGM_K;

__host__ __device__ __forceinline__ int lds_byte(int r, int c) { const int st = (r >> 4) * 2 + (c >> 5), rr = r & 15, cc = c & 31, ob = rr * 64 + cc * 2; return st * 1024 + (ob ^ (((ob >> 9) & 1) << 5)); }
__host__ __device__ __forceinline__ void stage_rc(int b, int& R, int& C) { const int st = b / 1024, sb = b % 1024, swz = sb ^ (((sb >> 9) & 1) << 5); R = (st >> 1) * 16 + swz / 64; C = (st & 1) * 32 + (swz % 64) / 2; }
__host__ __device__ __forceinline__ int perm32(int rho) { const int n = rho >> 4, i = rho & 15; return 8 * (i >> 2) + 4 * n + (i & 3); }

struct Unit { int pm, pn, aux; };

struct StaticOrder {
    int nM, nN, nwg, G, c;
    __host__ __device__ __forceinline__ void init(int nM_, int nN_, int G_, int c_) { nM = nM_; nN = nN_; nwg = nM * nN; G = G_; c = c_; }
    __host__ __device__ __forceinline__ bool map(long L, int& pm, int& pn) const {
        if (L >= nwg) return false;
        int wgid = (int)L; { const int q = nwg / NXCD, r = nwg % NXCD, xcd = wgid % NXCD, off = wgid / NXCD; wgid = (xcd < r ? xcd * (q + 1) : r * (q + 1) + (xcd - r) * q) + off; }
        const int nig = WGM * nN, gid = wgid / nig, fm = gid * WGM, gsz = (nM - fm) < WGM ? (nM - fm) : WGM;
        pm = fm + ((wgid % nig) % gsz); pn = (wgid % nig) / gsz; return true;
    }
};
struct StdSched {
    StaticOrder o; const char* A; const char* Bt; size_t tstep;
    __device__ __forceinline__ void init(const void* A_, const void* Bt_, int M, int N, int K, int G, int c) { o.init(M / BM, N / BM, G, c); A = (const char*)A_; Bt = (const char*)Bt_; tstep = (size_t)BM * K * 2; }
    __device__ __forceinline__ bool next(int i, Unit& u) const { u.aux = 0; return o.map((long)i * o.G + o.c, u.pm, u.pn); }
    __device__ __forceinline__ const char* abase(const Unit& u) const { return A + (size_t)u.pm * tstep; }
    __device__ __forceinline__ const char* bbase(const Unit& u) const { return Bt + (size_t)u.pn * tstep; }
};

typedef __bf16 bf16x2_t __attribute__((ext_vector_type(2)));
__device__ __forceinline__ unsigned cvt_pk_bf16(float lo, float hi) { const f32x2 v = {lo, hi}; const bf16x2_t b = __builtin_convertvector(v, bf16x2_t); return __builtin_bit_cast(unsigned, b); }

typedef f32x4 acc_t[2][2][4][2];
__device__ __forceinline__ void zero_acc(acc_t& acc) {
    float z = 0.f; asm volatile("" : "+v"(z));
#pragma unroll
    for (int a = 0; a < 2; ++a)
#pragma unroll
        for (int b = 0; b < 2; ++b)
#pragma unroll
            for (int m = 0; m < 4; ++m)
#pragma unroll
                for (int n = 0; n < 2; ++n) acc[a][b][m][n] = (f32x4){z, z, z, z};
}

typedef int v8i_t __attribute__((ext_vector_type(8)));
typedef int v4i_t __attribute__((ext_vector_type(4)));
__device__ __forceinline__ f32x4 mfma_fp8(const bf16x8& b0, const bf16x8& b1, const bf16x8& a0, const bf16x8& a1, const f32x4& c) {
    const v4i_t x0 = __builtin_bit_cast(v4i_t, b0), x1 = __builtin_bit_cast(v4i_t, b1), y0 = __builtin_bit_cast(v4i_t, a0), y1 = __builtin_bit_cast(v4i_t, a1);
    const v8i_t X = __builtin_shufflevector(x0, x1, 0, 1, 2, 3, 4, 5, 6, 7), Y = __builtin_shufflevector(y0, y1, 0, 1, 2, 3, 4, 5, 6, 7);
    return __builtin_amdgcn_mfma_scale_f32_16x16x128_f8f6f4(X, Y, c, 0, 0, 0, 0x7f7f7f7f, 0, 0x7f7f7f7f);
}
template <class Epi, class Sched, bool ALIGN_EPI = false, bool SP2 = false, bool FP8 = false>
__device__ __forceinline__ void gemm_phase(PG8_LAS unsigned char* lds, const int K, const Sched& S, const Epi& E, const int wid_in) {
    int lane = (int)__builtin_amdgcn_mbcnt_hi(~0u, __builtin_amdgcn_mbcnt_lo(~0u, 0u)); asm volatile("" : "+v"(lane));
    const int wid = wid_in, tid = wid * 64 + lane, wr = wid >> 2, wc = wid & 3, fr = lane & 15, fq = lane >> 4;
    const int nt = K / BK;
    unsigned voffA[2], voffB[2];
#pragma unroll
    for (int i = 0; i < 2; ++i) { int R, C; stage_rc(tid * 16 + i * 8192, R, C); const int Rb = Epi::PERM ? ((R & ~31) + perm32(R & 31)) : R;
        voffA[i] = (unsigned)(R * K + C) * 2u; voffB[i] = (unsigned)(Rb * K + C) * 2u; }
    const size_t kstep = (size_t)(BK * 2);
    const size_t hstep = (size_t)HALF * K * 2;
    const unsigned ldsw = (unsigned)wid * 1024u;
    const int aoff = lds_byte(wr * 64 + fr, fq * 8), boff = lds_byte(wc * 32 + fr, fq * 8);
#define PG8_SA(b, h) (((b) * 2 + (h)) * HTB)
#define PG8_SB(b, h) ((4 + (b) * 2 + (h)) * HTB)
#define PG8_STAGE(bufoff, gbase, voff) do { _Pragma("unroll") for (int _i = 0; _i < 2; ++_i) \
        __builtin_amdgcn_global_load_lds((const unsigned*)((const char*)(gbase) + (voff)[_i]), (PG8_LAS unsigned*)(lds + (bufoff) + ldsw + _i * 8192), 16, 0, 0); } while (0)
#define PG8_LDA(dst, b, h) do { if constexpr (FP8) { _Pragma("unroll") for (int m = 0; m < 4; ++m) { const v4i_t lo_ = *(const PG8_LAS v4i_t*)(lds + PG8_SA(b, h) + aoff + m * 2048), hi_ = *(const PG8_LAS v4i_t*)(lds + PG8_SA(b, h) + aoff + m * 2048 + 1024); \
            dst##8[m] = __builtin_shufflevector(lo_, hi_, 0, 1, 2, 3, 4, 5, 6, 7); } } \
        else { _Pragma("unroll") for (int m = 0; m < 4; ++m) _Pragma("unroll") for (int k = 0; k < 2; ++k) dst[m][k] = *(const PG8_LAS bf16x8*)(lds + PG8_SA(b, h) + aoff + m * 2048 + k * 1024); } } while (0)
#define PG8_LDB(dst, b, h) do { if constexpr (FP8) { _Pragma("unroll") for (int n = 0; n < 2; ++n) { const v4i_t lo_ = *(const PG8_LAS v4i_t*)(lds + PG8_SB(b, h) + boff + n * 2048), hi_ = *(const PG8_LAS v4i_t*)(lds + PG8_SB(b, h) + boff + n * 2048 + 1024); \
            dst##8[n] = __builtin_shufflevector(lo_, hi_, 0, 1, 2, 3, 4, 5, 6, 7); } } \
        else { _Pragma("unroll") for (int n = 0; n < 2; ++n) _Pragma("unroll") for (int k = 0; k < 2; ++k) dst[n][k] = *(const PG8_LAS bf16x8*)(lds + PG8_SB(b, h) + boff + n * 2048 + k * 1024); } } while (0)
#define PG8_MMA(ai, bj, At, Bt) do { __builtin_amdgcn_s_setprio(1); _Pragma("unroll") for (int m = 0; m < 4; ++m) _Pragma("unroll") for (int n = 0; n < 2; ++n) { \
        if constexpr (FP8) asm volatile("v_mfma_scale_f32_16x16x128_f8f6f4 %0, %1, %2, %0, %3, %3 op_sel_hi:[0,0,0]" : "+v"(acc[ai][bj][m][n]) : "v"(Bt##8[n]), "v"(At##8[m]), "v"(sc127));   \
        else { _Pragma("unroll") for (int k = 0; k < 2; ++k) acc[ai][bj][m][n] = __builtin_amdgcn_mfma_f32_16x16x32_bf16(Bt[n][k], At[m][k], acc[ai][bj][m][n], 0, 0, 0); } } \
        __builtin_amdgcn_s_setprio(0); } while (0)
#define PG8_WAIT_V(n) asm volatile("s_waitcnt vmcnt(" #n ")" ::: "memory")
#define PG8_WAIT_L(n) asm volatile("s_waitcnt lgkmcnt(" #n ")" ::: "memory")
#define PG8_BAR __builtin_amdgcn_s_barrier()
#define PG8_SCHED __builtin_amdgcn_sched_barrier(0)
    Unit cur, nxt; int ui = 0;
    if (!S.next(0, cur)) return;
    acc_t acc; zero_acc(acc);
    bf16x8 At[4][2], B0[2][2], B1[2][2];
    v8i_t At8[4], B08[2], B18[2];
    int sc127 = 0x7f7f7f7f; asm volatile("" : "+v"(sc127));
    const char* cA = S.abase(cur); const char* cB = S.bbase(cur);
    if constexpr (SP2) {
        PG8_STAGE(PG8_SB(0, 0), cB, voffB); PG8_STAGE(PG8_SB(0, 1), cB + hstep, voffB); PG8_STAGE(PG8_SA(0, 0), cA, voffA); PG8_STAGE(PG8_SA(0, 1), cA + hstep, voffA);
        if (wr == 1) PG8_BAR;
        PG8_WAIT_V(2); PG8_BAR;
        PG8_STAGE(PG8_SB(1, 0), cB + kstep, voffB); PG8_STAGE(PG8_SA(1, 0), cA + kstep, voffA); PG8_STAGE(PG8_SB(1, 1), cB + hstep + kstep, voffB);
        PG8_WAIT_V(6); PG8_BAR;
    } else {
        PG8_STAGE(PG8_SB(0, 0), cB, voffB); PG8_STAGE(PG8_SA(0, 0), cA, voffA); PG8_STAGE(PG8_SB(0, 1), cB + hstep, voffB); PG8_STAGE(PG8_SA(0, 1), cA + hstep, voffA);
        if (wr == 1) PG8_BAR;
        PG8_WAIT_V(4); PG8_BAR;
        PG8_STAGE(PG8_SB(1, 0), cB + kstep, voffB); PG8_STAGE(PG8_SA(1, 0), cA + kstep, voffA); PG8_STAGE(PG8_SB(1, 1), cB + hstep + kstep, voffB);
        PG8_WAIT_V(6); PG8_BAR;
    }
    for (;;) {
        const bool has_next = S.next(ui + 1, nxt);
        const char* nA = has_next ? S.abase(nxt) : cA; const char* nB = has_next ? S.bbase(nxt) : cB;
#pragma nounroll
        for (int t = 0; t < nt; t += 2) {
            const bool last = (t == nt - 2);
            const char* a1 = cA + (size_t)(t + 1) * kstep;
            const char* a2 = last ? nA : cA + (size_t)(t + 2) * kstep; const char* b2 = last ? nB : cB + (size_t)(t + 2) * kstep;
            const char* a3 = a2 + kstep; const char* b3 = b2 + kstep;
            if constexpr (SP2) {
            PG8_LDB(B0, 0, 0); PG8_LDB(B1, 0, 1); PG8_SCHED; PG8_LDA(At, 0, 0); PG8_STAGE(PG8_SA(1, 1), a1 + hstep, voffA);
            PG8_WAIT_V(8); PG8_WAIT_L(0); PG8_BAR; PG8_MMA(0, 0, At, B0); PG8_MMA(0, 1, At, B1); PG8_BAR; PG8_SCHED;
            PG8_LDA(At, 0, 1); PG8_STAGE(PG8_SB(0, 0), b2, voffB); PG8_STAGE(PG8_SB(0, 1), b2 + hstep, voffB); PG8_STAGE(PG8_SA(0, 0), a2, voffA);
            PG8_WAIT_V(8); PG8_WAIT_L(0); PG8_BAR; PG8_MMA(1, 0, At, B0); PG8_MMA(1, 1, At, B1); PG8_BAR; PG8_SCHED;
            PG8_LDB(B0, 1, 0); PG8_LDB(B1, 1, 1); PG8_SCHED; PG8_LDA(At, 1, 0); PG8_STAGE(PG8_SA(0, 1), a2 + hstep, voffA);
            PG8_WAIT_V(8); PG8_WAIT_L(0); PG8_BAR; PG8_MMA(0, 0, At, B0); PG8_MMA(0, 1, At, B1); PG8_BAR; PG8_SCHED;
            PG8_LDA(At, 1, 1); PG8_STAGE(PG8_SB(1, 0), b3, voffB); PG8_STAGE(PG8_SB(1, 1), b3 + hstep, voffB); PG8_STAGE(PG8_SA(1, 0), a3, voffA);
            PG8_WAIT_V(8); PG8_WAIT_L(0); PG8_BAR; PG8_MMA(1, 0, At, B0); PG8_MMA(1, 1, At, B1); PG8_BAR; PG8_SCHED;
            } else {
            PG8_LDB(B0, 0, 0); PG8_SCHED; PG8_LDA(At, 0, 0); PG8_STAGE(PG8_SA(1, 1), a1 + hstep, voffA);
            PG8_WAIT_L(8); PG8_BAR; PG8_WAIT_L(0); PG8_MMA(0, 0, At, B0); PG8_BAR; PG8_SCHED;
            PG8_LDB(B1, 0, 1); PG8_STAGE(PG8_SB(0, 0), b2, voffB);
            PG8_BAR; PG8_WAIT_L(0); PG8_MMA(0, 1, At, B1); PG8_BAR;
            PG8_LDA(At, 0, 1); PG8_STAGE(PG8_SA(0, 0), a2, voffA);
            PG8_BAR; PG8_WAIT_L(0); PG8_MMA(1, 0, At, B0); PG8_BAR; PG8_SCHED;
            PG8_STAGE(PG8_SB(0, 1), b2 + hstep, voffB);
            PG8_WAIT_V(6); PG8_BAR; PG8_MMA(1, 1, At, B1); PG8_BAR;
            PG8_LDB(B0, 1, 0); PG8_SCHED; PG8_LDA(At, 1, 0); PG8_STAGE(PG8_SA(0, 1), a2 + hstep, voffA);
            PG8_WAIT_L(8); PG8_BAR; PG8_WAIT_L(0); PG8_MMA(0, 0, At, B0); PG8_BAR; PG8_SCHED;
            PG8_LDB(B1, 1, 1); PG8_STAGE(PG8_SB(1, 0), b3, voffB);
            PG8_BAR; PG8_WAIT_L(0); PG8_MMA(0, 1, At, B1); PG8_BAR;
            PG8_LDA(At, 1, 1); PG8_STAGE(PG8_SA(1, 0), a3, voffA);
            PG8_BAR; PG8_WAIT_L(0); PG8_MMA(1, 0, At, B0); PG8_BAR; PG8_SCHED;
            PG8_STAGE(PG8_SB(1, 1), b3 + hstep, voffB);
            PG8_WAIT_V(6); PG8_BAR; PG8_MMA(1, 1, At, B1); PG8_BAR;
            }
        }
        if constexpr (ALIGN_EPI) { if (wr == 0) PG8_BAR; }
        if constexpr (FP8) asm volatile("s_nop 15\n\ts_nop 15" ::: "memory");
        E(acc, cur, wr, wc, fr, fq);
        if (!has_next) break;
        cur = nxt; cA = nA; cB = nB; ++ui;
        if constexpr (ALIGN_EPI) { if (wr == 1) PG8_BAR; }
    }
    PG8_WAIT_V(0);
    if constexpr (!ALIGN_EPI) { if (wr == 0) PG8_BAR; }
    PG8_BAR;
#undef PG8_SA
#undef PG8_SB
#undef PG8_STAGE
#undef PG8_LDA
#undef PG8_LDB
#undef PG8_MMA
#undef PG8_WAIT_V
#undef PG8_WAIT_L
#undef PG8_BAR
#undef PG8_SCHED
}
}

#ifndef GATES_FP8
#define GATES_FP8 1
#endif
#ifndef FFN_FP8
#define FFN_FP8 3
#endif
#ifndef MOE_FP8
#define MOE_FP8 1
#endif
constexpr int NWAVES = 8, NTHR = 512;
constexpr int BATCH = 16, SEQ = 2048, D = 1024, M = BATCH * SEQ;
constexpr int IN_COLS = 6432;
constexpr int NA = 3584;
constexpr int NG = 3072;
constexpr int WIN_ROWS = NA + NG;
constexpr int FF = 2816, FFE = 3584, NE = 8;
constexpr int NCH = 2, CHT = 256 / NCH, CH_TOK = M / NCH, CH_ROWS = (CHT + 8) * 256;
static_assert(MOE_FP8 || NCH == 4, "bf16 MoE buffers are sized for 4 chunks");
constexpr float LN_EPS = 1e-5f, RMS_EPS = 1e-6f;
constexpr float ALPHA = 1.4142135623730951f;

constexpr size_t MiB = 1u << 20;
constexpr size_t WS_CTL = 0, CTL_ZERO_BYTES = 1 * MiB;
constexpr size_t WS_HB = 1 * MiB;
constexpr size_t WS_META = 65 * MiB;
constexpr size_t WS_WIN = 67 * MiB;
constexpr size_t WS_WBR = 93 * MiB;
constexpr size_t WS_WOUT = 99 * MiB;
constexpr size_t WS_W13 = 103 * MiB;
constexpr size_t WS_W2 = 114 * MiB;
constexpr size_t WS_POOLW = 120 * MiB;
constexpr size_t WS_LNSTAT = 120 * MiB;
constexpr size_t WS_BIG = 121 * MiB;
constexpr size_t WS_AQ = WS_BIG + 0 * MiB;
constexpr size_t WS_DZ = WS_BIG + 32 * MiB;
constexpr size_t WS_OP = WS_BIG + 64 * MiB;
constexpr size_t WS_AK = WS_BIG + 96 * MiB;
constexpr size_t WS_AV = WS_BIG + 104 * MiB;
constexpr size_t WS_DAB = WS_BIG + 112 * MiB;
constexpr size_t WS_PU = WS_BIG + 128 * MiB;
constexpr size_t WS_DQKV = WS_BIG + 160 * MiB;
constexpr size_t WS_OF = WS_BIG + 256 * MiB;
constexpr size_t WS_OB = WS_BIG + 320 * MiB;
constexpr size_t WS_GT = WS_BIG + 160 * MiB;
constexpr size_t WS_MERGED = WS_BIG + 352 * MiB;
constexpr size_t WS_FACT = WS_BIG + 0 * MiB;
constexpr size_t WS_HBG8 = WS_BIG + 384 * MiB;
constexpr size_t WS_HB8 = WS_BIG + 200 * MiB;
constexpr size_t WS_END_L = WS_BIG + 416 * MiB;
constexpr size_t WS_MWGU = 67 * MiB;
constexpr size_t WS_MWD = 179 * MiB;
constexpr size_t WS_XG = 235 * MiB;
constexpr size_t WS_MACT = 271 * MiB;
constexpr size_t WS_YS = 397 * MiB;
constexpr size_t WS_END = 537 * MiB;
static_assert(WS_YS + (size_t)M * 2 * 1024 * 2 <= WS_END && WS_END_L <= WS_END, "ws map");
static_assert(WS_MACT + (size_t)CH_ROWS * FFE * (MOE_FP8 ? 1 : 2) <= WS_YS && WS_XG + (size_t)CH_ROWS * 1024 * (MOE_FP8 ? 1 : 2) <= WS_MACT, "ws map");
constexpr size_t MT_TOKE = 0;
constexpr size_t MT_TOKP = 256 * 1024;
constexpr size_t MT_RANK = 512 * 1024;
constexpr size_t MT_DEFER = 640 * 1024;
constexpr size_t MT_CNT = 768 * 1024;
constexpr size_t MT_ROWMAP = 1024 * 1024;
constexpr int CW_BAR = 4096;
constexpr int CW_LNX = 16384;
constexpr int LNX_LDS_OFF = 131072;

constexpr int RING_OFF = 0, RING_BYTES = 147456;
constexpr int LDSCTL_OFF = RING_BYTES, MISC_OFF = LDSCTL_OFF + 320;
constexpr int MOE_LDS_OFF = LDSCTL_OFF + 1024;
constexpr int LDS_BYTES = 163840;

#define RLX_AGENT __ATOMIC_RELAXED, __HIP_MEMORY_SCOPE_AGENT
#define LDS_WAIT() asm volatile("s_waitcnt lgkmcnt(0)" ::: "memory")
#define VM_WAIT() asm volatile("s_waitcnt vmcnt(0)" ::: "memory")
__device__ __forceinline__ unsigned f2bf(float f) { unsigned u = __builtin_bit_cast(unsigned, f); return (u + 0x7fffu + ((u >> 16) & 1u)) >> 16; }
__device__ __forceinline__ unsigned pk2(float lo, float hi) { return f2bf(lo) | (f2bf(hi) << 16); }
__device__ __forceinline__ float bf2f(unsigned short b) { return __builtin_bit_cast(float, ((unsigned)b) << 16); }
__device__ __forceinline__ float bflo(unsigned w) { return __builtin_bit_cast(float, w << 16); }
__device__ __forceinline__ float bfhi(unsigned w) { return __builtin_bit_cast(float, w & 0xffff0000u); }
__device__ __forceinline__ v4u ld_or_zero(const bf16* p, const bf16* safe, bool ok) { const v4u v = *(const v4u*)(ok ? p : safe); const unsigned mk = ok ? 0xffffffffu : 0u; return (v4u){v.x & mk, v.y & mk, v.z & mk, v.w & mk}; }
__device__ __forceinline__ float sigmoidf_(float x) { return __builtin_amdgcn_rcpf(1.0f + __expf(-x)); }
__device__ __forceinline__ float siluf_(float x) { return x * sigmoidf_(x); }

#define XB_TMO      128
#define XB_XCNT(j)  (256  + 64 * (j))
#define XB_XSUB(j)  (1280 + 64 * (j))
#define XB_XGEN(j)  (2304 + 64 * (j))
#define XB_TOP      3328
#define XB_TOPGEN   3392
#define XCD_BAR_WORDS 3456
#define XB_SPIN_CAP (1u << 22)
#ifndef XB_RELAY
#define XB_RELAY 0
#endif

__device__ __forceinline__ unsigned xb_ld(unsigned* p)              { return __hip_atomic_load(p, __ATOMIC_RELAXED, __HIP_MEMORY_SCOPE_AGENT); }
__device__ __forceinline__ unsigned xb_add(unsigned* p, unsigned v) { return __hip_atomic_fetch_add(p, v, __ATOMIC_RELAXED, __HIP_MEMORY_SCOPE_AGENT); }
__device__ __forceinline__ unsigned xb_xcc_id() { return (unsigned)__builtin_amdgcn_s_getreg((3 << 11) | 20) & 0xFu; }
#define XB_SPIN(cond, bar) do { unsigned _sp = 0; while (cond) { __builtin_amdgcn_s_sleep(1); \
    if ((++_sp & 255u) == 0u) { if (xb_ld(&(bar)[XB_TMO])) break; if (_sp > XB_SPIN_CAP) { atomicAdd(&(bar)[XB_TMO], 1u); break; } } } } while (0)

struct XcdBarrier {
    unsigned* bar; unsigned x; unsigned w0;
    volatile LAS unsigned* st;
};
__device__ __forceinline__ XcdBarrier xcd_barrier_post(unsigned* bar, volatile LAS unsigned* st) {
    XcdBarrier b; b.bar = bar; b.x = xb_xcc_id(); b.st = st; b.w0 = (__builtin_amdgcn_readfirstlane(threadIdx.x >> 6) == 0) ? 1u : 0u;
    if (threadIdx.x == 0) (void)xb_add(&bar[XB_XCNT(b.x)], 1u);
    return b;
}
__device__ __forceinline__ void xcd_barrier_complete(unsigned* bar, unsigned x, unsigned& nloc, unsigned& nx) {
    const unsigned G = gridDim.x * gridDim.y * gridDim.z;
    unsigned sum, cnt, mine, sp = 0u;
    for (;;) {
        sum = 0u; cnt = 0u; mine = 0u;
#pragma unroll
        for (unsigned j = 0; j < 16; ++j) { const unsigned c = xb_ld(&bar[XB_XCNT(j)]); sum += c; cnt += (c > 0u) ? 1u : 0u; mine = (j == x) ? c : mine; }
        if (sum == G) break;
        __builtin_amdgcn_s_sleep(1);
        if ((++sp & 255u) == 0u) { if (xb_ld(&bar[XB_TMO])) break; if (sp > XB_SPIN_CAP) { atomicAdd(&bar[XB_TMO], 1u); break; } }
    }
    nloc = mine > 0u ? mine : 1u; nx = cnt > 0u ? cnt : 1u;
}
__device__ __forceinline__ void xcd_barrier(const XcdBarrier& b) {
    asm volatile("s_waitcnt vmcnt(0)" ::: "memory");
    __syncthreads();
    if (b.w0 && __builtin_amdgcn_mbcnt_hi(~0u, __builtin_amdgcn_mbcnt_lo(~0u, 0u)) == 0u) {
        unsigned* bar = b.bar;
        __builtin_amdgcn_s_waitcnt(0);
        unsigned nloc = b.st[0], nx = b.st[1];
        if (nloc == 0u) { xcd_barrier_complete(bar, b.x, nloc, nx); b.st[0] = nloc; b.st[1] = nx; }
        const unsigned old = xb_add(&bar[XB_XSUB(b.x)], 1u);
        const unsigned gen = old / nloc;
#if XB_RELAY
        if (old + 1u == (gen + 1u) * nloc) {
            __builtin_amdgcn_fence(__ATOMIC_RELEASE, "agent");
            asm volatile("s_waitcnt vmcnt(0)" ::: "memory");
            const unsigned og = xb_add(&bar[XB_TOP], 1u);
            const unsigned tg = og / nx;
            if (og + 1u == (tg + 1u) * nx) xb_add(&bar[XB_TOPGEN], 1u);
            else XB_SPIN(xb_ld(&bar[XB_TOPGEN]) == tg, bar);
            __builtin_amdgcn_fence(__ATOMIC_ACQUIRE, "agent");
#if XB_RELAY
            xb_add(&bar[XB_XGEN(b.x)], 1u);
            asm volatile("s_waitcnt vmcnt(0)" ::: "memory");
#endif
        } else {
#if XB_RELAY
            XB_SPIN(xb_ld(&bar[XB_XGEN(b.x)]) == gen, bar);
#else
            XB_SPIN(xb_ld(&bar[XB_TOPGEN]) == gen, bar);
#endif
            __builtin_amdgcn_fence(__ATOMIC_ACQUIRE, "agent");
            asm volatile("s_waitcnt vmcnt(0)" ::: "memory");
        }
#else
        if (old + 1u == (gen + 1u) * nloc) {
            __builtin_amdgcn_fence(__ATOMIC_RELEASE, "agent");
            asm volatile("s_waitcnt vmcnt(0)" ::: "memory");
            (void)xb_add(&bar[XB_TOP], 1u);
        }
        { const unsigned want = nx * (gen + 1u); XB_SPIN(xb_ld(&bar[XB_TOP]) < want, bar); }
        __builtin_amdgcn_fence(__ATOMIC_ACQUIRE, "agent");
        asm volatile("s_waitcnt vmcnt(0)" ::: "memory");
#endif
    }
    __syncthreads();
}

struct Args { const float* in[23]; float* out; unsigned char* ws; int ph_lo, ph_hi; };
struct Frame {
    unsigned char* lds;
    int tid, lane, wave;
    int G, bx;
    unsigned char* ws;
    float* out;
    const Args* a;
};
#define IN_x(F)          ((F).a->in[0])
#define IN_w_in(F)       ((F).a->in[1])
#define IN_attn_sink(F)  ((F).a->in[2])
#define IN_rel_bias(F)   ((F).a->in[3])
#define IN_conv_w(F)     ((F).a->in[4])
#define IN_a_log(F)      ((F).a->in[5])
#define IN_dt_bias(F)    ((F).a->in[6])
#define IN_dn_norm_w(F)  ((F).a->in[7])
#define IN_pool_w(F)     ((F).a->in[8])
#define IN_pool_scale(F) ((F).a->in[9])
#define IN_w_branch(F)   ((F).a->in[10])
#define IN_w_out(F)      ((F).a->in[11])
#define IN_ln1_g(F)      ((F).a->in[12])
#define IN_ln1_b(F)      ((F).a->in[13])
#define IN_ln2_g(F)      ((F).a->in[14])
#define IN_ln2_b(F)      ((F).a->in[15])
#define IN_ffn_w1(F)     ((F).a->in[16])
#define IN_ffn_w3(F)     ((F).a->in[17])
#define IN_ffn_w2(F)     ((F).a->in[18])
#define IN_router_w(F)   ((F).a->in[19])
#define IN_moe_wg(F)     ((F).a->in[20])
#define IN_moe_wu(F)     ((F).a->in[21])
#define IN_moe_wd(F)     ((F).a->in[22])
__device__ __forceinline__ float wave_sum(float v) {
#pragma unroll
    for (int o = 1; o < 64; o <<= 1) v += __shfl_xor(v, o);
    return v;
}
template <int CTRL> __device__ __forceinline__ float dppf(float x) { return __builtin_bit_cast(float, __builtin_amdgcn_mov_dpp(__builtin_bit_cast(int, x), CTRL, 0xF, 0xF, true)); }
__device__ __forceinline__ float red4(float x) { x += dppf<0xB1>(x); x += dppf<0x4E>(x); return x; }
__device__ __forceinline__ float red8(float x) { x = red4(x); x += dppf<0x141>(x); return x; }
__device__ __forceinline__ float red16(float x) { x = red8(x); x += dppf<0x140>(x); return x; }

__device__ __forceinline__ float q8(float x) { const int p = __builtin_amdgcn_cvt_pk_fp8_f32(x, x, 0, false); return __builtin_amdgcn_cvt_f32_fp8(p, 0); }
#ifndef FP8_EMU
#define FP8_EMU 0
#endif
__device__ __forceinline__ unsigned pk4_fp8(float a, float b, float c, float d) { int w = __builtin_amdgcn_cvt_pk_fp8_f32(a, b, 0, false); w = __builtin_amdgcn_cvt_pk_fp8_f32(c, d, w, true); return (unsigned)w; }
template <bool Q8 = false>
__device__ __forceinline__ void tr_item(const float* W, int ldw, int k0, int n0, bf16* WT, int ldt, int drow0, float* scr, int lane) {
    f32x4 ld[8];
#pragma unroll
    for (int i = 0; i < 8; ++i) ld[i] = __builtin_nontemporal_load((const f32x4*)(W + (size_t)(k0 + 8 * i + (lane >> 3)) * ldw + n0 + 4 * (lane & 7)));
#pragma unroll
    for (int i = 0; i < 8; ++i) { float* d = scr + (8 * i + (lane >> 3)) * 33 + 4 * (lane & 7); d[0] = ld[i][0]; d[1] = ld[i][1]; d[2] = ld[i][2]; d[3] = ld[i][3]; }
    LDS_WAIT(); asm volatile("" ::: "memory");
    const int c = lane & 7;
#pragma unroll
    for (int j = 0; j < 4; ++j) { const int n = (lane >> 3) + 8 * j; const float* s = scr + (8 * c) * 33 + n;
        v4u o;
        if (Q8) { o.x = pk2(q8(32.f * s[0 * 33]), q8(32.f * s[1 * 33])); o.y = pk2(q8(32.f * s[2 * 33]), q8(32.f * s[3 * 33])); o.z = pk2(q8(32.f * s[4 * 33]), q8(32.f * s[5 * 33])); o.w = pk2(q8(32.f * s[6 * 33]), q8(32.f * s[7 * 33])); }
        else { o.x = pk2(s[0 * 33], s[1 * 33]); o.y = pk2(s[2 * 33], s[3 * 33]); o.z = pk2(s[4 * 33], s[5 * 33]); o.w = pk2(s[6 * 33], s[7 * 33]); }
        *(v4u*)(WT + (size_t)(drow0 + n) * ldt + k0 + 8 * c) = o; }
    LDS_WAIT(); asm volatile("" ::: "memory");
}

__device__ __forceinline__ void tr_item_fp8(const float* W, int ldw, int k0, int n0, unsigned char* WT8, int ldt, int drow0, float* scr, int lane) {
    f32x4 ld[8];
#pragma unroll
    for (int i = 0; i < 8; ++i) ld[i] = __builtin_nontemporal_load((const f32x4*)(W + (size_t)(k0 + 8 * i + (lane >> 3)) * ldw + n0 + 4 * (lane & 7)));
#pragma unroll
    for (int i = 0; i < 8; ++i) { float* d = scr + (8 * i + (lane >> 3)) * 33 + 4 * (lane & 7); d[0] = ld[i][0]; d[1] = ld[i][1]; d[2] = ld[i][2]; d[3] = ld[i][3]; }
    LDS_WAIT(); asm volatile("" ::: "memory");
    const int c = lane & 7;
#pragma unroll
    for (int j = 0; j < 4; ++j) { const int n = (lane >> 3) + 8 * j; const float* s = scr + (8 * c) * 33 + n;
        v2u o; o.x = pk4_fp8(32.f * s[0 * 33], 32.f * s[1 * 33], 32.f * s[2 * 33], 32.f * s[3 * 33]); o.y = pk4_fp8(32.f * s[4 * 33], 32.f * s[5 * 33], 32.f * s[6 * 33], 32.f * s[7 * 33]);
        *(v2u*)(WT8 + (size_t)(drow0 + n) * ldt + k0 + 8 * c) = o; }
    LDS_WAIT(); asm volatile("" ::: "memory");
}

struct TrItem { const float* W; int ldw, k0, n0; unsigned char* dst; int ldt, drow, kind; };
__device__ __forceinline__ void tr_load(f32x4 (&ld)[8], const TrItem& t, int lane) {
    if (t.kind == 0) return;
#pragma unroll
    for (int i = 0; i < 8; ++i) ld[i] = __builtin_nontemporal_load((const f32x4*)(t.W + (size_t)(t.k0 + 8 * i + (lane >> 3)) * t.ldw + t.n0 + 4 * (lane & 7)));
}
__device__ __forceinline__ void tr_store(const f32x4 (&ld)[8], const TrItem& t, float* scr, int lane) {
    if (t.kind == 0) return;
#pragma unroll
    for (int i = 0; i < 8; ++i) { float* d = scr + (8 * i + (lane >> 3)) * 33 + 4 * (lane & 7); d[0] = ld[i][0]; d[1] = ld[i][1]; d[2] = ld[i][2]; d[3] = ld[i][3]; }
    LDS_WAIT(); asm volatile("" ::: "memory");
    const int c = lane & 7;
    if (t.kind == 2) {
#pragma unroll
        for (int j = 0; j < 4; ++j) { const int n = (lane >> 3) + 8 * j; const float* s = scr + (8 * c) * 33 + n;
            v2u o; o.x = pk4_fp8(32.f * s[0 * 33], 32.f * s[1 * 33], 32.f * s[2 * 33], 32.f * s[3 * 33]); o.y = pk4_fp8(32.f * s[4 * 33], 32.f * s[5 * 33], 32.f * s[6 * 33], 32.f * s[7 * 33]);
            *(v2u*)(t.dst + (size_t)(t.drow + n) * t.ldt + t.k0 + 8 * c) = o; }
    } else {
#pragma unroll
        for (int j = 0; j < 4; ++j) { const int n = (lane >> 3) + 8 * j; const float* s = scr + (8 * c) * 33 + n;
            v4u o; o.x = pk2(s[0 * 33], s[1 * 33]); o.y = pk2(s[2 * 33], s[3 * 33]); o.z = pk2(s[4 * 33], s[5 * 33]); o.w = pk2(s[6 * 33], s[7 * 33]);
            *(v4u*)((bf16*)t.dst + (size_t)(t.drow + n) * t.ldt + t.k0 + 8 * c) = o; }
    }
    LDS_WAIT(); asm volatile("" ::: "memory");
}
#define TR_PIPELINE(FIRST, COUNT, STRIDE, DEC, scr, lane) do { f32x4 la_[8], lb_[8]; TrItem ta_, tb_; int it_ = (FIRST); \
        if (it_ < (COUNT)) { DEC(it_, ta_); tr_load(la_, ta_, lane); } \
        while (it_ < (COUNT)) { \
            int nx_ = it_ + (STRIDE); if (nx_ < (COUNT)) { DEC(nx_, tb_); tr_load(lb_, tb_, lane); } \
            tr_store(la_, ta_, scr, lane); it_ = nx_; if (it_ >= (COUNT)) break; \
            nx_ = it_ + (STRIDE); if (nx_ < (COUNT)) { DEC(nx_, ta_); tr_load(la_, ta_, lane); } \
            tr_store(lb_, tb_, scr, lane); it_ = nx_; } } while (0)

__device__ __forceinline__ void p0_prologue(Frame& F) {
    float* scr = (float*)(F.lds + F.wave * 16384);
    const int gw = F.bx * NWAVES + F.wave, NGW = F.G * NWAVES;
    constexpr int I_WIN = 16 * 201, I_WBR = 8 * 32, I_WOUT = 16 * 32, I_W1 = 16 * 88, I_W2 = 44 * 32, I_PW = 2 * 4;
    constexpr int NITEMS = 2 * I_WIN + 6 * I_WBR + 2 * I_WOUT + 2 * I_W1 + I_W2 + 8 * I_PW;
    bf16* WIN = (bf16*)(F.ws + WS_WIN); bf16* WBR = (bf16*)(F.ws + WS_WBR); bf16* WOUT = (bf16*)(F.ws + WS_WOUT);
    bf16* W13 = (bf16*)(F.ws + WS_W13); bf16* W2 = (bf16*)(F.ws + WS_W2); bf16* PW = (bf16*)(F.ws + WS_POOLW);
#define P0_DEC(it, t) do { int r = (it); t.kind = 0; \
        if (r < 2 * I_WIN) { const int l = r / I_WIN, q = r % I_WIN, kb = q / 201, n0 = (q % 201) * 32; \
            const int drow = n0 < 2816 ? n0 : (n0 < 2848 ? 3328 + (n0 - 2816) : (n0 < 3360 ? n0 - 32 : 3584 + (n0 - 3360))); \
            t.W = IN_w_in(F) + (size_t)l * 1024 * IN_COLS; t.ldw = IN_COLS; t.k0 = kb * 64; t.n0 = n0; t.ldt = 1024; \
            if (GATES_FP8 && n0 >= 3360) { t.dst = (unsigned char*)(WIN + (size_t)l * WIN_ROWS * 1024 + (size_t)NA * 1024); t.drow = n0 - 3360; t.kind = 2; } \
            else { t.dst = (unsigned char*)(WIN + (size_t)l * WIN_ROWS * 1024); t.drow = drow; t.kind = 1; } } \
        else if ((r -= 2 * I_WIN) < 6 * I_WBR) { const int ln = r / I_WBR, q = r % I_WBR, kb = q / 32, n0 = (q % 32) * 32;        \
            if (ln % 3 != 2) { t.W = IN_w_branch(F) + (size_t)ln * 512 * 1024; t.ldw = 1024; t.k0 = kb * 64; t.n0 = n0; t.dst = (unsigned char*)(WBR + (size_t)ln * 1024 * 512); t.ldt = 512; t.drow = n0; t.kind = 1; } } \
        else if ((r -= 6 * I_WBR) < 2 * I_WOUT) { const int l = r / I_WOUT, q = r % I_WOUT, kb = q / 32, n0 = (q % 32) * 32; \
            t.W = IN_w_out(F) + (size_t)l * 1024 * 1024; t.ldw = 1024; t.k0 = kb * 64; t.n0 = n0; t.dst = (unsigned char*)(WOUT + (size_t)l * 1024 * 1024); t.ldt = 1024; t.drow = n0; t.kind = 1; } \
        else if ((r -= 2 * I_WOUT) < 2 * I_W1) { const int w = r / I_W1, q = r % I_W1, kb = q / 88, n0 = (q % 88) * 32; \
            t.W = w ? IN_ffn_w3(F) : IN_ffn_w1(F); t.ldw = FF; t.k0 = kb * 64; t.n0 = n0; t.dst = (unsigned char*)W13; t.ldt = 1024; t.drow = (n0 >> 7) * 256 + (n0 & 127) + w * 128; t.kind = (FFN_FP8 == 1 || FFN_FP8 == 2) ? 2 : 1; } \
        else if ((r -= 2 * I_W1) < I_W2) { const int kb = r / 32, n0 = (r % 32) * 32; \
            t.W = IN_ffn_w2(F); t.ldw = 1024; t.k0 = kb * 64; t.n0 = n0; t.dst = (unsigned char*)W2; t.ldt = FF; t.drow = n0; t.kind = (FFN_FP8 == 1 || FFN_FP8 == 3) ? 2 : 1; } } while (0)
    (void)PW;
    TR_PIPELINE(gw, NITEMS, NGW, P0_DEC, scr, F.lane);
#undef P0_DEC
    for (int it = gw; it < 2 * 64 * 16; it += NGW) { const int l = it >> 10, cg = (it >> 4) & 63, db = it & 15, g = cg >> 4, c0 = (cg & 15) * 8, d = db * 64 + F.lane;
        const float* pw = IN_pool_w(F) + (((size_t)l * 4 + g) * 128 + c0) * 128; const float* ps = IN_pool_scale(F) + l * 512 + g * 128;
        const float* wb = IN_w_branch(F) + (((size_t)l * 3 + 2) * 512 + g * 128) * 1024 + d;
        float acc[8];
#pragma unroll
        for (int j = 0; j < 8; ++j) acc[j] = 0.f;
#pragma unroll 4
        for (int k = 0; k < 128; ++k) { const float sv = ps[k] * wb[(size_t)k * 1024];
#pragma unroll
            for (int j = 0; j < 8; ++j) acc[j] += pw[j * 128 + k] * sv; }
        v4u o; o.x = pk2(acc[0], acc[1]); o.y = pk2(acc[2], acc[3]); o.z = pk2(acc[4], acc[5]); o.w = pk2(acc[6], acc[7]);
        *(v4u*)(WBR + (((size_t)l * 3 + 2) * 1024 + d) * 512 + g * 128 + c0) = o; }
    bf16* HB = (bf16*)(F.ws + WS_HB);
    const size_t gt = (size_t)F.bx * NTHR + F.tid, NT = (size_t)F.G * NTHR;
    const f32x4* xp = (const f32x4*)IN_x(F);
    for (size_t i0 = gt; i0 < (size_t)M * D / 8; i0 += 4 * NT) {
        f32x4 a[4], b[4];
#pragma unroll
        for (int u = 0; u < 4; ++u) { const size_t i = i0 + u * NT; a[u] = __builtin_nontemporal_load(xp + 2 * i); b[u] = __builtin_nontemporal_load(xp + 2 * i + 1); }
#pragma unroll
        for (int u = 0; u < 4; ++u) { const size_t i = i0 + u * NT; v4u o; o.x = pk2(a[u].x, a[u].y); o.y = pk2(a[u].z, a[u].w); o.z = pk2(b[u].x, b[u].y); o.w = pk2(b[u].z, b[u].w); ((v4u*)HB)[i] = o;
            if (GATES_FP8) { v2u o8; o8.x = pk4_fp8(a[u].x, a[u].y, a[u].z, a[u].w); o8.y = pk4_fp8(b[u].x, b[u].y, b[u].z, b[u].w); ((v2u*)(F.ws + WS_HBG8))[i] = o8; } }
    }
}
__device__ __forceinline__ void moe_weight_convert(Frame& F) {
    float* scr = (float*)(F.lds + F.wave * 16384);
    const int gw = F.bx * NWAVES + F.wave, NGW = F.G * NWAVES;
    constexpr int I_GU = 16 * 112, I_D = 56 * 32;
    constexpr int NITEMS = NE * (2 * I_GU + I_D);
    bf16* MWGU = (bf16*)(F.ws + WS_MWGU); bf16* MWD = (bf16*)(F.ws + WS_MWD);
#if MOE_FP8
#define MOE_DEC(it, t) do { int r = (it); \
        if (r < NE * 2 * I_GU) { const int e = r / (2 * I_GU), q2 = r % (2 * I_GU), w = q2 / I_GU, q = q2 % I_GU, kb = q / 112, n0 = (q % 112) * 32; \
            t.W = (w ? IN_moe_wu(F) : IN_moe_wg(F)) + (size_t)e * 1024 * FFE; t.ldw = FFE; t.k0 = kb * 64; t.n0 = n0; t.dst = (unsigned char*)MWGU; t.ldt = 1024; t.drow = e * 2 * FFE + (n0 >> 7) * 256 + (n0 & 127) + w * 128; t.kind = 2; } \
        else { r -= NE * 2 * I_GU; const int e = r / I_D, q = r % I_D, kb = q / 32, n0 = (q % 32) * 32; \
            t.W = IN_moe_wd(F) + (size_t)e * FFE * 1024; t.ldw = 1024; t.k0 = kb * 64; t.n0 = n0; t.dst = (unsigned char*)MWD + (size_t)e * 1024 * FFE; t.ldt = FFE; t.drow = n0; t.kind = 2; } } while (0)
    TR_PIPELINE(gw, NITEMS, NGW, MOE_DEC, scr, F.lane);
#undef MOE_DEC
#else
    for (int it = gw; it < NITEMS; it += NGW) {
        int r = it;
        if (r < NE * 2 * I_GU) { const int e = r / (2 * I_GU), q2 = r % (2 * I_GU), w = q2 / I_GU, q = q2 % I_GU, kb = q / 112, n0 = (q % 112) * 32;
            const int drow = e * 2 * FFE + (n0 >> 7) * 256 + (n0 & 127) + w * 128;
            tr_item<FP8_EMU != 0>((w ? IN_moe_wu(F) : IN_moe_wg(F)) + (size_t)e * 1024 * FFE, FFE, kb * 64, n0, MWGU, 1024, drow, scr, F.lane);
            continue; }
        r -= NE * 2 * I_GU;
        { const int e = r / I_D, q = r % I_D, kb = q / 32, n0 = (q % 32) * 32;
            tr_item<FP8_EMU != 0>(IN_moe_wd(F) + (size_t)e * FFE * 1024, 1024, kb * 64, n0, MWD + (size_t)e * 1024 * FFE, FFE, n0, scr, F.lane); }
    }
#endif
}

using pg8::acc_t; using pg8::Unit; using pg8::cvt_pk_bf16; using pg8::zero_acc;
__device__ __forceinline__ v4u pack8(const f32x4& v0, const f32x4& v1) { v4u w; w.x = cvt_pk_bf16(v0[0], v0[1]); w.y = cvt_pk_bf16(v0[2], v0[3]); w.z = cvt_pk_bf16(v1[0], v1[1]); w.w = cvt_pk_bf16(v1[2], v1[3]); return w; }

struct EpiInA {
    static constexpr bool PERM = true;
    unsigned char* ws;
    __device__ __forceinline__ void operator()(acc_t& acc, const Unit& u, int wr, int wc, int fr, int fq) const {
        const int pn = u.pn; const size_t row0 = (size_t)u.pm * 256 + wr * 64 + fr;
        if (pn == 13) {
            if (wc == 0) { float* dab = (float*)(ws + WS_DAB);
#pragma unroll
                for (int ai = 0; ai < 2; ++ai)
#pragma unroll
                    for (int m = 0; m < 4; ++m) { float* p = dab + (row0 + ai * 128 + m * 16) * 32 + 8 * fq; *(f32x4*)p = acc[ai][0][m][0]; *(f32x4*)(p + 4) = acc[ai][0][m][1]; } }
        } else {
            bf16* b0; bf16* b1; int ldc;
            if (pn < 2) { ldc = 512; b0 = (bf16*)(ws + WS_AQ) + pn * 256; b1 = b0 + 128; }
            else if (pn == 2) { ldc = 128; b0 = (bf16*)(ws + WS_AK); b1 = (bf16*)(ws + WS_AV); }
            else if (pn < 9) { ldc = 1536; b0 = (bf16*)(ws + WS_DQKV) + (pn - 3) * 256; b1 = b0 + 128; }
            else if (pn < 11) { ldc = 512; b0 = (bf16*)(ws + WS_DZ) + (pn - 9) * 256; b1 = b0 + 128; }
            else { ldc = 512; b0 = (bf16*)(ws + WS_PU) + (pn - 11) * 256; b1 = b0 + 128; }
            const int cl = wc * 32 + 8 * fq;
#pragma unroll
            for (int ai = 0; ai < 2; ++ai)
#pragma unroll
                for (int m = 0; m < 4; ++m) { const size_t ro = (row0 + ai * 128 + m * 16) * ldc + cl;
                    *(v4u*)(b0 + ro) = pack8(acc[ai][0][m][0], acc[ai][0][m][1]);
                    *(v4u*)(b1 + ro) = pack8(acc[ai][1][m][0], acc[ai][1][m][1]); }
        }
        zero_acc(acc);
    }
};
struct EpiGates {
    static constexpr bool PERM = true;
    bf16* GT; float asc;
    __device__ __forceinline__ void operator()(acc_t& acc, const Unit& u, int wr, int wc, int fr, int fq) const {
        const size_t row0 = (size_t)u.pm * 256 + wr * 64 + fr;
        bf16* base = GT + (size_t)(u.pn >> 2) * M * 1024 + (u.pn & 3) * 256 + wc * 32 + 8 * fq;
#pragma unroll
        for (int ai = 0; ai < 2; ++ai)
#pragma unroll
            for (int m = 0; m < 4; ++m)
#pragma unroll
                for (int bj = 0; bj < 2; ++bj) { f32x4 v0 = acc[ai][bj][m][0], v1 = acc[ai][bj][m][1];
#pragma unroll
                    for (int j = 0; j < 4; ++j) { v0[j] = sigmoidf_(v0[j] * asc); v1[j] = sigmoidf_(v1[j] * asc); }
                    *(v4u*)(base + (row0 + ai * 128 + m * 16) * 1024 + bj * 128) = pack8(v0, v1); }
        zero_acc(acc);
    }
};
struct BrSched {
    pg8::StaticOrder o; const char *A0, *B0; size_t tstep;
    __device__ __forceinline__ bool next(int i, Unit& u) const { const int t = i / 3; u.aux = i - 3 * t; return o.map((long)t * o.G + o.c, u.pm, u.pn); }
    __device__ __forceinline__ const char* abase(const Unit& u) const { return A0 + (size_t)u.aux * (32 * MiB) + (size_t)u.pm * tstep; }
    __device__ __forceinline__ const char* bbase(const Unit& u) const { return B0 + (size_t)u.aux * (1024 * 512 * 2) + (size_t)u.pn * tstep; }
};
__device__ __forceinline__ void unpack8(const v4u& w, f32x4& a, f32x4& b) { a[0] = bflo(w.x); a[1] = bfhi(w.x); a[2] = bflo(w.y); a[3] = bfhi(w.y); b[0] = bflo(w.z); b[1] = bfhi(w.z); b[2] = bflo(w.w); b[3] = bfhi(w.w); }
#ifndef GNT
#define GNT 1
#endif
struct EpiBranch {
    static constexpr bool PERM = true;
    const bf16* GT; bf16* MG;
    __device__ __forceinline__ void operator()(acc_t& acc, const Unit& u, int wr, int wc, int fr, int fq) const {
        const unsigned eoff = ((unsigned)u.pm * 256u + (unsigned)(wr * 64 + fr)) * 1024u + (unsigned)(u.pn * 256 + wc * 32 + 8 * fq); const int seg = u.aux;
        const char* gn = (const char*)(GT + (size_t)seg * M * 1024);
        const char* gd = (const char*)(GT + (size_t)(seg < 2 ? seg + 1 : 2) * M * 1024);
#pragma unroll
        for (int ai = 0; ai < 2; ++ai)
#pragma unroll
          for (int mh = 0; mh < 2; ++mh) {
            v4u nb[4], db[4];
#pragma unroll
            for (int mm = 0; mm < 2; ++mm)
#pragma unroll
                for (int bj = 0; bj < 2; ++bj) { const int m = 2 * mh + mm; const size_t off = (size_t)((eoff + (unsigned)((ai * 128 + m * 16) * 1024 + bj * 128)) * 2u);
                    nb[mm * 2 + bj] = GNT ? __builtin_nontemporal_load((const v4u*)(gn + off)) : *(const v4u*)(gn + off);
                    if (seg < 2) db[mm * 2 + bj] = *(const v4u*)(gd + off); }
            __builtin_amdgcn_sched_barrier(0);
#pragma unroll
            for (int mm = 0; mm < 2; ++mm)
#pragma unroll
                for (int bj = 0; bj < 2; ++bj) { const int m = 2 * mh + mm; const size_t off = (size_t)((eoff + (unsigned)((ai * 128 + m * 16) * 1024 + bj * 128)) * 2u);
                    f32x4 n0, n1; unpack8(nb[mm * 2 + bj], n0, n1);
                    if (seg < 2) { f32x4 d0, d1; unpack8(db[mm * 2 + bj], d0, d1);
#pragma unroll
                        for (int j = 0; j < 4; ++j) { n0[j] *= __builtin_amdgcn_rcpf(fmaxf(d0[j], 1e-30f)); n1[j] *= __builtin_amdgcn_rcpf(fmaxf(d1[j], 1e-30f)); } }
                    acc[ai][bj][m][0] *= n0; acc[ai][bj][m][1] *= n1;
                    if (seg == 2) *(v4u*)((char*)MG + off) = pack8(acc[ai][bj][m][0], acc[ai][bj][m][1]); }
            __builtin_amdgcn_sched_barrier(0);
          }
        if (seg == 2) zero_acc(acc);
    }
};
struct EpiBranchRMW {
    static constexpr bool PERM = true;
    const bf16* GT; bf16* MG;
    __device__ __forceinline__ void operator()(acc_t& acc, const Unit& u, int wr, int wc, int fr, int fq) const {
        const size_t row0 = (size_t)u.pm * 256 + wr * 64 + fr; const int col = u.pn * 256 + wc * 32 + 8 * fq; const int seg = u.aux;
        const bf16* gn = GT + (size_t)seg * M * 1024;
#pragma unroll
        for (int ai = 0; ai < 2; ++ai)
#pragma unroll
            for (int m = 0; m < 4; ++m)
#pragma unroll
                for (int bj = 0; bj < 2; ++bj) { const size_t off = (row0 + ai * 128 + m * 16) * 1024 + col + bj * 128;
                    f32x4 n0, n1; unpack8(*(const v4u*)(gn + off), n0, n1);
                    f32x4 r0 = acc[ai][bj][m][0] * n0, r1 = acc[ai][bj][m][1] * n1;
                    if (seg > 0) { f32x4 p0, p1; unpack8(*(const v4u*)(MG + off), p0, p1); r0 += p0; r1 += p1; }
                    *(v4u*)(MG + off) = pack8(r0, r1); }
        zero_acc(acc);
    }
};
struct EpiResid {
    static constexpr bool PERM = true;
    bf16* HBp; float ys;
    __device__ __forceinline__ void operator()(acc_t& acc, const Unit& u, int wr, int wc, int fr, int fq) const {
        const size_t row0 = (size_t)u.pm * 256 + wr * 64 + fr; const int col0 = u.pn * 256 + wc * 32 + 8 * fq;
#pragma unroll
        for (int ai = 0; ai < 2; ++ai)
#pragma unroll
            for (int m = 0; m < 4; ++m) { bf16* rp = HBp + (row0 + ai * 128 + m * 16) * 1024 + col0;
#pragma unroll
                for (int bj = 0; bj < 2; ++bj) { f32x4 h0, h1; unpack8(*(const v4u*)(rp + bj * 128), h0, h1);
                    *(v4u*)(rp + bj * 128) = pack8(h0 * ALPHA + acc[ai][bj][m][0] * ys, h1 * ALPHA + acc[ai][bj][m][1] * ys); } }
        zero_acc(acc);
    }
};
template <int use, bool g8, int LNI  >
struct EpiResidLN {
    static constexpr bool PERM = true;
    unsigned char* ws; const Args* a; LAS unsigned char* ldsl; float ys;
    __device__ __forceinline__ void operator()(acc_t& acc, const Unit& u, int wr, int wc, int fr_in, int fq_in) const {
        int fr = fr_in, fq = fq_in; asm volatile("" : "+v"(fr), "+v"(fq));
        const int tid = (wr * 4 + wc) * 64 + fq * 16 + fr;
        LAS float* part = (LAS float*)(ldsl + LNX_LDS_OFF); LAS float* mr = part + 2048;
        const int rloc = wr * 64 + fr; const int col0 = u.pn * 256 + wc * 32 + 8 * fq;
        const unsigned eoff = ((unsigned)u.pm * 256u + (unsigned)rloc) * 1024u + (unsigned)col0;
        const char* hb = (const char*)(ws + WS_HB);
#pragma unroll
        for (int ai = 0; ai < 2; ++ai) {
            v4u rb[8];
#pragma unroll
            for (int m = 0; m < 4; ++m)
#pragma unroll
                for (int bj = 0; bj < 2; ++bj) rb[m * 2 + bj] = *(const v4u*)(hb + (size_t)((eoff + (unsigned)(ai * 128 + m * 16) * 1024u) * 2u + bj * 256u));
            __builtin_amdgcn_sched_barrier(0);
#pragma unroll
            for (int m = 0; m < 4; ++m) { float a = 0.f, q = 0.f;
#pragma unroll
                for (int bj = 0; bj < 2; ++bj) { f32x4 h0, h1; unpack8(rb[m * 2 + bj], h0, h1);
                    const f32x4 z0 = h0 * ALPHA + acc[ai][bj][m][0] * ys, z1 = h1 * ALPHA + acc[ai][bj][m][1] * ys; acc[ai][bj][m][0] = z0; acc[ai][bj][m][1] = z1;
                    a += ((z0[0] + z0[1]) + (z0[2] + z0[3])) + ((z1[0] + z1[1]) + (z1[2] + z1[3]));
                    q += ((z0[0] * z0[0] + z0[1] * z0[1]) + (z0[2] * z0[2] + z0[3] * z0[3])) + ((z1[0] * z1[0] + z1[1] * z1[1]) + (z1[2] * z1[2] + z1[3] * z1[3])); }
                a += __shfl_xor(a, 16); a += __shfl_xor(a, 32); q += __shfl_xor(q, 16); q += __shfl_xor(q, 32);
                if (fq == 0) { LAS float* d = part + (wc * 256 + rloc + ai * 128 + m * 16) * 2; d[0] = a; d[1] = q; } }
            __builtin_amdgcn_sched_barrier(0);
        }
        __syncthreads();
        float S1 = 0.f, S2 = 0.f;
        float* stat = (float*)(ws + WS_LNSTAT) + (size_t)u.pm * 4 * 512;
        if (tid < 256) {
#pragma unroll
            for (int w = 0; w < 4; ++w) { S1 += part[(w * 256 + tid) * 2]; S2 += part[(w * 256 + tid) * 2 + 1]; }
            __hip_atomic_store(stat + (u.pn * 256 + tid) * 2, S1, RLX_AGENT); __hip_atomic_store(stat + (u.pn * 256 + tid) * 2 + 1, S2, RLX_AGENT); }
        asm volatile("s_waitcnt vmcnt(0)" ::: "memory");
        __syncthreads();
        if (tid == 0) { unsigned* flag = (unsigned*)(ws + WS_CTL) + CW_LNX + use * 128 + u.pm;
            (void)__hip_atomic_fetch_add(flag, 1u, RLX_AGENT);
            unsigned sp = 0u; while (__hip_atomic_load(flag, RLX_AGENT) < 4u && ++sp < (1u << 20)) __builtin_amdgcn_s_sleep(1); }
        __syncthreads();
        if (tid < 256) {
#pragma unroll
            for (int p = 1; p < 4; ++p) { const int pn2 = (u.pn + p) & 3; S1 += __hip_atomic_load(stat + (pn2 * 256 + tid) * 2, RLX_AGENT); S2 += __hip_atomic_load(stat + (pn2 * 256 + tid) * 2 + 1, RLX_AGENT); }
            const float mean = S1 * (1.0f / 1024.0f), var = S2 * (1.0f / 1024.0f) - mean * mean;
            mr[tid * 2] = mean; mr[tid * 2 + 1] = __builtin_amdgcn_rsqf((var > 0.f ? var : 0.f) + LN_EPS); }
        __syncthreads();
        asm volatile("" : "+v"(fr), "+v"(fq));
        const int rloc2 = wr * 64 + fr; const int col2 = u.pn * 256 + wc * 32 + 8 * fq;
        const unsigned eoff2 = ((unsigned)u.pm * 256u + (unsigned)rloc2) * 1024u + (unsigned)col2;
        char* hbw = (char*)(ws + WS_HB); unsigned char* h8 = ws + WS_HBG8; const float* gam = a->in[12 + 2 * LNI]; const float* bet = a->in[13 + 2 * LNI];
#pragma unroll
        for (int bj = 0; bj < 2; ++bj) {
            const f32x4 g0 = *(const f32x4*)(gam + col2 + bj * 128), g1 = *(const f32x4*)(gam + col2 + bj * 128 + 4), b0 = *(const f32x4*)(bet + col2 + bj * 128), b1 = *(const f32x4*)(bet + col2 + bj * 128 + 4);
#pragma unroll
            for (int ai = 0; ai < 2; ++ai)
#pragma unroll
                for (int m = 0; m < 4; ++m) { const int rl = rloc2 + ai * 128 + m * 16; const float mean = mr[rl * 2], rstd = mr[rl * 2 + 1];
                    const unsigned eo = eoff2 + (unsigned)(ai * 128 + m * 16) * 1024u + bj * 128u;
                    const f32x4 v0 = (acc[ai][bj][m][0] - mean) * rstd * g0 + b0, v1 = (acc[ai][bj][m][1] - mean) * rstd * g1 + b1;
                    *(v4u*)(hbw + (size_t)(eo * 2u)) = pack8(v0, v1);
                    if (g8) { v2u o; o.x = pk4_fp8(v0[0], v0[1], v0[2], v0[3]); o.y = pk4_fp8(v1[0], v1[1], v1[2], v1[3]); *(v2u*)(h8 + (size_t)eo) = o; } } }
        zero_acc(acc);
    }
};
struct EpiSwiglu {
    static constexpr bool PERM = true;
    bf16* ACT; int ldc; float asc; int q;
    __device__ __forceinline__ void operator()(acc_t& acc, const Unit& u, int wr, int wc, int fr, int fq) const {
        const size_t row0 = (size_t)u.pm * 256 + wr * 64 + fr; const int col = u.aux * 128 + wc * 32 + 8 * fq;
#pragma unroll
        for (int ai = 0; ai < 2; ++ai)
#pragma unroll
            for (int m = 0; m < 4; ++m) { f32x4 v0, v1;
#pragma unroll
                for (int j = 0; j < 4; ++j) { v0[j] = siluf_(acc[ai][0][m][0][j] * asc) * (acc[ai][1][m][0][j] * asc); v1[j] = siluf_(acc[ai][0][m][1][j] * asc) * (acc[ai][1][m][1][j] * asc); if (q) { v0[j] = q8(v0[j]); v1[j] = q8(v1[j]); } }
                *(v4u*)(ACT + (row0 + ai * 128 + m * 16) * ldc + col) = pack8(v0, v1); }
        zero_acc(acc);
    }
};
struct EpiSwiglu8 {
    static constexpr bool PERM = true;
    unsigned char* ACT; int ldc; float asc;
    __device__ __forceinline__ void operator()(acc_t& acc, const Unit& u, int wr, int wc, int fr, int fq) const {
        const size_t row0 = (size_t)u.pm * 256 + wr * 64 + fr; const int col = u.aux * 128 + wc * 32 + 8 * fq;
#pragma unroll
        for (int ai = 0; ai < 2; ++ai)
#pragma unroll
            for (int m = 0; m < 4; ++m) { float v[8];
#pragma unroll
                for (int j = 0; j < 4; ++j) { v[j] = siluf_(acc[ai][0][m][0][j] * asc) * (acc[ai][1][m][0][j] * asc); v[4 + j] = siluf_(acc[ai][0][m][1][j] * asc) * (acc[ai][1][m][1][j] * asc); }
                v2u o; o.x = pk4_fp8(v[0], v[1], v[2], v[3]); o.y = pk4_fp8(v[4], v[5], v[6], v[7]);
                *(v2u*)(ACT + (row0 + ai * 128 + m * 16) * ldc + col) = o;
                __builtin_amdgcn_sched_barrier(0); }
        zero_acc(acc);
    }
};
struct FfnUpSched {
    pg8::StaticOrder o; const char* A; const char* Bt; size_t tstep;
    __device__ __forceinline__ bool next(int i, Unit& u) const { const bool ok = o.map((long)i * o.G + o.c, u.pm, u.pn); u.aux = u.pn; return ok; }
    __device__ __forceinline__ const char* abase(const Unit& u) const { return A + (size_t)u.pm * tstep; }
    __device__ __forceinline__ const char* bbase(const Unit& u) const { return Bt + (size_t)u.pn * tstep; }
};

constexpr int DN_RAW_OFF = 0;
constexpr int DN_XS_OFF = 26624;
constexpr int DN_OB_OFF = DN_XS_OFF + 49152;
constexpr int DN_AB_OFF = DN_OB_OFF + 16384;
constexpr int DN_CW_OFF = DN_AB_OFF + 512;
static_assert(DN_CW_OFF + 3840 <= RING_BYTES, "delta LDS");
__device__ __forceinline__ void delta_seq(Frame& F, int layer, int seq) {
    const int dir = seq >> 7, b = (seq >> 3) & 15, h = seq & 7;
    bf16* raw = (bf16*)(F.lds + DN_RAW_OFF); float* xs = (float*)(F.lds + DN_XS_OFF); float* ob = (float*)(F.lds + DN_OB_OFF);
    float* ab = (float*)(F.lds + DN_AB_OFF); float* cw = (float*)(F.lds + DN_CW_OFF);
    const bf16* DQKV = (const bf16*)(F.ws + WS_DQKV); const float* DAB = (const float*)(F.ws + WS_DAB);
    float* OUT = (float*)(F.ws + (dir ? WS_OB : WS_OF));
    const int tid = F.tid, lane = F.lane, wave = F.wave, p = lane & 7, j = wave * 8 + (lane >> 3);
    __syncthreads();
    for (int i = tid; i < 5 * 192; i += NTHR) { const int jj = i / 192, ch = i % 192; cw[i] = IN_conv_w(F)[((size_t)layer * 5 + jj) * 1536 + (ch >> 6) * 512 + h * 64 + (ch & 63)]; }
    const float nA = -__expf(IN_a_log(F)[layer * 16 + dir * 8 + h]), dtb = IN_dt_bias(F)[layer * 16 + dir * 8 + h];
    float S[8];
#pragma unroll
    for (int i = 0; i < 8; ++i) S[i] = 0.f;
    for (int blk = 0; blk < SEQ / 64; ++blk) {
        const int tb = dir ? (SEQ / 64 - 1 - blk) : blk, t0 = tb * 64;
        __syncthreads();
        for (int idx = tid; idx < 68 * 24; idx += NTHR) { const int r = idx / 24, pc = idx % 24, sec = pc >> 3, c8 = pc & 7, t = t0 - 2 + r;
            const v4u v = ld_or_zero(DQKV + ((size_t)b * SEQ + t) * 1536 + sec * 512 + h * 64 + c8 * 8, DQKV, t >= 0 && t < SEQ);
            *(v4u*)(raw + r * 192 + sec * 64 + c8 * 8) = v; }
        if (tid < 64) { const size_t m = (size_t)b * SEQ + t0 + tid; const float a = DAB[m * 32 + dir * 8 + h], bq = DAB[m * 32 + 16 + dir * 8 + h];
            const float xx = a + dtb; const float sp = xx > 20.f ? xx : log1pf(__expf(xx));
            ab[tid * 2] = __expf(nA * sp); ab[tid * 2 + 1] = sigmoidf_(bq); }
        __syncthreads();
        for (int idx = tid; idx < 64 * 192; idx += NTHR) { const int tt = idx / 192, ch = idx % 192; float x = 0.f;
#pragma unroll
            for (int jj = 0; jj < 5; ++jj) x += cw[jj * 192 + ch] * bf2f(raw[(tt + jj) * 192 + ch]);
            xs[idx] = siluf_(x); }
        __syncthreads();
        { const int row = tid >> 2, part = tid & 3, tt = row >> 1, sec = row & 1; float* xp = xs + tt * 192 + sec * 64 + part * 16; float ss = 0.f; float v[16];
#pragma unroll
            for (int i = 0; i < 16; ++i) { v[i] = xp[i]; ss += v[i] * v[i]; }
            ss = red4(ss);
            const float sc = __builtin_amdgcn_rsqf(ss + 1e-6f) * (sec == 0 ? 0.125f : 1.0f);
#pragma unroll
            for (int i = 0; i < 16; ++i) xp[i] = v[i] * sc; }
        __syncthreads();
        for (int s = 0; s < 64; ++s) {
            const int tt = dir ? 63 - s : s; const float* xr = xs + tt * 192;
            const f32x4 q0 = *(const f32x4*)(xr + 8 * p), q1 = *(const f32x4*)(xr + 8 * p + 4);
            const f32x4 k0 = *(const f32x4*)(xr + 64 + 8 * p), k1 = *(const f32x4*)(xr + 64 + 8 * p + 4);
            const float v = xr[128 + j], al = ab[tt * 2], be = ab[tt * 2 + 1];
            float part = (S[0] * k0[0] + S[1] * k0[1]) + (S[2] * k0[2] + S[3] * k0[3]) + (S[4] * k1[0] + S[5] * k1[1]) + (S[6] * k1[2] + S[7] * k1[3]);
            part = red8(part);
            const float c = be * (v - al * part);
            S[0] = al * S[0] + k0[0] * c; S[1] = al * S[1] + k0[1] * c; S[2] = al * S[2] + k0[2] * c; S[3] = al * S[3] + k0[3] * c;
            S[4] = al * S[4] + k1[0] * c; S[5] = al * S[5] + k1[1] * c; S[6] = al * S[6] + k1[2] * c; S[7] = al * S[7] + k1[3] * c;
            float op = (S[0] * q0[0] + S[1] * q0[1]) + (S[2] * q0[2] + S[3] * q0[3]) + (S[4] * q1[0] + S[5] * q1[1]) + (S[6] * q1[2] + S[7] * q1[3]);
            op = red8(op);
            if (p == 0) ob[tt * 64 + j] = op;
        }
        __syncthreads();
        for (int idx = tid; idx < 64 * 16; idx += NTHR) { const int tt = idx >> 4, c4 = idx & 15;
            *(f32x4*)(OUT + ((size_t)b * SEQ + t0 + tt) * 512 + h * 64 + c4 * 4) = *(const f32x4*)(ob + tt * 64 + c4 * 4); }
    }
}
__device__ __forceinline__ void delta_post(Frame& F, int layer) {
    const bf16* OFp = (const bf16*)(F.ws + WS_OF); const bf16* OBp = (const bf16*)(F.ws + WS_OB); bf16* DZ = (bf16*)(F.ws + WS_DZ);
    const int d4 = (F.lane & 15) * 4; const f32x4 nw = *(const f32x4*)(IN_dn_norm_w(F) + layer * 64 + d4);
    const size_t gq = ((size_t)F.bx * NTHR + F.tid) >> 4, NQ = ((size_t)F.G * NTHR) >> 4;
    for (size_t pr0 = gq; pr0 < (size_t)M * 8; pr0 += 4 * NQ) {
        v2u ofw[4], obw[4], zw[4];
#pragma unroll
        for (int u = 0; u < 4; ++u) { const size_t off = (pr0 + u * NQ) * 64 + d4; ofw[u] = *(const v2u*)(OFp + off); obw[u] = *(const v2u*)(OBp + off); zw[u] = *(const v2u*)(DZ + off); }
#pragma unroll
        for (int u = 0; u < 4; ++u) { const size_t off = (pr0 + u * NQ) * 64 + d4;
            const f32x4 o = (f32x4){bflo(ofw[u].x) + bflo(obw[u].x), bfhi(ofw[u].x) + bfhi(obw[u].x), bflo(ofw[u].y) + bflo(obw[u].y), bfhi(ofw[u].y) + bfhi(obw[u].y)};
            float ss = (o[0] * o[0] + o[1] * o[1]) + (o[2] * o[2] + o[3] * o[3]); ss = red16(ss);
            const float rs = (ABL == 2) ? 0.f : __builtin_amdgcn_rsqf(ss * (1.0f / 64.0f) + RMS_EPS);
            const float z0 = bflo(zw[u].x), z1 = bfhi(zw[u].x), z2 = bflo(zw[u].y), z3 = bfhi(zw[u].y);
            v2u w; w.x = pk2(o[0] * rs * nw[0] * siluf_(z0), o[1] * rs * nw[1] * siluf_(z1)); w.y = pk2(o[2] * rs * nw[2] * siluf_(z2), o[3] * rs * nw[3] * siluf_(z3));
            *(v2u*)(DZ + off) = w; }
    }
}

typedef short v4i16_t __attribute__((ext_vector_type(4)));
constexpr int AT_K_OFF = 0;
constexpr int AT_V_OFF = 46080;
constexpr int AT_BIAS_OFF = 92160;
static_assert(AT_V_OFF + 46080 <= AT_BIAS_OFF && AT_BIAS_OFF + 8320 <= RING_BYTES, "attn LDS");
__device__ __forceinline__ int t5_bucket(int rel) {
    const int n = rel < 0 ? -rel : rel;
    const int large = 8 + (n >= 12) + (n >= 16) + (n >= 23) + (n >= 32) + (n >= 46) + (n >= 64) + (n >= 91);
    return (rel > 0 ? 16 : 0) + (n < 8 ? n : large);
}
__device__ __forceinline__ void attn_bias_setup(Frame& F) {
    float* bl = (float*)(F.lds + AT_BIAS_OFF);
    for (int i = F.tid; i < 8 * 257; i += NTHR) { const int h = i / 257, r = i % 257; bl[h * 260 + r] = IN_rel_bias(F)[t5_bucket(r - 128) * 8 + h] * 1.44269504f; }
}
__device__ __forceinline__ void attn_load(Frame& F, int unit, v4u (&kr)[5], v4u (&vr)[5], bf16x8 (&qn)[4]) {
    const int b = unit >> 6, kvh = (unit >> 5) & 1, q0 = (unit & 31) * 64;
    const bf16* AK = (const bf16*)(F.ws + WS_AK); const bf16* AV = (const bf16*)(F.ws + WS_AV);
    { const int hq = kvh * 4 + (F.wave & 3), qw = q0 + 32 * (F.wave >> 2), qi = F.lane & 31, hl = F.lane >> 5;
        const bf16* qp = (const bf16*)(F.ws + WS_AQ) + ((size_t)b * SEQ + qw + qi) * 512 + hq * 64 + 8 * hl;
#pragma unroll
        for (int s = 0; s < 4; ++s) qn[s] = *(const bf16x8*)(qp + 16 * s); }
#pragma unroll
    for (int it = 0; it < 5; ++it) { const int idx = F.tid + it * NTHR, i = idx >> 3, d8 = idx & 7, kp = q0 - 128 + i; const bool ok = kp >= 0 && kp < SEQ;
        const size_t off = ((size_t)b * SEQ + kp) * 128 + kvh * 64 + d8 * 8;
        kr[it] = ld_or_zero(AK + off, AK, ok); vr[it] = ld_or_zero(AV + off, AV, ok); }
}
__device__ __forceinline__ void attn_store(Frame& F, const v4u (&kr)[5], const v4u (&vr)[5]) {
    bf16* Kl = (bf16*)(F.lds + AT_K_OFF); bf16* Vl = (bf16*)(F.lds + AT_V_OFF);
#pragma unroll
    for (int it = 0; it < 5; ++it) { const int idx = F.tid + it * NTHR, i = idx >> 3, d8 = idx & 7;
        *(v4u*)(Kl + i * 72 + d8 * 8) = kr[it]; *(v4u*)(Vl + i * 72 + d8 * 8) = vr[it]; }
}
__device__ __forceinline__ void attn_compute(Frame& F, int layer, int unit, bf16* OUT, const bf16x8 (&qf)[4]) {
    const int b = unit >> 6, kvh = (unit >> 5) & 1, qb = unit & 31, q0 = qb * 64;
    const bf16* Kl = (const bf16*)(F.lds + AT_K_OFF); const bf16* Vl = (const bf16*)(F.lds + AT_V_OFF); const float* bl = (const float*)(F.lds + AT_BIAS_OFF);
    bf16* AQ = (bf16*)(F.ws + WS_AQ);
    const int lane = F.lane, wave = F.wave;
    const int hq = kvh * 4 + (wave & 3), half = wave >> 2, qw = q0 + 32 * half, qi = lane & 31, hl = lane >> 5;
    const size_t qrow = ((size_t)b * SEQ + qw + qi) * 512 + hq * 64;
    f32x16 o0, o1;
#pragma unroll
    for (int i = 0; i < 16; ++i) { o0[i] = 0.f; o1[i] = 0.f; }
    float mrun = IN_attn_sink(F)[layer * 8 + hq] * 1.44269504f, lrun = hl == 0 ? 1.0f : 0.0f;
    const bool interior = (qb >= 2) && (qb <= 29);
    const float qsc = 0.125f * 1.44269504f;
    const float* bh = bl + hq * 260;
    auto qk = [&](int kt, f32x16& sc) {
        const int kb = 32 * half + 32 * kt;
#pragma unroll
        for (int i = 0; i < 16; ++i) sc[i] = 0.f;
#pragma unroll
        for (int s = 0; s < 4; ++s) { const bf16x8 a = *(const bf16x8*)(Kl + (kb + qi) * 72 + 16 * s + 8 * hl); sc = __builtin_amdgcn_mfma_f32_32x32x16_bf16(a, qf[s], sc, 0, 0, 0); }
    };
    auto smpv = [&](int kt, f32x16& sc) {
        const int kb = 32 * half + 32 * kt;
        float mt = -1e30f;
        if (interior && kt >= 1 && kt <= 7) {
            const float* bp = bh + 32 * kt + 4 * hl - qi;
#pragma unroll
            for (int i = 0; i < 16; ++i) { const float sv = sc[i] * qsc + bp[(i & 3) + 8 * (i >> 2)]; sc[i] = sv; mt = fmaxf(mt, sv); }
        } else {
#pragma unroll
            for (int i = 0; i < 16; ++i) { const int krow = (i & 3) + 8 * (i >> 2) + 4 * hl, kp = q0 - 128 + kb + krow, rel = kp - (qw + qi);
                const bool valid = (kp >= 0) && (kp < SEQ) && (rel >= -128) && (rel <= 128);
                const int ri = rel < -128 ? 0 : (rel > 128 ? 256 : rel + 128);
                const float sv = valid ? sc[i] * qsc + bh[ri] : -1e30f; sc[i] = sv; mt = fmaxf(mt, sv); }
        }
        mt = fmaxf(mt, __shfl_xor(mt, 32));
        if (__builtin_amdgcn_ballot_w64(mt > mrun) != 0ull) {
            const float mnew = fmaxf(mrun, mt), corr = __builtin_amdgcn_exp2f(mrun - mnew); mrun = mnew;
            lrun *= corr;
#pragma unroll
            for (int i = 0; i < 16; ++i) { o0[i] *= corr; o1[i] *= corr; }
        }
        float ls = 0.f;
#pragma unroll
        for (int i = 0; i < 16; ++i) { const float pv = __builtin_amdgcn_exp2f(sc[i] - mrun); sc[i] = pv; ls += pv; }
        lrun += ls;
#pragma unroll
        for (int s2 = 0; s2 < 2; ++s2) {
            v4u pw; pw.x = cvt_pk_bf16(sc[8 * s2 + 0], sc[8 * s2 + 1]); pw.y = cvt_pk_bf16(sc[8 * s2 + 2], sc[8 * s2 + 3]); pw.z = cvt_pk_bf16(sc[8 * s2 + 4], sc[8 * s2 + 5]); pw.w = cvt_pk_bf16(sc[8 * s2 + 6], sc[8 * s2 + 7]);
            const bf16x8 pb = __builtin_bit_cast(bf16x8, pw);
            const bf16* v0p = Vl + (size_t)(kb + 16 * s2 + 4 * hl + ((lane & 15) >> 2)) * 72 + 16 * ((lane >> 4) & 1) + 4 * (lane & 3);
            const v4i16_t a0 = __builtin_amdgcn_ds_read_tr16_b64_v4i16((LAS v4i16_t*)v0p), a1 = __builtin_amdgcn_ds_read_tr16_b64_v4i16((LAS v4i16_t*)(v0p + 8 * 72));
            const v4i16_t c0 = __builtin_amdgcn_ds_read_tr16_b64_v4i16((LAS v4i16_t*)(v0p + 32)), c1 = __builtin_amdgcn_ds_read_tr16_b64_v4i16((LAS v4i16_t*)(v0p + 32 + 8 * 72));
            const bf16x8 va = __builtin_shufflevector(a0, a1, 0, 1, 2, 3, 4, 5, 6, 7), vc = __builtin_shufflevector(c0, c1, 0, 1, 2, 3, 4, 5, 6, 7);
            o0 = __builtin_amdgcn_mfma_f32_32x32x16_bf16(va, pb, o0, 0, 0, 0);
            o1 = __builtin_amdgcn_mfma_f32_32x32x16_bf16(vc, pb, o1, 0, 0, 0);
        }
    };
    f32x16 sA, sB;
    qk(0, sA);
#pragma nounroll
    for (int kt = 0; kt < 8; kt += 2) { qk(kt + 1, sB); smpv(kt, sA); qk(kt + 2, sA); smpv(kt + 1, sB); }
    smpv(8, sA);
    lrun += __shfl_xor(lrun, 32);
    const float inv = (ABL == 1) ? 0.f : 1.0f / lrun;
#pragma unroll
    for (int g = 0; g < 4; ++g) {
        v2u w0, w1; w0.x = cvt_pk_bf16(o0[4 * g] * inv, o0[4 * g + 1] * inv); w0.y = cvt_pk_bf16(o0[4 * g + 2] * inv, o0[4 * g + 3] * inv);
        w1.x = cvt_pk_bf16(o1[4 * g] * inv, o1[4 * g + 1] * inv); w1.y = cvt_pk_bf16(o1[4 * g + 2] * inv, o1[4 * g + 3] * inv);
        bf16* OQ = OUT ? OUT : AQ; *(v2u*)(OQ + qrow + 8 * g + 4 * hl) = w0; *(v2u*)(OQ + qrow + 32 + 8 * g + 4 * hl) = w1; }
}

__device__ __forceinline__ void attn_phase(Frame& F, int layer, bf16* OUT) {
    v4u kr[5], vr[5]; bf16x8 qn[4];
    int u = F.bx;
    if (u < 1024) attn_load(F, u, kr, vr, qn);
    for (; u < 1024; u += F.G) {
        __syncthreads();
        attn_store(F, kr, vr);
        bf16x8 qf[4];
#pragma unroll
        for (int s = 0; s < 4; ++s) qf[s] = qn[s];
        __syncthreads();
        if (u + F.G < 1024) attn_load(F, u + F.G, kr, vr, qn);
        attn_compute(F, layer, u, OUT, qf);
    }
}

constexpr int PL_U_OFF = 0;
constexpr int PL_MX_OFF = 49152;
static_assert(PL_MX_OFF + 32768 <= RING_BYTES, "pool LDS");
__device__ __forceinline__ void pool_unit(Frame& F, int layer, int unit) {
    const int b = unit >> 6, t0 = (unit & 63) * 32;
    bf16* U = (bf16*)(F.lds + PL_U_OFF); bf16* MX = (bf16*)(F.lds + PL_MX_OFF);
    const bf16* PU = (const bf16*)(F.ws + WS_PU); bf16* OP = (bf16*)(F.ws + WS_OP);
    const int tid = F.tid;
    __syncthreads();
    for (int idx = tid; idx < 48 * 64; idx += NTHR) { const int r = idx >> 6, c8 = idx & 63, t = t0 - 8 + r;
        const v4u v = ld_or_zero(PU + ((size_t)b * SEQ + t) * 512 + c8 * 8, PU, t >= 0 && t < SEQ);
        *(v4u*)(U + r * 512 + c8 * 8) = v; }
    __syncthreads();
    { const int chp = tid & 255, tt0 = (tid >> 8) * 16, g = chp >> 6, r = 1 << g;
        const unsigned* Uw = (const unsigned*)U + chp;
        float s0 = 0.f, s1 = 0.f;
        for (int d = -r; d <= r; ++d) { const unsigned w = Uw[(8 + tt0 + d) * 256]; s0 += bflo(w); s1 += bfhi(w); }
        for (int i = 0; i < 16; ++i) { const int tt = tt0 + i, t = t0 + tt; const int lo = t - r < 0 ? 0 : t - r, hi = t + r > SEQ - 1 ? SEQ - 1 : t + r;
            const float rc = __builtin_amdgcn_rcpf((float)(hi - lo + 1)); const unsigned c = Uw[(8 + tt) * 256];
            ((unsigned*)MX)[tt * 256 + chp] = (ABL == 3) ? 0u : pk2(s0 * rc - bflo(c), s1 * rc - bfhi(c));
            if (i < 15) { const unsigned a = Uw[(8 + tt + 1 + r) * 256], sb = Uw[(8 + tt - r) * 256]; s0 += bflo(a) - bflo(sb); s1 += bfhi(a) - bfhi(sb); } } }
    __syncthreads();
    for (int idx = tid; idx < 32 * 64; idx += NTHR) { const int tt = idx >> 6, c8 = idx & 63;
        *(v4u*)(OP + ((size_t)b * SEQ + t0 + tt) * 512 + c8 * 8) = *(const v4u*)(MX + tt * 512 + c8 * 8); }
}

constexpr int DC_QN = 0, DC_KN = 9216, DC_KBT = 18432, DC_KDT = 27648, DC_VBT = 36864;
constexpr int DC_ST = 46080, DC_VNT = 55296, DC_T = 64512, DC_QKM = 73728;
constexpr int DC_AF = 82944;
constexpr int DC_AB = 100352;
constexpr int DC_DT1 = 109568;
constexpr int DC_DTS = 112128;
constexpr int DC_OB = 113664;
constexpr int DC_RAW = 55296;
static_assert(DC_RAW + 52224 <= DC_DT1 && DC_OB + 16384 <= RING_BYTES, "delta chunk LDS");
constexpr int DC_CW = LDSCTL_OFF + 2048;
constexpr int DC_VEC = DC_CW + 3840;
static_assert(DC_VEC + 7 * 256 <= LDS_BYTES, "delta chunk LDS (vectors)");
#ifndef DCREP
#define DCREP 0
#endif
__device__ __forceinline__ f32x4 mfma16(const bf16x8& a, const bf16x8& b, const f32x4& c) { return __builtin_amdgcn_mfma_f32_16x16x32_bf16(a, b, c, 0, 0, 0); }
__device__ __forceinline__ bf16x8 ld8(const bf16* p) { return *(const bf16x8*)p; }
__device__ __forceinline__ int tsw(int row, int col) { return row * 72 + ((((col >> 3) ^ (row >> 3)) & 7) << 3) + (col & 7); }
__device__ __forceinline__ int tswc(int row, int chunk) { return row * 72 + (((chunk ^ (row >> 3)) & 7) << 3); }
__device__ __forceinline__ bf16x8 ld44(const bf16* p0, const bf16* p1) { const v2u a = *(const v2u*)p0, b = *(const v2u*)p1; return __builtin_bit_cast(bf16x8, (v4u){a.x, a.y, b.x, b.y}); }
__device__ __forceinline__ void st4(bf16* p, float a, float b, float c, float d) { v2u w; w.x = cvt_pk_bf16(a, b); w.y = cvt_pk_bf16(c, d); *(v2u*)p = w; }

__device__ __forceinline__ void delta_seq_chunked(Frame& F, int layer, int seq) {
    const int dir = seq >> 7, b = (seq >> 3) & 15, h = seq & 7;
    unsigned char* L = F.lds;
    bf16* Qn = (bf16*)(L + DC_QN); bf16* Kn = (bf16*)(L + DC_KN); bf16* KbT = (bf16*)(L + DC_KBT); bf16* KdT = (bf16*)(L + DC_KDT); bf16* VbT = (bf16*)(L + DC_VBT);
    bf16* St = (bf16*)(L + DC_ST); bf16* VnT = (bf16*)(L + DC_VNT); bf16* T = (bf16*)(L + DC_T); bf16* QKm = (bf16*)(L + DC_QKM);
    float* Af = (float*)(L + DC_AF); bf16* Ab = (bf16*)(L + DC_AB); bf16* DT1 = (bf16*)(L + DC_DT1); bf16* DTs = (bf16*)(L + DC_DTS); float* ob = (float*)(L + DC_OB);
    float* raw = (float*)(L + DC_RAW); float* cw = (float*)(L + DC_CW);
    float* Gs = (float*)(L + DC_VEC); float* gam = Gs + 64; float* del = Gs + 128; float* bet = Gs + 192; float* rq = Gs + 256; float* rk = Gs + 320; float* cdp = Gs + 384;
    const bf16* DQKV = (const bf16*)(F.ws + WS_DQKV); const float* DAB = (const float*)(F.ws + WS_DAB);
    float* OUT = (float*)(F.ws + (dir ? WS_OB : WS_OF));
    const int tid0 = F.tid, wave = F.wave; int tid = tid0, lane = tid0 & 63;
    const int tr = wave >> 1, tc0 = 2 * (wave & 1); int l15 = 0, q4 = 0;
    __syncthreads();
    for (int i = tid; i < 5 * 192; i += NTHR) { const int jj = i / 192, ch = i % 192; cw[i] = IN_conv_w(F)[((size_t)layer * 5 + jj) * 1536 + (ch >> 6) * 512 + h * 64 + (ch & 63)]; }
    for (int i = tid; i < 64 * 72 / 2; i += NTHR) { ((unsigned*)St)[i] = 0u; ((unsigned*)T)[i] = 0u; }
    const float nA = -__expf(IN_a_log(F)[layer * 16 + dir * 8 + h]), dtb = IN_dt_bias(F)[layer * 16 + dir * 8 + h];
    f32x4 Sacc[2];
    Sacc[0] = (f32x4){0.f, 0.f, 0.f, 0.f}; Sacc[1] = Sacc[0];
    v4u pre[4]; float pa = 0.f, pb = 0.f;
    { const int t0n = dir ? SEQ - 64 : 0;
#pragma unroll
        for (int it = 0; it < 4; ++it) { const int idx = tid + it * NTHR; const int r = idx / 24, pc = idx % 24, t = t0n - 2 + r;
            pre[it] = ld_or_zero(DQKV + ((size_t)b * SEQ + t) * 1536 + (pc >> 3) * 512 + h * 64 + (pc & 7) * 8, DQKV, idx < 68 * 24 && t >= 0 && t < SEQ); }
        if (wave == 0) { const size_t m = (size_t)b * SEQ + t0n + (dir ? 63 - lane : lane); pa = DAB[m * 32 + dir * 8 + h]; pb = DAB[m * 32 + 16 + dir * 8 + h]; } }
    for (int blk = 0; blk < SEQ / 64; ++blk) {
        const int tb = dir ? (SEQ / 64 - 1 - blk) : blk, t0 = tb * 64;
        tid = tid0; asm volatile("" : "+v"(tid)); lane = tid & 63;
        __syncthreads();
#pragma unroll
        for (int it = 0; it < 4; ++it) { const int idx = tid + it * NTHR; if (idx < 68 * 24) { const int r = idx / 24, pc = idx % 24; float* rp = raw + r * 192 + (pc >> 3) * 64 + (pc & 7) * 8;
                f32x4 lo, hi; unpack8(pre[it], lo, hi); *(f32x4*)rp = lo; *(f32x4*)(rp + 4) = hi; } }
        if (wave == 0) { const float xx = pa + dtb; const float sp = xx > 20.f ? xx : log1pf(__expf(xx));
            float g = nA * sp;
#pragma unroll
            for (int o = 1; o < 64; o <<= 1) { const float u = __shfl_up(g, o); if (lane >= o) g += u; }
            const float gl = __shfl(g, 63);
            Gs[lane] = g; gam[lane] = __expf(g); del[lane] = __expf(gl - g); bet[lane] = sigmoidf_(pb); if (lane == 63) cdp[0] = __expf(g); }
        if (blk + 1 < SEQ / 64) { const int tbn = dir ? (SEQ / 64 - 2 - blk) : blk + 1, t0n = tbn * 64;
#pragma unroll
            for (int it = 0; it < 4; ++it) { const int idx = tid + it * NTHR; const int r = idx / 24, pc = idx % 24, t = t0n - 2 + r;
                pre[it] = ld_or_zero(DQKV + ((size_t)b * SEQ + t) * 1536 + (pc >> 3) * 512 + h * 64 + (pc & 7) * 8, DQKV, idx < 68 * 24 && t >= 0 && t < SEQ); }
            if (wave == 0) { const size_t m = (size_t)b * SEQ + t0n + (dir ? 63 - lane : lane); pa = DAB[m * 32 + dir * 8 + h]; pb = DAB[m * 32 + 16 + dir * 8 + h]; } }
        __syncthreads();
        for (int rep1 = 0; rep1 < (DCREP == 1 ? 2 : 1); ++rep1)
        { const int tt = tid >> 3, d0 = (tid & 7) * 8, s = dir ? 63 - tt : tt;
            float xv[3][8];
#pragma unroll
            for (int sec = 0; sec < 3; ++sec) {
                f32x2 a2[4];
#pragma unroll
                for (int pq = 0; pq < 4; ++pq) a2[pq] = (f32x2){0.f, 0.f};
#pragma unroll
                for (int jj = 0; jj < 5; ++jj) { const float* rp = raw + (tt + jj) * 192 + sec * 64 + d0; const float* cp = cw + jj * 192 + sec * 64 + d0;
                    const f32x4 r0 = *(const f32x4*)rp, r1 = *(const f32x4*)(rp + 4), c0 = *(const f32x4*)cp, c1 = *(const f32x4*)(cp + 4);
                    a2[0] += (f32x2){c0[0], c0[1]} * (f32x2){r0[0], r0[1]}; a2[1] += (f32x2){c0[2], c0[3]} * (f32x2){r0[2], r0[3]};
                    a2[2] += (f32x2){c1[0], c1[1]} * (f32x2){r1[0], r1[1]}; a2[3] += (f32x2){c1[2], c1[3]} * (f32x2){r1[2], r1[3]}; }
#pragma unroll
                for (int e = 0; e < 8; ++e) xv[sec][e] = siluf_(a2[e >> 1][e & 1]);
                __builtin_amdgcn_sched_barrier(0); }
            float sq = 0.f, sk = 0.f;
#pragma unroll
            for (int e = 0; e < 8; ++e) { sq += xv[0][e] * xv[0][e]; sk += xv[1][e] * xv[1][e]; }
            sq = __builtin_amdgcn_rsqf(red8(sq) + 1e-6f) * 0.125f; sk = __builtin_amdgcn_rsqf(red8(sk) + 1e-6f);
            const float be = bet[s], bg = be * gam[s], dl = del[s];
#pragma unroll
            for (int e = 0; e < 8; ++e) { xv[0][e] *= sq; xv[1][e] *= sk; }
            v4u w; w.x = cvt_pk_bf16(xv[0][0], xv[0][1]); w.y = cvt_pk_bf16(xv[0][2], xv[0][3]); w.z = cvt_pk_bf16(xv[0][4], xv[0][5]); w.w = cvt_pk_bf16(xv[0][6], xv[0][7]); *(v4u*)(Qn + s * 72 + d0) = w;
            w.x = cvt_pk_bf16(xv[1][0], xv[1][1]); w.y = cvt_pk_bf16(xv[1][2], xv[1][3]); w.z = cvt_pk_bf16(xv[1][4], xv[1][5]); w.w = cvt_pk_bf16(xv[1][6], xv[1][7]); *(v4u*)(Kn + s * 72 + d0) = w;
#pragma unroll
            for (int e = 0; e < 8; e += 2) { const int o0 = tsw(d0 + e, s), o1 = tsw(d0 + e + 1, s);
                const unsigned wb = cvt_pk_bf16(xv[1][e] * bg, xv[1][e + 1] * bg), wd = cvt_pk_bf16(xv[1][e] * dl, xv[1][e + 1] * dl), wv = cvt_pk_bf16(xv[2][e] * be, xv[2][e + 1] * be);
                KbT[o0] = (bf16)(wb & 0xffffu); KbT[o1] = (bf16)(wb >> 16); KdT[o0] = (bf16)(wd & 0xffffu); KdT[o1] = (bf16)(wd >> 16); VbT[o0] = (bf16)(wv & 0xffffu); VbT[o1] = (bf16)(wv >> 16); } }
        __syncthreads();
        { int lv = lane; asm volatile("" : "+v"(lv)); l15 = lv & 15; q4 = lv >> 4; }
        for (int rep4 = 0; rep4 < (DCREP == 4 ? 2 : 1); ++rep4)
        { const bf16x8 a0 = ld8(Kn + (16 * tr + l15) * 72 + 8 * q4), a1 = ld8(Kn + (16 * tr + l15) * 72 + 32 + 8 * q4);
            float Gj[4];
#pragma unroll
            for (int r = 0; r < 4; ++r) Gj[r] = Gs[16 * tr + 4 * q4 + r];
#pragma unroll
            for (int tcx = 0; tcx < 2; ++tcx) { const int tc = tc0 + tcx, i = 16 * tc + l15, j0 = 16 * tr + 4 * q4;
                f32x4 ckk = (f32x4){0.f, 0.f, 0.f, 0.f}, cqk = ckk;
                if (tc >= tr) {
                    const bf16x8 bk0 = ld8(Kn + i * 72 + 8 * q4), bk1 = ld8(Kn + i * 72 + 32 + 8 * q4), bq0 = ld8(Qn + i * 72 + 8 * q4), bq1 = ld8(Qn + i * 72 + 32 + 8 * q4);
                    ckk = mfma16(a0, bk0, ckk); ckk = mfma16(a1, bk1, ckk); cqk = mfma16(a0, bq0, cqk); cqk = mfma16(a1, bq1, cqk);
                    const float Gi = Gs[i], bi = bet[i];
#pragma unroll
                    for (int r = 0; r < 4; ++r) { const int j = j0 + r; const float dec = __expf(Gi - Gj[r]); ckk[r] = (i > j) ? ckk[r] * dec * bi : 0.f; cqk[r] = (i >= j) ? cqk[r] * dec : 0.f; } }
#pragma unroll
                for (int r = 0; r < 4; ++r) Af[(j0 + r) * 68 + i] = ckk[r];
                st4(QKm + i * 72 + j0, cqk[0], cqk[1], cqk[2], cqk[3]);
                st4(Ab + i * 72 + j0, ckk[0], ckk[1], ckk[2], ckk[3]); } }
        __syncthreads();
        for (int rep5 = 0; rep5 < (DCREP == 5 ? 2 : 1); ++rep5)
        if (wave == 0) { const int b4 = lane >> 4, c = lane & 15; const float* Ar = Af + (16 * b4) * 68 + 16 * b4;
            float t[16];
#pragma unroll
            for (int i = 0; i < 16; ++i) t[i] = (i == c) ? 1.f : 0.f;
#pragma unroll
            for (int j = 0; j < 15; ++j) {
#pragma unroll
                for (int i4 = (j + 1) / 4; i4 < 4; ++i4) { const f32x4 a = *(const f32x4*)(Ar + j * 68 + 4 * i4);
#pragma unroll
                    for (int e = 0; e < 4; ++e) if (4 * i4 + e > j) t[4 * i4 + e] -= a[e] * t[j]; } }
#pragma unroll
            for (int i = 0; i < 16; ++i) T[(16 * b4 + i) * 72 + 16 * b4 + c] = (bf16)f2bf(t[i]);
            { v4u w0, w1; w0.x = cvt_pk_bf16(t[0], t[1]); w0.y = cvt_pk_bf16(t[2], t[3]); w0.z = cvt_pk_bf16(t[4], t[5]); w0.w = cvt_pk_bf16(t[6], t[7]);
                w1.x = cvt_pk_bf16(t[8], t[9]); w1.y = cvt_pk_bf16(t[10], t[11]); w1.z = cvt_pk_bf16(t[12], t[13]); w1.w = cvt_pk_bf16(t[14], t[15]);
                const v4u z = (v4u){0u, 0u, 0u, 0u};
                if ((b4 & 1) == 0) { *(v4u*)(DTs + ((b4 >> 1) * 16 + c) * 24) = w0; *(v4u*)(DTs + ((b4 >> 1) * 16 + c) * 24 + 8) = w1; }
                if (b4 == 0) { *(v4u*)(DT1 + c * 40) = w0; *(v4u*)(DT1 + c * 40 + 8) = w1; }
                if (b4 == 1) { *(v4u*)(DT1 + (16 + c) * 40 + 16) = w0; *(v4u*)(DT1 + (16 + c) * 40 + 24) = w1; *(v4u*)(DT1 + (16 + c) * 40) = z; *(v4u*)(DT1 + (16 + c) * 40 + 8) = z; }
                if (lane < 32) { *(v4u*)(T + lane * 72 + 32) = z; *(v4u*)(T + lane * 72 + 40) = z; *(v4u*)(T + lane * 72 + 48) = z; *(v4u*)(T + lane * 72 + 56) = z; }
                if (lane < 16) { *(v4u*)(T + lane * 72 + 16) = z; *(v4u*)(T + lane * 72 + 24) = z; }
                if (lane >= 32 && lane < 48) { *(v4u*)(T + lane * 72 + 48) = z; *(v4u*)(T + lane * 72 + 56) = z; } }
            LDS_WAIT(); asm volatile("" ::: "memory");
            const int m15 = lane & 15, qq = lane >> 4;
#pragma unroll
            for (int p = 0; p < 2; ++p) { const int b0 = 2 * p, b1 = 2 * p + 1;
                const v4u zz = (v4u){0u, 0u, 0u, 0u};
                v4u av = zz, bv = zz;
                if (qq < 2) { av = *(const v4u*)(Ab + (16 * b1 + m15) * 72 + 16 * b0 + 8 * qq); bv = *(const v4u*)(DTs + (p * 16 + m15) * 24 + 8 * qq); }
                f32x4 X4 = (f32x4){0.f, 0.f, 0.f, 0.f};
                X4 = mfma16(__builtin_bit_cast(bf16x8, av), __builtin_bit_cast(bf16x8, bv), X4);
                v4u xa = zz; xa.x = cvt_pk_bf16(X4[0], X4[1]); xa.y = cvt_pk_bf16(X4[2], X4[3]);
                const v2u dr = *(const v2u*)(T + (16 * b1 + m15) * 72 + 16 * b1 + 4 * qq);
                v4u db = zz; db.x = dr.x; db.y = dr.y;
                f32x4 Z4 = (f32x4){0.f, 0.f, 0.f, 0.f};
                Z4 = mfma16(__builtin_bit_cast(bf16x8, xa), __builtin_bit_cast(bf16x8, db), Z4);
                st4(T + (16 * b1 + m15) * 72 + 16 * b0 + 4 * qq, -Z4[0], -Z4[1], -Z4[2], -Z4[3]);
                if (p == 0) {
#pragma unroll
                    for (int r = 0; r < 4; ++r) DT1[(4 * qq + r) * 40 + 16 + m15] = (bf16)f2bf(-Z4[r]); } }
            LDS_WAIT(); asm volatile("" ::: "memory");
            const int r31 = lane & 31, hh = lane >> 5;
            f32x16 X;
#pragma unroll
            for (int i = 0; i < 16; ++i) X[i] = 0.f;
#pragma unroll
            for (int ks = 0; ks < 2; ++ks) X = __builtin_amdgcn_mfma_f32_32x32x16_bf16(ld8(Ab + (32 + r31) * 72 + 16 * ks + 8 * hh), ld8(DT1 + r31 * 40 + 16 * ks + 8 * hh), X, 0, 0, 0);
            f32x16 Z;
#pragma unroll
            for (int i = 0; i < 16; ++i) Z[i] = 0.f;
#pragma unroll
            for (int ks = 0; ks < 2; ++ks) { v4u pw; pw.x = cvt_pk_bf16(X[8 * ks + 0], X[8 * ks + 1]); pw.y = cvt_pk_bf16(X[8 * ks + 2], X[8 * ks + 3]); pw.z = cvt_pk_bf16(X[8 * ks + 4], X[8 * ks + 5]); pw.w = cvt_pk_bf16(X[8 * ks + 6], X[8 * ks + 7]);
                const bf16* d2 = T + (32 + r31) * 72 + 32 + 16 * ks + 4 * hh;
                Z = __builtin_amdgcn_mfma_f32_32x32x16_bf16(__builtin_bit_cast(bf16x8, pw), ld44(d2, d2 + 8), Z, 0, 0, 0); }
#pragma unroll
            for (int g = 0; g < 4; ++g) st4(T + (32 + r31) * 72 + 8 * g + 4 * hh, -Z[4 * g], -Z[4 * g + 1], -Z[4 * g + 2], -Z[4 * g + 3]); }
        __syncthreads();
        { int lv = lane; asm volatile("" : "+v"(lv)); l15 = lv & 15; q4 = lv >> 4; }
        for (int rep7 = 0; rep7 < (DCREP == 7 ? 2 : 1); ++rep7)
        { const bf16x8 ti0 = ld8(T + (16 * tr + l15) * 72 + 8 * q4), ti1 = ld8(T + (16 * tr + l15) * 72 + 32 + 8 * q4);
            f32x4 wt[4];
#pragma unroll
            for (int dt = 0; dt < 4; ++dt) { wt[dt] = (f32x4){0.f, 0.f, 0.f, 0.f};
                wt[dt] = mfma16(ld8(KbT + tswc(16 * dt + l15, q4)), ti0, wt[dt]); wt[dt] = mfma16(ld8(KbT + tswc(16 * dt + l15, 4 + q4)), ti1, wt[dt]); }
            v4u wa0, wa1;
            wa0.x = cvt_pk_bf16(-wt[0][0], -wt[0][1]); wa0.y = cvt_pk_bf16(-wt[0][2], -wt[0][3]); wa0.z = cvt_pk_bf16(-wt[1][0], -wt[1][1]); wa0.w = cvt_pk_bf16(-wt[1][2], -wt[1][3]);
            wa1.x = cvt_pk_bf16(-wt[2][0], -wt[2][1]); wa1.y = cvt_pk_bf16(-wt[2][2], -wt[2][3]); wa1.z = cvt_pk_bf16(-wt[3][0], -wt[3][1]); wa1.w = cvt_pk_bf16(-wt[3][2], -wt[3][3]);
#pragma unroll
            for (int tcx = 0; tcx < 2; ++tcx) { const int e = 16 * (tc0 + tcx) + l15;
                f32x4 u = (f32x4){0.f, 0.f, 0.f, 0.f};
                u = mfma16(ti0, ld8(VbT + tswc(e, q4)), u); u = mfma16(ti1, ld8(VbT + tswc(e, 4 + q4)), u);
                const bf16* sp = St + e * 72 + 4 * q4;
                u = mfma16(__builtin_bit_cast(bf16x8, wa0), ld44(sp, sp + 16), u); u = mfma16(__builtin_bit_cast(bf16x8, wa1), ld44(sp + 32, sp + 48), u);
                st4(VnT + e * 72 + 16 * tr + 4 * q4, u[0], u[1], u[2], u[3]); } }
        __syncthreads();
        { int lv = lane; asm volatile("" : "+v"(lv)); l15 = lv & 15; q4 = lv >> 4; }
        { const bf16x8 qa0 = ld8(Qn + (16 * tr + l15) * 72 + 8 * q4), qa1 = ld8(Qn + (16 * tr + l15) * 72 + 32 + 8 * q4);
            const bf16x8 ma0 = ld8(QKm + (16 * tr + l15) * 72 + 8 * q4), ma1 = ld8(QKm + (16 * tr + l15) * 72 + 32 + 8 * q4);
            const bf16x8 ka0 = ld8(KdT + tswc(16 * tr + l15, q4)), ka1 = ld8(KdT + tswc(16 * tr + l15, 4 + q4));
            const float cd = cdp[0]; float gi[4];
#pragma unroll
            for (int r = 0; r < 4; ++r) gi[r] = gam[16 * tr + 4 * q4 + r];
#pragma unroll
            for (int tcx = 0; tcx < 2; ++tcx) { const int e = 16 * (tc0 + tcx) + l15;
                const bf16x8 s0 = ld8(St + e * 72 + 8 * q4), s1 = ld8(St + e * 72 + 32 + 8 * q4), n0 = ld8(VnT + e * 72 + 8 * q4), n1 = ld8(VnT + e * 72 + 32 + 8 * q4);
                f32x4 o = (f32x4){0.f, 0.f, 0.f, 0.f};
                o = mfma16(qa0, s0, o); o = mfma16(qa1, s1, o);
#pragma unroll
                for (int r = 0; r < 4; ++r) o[r] *= gi[r];
                o = mfma16(ma0, n0, o); o = mfma16(ma1, n1, o);
#pragma unroll
                for (int r = 0; r < 4; ++r) ob[(16 * tr + 4 * q4 + r) * 64 + e] = o[r];
                Sacc[tcx] = Sacc[tcx] * cd; Sacc[tcx] = mfma16(ka0, n0, Sacc[tcx]); Sacc[tcx] = mfma16(ka1, n1, Sacc[tcx]); } }
        __syncthreads();
#pragma unroll
        for (int tcx = 0; tcx < 2; ++tcx) { const int e = 16 * (tc0 + tcx) + l15; st4(St + e * 72 + 16 * tr + 4 * q4, Sacc[tcx][0], Sacc[tcx][1], Sacc[tcx][2], Sacc[tcx][3]); }
        for (int idx = tid; idx < 64 * 16; idx += NTHR) { const int s = idx >> 4, c4 = idx & 15; const int t = t0 + (dir ? 63 - s : s);
            const f32x4 ov = *(const f32x4*)(ob + s * 64 + c4 * 4); v2u ow; ow.x = cvt_pk_bf16(ov[0], ov[1]); ow.y = cvt_pk_bf16(ov[2], ov[3]);
            *(v2u*)((bf16*)OUT + ((size_t)b * SEQ + t) * 512 + h * 64 + c4 * 4) = ow; }
    }
}

#ifndef DPREP
#define DPREP 0
#endif
constexpr int DP_QN = 0, DP_KD = 18432;
constexpr int DP_KN = 36864, DP_KBT = 46080, DP_VBT = 55296, DP_ST = 64512, DP_VNT = 73728, DP_T = 82944, DP_QKM = 92160, DP_AB = 101376;
constexpr int DP_AF4 = 110592;
constexpr int DP_DT1 = 115712, DP_DTS = 118272;
constexpr int DP_RAW = 119808;
static_assert(DP_RAW + 26112 <= RING_BYTES, "pipelined delta LDS");

__device__ __forceinline__ bf16x8 ldtr8(const bf16* img, int ks, int c, int lane) {
    const int q = lane >> 4, qq = (lane & 15) >> 2, p = lane & 3;
    const bf16* a0 = img + (32 * ks + 8 * q + qq) * 72 + 16 * c + 4 * p;
    const v4i16_t lo = __builtin_amdgcn_ds_read_tr16_b64_v4i16((LAS v4i16_t*)a0), hi = __builtin_amdgcn_ds_read_tr16_b64_v4i16((LAS v4i16_t*)(a0 + 4 * 72));
    return __builtin_shufflevector(lo, hi, 0, 1, 2, 3, 4, 5, 6, 7);
}
typedef __bf16 bf16x2v_t __attribute__((ext_vector_type(2)));
__device__ __forceinline__ float dot2bf(unsigned a, unsigned b, float c) { return __builtin_amdgcn_fdot2_f32_bf16(__builtin_bit_cast(bf16x2v_t, a), __builtin_bit_cast(bf16x2v_t, b), c, false); }
__device__ __forceinline__ void delta_seq_pipe(Frame& F, int layer, int seq) {
    const int dir = seq >> 7, b = (seq >> 3) & 15, h = seq & 7;
    unsigned char* L = F.lds;
    bf16* Qn2 = (bf16*)(L + DP_QN); bf16* Kd2 = (bf16*)(L + DP_KD); bf16* Kn = (bf16*)(L + DP_KN); bf16* KbT = (bf16*)(L + DP_KBT); bf16* VbT = (bf16*)(L + DP_VBT);
    bf16* St = (bf16*)(L + DP_ST); bf16* VnT = (bf16*)(L + DP_VNT); bf16* T = (bf16*)(L + DP_T); bf16* QKm = (bf16*)(L + DP_QKM); bf16* Ab = (bf16*)(L + DP_AB);
    float* Af4 = (float*)(L + DP_AF4); bf16* DT1 = (bf16*)(L + DP_DT1); bf16* DTs = (bf16*)(L + DP_DTS); bf16* raw = (bf16*)(L + DP_RAW);
    float* cw = (float*)(L + DC_CW); float* vec0 = (float*)(L + DC_VEC);
    const bf16* DQKV = (const bf16*)(F.ws + WS_DQKV); const float* DAB = (const float*)(F.ws + WS_DAB);
    bf16* OUT = (bf16*)(F.ws + (dir ? WS_OB : WS_OF));
    const int tid0 = F.tid, wave = F.wave; int tid = tid0, lane = tid0 & 63, l15 = 0, q4 = 0;
    const int tr = wave >> 1, tc0 = 2 * (wave & 1);
    __syncthreads();
    for (int i = tid; i < 5 * 192; i += NTHR) { const int jj = i / 192, ch = i % 192; const unsigned wb = f2bf(IN_conv_w(F)[((size_t)layer * 5 + jj) * 1536 + (ch >> 6) * 512 + h * 64 + (ch & 63)]); ((unsigned*)cw)[i] = (ch & 1) ? (wb << 16) : wb; }
    for (int i = tid; i < 64 * 72 / 2; i += NTHR) ((unsigned*)St)[i] = 0u;
    const float nA = -__expf(IN_a_log(F)[layer * 16 + dir * 8 + h]), dtb = IN_dt_bias(F)[layer * 16 + dir * 8 + h];
    f32x4 Sacc[2];
    Sacc[0] = (f32x4){0.f, 0.f, 0.f, 0.f}; Sacc[1] = Sacc[0];
    v4u pre[4]; float pa = 0.f, pb = 0.f;
    v4u kbw = (v4u){0u, 0u, 0u, 0u}, vbw = kbw;

#define DP_LANE() do { tid = tid0; asm volatile("" : "+v"(tid)); lane = tid & 63; l15 = lane & 15; q4 = lane >> 4; } while (0)
#define DP_T0(NB) ((dir ? (SEQ / 64 - 1 - (NB)) : (NB)) * 64)
#define DP_PREFETCH(NB) do { const int t0n_ = DP_T0(NB); \
        _Pragma("unroll") for (int it = 0; it < 4; ++it) { const int idx = tid + it * NTHR; const int r = idx / 24, pc = idx % 24, t = t0n_ - 2 + r; \
            pre[it] = ld_or_zero(DQKV + ((size_t)b * SEQ + t) * 1536 + (pc >> 3) * 512 + h * 64 + (pc & 7) * 8, DQKV, idx < 68 * 24 && t >= 0 && t < SEQ); } \
        if (wave == 0) { const size_t m_ = (size_t)b * SEQ + t0n_ + (dir ? 63 - lane : lane); pa = DAB[m_ * 32 + dir * 8 + h]; pb = DAB[m_ * 32 + 16 + dir * 8 + h]; } } while (0)
#define DP_S0(NB) do { const int nb_ = (NB); \
        _Pragma("unroll") for (int it = 0; it < 4; ++it) { const int idx = tid + it * NTHR; if (idx < 68 * 24) { const int r = idx / 24, pc = idx % 24; *(v4u*)(raw + r * 192 + (pc >> 3) * 64 + (pc & 7) * 8) = pre[it]; } } \
        if (wave == 0) { float* vd_ = vec0 + (nb_ & 1) * 448; const float xx_ = pa + dtb; const float sp_ = xx_ > 20.f ? xx_ : log1pf(__expf(xx_)); float g_ = nA * sp_; \
            _Pragma("unroll") for (int o_ = 1; o_ < 64; o_ <<= 1) { const float u_ = __shfl_up(g_, o_); if (lane >= o_) g_ += u_; } \
            const float gl_ = __shfl(g_, 63); vd_[lane] = g_; vd_[64 + lane] = __expf(g_); vd_[128 + lane] = __expf(gl_ - g_); vd_[192 + lane] = sigmoidf_(pb); if (lane == 63) vd_[256] = __expf(g_); } \
        if (nb_ + 1 < SEQ / 64) DP_PREFETCH(nb_ + 1); } while (0)
#define DP_S1A(NB) do { const int nb_ = (NB); const float* vd_ = vec0 + (nb_ & 1) * 448; bf16* Qn_ = Qn2 + (nb_ & 1) * 4608; bf16* Kd_ = Kd2 + (nb_ & 1) * 4608; \
        const int tt = tid >> 3, d0 = (tid & 7) * 8, s = dir ? 63 - tt : tt; \
        float xv[3][8]; \
        _Pragma("unroll") for (int sec = 0; sec < 3; ++sec) { float a1[8]; \
            _Pragma("unroll") for (int e = 0; e < 8; ++e) a1[e] = 0.f; \
            _Pragma("unroll") for (int jj = 0; jj < 5; ++jj) { const v4u rw = *(const v4u*)(raw + (tt + jj) * 192 + sec * 64 + d0); const float* cp = cw + jj * 192 + sec * 64 + d0; \
                const v4u c0 = *(const v4u*)cp, c1 = *(const v4u*)(cp + 4); \
                a1[0] = dot2bf(rw.x, c0.x, a1[0]); a1[1] = dot2bf(rw.x, c0.y, a1[1]); a1[2] = dot2bf(rw.y, c0.z, a1[2]); a1[3] = dot2bf(rw.y, c0.w, a1[3]); \
                a1[4] = dot2bf(rw.z, c1.x, a1[4]); a1[5] = dot2bf(rw.z, c1.y, a1[5]); a1[6] = dot2bf(rw.w, c1.z, a1[6]); a1[7] = dot2bf(rw.w, c1.w, a1[7]); } \
            _Pragma("unroll") for (int e = 0; e < 8; ++e) xv[sec][e] = siluf_(a1[e]); \
            __builtin_amdgcn_sched_barrier(0); } \
        float sq = 0.f, sk = 0.f; \
        _Pragma("unroll") for (int e = 0; e < 8; ++e) { sq += xv[0][e] * xv[0][e]; sk += xv[1][e] * xv[1][e]; } \
        sq = __builtin_amdgcn_rsqf(red8(sq) + 1e-6f) * 0.125f; sk = __builtin_amdgcn_rsqf(red8(sk) + 1e-6f); \
        const float be = vd_[192 + s], bg = be * vd_[64 + s], dl = vd_[128 + s]; \
        _Pragma("unroll") for (int e = 0; e < 8; ++e) { xv[0][e] *= sq; xv[1][e] *= sk; } \
        v4u w; w.x = cvt_pk_bf16(xv[0][0], xv[0][1]); w.y = cvt_pk_bf16(xv[0][2], xv[0][3]); w.z = cvt_pk_bf16(xv[0][4], xv[0][5]); w.w = cvt_pk_bf16(xv[0][6], xv[0][7]); *(v4u*)(Qn_ + s * 72 + d0) = w; \
        w.x = cvt_pk_bf16(xv[1][0], xv[1][1]); w.y = cvt_pk_bf16(xv[1][2], xv[1][3]); w.z = cvt_pk_bf16(xv[1][4], xv[1][5]); w.w = cvt_pk_bf16(xv[1][6], xv[1][7]); *(v4u*)(Kn + s * 72 + d0) = w; \
        w.x = cvt_pk_bf16(xv[1][0] * bg, xv[1][1] * bg); w.y = cvt_pk_bf16(xv[1][2] * bg, xv[1][3] * bg); w.z = cvt_pk_bf16(xv[1][4] * bg, xv[1][5] * bg); w.w = cvt_pk_bf16(xv[1][6] * bg, xv[1][7] * bg); kbw = w; \
        w.x = cvt_pk_bf16(xv[1][0] * dl, xv[1][1] * dl); w.y = cvt_pk_bf16(xv[1][2] * dl, xv[1][3] * dl); w.z = cvt_pk_bf16(xv[1][4] * dl, xv[1][5] * dl); w.w = cvt_pk_bf16(xv[1][6] * dl, xv[1][7] * dl); *(v4u*)(Kd_ + s * 72 + d0) = w; \
        w.x = cvt_pk_bf16(xv[2][0] * be, xv[2][1] * be); w.y = cvt_pk_bf16(xv[2][2] * be, xv[2][3] * be); w.z = cvt_pk_bf16(xv[2][4] * be, xv[2][5] * be); w.w = cvt_pk_bf16(xv[2][6] * be, xv[2][7] * be); vbw = w; } while (0)
#define DP_S1B() do { const int tt = tid >> 3, d0 = (tid & 7) * 8, s = dir ? 63 - tt : tt; *(v4u*)(KbT + s * 72 + d0) = kbw; *(v4u*)(VbT + s * 72 + d0) = vbw; } while (0)
#define DP_S4(NB) do { const int nb_ = (NB); const float* vd_ = vec0 + (nb_ & 1) * 448; const bf16* Qn_ = Qn2 + (nb_ & 1) * 4608; \
        const bf16x8 a0 = ld8(Kn + (16 * tr + l15) * 72 + 8 * q4), a1 = ld8(Kn + (16 * tr + l15) * 72 + 32 + 8 * q4); \
        float Gj[4]; \
        _Pragma("unroll") for (int r = 0; r < 4; ++r) Gj[r] = vd_[16 * tr + 4 * q4 + r]; \
        _Pragma("unroll") for (int tcx = 0; tcx < 2; ++tcx) { const int tc = tc0 + tcx, i = 16 * tc + l15, j0 = 16 * tr + 4 * q4; \
            f32x4 ckk = (f32x4){0.f, 0.f, 0.f, 0.f}, cqk = ckk; \
            if (tc >= tr) { \
                const bf16x8 bk0 = ld8(Kn + i * 72 + 8 * q4), bk1 = ld8(Kn + i * 72 + 32 + 8 * q4), bq0 = ld8(Qn_ + i * 72 + 8 * q4), bq1 = ld8(Qn_ + i * 72 + 32 + 8 * q4); \
                ckk = mfma16(a0, bk0, ckk); ckk = mfma16(a1, bk1, ckk); cqk = mfma16(a0, bq0, cqk); cqk = mfma16(a1, bq1, cqk); \
                const float Gi = vd_[i], bi = vd_[192 + i]; \
                _Pragma("unroll") for (int r = 0; r < 4; ++r) { const int j = j0 + r; const float dec = __expf(Gi - Gj[r]); ckk[r] = (i > j) ? ckk[r] * dec * bi : 0.f; cqk[r] = (i >= j) ? cqk[r] * dec : 0.f; } } \
            if (tc == tr) { _Pragma("unroll") for (int r = 0; r < 4; ++r) Af4[tr * 320 + (4 * q4 + r) * 20 + l15] = ckk[r]; } \
            st4(QKm + i * 72 + j0, cqk[0], cqk[1], cqk[2], cqk[3]); \
            st4(Ab + i * 72 + j0, ckk[0], ckk[1], ckk[2], ckk[3]); } } while (0)
#define DP_S5() do { if (wave == 0) { const int b4 = lane >> 4, c = lane & 15; const float* Ar = Af4 + b4 * 320; \
        f32x4 ar[15][4];                                            \
        _Pragma("unroll") for (int j = 0; j < 15; ++j) { _Pragma("unroll") for (int i4 = (j + 1) / 4; i4 < 4; ++i4) ar[j][i4] = *(const f32x4*)(Ar + j * 20 + 4 * i4); } \
        float t[16]; \
        _Pragma("unroll") for (int i = 0; i < 16; ++i) t[i] = (i == c) ? 1.f : 0.f; \
        _Pragma("unroll") for (int j = 0; j < 15; ++j) { \
            _Pragma("unroll") for (int i4 = (j + 1) / 4; i4 < 4; ++i4) { \
                _Pragma("unroll") for (int e = 0; e < 4; ++e) if (4 * i4 + e > j) t[4 * i4 + e] -= ar[j][i4][e] * t[j]; } } \
        _Pragma("unroll") for (int i = 0; i < 16; ++i) T[(16 * b4 + i) * 72 + 16 * b4 + c] = (bf16)f2bf(t[i]); \
        { v4u w0, w1; w0.x = cvt_pk_bf16(t[0], t[1]); w0.y = cvt_pk_bf16(t[2], t[3]); w0.z = cvt_pk_bf16(t[4], t[5]); w0.w = cvt_pk_bf16(t[6], t[7]); \
            w1.x = cvt_pk_bf16(t[8], t[9]); w1.y = cvt_pk_bf16(t[10], t[11]); w1.z = cvt_pk_bf16(t[12], t[13]); w1.w = cvt_pk_bf16(t[14], t[15]); \
            const v4u z = (v4u){0u, 0u, 0u, 0u}; \
            if ((b4 & 1) == 0) { *(v4u*)(DTs + ((b4 >> 1) * 16 + c) * 24) = w0; *(v4u*)(DTs + ((b4 >> 1) * 16 + c) * 24 + 8) = w1; } \
            if (b4 == 0) { *(v4u*)(DT1 + c * 40) = w0; *(v4u*)(DT1 + c * 40 + 8) = w1; } \
            if (b4 == 1) { *(v4u*)(DT1 + (16 + c) * 40 + 16) = w0; *(v4u*)(DT1 + (16 + c) * 40 + 24) = w1; *(v4u*)(DT1 + (16 + c) * 40) = z; *(v4u*)(DT1 + (16 + c) * 40 + 8) = z; } \
            if (lane < 32) { *(v4u*)(T + lane * 72 + 32) = z; *(v4u*)(T + lane * 72 + 40) = z; *(v4u*)(T + lane * 72 + 48) = z; *(v4u*)(T + lane * 72 + 56) = z; } \
            if (lane < 16) { *(v4u*)(T + lane * 72 + 16) = z; *(v4u*)(T + lane * 72 + 24) = z; } \
            if (lane >= 32 && lane < 48) { *(v4u*)(T + lane * 72 + 48) = z; *(v4u*)(T + lane * 72 + 56) = z; } } \
        asm volatile("" ::: "memory");                              \
        const int m15 = lane & 15, qq = lane >> 4; \
        { const v4u zz = (v4u){0u, 0u, 0u, 0u}; v4u av[2], bv[2]; v2u dr[2]; \
            _Pragma("unroll") for (int p = 0; p < 2; ++p) { const int b0 = 2 * p, b1 = 2 * p + 1; av[p] = zz; bv[p] = zz; \
                if (qq < 2) { av[p] = *(const v4u*)(Ab + (16 * b1 + m15) * 72 + 16 * b0 + 8 * qq); bv[p] = *(const v4u*)(DTs + (p * 16 + m15) * 24 + 8 * qq); } \
                dr[p] = *(const v2u*)(T + (16 * b1 + m15) * 72 + 16 * b1 + 4 * qq); } \
            f32x4 Z4[2]; \
            _Pragma("unroll") for (int p = 0; p < 2; ++p) { \
                f32x4 X4 = (f32x4){0.f, 0.f, 0.f, 0.f}; X4 = mfma16(__builtin_bit_cast(bf16x8, av[p]), __builtin_bit_cast(bf16x8, bv[p]), X4); \
                v4u xa = zz; xa.x = cvt_pk_bf16(X4[0], X4[1]); xa.y = cvt_pk_bf16(X4[2], X4[3]); \
                v4u db = zz; db.x = dr[p].x; db.y = dr[p].y; \
                Z4[p] = (f32x4){0.f, 0.f, 0.f, 0.f}; Z4[p] = mfma16(__builtin_bit_cast(bf16x8, xa), __builtin_bit_cast(bf16x8, db), Z4[p]); } \
            _Pragma("unroll") for (int p = 0; p < 2; ++p) { const int b0 = 2 * p, b1 = 2 * p + 1; \
                st4(T + (16 * b1 + m15) * 72 + 16 * b0 + 4 * qq, -Z4[p][0], -Z4[p][1], -Z4[p][2], -Z4[p][3]); \
                if (p == 0) { _Pragma("unroll") for (int r = 0; r < 4; ++r) DT1[(4 * qq + r) * 40 + 16 + m15] = (bf16)f2bf(-Z4[p][r]); } } } \
        asm volatile("" ::: "memory"); \
        const int r31 = lane & 31, hh = lane >> 5; \
        f32x16 X; _Pragma("unroll") for (int i = 0; i < 16; ++i) X[i] = 0.f; \
        _Pragma("unroll") for (int ks = 0; ks < 2; ++ks) X = __builtin_amdgcn_mfma_f32_32x32x16_bf16(ld8(Ab + (32 + r31) * 72 + 16 * ks + 8 * hh), ld8(DT1 + r31 * 40 + 16 * ks + 8 * hh), X, 0, 0, 0); \
        f32x16 Z; _Pragma("unroll") for (int i = 0; i < 16; ++i) Z[i] = 0.f; \
        _Pragma("unroll") for (int ks = 0; ks < 2; ++ks) { v4u pw; pw.x = cvt_pk_bf16(X[8 * ks + 0], X[8 * ks + 1]); pw.y = cvt_pk_bf16(X[8 * ks + 2], X[8 * ks + 3]); pw.z = cvt_pk_bf16(X[8 * ks + 4], X[8 * ks + 5]); pw.w = cvt_pk_bf16(X[8 * ks + 6], X[8 * ks + 7]); \
            const bf16* d2 = T + (32 + r31) * 72 + 32 + 16 * ks + 4 * hh; \
            Z = __builtin_amdgcn_mfma_f32_32x32x16_bf16(__builtin_bit_cast(bf16x8, pw), ld44(d2, d2 + 8), Z, 0, 0, 0); } \
        _Pragma("unroll") for (int g = 0; g < 4; ++g) st4(T + (32 + r31) * 72 + 8 * g + 4 * hh, -Z[4 * g], -Z[4 * g + 1], -Z[4 * g + 2], -Z[4 * g + 3]); } } while (0)
#define DP_S7() do { const bf16x8 ti0 = ld8(T + (16 * tr + l15) * 72 + 8 * q4), ti1 = ld8(T + (16 * tr + l15) * 72 + 32 + 8 * q4); \
        f32x4 wt[4]; \
        _Pragma("unroll") for (int dt = 0; dt < 4; ++dt) { wt[dt] = (f32x4){0.f, 0.f, 0.f, 0.f}; \
            wt[dt] = mfma16(ldtr8(KbT, 0, dt, lane), ti0, wt[dt]); wt[dt] = mfma16(ldtr8(KbT, 1, dt, lane), ti1, wt[dt]); } \
        v4u wa0, wa1; \
        wa0.x = cvt_pk_bf16(-wt[0][0], -wt[0][1]); wa0.y = cvt_pk_bf16(-wt[0][2], -wt[0][3]); wa0.z = cvt_pk_bf16(-wt[1][0], -wt[1][1]); wa0.w = cvt_pk_bf16(-wt[1][2], -wt[1][3]); \
        wa1.x = cvt_pk_bf16(-wt[2][0], -wt[2][1]); wa1.y = cvt_pk_bf16(-wt[2][2], -wt[2][3]); wa1.z = cvt_pk_bf16(-wt[3][0], -wt[3][1]); wa1.w = cvt_pk_bf16(-wt[3][2], -wt[3][3]); \
        _Pragma("unroll") for (int tcx = 0; tcx < 2; ++tcx) { const int e = 16 * (tc0 + tcx) + l15; \
            f32x4 u = (f32x4){0.f, 0.f, 0.f, 0.f}; \
            u = mfma16(ti0, ldtr8(VbT, 0, tc0 + tcx, lane), u); u = mfma16(ti1, ldtr8(VbT, 1, tc0 + tcx, lane), u); \
            const bf16* sp = St + e * 72 + 4 * q4; \
            u = mfma16(__builtin_bit_cast(bf16x8, wa0), ld44(sp, sp + 16), u); u = mfma16(__builtin_bit_cast(bf16x8, wa1), ld44(sp + 32, sp + 48), u); \
            st4(VnT + e * 72 + 16 * tr + 4 * q4, u[0], u[1], u[2], u[3]); } } while (0)
#define DP_S8(NB) do { const int nb_ = (NB); const float* vd_ = vec0 + (nb_ & 1) * 448; const bf16* Qn_ = Qn2 + (nb_ & 1) * 4608; const bf16* Kd_ = Kd2 + (nb_ & 1) * 4608; const int t0_ = DP_T0(nb_); \
        const bf16x8 sa0 = ld8(St + (16 * tr + l15) * 72 + 8 * q4), sa1 = ld8(St + (16 * tr + l15) * 72 + 32 + 8 * q4); \
        const bf16x8 va0 = ld8(VnT + (16 * tr + l15) * 72 + 8 * q4), va1 = ld8(VnT + (16 * tr + l15) * 72 + 32 + 8 * q4); \
        const bf16x8 ka0 = ldtr8(Kd_, 0, tr, lane), ka1 = ldtr8(Kd_, 1, tr, lane); \
        const float cd = vd_[256]; \
        _Pragma("unroll") for (int tcx = 0; tcx < 2; ++tcx) { const int i = 16 * (tc0 + tcx) + l15; \
            f32x4 o = (f32x4){0.f, 0.f, 0.f, 0.f}; \
            o = mfma16(sa0, ld8(Qn_ + i * 72 + 8 * q4), o); o = mfma16(sa1, ld8(Qn_ + i * 72 + 32 + 8 * q4), o); \
            o = o * vd_[64 + i]; \
            o = mfma16(va0, ld8(QKm + i * 72 + 8 * q4), o); o = mfma16(va1, ld8(QKm + i * 72 + 32 + 8 * q4), o); \
            const int t = t0_ + (dir ? 63 - i : i); \
            st4(OUT + ((size_t)b * SEQ + t) * 512 + h * 64 + 16 * tr + 4 * q4, o[0], o[1], o[2], o[3]); \
            const int e = 16 * (tc0 + tcx) + l15; \
            Sacc[tcx] = Sacc[tcx] * cd; Sacc[tcx] = mfma16(ka0, ld8(VnT + e * 72 + 8 * q4), Sacc[tcx]); Sacc[tcx] = mfma16(ka1, ld8(VnT + e * 72 + 32 + 8 * q4), Sacc[tcx]); } } while (0)
#define DP_STW() do { _Pragma("unroll") for (int tcx = 0; tcx < 2; ++tcx) { const int e = 16 * (tc0 + tcx) + l15; st4(St + e * 72 + 16 * tr + 4 * q4, Sacc[tcx][0], Sacc[tcx][1], Sacc[tcx][2], Sacc[tcx][3]); } } while (0)

    constexpr int NCK = SEQ / 64;
    DP_LANE(); DP_PREFETCH(0);
    __syncthreads();
    DP_S0(0);
    __syncthreads();
    DP_S1A(0); DP_S1B();
    __syncthreads();
    DP_LANE(); DP_S4(0); DP_S0(1);
    __syncthreads();
    DP_LANE(); DP_S5(); DP_S1A(1);
    __syncthreads();
#pragma nounroll
    for (int n = 0; n < NCK; ++n) {
        const bool has1 = n + 1 < NCK, has2 = n + 2 < NCK;
        DP_LANE(); DP_S7();
        __syncthreads();
        DP_LANE(); DP_S8(n); if (has1) DP_S1B();
        __syncthreads();
        DP_LANE(); DP_STW(); if (has1) DP_S4(n + 1); if (has2) DP_S0(n + 2);
        __syncthreads();
        DP_LANE(); if (has1) DP_S5(); if (has2) DP_S1A(n + 2);
        __syncthreads();
    }
#undef DP_LANE
#undef DP_T0
#undef DP_PREFETCH
#undef DP_S0
#undef DP_S1A
#undef DP_S1B
#undef DP_S4
#undef DP_S5
#undef DP_S7
#undef DP_S8
#undef DP_STW
}

constexpr int LN_CNT_OFF = LDSCTL_OFF + 512;
template <int MODE, bool W8 = false, bool G8 = false>
__device__ __forceinline__ void ln_phase(Frame& F, const float* gam, const float* bet) {
    float* out = F.out; bf16* HB = (bf16*)(F.ws + WS_HB);
    unsigned* lcnt = (unsigned*)(F.lds + LN_CNT_OFF);
    unsigned* TOKE = (unsigned*)(F.ws + WS_META + MT_TOKE); float* TOKP = (float*)(F.ws + WS_META + MT_TOKP); unsigned short* RANK = (unsigned short*)(F.ws + WS_META + MT_RANK);
    unsigned* CNT = (unsigned*)(F.ws + WS_META + MT_CNT); const bf16* YS = (const bf16*)(F.ws + WS_YS);
    const int lane = F.lane;
    if (MODE == 1) { if (F.tid < 8) lcnt[F.tid] = 0u; __syncthreads(); }
    f32x4 gv[4], bv[4];
#pragma unroll
    for (int j = 0; j < 4; ++j) { gv[j] = *(const f32x4*)(gam + lane * 4 + 256 * j); bv[j] = *(const f32x4*)(bet + lane * 4 + 256 * j); }
    v2u nx[2][4];
    { const bf16* h0 = HB + ((size_t)F.bx * 128 + F.wave * 16) * 1024 + lane * 4;
#pragma unroll
        for (int u = 0; u < 2; ++u)
#pragma unroll
            for (int j = 0; j < 4; ++j) nx[u][j] = *(const v2u*)(h0 + u * 1024 + 256 * j); }
    for (int i2 = 0; i2 < 16; i2 += 2) {
      v2u cur[2][4];
#pragma unroll
      for (int u = 0; u < 2; ++u)
#pragma unroll
          for (int j = 0; j < 4; ++j) cur[u][j] = nx[u][j];
      if (i2 + 2 < 16) { const bf16* h0 = HB + ((size_t)F.bx * 128 + F.wave * 16 + i2 + 2) * 1024 + lane * 4;
#pragma unroll
          for (int u = 0; u < 2; ++u)
#pragma unroll
              for (int j = 0; j < 4; ++j) nx[u][j] = *(const v2u*)(h0 + u * 1024 + 256 * j); }
#pragma unroll
      for (int u = 0; u < 2; ++u) {
        const int i = i2 + u;
        const size_t m = (size_t)F.bx * 128 + F.wave * 16 + i;
        float* zr = out + m * 1024 + lane * 4; bf16* hr = HB + m * 1024 + lane * 4;
        f32x4 v[4];
#pragma unroll
        for (int j = 0; j < 4; ++j) v[j] = (f32x4){bflo(cur[u][j].x), bfhi(cur[u][j].x), bflo(cur[u][j].y), bfhi(cur[u][j].y)};
        if (MODE == 2) {
            const float p1 = (ABL == 5) ? 0.f : TOKP[m * 2], p2 = (ABL == 5) ? 0.f : TOKP[m * 2 + 1];
            const bf16* y1 = YS + m * 2048 + lane * 4; const bf16* y2 = y1 + 1024;
#pragma unroll
            for (int j = 0; j < 4; ++j) { const v2u a = *(const v2u*)(y1 + 256 * j), b = *(const v2u*)(y2 + 256 * j);
                v[j][0] = v[j][0] * ALPHA + p1 * bflo(a.x) + p2 * bflo(b.x); v[j][1] = v[j][1] * ALPHA + p1 * bfhi(a.x) + p2 * bfhi(b.x);
                v[j][2] = v[j][2] * ALPHA + p1 * bflo(a.y) + p2 * bflo(b.y); v[j][3] = v[j][3] * ALPHA + p1 * bfhi(a.y) + p2 * bfhi(b.y); }
        }
        float s = 0.f;
#pragma unroll
        for (int j = 0; j < 4; ++j) s += (v[j][0] + v[j][1]) + (v[j][2] + v[j][3]);
        const float mean = wave_sum(s) * (1.0f / 1024.0f);
        float q = 0.f;
#pragma unroll
        for (int j = 0; j < 4; ++j) { v[j] = v[j] - mean; q += (v[j][0] * v[j][0] + v[j][1] * v[j][1]) + (v[j][2] * v[j][2] + v[j][3] * v[j][3]); }
        const float rstd = __builtin_amdgcn_rsqf(wave_sum(q) * (1.0f / 1024.0f) + LN_EPS);
#pragma unroll
        for (int j = 0; j < 4; ++j) { v[j] = v[j] * rstd * gv[j] + bv[j]; if (MODE == 2) *(f32x4*)(zr + 256 * j) = v[j]; }
        if (MODE != 2) {
#pragma unroll
            for (int j = 0; j < 4; ++j) { v2u w; w.x = pk2(v[j][0], v[j][1]); w.y = pk2(v[j][2], v[j][3]); *(v2u*)(hr + 256 * j) = w; }
        }
        if (G8) { unsigned char* h8 = F.ws + WS_HBG8 + m * 1024 + lane * 4;
#pragma unroll
            for (int j = 0; j < 4; ++j) *(unsigned*)(h8 + 256 * j) = pk4_fp8(v[j][0], v[j][1], v[j][2], v[j][3]); }
        if (W8) { unsigned char* h8 = F.ws + WS_HB8 + m * 1024 + lane * 4;
#pragma unroll
            for (int j = 0; j < 4; ++j) *(unsigned*)(h8 + 256 * j) = pk4_fp8(v[j][0], v[j][1], v[j][2], v[j][3]); }
        if (MODE == 1) {
            float lg[8];
#pragma unroll
            for (int e = 0; e < 8; ++e) lg[e] = 0.f;
#pragma unroll
            for (int j = 0; j < 4; ++j)
#pragma unroll
                for (int c = 0; c < 4; ++c) { const float* rw = IN_router_w(F) + (size_t)(lane * 4 + 256 * j + c) * 8; const f32x4 r0 = *(const f32x4*)rw, r1 = *(const f32x4*)(rw + 4); const float hv = v[j][c];
                    lg[0] += hv * r0[0]; lg[1] += hv * r0[1]; lg[2] += hv * r0[2]; lg[3] += hv * r0[3]; lg[4] += hv * r1[0]; lg[5] += hv * r1[1]; lg[6] += hv * r1[2]; lg[7] += hv * r1[3]; }
#pragma unroll
            for (int e = 0; e < 8; ++e) lg[e] = wave_sum(lg[e]);
            int e1 = 0; float l1 = lg[0];
#pragma unroll
            for (int e = 1; e < 8; ++e) if (lg[e] > l1) { l1 = lg[e]; e1 = e; }
            int e2 = -1; float l2 = -3.0e38f;
#pragma unroll
            for (int e = 0; e < 8; ++e) if (e != e1 && lg[e] > l2) { l2 = lg[e]; e2 = e; }
            if (lane == 0) {
                const float p1 = 1.0f / (1.0f + __expf(l2 - l1));
                TOKE[m] = (unsigned)e1 | ((unsigned)e2 << 8); TOKP[m * 2] = p1; TOKP[m * 2 + 1] = 1.0f - p1; (F.ws + WS_META + MT_DEFER)[m] = 0;
                RANK[m * 2] = (unsigned short)atomicAdd(&lcnt[e1], 1u); RANK[m * 2 + 1] = (unsigned short)atomicAdd(&lcnt[e2], 1u);
            }
        }
      }
    }
    if (MODE == 1) { __syncthreads(); if (F.tid < 8) CNT[F.bx * 8 + F.tid] = lcnt[F.tid]; }
}

constexpr int MT_BASE = 288, MT_TOT = 304, MT_NT = 312, MT_PRE = 320;
constexpr int TAIL_U0 = 512, TAIL_ROW0 = (CHT * (NCH - 1) + TAIL_U0 / 4) * 256;
__device__ __forceinline__ void moe_meta(Frame& F, int ln_wg  ) {
    int* mt = (int*)(F.lds + MOE_LDS_OFF); const unsigned* CNT = (const unsigned*)(F.ws + WS_META + MT_CNT);
    __syncthreads();
    { const int e = F.wave; int tot = 0, pre = 0;
#pragma unroll
        for (int k = 0; k < 4; ++k) { const int w = F.lane + 64 * k; const int v = (int)CNT[w * 8 + e]; tot += v; if (w < ln_wg) pre += v; }
#pragma unroll
        for (int o = 1; o < 64; o <<= 1) { tot += __shfl_xor(tot, o); pre += __shfl_xor(pre, o); }
        if (F.lane == 0) { mt[MT_TOT + e] = tot; mt[MT_PRE + e] = pre; } }
    __syncthreads();
    if (F.tid == 0) { int base = 0;
        for (int e = 0; e < 8; ++e) { mt[MT_BASE + e] = base; const int nt = (mt[MT_TOT + e] + 255) >> 8; for (int t = 0; t < nt; ++t) mt[(base >> 8) + t] = e; base += nt << 8; }
        mt[MT_BASE + 8] = base; mt[MT_NT] = base >> 8; }
    __syncthreads();
}
__device__ __forceinline__ int moe_chunk_tiles(const int* mt, int c) { return c < NCH - 1 ? CHT : mt[MT_NT] - CHT * (NCH - 1); }
__device__ __forceinline__ void moe_gather(Frame& F, int c) {
    if (MK_PER_PHASE || c == 0) moe_meta(F, F.bx);
    const int* mt = (const int*)(F.lds + MOE_LDS_OFF);
    const unsigned* TOKE = (const unsigned*)(F.ws + WS_META + MT_TOKE); const unsigned short* RANK = (const unsigned short*)(F.ws + WS_META + MT_RANK);
    unsigned* ROWMAP = (unsigned*)(F.ws + WS_META + MT_ROWMAP);
    const bf16* HB = (const bf16*)(F.ws + WS_HB); bf16* XG = (bf16*)(F.ws + WS_XG);
    const int lane = F.lane, li = lane & 31; const size_t mbase = (size_t)F.bx * 128 + F.wave * 16;
    int pos; bool mine;
    { const size_t m = mbase + (li >> 1); const int slot = li & 1;
        const int e = (int)((TOKE[m] >> (8 * slot)) & 0xffu);
        pos = mt[MT_BASE + e] + mt[MT_PRE + e] + (int)RANK[m * 2 + slot];
        int cc = pos / (CHT * 256); if (cc > NCH - 1) cc = NCH - 1;
        mine = lane < 32 && cc == c;
        if (mine) { ROWMAP[pos] = (unsigned)(m * 2 + slot); if (c == NCH - 1 && pos >= TAIL_ROW0) (F.ws + WS_META + MT_DEFER)[m] = 1; } }
    unsigned mask = (unsigned)__ballot(mine);
    while (mask) {
        int id[4];
#pragma unroll
        for (int k = 0; k < 4; ++k) { if (mask) { id[k] = __builtin_ctz(mask); mask &= mask - 1u; } else id[k] = -1; }
        v4u a[4], b[4];
#pragma unroll
        for (int k = 0; k < 4; ++k) if (id[k] >= 0) { const bf16* src = HB + (mbase + (id[k] >> 1)) * 1024 + lane * 16; a[k] = *(const v4u*)src; b[k] = *(const v4u*)(src + 8); }
#pragma unroll
        for (int k = 0; k < 4; ++k) if (id[k] >= 0) {
            const size_t lr = (size_t)(__builtin_amdgcn_readlane(pos, id[k]) - CHT * 256 * c);
            if (MOE_FP8) { f32x4 t0, t1, t2, t3; unpack8(a[k], t0, t1); unpack8(b[k], t2, t3);
                v4u o; o.x = pk4_fp8(t0[0], t0[1], t0[2], t0[3]); o.y = pk4_fp8(t1[0], t1[1], t1[2], t1[3]); o.z = pk4_fp8(t2[0], t2[1], t2[2], t2[3]); o.w = pk4_fp8(t3[0], t3[1], t3[2], t3[3]);
                *(v4u*)((unsigned char*)XG + lr * 1024 + lane * 16) = o; }
            else { *(v4u*)(XG + lr * 1024 + lane * 16) = a[k]; *(v4u*)(XG + lr * 1024 + lane * 16 + 8) = b[k]; }
        }
    }
}
template <int PASS>
__device__ __forceinline__ void ln_final(Frame& F, const float* gam, const float* bet, int nskip) {
    float* out = F.out; const bf16* HB = (const bf16*)(F.ws + WS_HB);
    const float* TOKP = (const float*)(F.ws + WS_META + MT_TOKP); const bf16* YS = (const bf16*)(F.ws + WS_YS); const unsigned char* DEFER = F.ws + WS_META + MT_DEFER;
    const int lane = F.lane;
    f32x4 gv[4], bv[4];
#pragma unroll
    for (int j = 0; j < 4; ++j) { gv[j] = *(const f32x4*)(gam + lane * 4 + 256 * j); bv[j] = *(const f32x4*)(bet + lane * 4 + 256 * j); }
    int r0, r1; unsigned long long dmask = 0ull;
    if (PASS == 1) { const int nw = (F.G - nskip) * NWAVES, wv = (F.bx - nskip) * NWAVES + F.wave; r0 = (int)(((long)wv * M) / nw); r1 = (int)(((long)(wv + 1) * M) / nw); }
    else { r0 = F.bx * 128 + F.wave * 16; r1 = r0 + 16; dmask = __ballot(lane < 16 && DEFER[r0 + (lane & 15)] != 0); }
    v2u nx[4], ny1[4], ny2[4]; unsigned nfl = 0u; float np1 = 0.f, np2 = 0.f;
    if (PASS == 1 && r0 < r1) { const bf16* h0 = HB + (size_t)r0 * 1024 + lane * 4; const bf16* y0 = YS + (size_t)r0 * 2048 + lane * 4; nfl = DEFER[r0]; np1 = TOKP[(size_t)r0 * 2]; np2 = TOKP[(size_t)r0 * 2 + 1];
#pragma unroll
        for (int j = 0; j < 4; ++j) { nx[j] = *(const v2u*)(h0 + 256 * j); ny1[j] = *(const v2u*)(y0 + 256 * j); ny2[j] = *(const v2u*)(y0 + 1024 + 256 * j); } }
    for (int m_ = r0; m_ < r1; ++m_) {
        const size_t m = (size_t)m_;
        float* zr = out + m * 1024 + lane * 4; const bf16* hr = HB + m * 1024 + lane * 4;
        const bf16* y1 = YS + m * 2048 + lane * 4; const bf16* y2 = y1 + 1024;
        f32x4 v[4]; v2u ya[4], yb[4]; float p1, p2; bool skip;
        if (PASS == 1) {
#pragma unroll
            for (int j = 0; j < 4; ++j) { v[j] = (f32x4){bflo(nx[j].x), bfhi(nx[j].x), bflo(nx[j].y), bfhi(nx[j].y)}; ya[j] = ny1[j]; yb[j] = ny2[j]; }
            p1 = np1; p2 = np2;
            skip = __builtin_amdgcn_readfirstlane(nfl) != 0u;
            if (m_ + 1 < r1) { nfl = DEFER[m + 1]; np1 = TOKP[m * 2 + 2]; np2 = TOKP[m * 2 + 3];
#pragma unroll
                for (int j = 0; j < 4; ++j) { nx[j] = *(const v2u*)(hr + 1024 + 256 * j); ny1[j] = *(const v2u*)(y1 + 2048 + 256 * j); ny2[j] = *(const v2u*)(y2 + 2048 + 256 * j); } }
        } else {
            skip = ((dmask >> (m_ - r0)) & 1ull) == 0ull;
            if (!skip) { p1 = TOKP[m * 2]; p2 = TOKP[m * 2 + 1];
#pragma unroll
                for (int j = 0; j < 4; ++j) { const v2u w = *(const v2u*)(hr + 256 * j); v[j] = (f32x4){bflo(w.x), bfhi(w.x), bflo(w.y), bfhi(w.y)}; ya[j] = *(const v2u*)(y1 + 256 * j); yb[j] = *(const v2u*)(y2 + 256 * j); } }
        }
        if (skip) continue;
        if (ABL == 5) { p1 = 0.f; p2 = 0.f; }
#pragma unroll
        for (int j = 0; j < 4; ++j) { const v2u a = ya[j], b = yb[j];
            v[j][0] = v[j][0] * ALPHA + p1 * bflo(a.x) + p2 * bflo(b.x); v[j][1] = v[j][1] * ALPHA + p1 * bfhi(a.x) + p2 * bfhi(b.x);
            v[j][2] = v[j][2] * ALPHA + p1 * bflo(a.y) + p2 * bflo(b.y); v[j][3] = v[j][3] * ALPHA + p1 * bfhi(a.y) + p2 * bfhi(b.y); }
        float s = 0.f;
#pragma unroll
        for (int j = 0; j < 4; ++j) s += (v[j][0] + v[j][1]) + (v[j][2] + v[j][3]);
        const float mean = wave_sum(s) * (1.0f / 1024.0f);
        float q = 0.f;
#pragma unroll
        for (int j = 0; j < 4; ++j) { v[j] = v[j] - mean; q += (v[j][0] * v[j][0] + v[j][1] * v[j][1]) + (v[j][2] * v[j][2] + v[j][3] * v[j][3]); }
        const float rstd = __builtin_amdgcn_rsqf(wave_sum(q) * (1.0f / 1024.0f) + LN_EPS);
#pragma unroll
        for (int j = 0; j < 4; ++j) { v[j] = v[j] * rstd * gv[j] + bv[j]; *(f32x4*)(zr + 256 * j) = v[j]; }
    }
}
struct MoeSched {
    int G, c, NJ, nunits, t0; const int* mt; const char* A; const char* B; size_t tsA, tsB; int off = 0;
    __device__ __forceinline__ bool next(int i, Unit& u) const { const int L = i * G + c + off; if (L >= nunits) return false; u.pm = L / NJ; u.aux = L - u.pm * NJ; u.pn = mt[t0 + u.pm] * NJ + u.aux; return true; }
    __device__ __forceinline__ const char* abase(const Unit& u) const { return A + (size_t)u.pm * tsA; }
    __device__ __forceinline__ const char* bbase(const Unit& u) const { return B + (size_t)u.pn * tsB; }
};
struct EpiMoeDown {
    static constexpr bool PERM = true;
    bf16* YS; const unsigned* rowmap; const int* mt; int t0;
    __device__ __forceinline__ void operator()(acc_t& acc, const Unit& u, int wr, int wc, int fr, int fq) const {
        const int tg = t0 + u.pm, e = mt[tg], lim = mt[MT_BASE + e] + mt[MT_TOT + e]; const int row0 = tg * 256 + wr * 64 + fr; const int col = u.aux * 256 + wc * 32 + 8 * fq;
#pragma unroll
        for (int ai = 0; ai < 2; ++ai)
#pragma unroll
            for (int m = 0; m < 4; ++m) { const int r = row0 + ai * 128 + m * 16;
                if (r < lim) { const size_t pr = rowmap[r]; bf16* dst = YS + pr * 1024 + col;
                    const float ds = (FP8_EMU || MOE_FP8) ? (1.0f / 32.0f) : 1.0f;
                    *(v4u*)(dst) = pack8(acc[ai][0][m][0] * ds, acc[ai][0][m][1] * ds); *(v4u*)(dst + 128) = pack8(acc[ai][1][m][0] * ds, acc[ai][1][m][1] * ds); } }
        zero_acc(acc);
    }
};

__global__ void __launch_bounds__(NTHR, 2) fwd_kernel(Args args) {
    extern __shared__ __attribute__((aligned(16))) unsigned char lds[];
    Frame F0;
    F0.lds = lds;
    F0.tid = threadIdx.x; F0.lane = F0.tid & 63; F0.wave = __builtin_amdgcn_readfirstlane(F0.tid >> 6);
    F0.G = gridDim.x; F0.bx = blockIdx.x;
    F0.ws = args.ws; F0.out = args.out;
    F0.a = &args;
    { LAS unsigned char* ldsl0 = (LAS unsigned char*)lds;
    for (int u = F0.tid; u < (LDS_BYTES - LDSCTL_OFF) / 4; u += NTHR) ((LAS unsigned*)(ldsl0 + LDSCTL_OFF))[u] = 0u; }
    __syncthreads();
    unsigned* ctl = (unsigned*)(F0.ws + WS_CTL);
    XcdBarrier bar; bar.bar = ctl + CW_BAR; bar.x = 0; bar.st = nullptr; bar.w0 = 0;
    if (!MK_PER_PHASE) bar = xcd_barrier_post(ctl + CW_BAR, (volatile LAS unsigned*)((LAS unsigned char*)lds + MISC_OFF) + 8);
    const int lo = args.ph_lo, hi = args.ph_hi;
#ifndef PHASE_MASK
#define PHASE_MASK 0xFFFFFFFFu
#endif
#define EN(b) (((PHASE_MASK) >> (b)) & 1u)
#ifndef SP2K
#define SP2K 0
#endif
#ifndef ALN
#define ALN 14
#endif
#ifndef DBL
#define DBL 0
#endif
#define REP(k) for (int rep_ = 0; rep_ < ((DBL) == (k) ? 2 : 1); ++rep_)
#define IN(k) (lo <= (k) && (k) < hi)
#define GRID_BAR() do { if (!MK_PER_PHASE) xcd_barrier(bar); } while (0)
#define PH_BEGIN() Frame P = F0; asm volatile("" : "+s"(P.ws), "+s"(P.out), "+s"(P.G), "+s"(P.bx)); P.lane = (int)__builtin_amdgcn_mbcnt_hi(~0u, __builtin_amdgcn_mbcnt_lo(~0u, 0u)); asm volatile("" : "+v"(P.lane)); P.tid = P.wave * 64 + P.lane; Frame& F = P; LAS unsigned char* ldsl = (LAS unsigned char*)P.lds;

    if (EN(0) && IN(0)) { PH_BEGIN(); REP(100) p0_prologue(F); }
    GRID_BAR();
#if defined(XBAR)
    for (int xb_ = 0; xb_ < XBAR; ++xb_) GRID_BAR();
#endif

#pragma nounroll
    for (int layer = 0; layer < 2; ++layer) {
        const int pb = 1 + 40 * layer;
        if (EN(1) && IN(pb + 0)) { PH_BEGIN(); const bf16* HB = (const bf16*)(F.ws + WS_HB); const bf16* WIN = (const bf16*)(F.ws + WS_WIN) + (size_t)layer * WIN_ROWS * 1024;
            pg8::StdSched S; S.init(HB, WIN, M, NA, 1024, F.G, F.bx);
            EpiInA E{F.ws};
            REP(1) pg8::gemm_phase<EpiInA, pg8::StdSched, (ALN & 8) == 0, true>(ldsl + RING_OFF, 1024, S, E, F.wave);
        }
        GRID_BAR();
        if (EN(2) && IN(pb + 1)) { PH_BEGIN();
#if defined(DELTA_RECURRENT)
            REP(21) for (int s = F.bx; s < 256; s += F.G) delta_seq(F, layer, s);
#else
#if defined(DELTA_NOPIPE)
            REP(21) for (int s = F.bx; s < 256; s += F.G) delta_seq_chunked(F, layer, s);
#else
            REP(21) for (int s = F.bx; s < 256; s += F.G) delta_seq_pipe(F, layer, s);
#endif
#endif
            __syncthreads();
            attn_bias_setup(F);
            if (DBL == 22) attn_phase(F, layer, (bf16*)(F.ws + WS_OP));
            attn_phase(F, layer, nullptr);
            REP(23) for (int u = F.bx; u < 1024; u += F.G) pool_unit(F, layer, u);
        }
        GRID_BAR();
        if (EN(3) && IN(pb + 20)) { PH_BEGIN(); delta_post(F, layer); }
        GRID_BAR();
        if (EN(3) && IN(pb + 2)) { PH_BEGIN(); const bf16* HB = (const bf16*)(F.ws + WS_HB); const bf16* WIN = (const bf16*)(F.ws + WS_WIN) + (size_t)layer * WIN_ROWS * 1024;
#if GATES_FP8
            pg8::StdSched S; S.init(F.ws + WS_HBG8, WIN + (size_t)NA * 1024, M, NG, 512, F.G, F.bx); (void)HB;
            EpiGates E{(bf16*)(F.ws + WS_GT), 1.0f / 32.0f};
            REP(3) pg8::gemm_phase<EpiGates, pg8::StdSched, (ALN & 2) == 0, (SP2K & 2) == 0, true>(ldsl + RING_OFF, 512, S, E, F.wave);
#else
            pg8::StdSched S; S.init(HB, WIN + (size_t)NA * 1024, M, NG, 1024, F.G, F.bx);
            EpiGates E{(bf16*)(F.ws + WS_GT), 1.0f};
            REP(3) pg8::gemm_phase<EpiGates, pg8::StdSched, true, true>(ldsl + RING_OFF, 1024, S, E, F.wave);
#endif
        }
        GRID_BAR();
        if (EN(4) && IN(pb + 3)) { PH_BEGIN();
#if defined(BRSKEW)
            if (F.bx & 1) { for (int i_ = 0; i_ < BRSKEW; ++i_) __builtin_amdgcn_s_sleep(127); }
#endif
            BrSched S; S.o.init(M / 256, 4, F.G, F.bx); S.A0 = (const char*)(F.ws + WS_AQ); static_assert(WS_DZ == WS_AQ + 32 * MiB && WS_OP == WS_AQ + 64 * MiB, "branch planes");
            S.B0 = (const char*)(F.ws + WS_WBR) + (size_t)layer * 3 * 1024 * 512 * 2; S.tstep = (size_t)256 * 512 * 2;
#if defined(BR_RMW)
            EpiBranchRMW E{(const bf16*)(F.ws + WS_GT), (bf16*)(F.ws + WS_MERGED)};
            pg8::gemm_phase<EpiBranchRMW, BrSched, false, true>(ldsl + RING_OFF, 512, S, E, F.wave);
#else
            EpiBranch E{(const bf16*)(F.ws + WS_GT), (bf16*)(F.ws + WS_MERGED)};
            REP(4) pg8::gemm_phase<EpiBranch, BrSched, (ALN & 16) == 0, true>(ldsl + RING_OFF, 512, S, E, F.wave);
#endif
        }
        GRID_BAR();
        if (EN(5) && IN(pb + 4)) { PH_BEGIN();
            pg8::StdSched S; S.init(F.ws + WS_MERGED, (const bf16*)(F.ws + WS_WOUT) + (size_t)layer * 1024 * 1024, M, 1024, 1024, F.G, F.bx);
#if (LN_FUSE & 1)
            if (layer == 0) { EpiResidLN<0, false, 0> E{F.ws, F.a, ldsl, 1.0f};
                pg8::gemm_phase<EpiResidLN<0, false, 0>, pg8::StdSched, true, true>(ldsl + RING_OFF, 1024, S, E, F.wave); }
            else
#endif
            { EpiResid E{(bf16*)(F.ws + WS_HB), 1.0f};
            pg8::gemm_phase<EpiResid, pg8::StdSched, (ALN & 32) == 0, true>(ldsl + RING_OFF, 1024, S, E, F.wave); }
        }
        GRID_BAR();
        if (EN(6) && IN(pb + 5) && !((LN_FUSE & 1) && layer == 0)) { PH_BEGIN();
            if (layer == 0) ln_phase<0, FFN_FP8 == 1 || FFN_FP8 == 2>(F, IN_ln1_g(F), IN_ln1_b(F));
            else { ln_phase<1>(F, IN_ln1_g(F) + 1024, IN_ln1_b(F) + 1024); REP(101) moe_weight_convert(F); }
        }
        if (!((LN_FUSE & 1) && layer == 0)) GRID_BAR();
        if (layer == 0) {
            if (EN(7) && IN(pb + 6)) { PH_BEGIN(); const bf16* HB = (const bf16*)(F.ws + WS_HB);
#if FFN_FP8 == 2
                FfnUpSched S; S.o.init(M / 256, FF / 128, F.G, F.bx); S.A = (const char*)(F.ws + WS_HB8); S.Bt = (const char*)(F.ws + WS_W13); S.tstep = (size_t)256 * 1024; (void)HB;
                EpiSwiglu E{(bf16*)(F.ws + WS_FACT), FF, 1.0f / 32.0f, 0};
                REP(7) pg8::gemm_phase<EpiSwiglu, FfnUpSched, true, true, true>(ldsl + RING_OFF, 512, S, E, F.wave);
#elif FFN_FP8 == 1
                FfnUpSched S; S.o.init(M / 256, FF / 128, F.G, F.bx); S.A = (const char*)(F.ws + WS_HB8); S.Bt = (const char*)(F.ws + WS_W13); S.tstep = (size_t)256 * 1024; (void)HB;
                EpiSwiglu8 E{(unsigned char*)(F.ws + WS_FACT), FF, 1.0f / 32.0f};
                REP(7) pg8::gemm_phase<EpiSwiglu8, FfnUpSched, true, true, true>(ldsl + RING_OFF, 512, S, E, F.wave);
#elif FFN_FP8 == 3
                FfnUpSched S; S.o.init(M / 256, FF / 128, F.G, F.bx); S.A = (const char*)HB; S.Bt = (const char*)(F.ws + WS_W13); S.tstep = (size_t)256 * 1024 * 2;
                EpiSwiglu8 E{(unsigned char*)(F.ws + WS_FACT), FF, 1.0f};
                REP(7) pg8::gemm_phase<EpiSwiglu8, FfnUpSched, (ALN & 4) == 0, true>(ldsl + RING_OFF, 1024, S, E, F.wave);
#else
                FfnUpSched S; S.o.init(M / 256, FF / 128, F.G, F.bx); S.A = (const char*)HB; S.Bt = (const char*)(F.ws + WS_W13); S.tstep = (size_t)256 * 1024 * 2;
                EpiSwiglu E{(bf16*)(F.ws + WS_FACT), FF, 1.0f, 0};
                REP(7) pg8::gemm_phase<EpiSwiglu, FfnUpSched, (ALN & 4) == 0, true>(ldsl + RING_OFF, 1024, S, E, F.wave);
#endif
            }
            GRID_BAR();
            if (EN(8) && IN(pb + 7)) { PH_BEGIN();
#if FFN_FP8 == 1 || FFN_FP8 == 3
                pg8::StdSched S; S.init(F.ws + WS_FACT, F.ws + WS_W2, M, 1024, FF / 2, F.G, F.bx);
#if (LN_FUSE & 2)
                EpiResidLN<1, GATES_FP8 != 0, 1> E{F.ws, F.a, ldsl, (ABL == 4) ? 0.f : (1.0f / 32.0f)};
                pg8::gemm_phase<EpiResidLN<1, GATES_FP8 != 0, 1>, pg8::StdSched, true, true, true>(ldsl + RING_OFF, FF / 2, S, E, F.wave);
#else
                EpiResid E{(bf16*)(F.ws + WS_HB), (ABL == 4) ? 0.f : (1.0f / 32.0f)};
                pg8::gemm_phase<EpiResid, pg8::StdSched, true, true, true>(ldsl + RING_OFF, FF / 2, S, E, F.wave);
#endif
#else
                pg8::StdSched S; S.init(F.ws + WS_FACT, F.ws + WS_W2, M, 1024, FF, F.G, F.bx);
                EpiResid E{(bf16*)(F.ws + WS_HB), (ABL == 4) ? 0.f : 1.0f};
                pg8::gemm_phase<EpiResid, pg8::StdSched, (ALN & 64) == 0, true>(ldsl + RING_OFF, FF, S, E, F.wave);
#endif
            }
            GRID_BAR();
#if !((LN_FUSE & 2) && (FFN_FP8 == 1 || FFN_FP8 == 3))
            if (EN(9) && IN(pb + 8)) { PH_BEGIN(); ln_phase<0, false, GATES_FP8 != 0>(F, IN_ln2_g(F), IN_ln2_b(F)); }
            GRID_BAR();
#endif
        } else {
            if (EN(10) && IN(pb + 6)) { PH_BEGIN(); moe_gather(F, 0); }
            GRID_BAR();
#pragma nounroll
            for (int c = 0; c < NCH; ++c) {
                if (EN(11) && IN(pb + 7 + 2 * c)) { PH_BEGIN(); const int* mt = (const int*)(F.lds + MOE_LDS_OFF);
                    if (MK_PER_PHASE) moe_meta(F, -1);
                    MoeSched S; S.G = F.G; S.c = F.bx; S.NJ = FFE / 128; S.t0 = CHT * c; S.nunits = moe_chunk_tiles(mt, c) * S.NJ; S.mt = mt; S.A = (const char*)(F.ws + WS_XG); S.B = (const char*)(F.ws + WS_MWGU);
                    S.tsA = (size_t)256 * 1024 * (MOE_FP8 ? 1 : 2); S.tsB = S.tsA;
#if MOE_FP8
                    EpiSwiglu8 E{(unsigned char*)(F.ws + WS_MACT), FFE, 1.0f / 32.0f};
                    REP(11) pg8::gemm_phase<EpiSwiglu8, MoeSched, (ALN & 1) == 0, (SP2K & 1) == 0, true>(ldsl + RING_OFF, 512, S, E, F.wave);
#else
                    EpiSwiglu E{(bf16*)(F.ws + WS_MACT), FFE, FP8_EMU ? (1.0f / 32.0f) : 1.0f, FP8_EMU};
                    REP(11) pg8::gemm_phase<EpiSwiglu, MoeSched, true, true>(ldsl + RING_OFF, 1024, S, E, F.wave);
#endif
                }
                GRID_BAR();
                if (EN(12) && IN(pb + 8 + 2 * c)) { PH_BEGIN(); const int* mt = (const int*)(F.lds + MOE_LDS_OFF);
                    if (MK_PER_PHASE) moe_meta(F, -1);
                    MoeSched S; S.G = F.G; S.c = F.bx; S.NJ = 4; S.t0 = CHT * c; S.nunits = moe_chunk_tiles(mt, c) * 4; if (c == NCH - 1 && S.nunits > TAIL_U0) S.nunits = TAIL_U0; S.mt = mt; S.A = (const char*)(F.ws + WS_MACT); S.B = (const char*)(F.ws + WS_MWD);
                    S.tsA = (size_t)256 * FFE * (MOE_FP8 ? 1 : 2); S.tsB = S.tsA;
                    EpiMoeDown E{(bf16*)(F.ws + WS_YS), (const unsigned*)(F.ws + WS_META + MT_ROWMAP), mt, CHT * c};
#if MOE_FP8
                    REP(12) pg8::gemm_phase<EpiMoeDown, MoeSched, (ALN & 128) == 0, (SP2K & 4) == 0, true>(ldsl + RING_OFF, FFE / 2, S, E, F.wave);
#else
                    REP(12) pg8::gemm_phase<EpiMoeDown, MoeSched, true, true>(ldsl + RING_OFF, FFE, S, E, F.wave);
#endif
                }
                if (EN(12) && IN(pb + 8 + 2 * c) && c + 1 < NCH) { PH_BEGIN(); moe_gather(F, c + 1); }
                GRID_BAR();
            }
            if (EN(13) && IN(pb + 13)) { PH_BEGIN(); const int* mt = (const int*)(F.lds + MOE_LDS_OFF);
                if (MK_PER_PHASE) moe_meta(F, -1);
                const int total = moe_chunk_tiles(mt, NCH - 1) * 4, ntail = total > TAIL_U0 ? total - TAIL_U0 : 0;
                if (F.bx < ntail) {
                    MoeSched S; S.G = F.G; S.c = F.bx; S.NJ = 4; S.t0 = CHT * (NCH - 1); S.nunits = total; S.off = TAIL_U0; S.mt = mt; S.A = (const char*)(F.ws + WS_MACT); S.B = (const char*)(F.ws + WS_MWD);
                    S.tsA = (size_t)256 * FFE * (MOE_FP8 ? 1 : 2); S.tsB = S.tsA;
                    EpiMoeDown E{(bf16*)(F.ws + WS_YS), (const unsigned*)(F.ws + WS_META + MT_ROWMAP), mt, CHT * (NCH - 1)};
#if MOE_FP8
                    pg8::gemm_phase<EpiMoeDown, MoeSched, true, true, true>(ldsl + RING_OFF, FFE / 2, S, E, F.wave);
#else
                    pg8::gemm_phase<EpiMoeDown, MoeSched, true, true>(ldsl + RING_OFF, FFE, S, E, F.wave);
#endif
                } else ln_final<1>(F, IN_ln2_g(F) + 1024, IN_ln2_b(F) + 1024, ntail);
            }
            GRID_BAR();
            if (EN(13) && IN(pb + 15)) { PH_BEGIN(); ln_final<2>(F, IN_ln2_g(F) + 1024, IN_ln2_b(F) + 1024, 0); }
        }
    }
#undef IN
#undef GRID_BAR
}


#if defined(DBG_CHECK)
constexpr int CK_BASE = 512;
__device__ __forceinline__ unsigned ck_hash(unsigned x) { x ^= x >> 16; x *= 0x7feb352du; x ^= x >> 15; x *= 0x846ca68bu; x ^= x >> 16; return x; }
__device__ __forceinline__ void ck_record(unsigned* ctl, int stage, float mine, float ref) {
    const float e = fabsf(mine - ref), r = fabsf(ref);
    atomicMax(ctl + CK_BASE + 2 * stage, __float_as_uint(e == e ? e : 1e30f)); atomicMax(ctl + CK_BASE + 2 * stage + 1, __float_as_uint(r));
}
__device__ __forceinline__ float ck_dot(const bf16* a, int K, const float* w, int ldw) { float s = 0.f; for (int k = 0; k < K; ++k) s += bf2f(a[k]) * w[(size_t)k * ldw]; return s; }
__global__ void __launch_bounds__(256) check_kernel(Args args, int stage, int layer) {
    unsigned char* ws = args.ws; unsigned* ctl = (unsigned*)(ws + WS_CTL);
    const bf16* HB = (const bf16*)(ws + WS_HB);
    const int gt = blockIdx.x * 256 + threadIdx.x;
    const unsigned hsh = ck_hash((unsigned)gt * 2654435761u + 12345u * stage);
    if (stage == 1) {
        const int r = hsh % M; int c = (hsh >> 15) % 3328; if (c >= 2816) c += 32;
        const float ref = ck_dot(HB + (size_t)r * 1024, 1024, args.in[1] + (size_t)layer * 1024 * IN_COLS + c, IN_COLS);
        float mine;
        if (c < 512) mine = bf2f(((const bf16*)(ws + WS_AQ))[(size_t)r * 512 + c]);
        else if (c < 640) mine = bf2f(((const bf16*)(ws + WS_AK))[(size_t)r * 128 + c - 512]);
        else if (c < 768) mine = bf2f(((const bf16*)(ws + WS_AV))[(size_t)r * 128 + c - 640]);
        else if (c < 2304) mine = bf2f(((const bf16*)(ws + WS_DQKV))[(size_t)r * 1536 + c - 768]);
        else if (c < 2816) mine = bf2f(((const bf16*)(ws + WS_DZ))[(size_t)r * 512 + c - 2304]);
        else mine = bf2f(((const bf16*)(ws + WS_PU))[(size_t)r * 512 + c - 2848]);
        ck_record(ctl, 1, mine, ref);
    } else if (stage == 2) {
        const int r = hsh % M, c = (hsh >> 15) % 32;
        const float ref = ck_dot(HB + (size_t)r * 1024, 1024, args.in[1] + (size_t)layer * 1024 * IN_COLS + 2816 + c, IN_COLS);
        ck_record(ctl, 2, ((const float*)(ws + WS_DAB))[(size_t)r * 32 + c], ref);
    } else if (stage == 3) {
        const int r = hsh % M, c = (hsh >> 15) % 3072;
        const float ref = 1.0f / (1.0f + expf(-ck_dot(HB + (size_t)r * 1024, 1024, args.in[1] + (size_t)layer * 1024 * IN_COLS + 3360 + c, IN_COLS)));
        const float mine3 = bf2f(((const bf16*)(ws + WS_GT))[(size_t)(c >> 10) * M * 1024 + (size_t)r * 1024 + (c & 1023)]);
        ck_record(ctl, 3, mine3, ref);
        ck_record(ctl, 14 + (c >> 10), mine3, ref);
        ck_record(ctl, 17 + (r >> 13), mine3, ref);
        ck_record(ctl, 21 + ((c >> 8) & 3), mine3, ref);
        if (fabsf(mine3 - ref) > 0.04f) { const unsigned ix = atomicAdd(ctl + CK_BASE + 100, 1u); if (ix < 256) { ctl[1024 + 2 * ix] = (unsigned)c; ctl[1025 + 2 * ix] = (unsigned)r; } atomicMax(ctl + 2048, __float_as_uint(mine3)); atomicMax(ctl + 2049, __float_as_uint(1.0f - mine3)); atomicMax(ctl + 2050, __float_as_uint(ref)); atomicMax(ctl + 2051, __float_as_uint(1.0f - ref)); }
    } else if (stage == 4) {
        __shared__ float q_s[64]; __shared__ float sc_s[260];
        const unsigned hb_ = ck_hash((unsigned)blockIdx.x * 2654435761u + 777u);
        const int m = hb_ % M, hq = (hb_ >> 15) & 7, d = (hb_ >> 18) & 63, b = m / SEQ, t = m % SEQ, kvh = hq >> 2;
        if (threadIdx.x < 64) q_s[threadIdx.x] = ck_dot(HB + (size_t)m * 1024, 1024, args.in[1] + (size_t)layer * 1024 * IN_COLS + hq * 64 + threadIdx.x, IN_COLS);
        __syncthreads();
        const bf16* AK = (const bf16*)(ws + WS_AK); const bf16* AV = (const bf16*)(ws + WS_AV);
        const float sink = args.in[2][layer * 8 + hq];
        for (int j = threadIdx.x; j < 257; j += 256) { const int kp = t - 128 + j; float s = -1e30f;
            if (kp >= 0 && kp < SEQ) { s = 0.f; for (int i = 0; i < 64; ++i) s += q_s[i] * bf2f(AK[((size_t)b * SEQ + kp) * 128 + kvh * 64 + i]);
                const int rel = kp - t, n = rel < 0 ? -rel : rel;
                int bk; if (n < 8) bk = n; else { bk = 8 + (int)(logf((float)n / 8.f) / logf(16.f) * 8.f + 1e-4f); if (bk > 15) bk = 15; } if (rel > 0) bk += 16;
                s = s * 0.125f + args.in[3][bk * 8 + hq]; }
            sc_s[j] = s; }
        __syncthreads();
        if (threadIdx.x == 0) { float mx = sink; for (int j = 0; j < 257; ++j) mx = fmaxf(mx, sc_s[j]);
            float den = expf(sink - mx), o = 0.f;
            for (int j = 0; j < 257; ++j) { if (sc_s[j] < -1e29f) continue; const int kp = t - 128 + j; const float p = expf(sc_s[j] - mx); den += p; o += p * bf2f(AV[((size_t)b * SEQ + kp) * 128 + kvh * 64 + d]); }
            ck_record(ctl, 4, bf2f(((const bf16*)(ws + WS_AQ))[(size_t)m * 512 + hq * 64 + d]), o / den); }
    } else if (stage == 5) {
        const int m = hsh % M, g = (hsh >> 15) & 3, d = (hsh >> 17) & 127, b = m / SEQ, t = m % SEQ, r = 1 << g;
        const bf16* PU = (const bf16*)(ws + WS_PU); const float* pw = args.in[8] + ((size_t)layer * 4 + g) * 128 * 128;
        const int lo = t - r < 0 ? 0 : t - r, hi = t + r > SEQ - 1 ? SEQ - 1 : t + r; float y = 0.f;
        for (int c = 0; c < 128; ++c) { float s = 0.f; for (int tt = lo; tt <= hi; ++tt) s += bf2f(PU[((size_t)b * SEQ + tt) * 512 + g * 128 + c]);
            const float mxv = s / (float)(hi - lo + 1) - bf2f(PU[(size_t)m * 512 + g * 128 + c]); y += mxv * pw[c * 128 + d]; }
        y *= args.in[9][layer * 512 + g * 128 + d];
        ck_record(ctl, 5, bf2f(((const bf16*)(ws + WS_OP))[(size_t)m * 512 + g * 128 + d]), y);
    } else if (stage == 6) {
        constexpr int TCK = 192;
        __shared__ float q_s[64]; __shared__ float k_s[64];
        const int j = threadIdx.x & 63; if (threadIdx.x >= 64) return;
        const int seq = (blockIdx.x * 17 + 3) & 255;
        const int dir = seq >> 7, b = (seq >> 3) & 15, h = seq & 7;
        const bf16* DQKV = (const bf16*)(ws + WS_DQKV); const float* DAB = (const float*)(ws + WS_DAB); const float* cwp = args.in[4] + (size_t)layer * 5 * 1536;
        const float nA = -expf(args.in[5][layer * 16 + dir * 8 + h]), dtb = args.in[6][layer * 16 + dir * 8 + h];
        float S[64];
#pragma unroll
        for (int i = 0; i < 64; ++i) S[i] = 0.f;
        float maxe = 0.f, maxr = 0.f;
        for (int s2 = 0; s2 < TCK; ++s2) { const int t = dir ? SEQ - 1 - s2 : s2; const size_t m = (size_t)b * SEQ + t;
            float xq = 0.f, xk = 0.f, v = 0.f;
            for (int jj = 0; jj < 5; ++jj) { const int tt = t + jj - 2; if (tt < 0 || tt >= SEQ) continue; const size_t mm = (size_t)b * SEQ + tt;
                xq += cwp[jj * 1536 + h * 64 + j] * bf2f(DQKV[mm * 1536 + h * 64 + j]); xk += cwp[jj * 1536 + 512 + h * 64 + j] * bf2f(DQKV[mm * 1536 + 512 + h * 64 + j]);
                v += cwp[jj * 1536 + 1024 + h * 64 + j] * bf2f(DQKV[mm * 1536 + 1024 + h * 64 + j]); }
            xq = xq / (1.f + expf(-xq)); xk = xk / (1.f + expf(-xk)); v = v / (1.f + expf(-v));
            __syncthreads(); q_s[j] = xq; k_s[j] = xk; __syncthreads();
            float qs = 0.f, ks = 0.f;
            for (int i = 0; i < 64; ++i) { qs += q_s[i] * q_s[i]; ks += k_s[i] * k_s[i]; }
            const float qn = 0.125f / sqrtf(qs + 1e-6f), kn = 1.0f / sqrtf(ks + 1e-6f);
            const float a = DAB[m * 32 + dir * 8 + h] + dtb, sp = a > 20.f ? a : log1pf(expf(a)), al = expf(nA * sp), be = 1.f / (1.f + expf(-DAB[m * 32 + 16 + dir * 8 + h]));
            float part = 0.f;
#pragma unroll
            for (int i = 0; i < 64; ++i) part += S[i] * k_s[i];
            const float c = be * (v - al * part * kn); float o = 0.f;
#pragma unroll
            for (int i = 0; i < 64; ++i) { S[i] = al * S[i] + k_s[i] * kn * c; o += S[i] * q_s[i]; }
            o *= qn;
            const float mine = ((const float*)(ws + (dir ? WS_OB : WS_OF)))[m * 512 + h * 64 + j];
            maxe = fmaxf(maxe, fabsf(mine - o)); maxr = fmaxf(maxr, fabsf(o)); }
        atomicMax(ctl + CK_BASE + 12, __float_as_uint(maxe == maxe ? maxe : 1e30f)); atomicMax(ctl + CK_BASE + 13, __float_as_uint(maxr));
    } else if (stage == 8) {
        const int r = hsh % M, d = (hsh >> 15) & 1023; float mg = 0.f;
        for (int n = 0; n < 3; ++n) { const bf16* O = (const bf16*)(ws + WS_AQ + (size_t)n * 32 * MiB) + (size_t)r * 512;
            mg += bf2f(((const bf16*)(ws + WS_GT))[(size_t)n * M * 1024 + (size_t)r * 1024 + d]) * ck_dot(O, 512, args.in[10] + ((size_t)layer * 3 + n) * 512 * 1024 + d, 1024); }
        ck_record(ctl, 8, bf2f(((const bf16*)(ws + WS_MERGED))[(size_t)r * 1024 + d]), mg);
    } else if (stage == 9) {
        const int r = hsh % M, c = (hsh >> 15) & 1023;
        const float ref = ALPHA * bf2f(HB[(size_t)r * 1024 + c]) + ck_dot((const bf16*)(ws + WS_MERGED) + (size_t)r * 1024, 1024, args.in[11] + (size_t)layer * 1024 * 1024 + c, 1024);
        ck_record(ctl, 9, args.out[(size_t)r * 1024 + c], ref);
    } else if (stage == 10 || stage == 13) {
        const int r = hsh % M; const float* g = args.in[stage == 10 ? 12 : 14] + layer * 1024; const float* bb = args.in[stage == 10 ? 13 : 15] + layer * 1024;
        float s = 0.f, s2 = 0.f, de = 0.f; for (int c = 0; c < 1024; ++c) { const float hv = args.out[(size_t)r * 1024 + c]; const float u = (hv - bb[c]) / g[c]; s += u; s2 += u * u; de = fmaxf(de, fabsf(hv - bf2f(HB[(size_t)r * 1024 + c]))); }
        const float mean = s / 1024.f, var = s2 / 1024.f - mean * mean;
        ck_record(ctl, stage, fabsf(mean) + fabsf(var - 1.0f) + de * 0.1f, 0.0f); atomicMax(ctl + CK_BASE + 2 * stage + 1, __float_as_uint(1.0f));
    } else if (stage == 11) {
        const int r = hsh % M, c = (hsh >> 15) % FF;
        const float g = ck_dot(HB + (size_t)r * 1024, 1024, args.in[16] + c, FF), u = ck_dot(HB + (size_t)r * 1024, 1024, args.in[17] + c, FF);
        ck_record(ctl, 11, bf2f(((const bf16*)(ws + WS_FACT))[(size_t)r * FF + c]), g / (1.f + expf(-g)) * u);
    } else if (stage == 12) {
        const int r = hsh % M, c = (hsh >> 15) & 1023;
        const float ref = ALPHA * bf2f(HB[(size_t)r * 1024 + c]) + ck_dot((const bf16*)(ws + WS_FACT) + (size_t)r * FF, FF, args.in[18] + c, 1024);
        ck_record(ctl, 12, args.out[(size_t)r * 1024 + c], ref);
    } else if (stage == 30) {
        const int rr = 3584 + (int)(hsh % 3072), k = (hsh >> 15) & 1023;
        const float mine = bf2f(((const bf16*)(ws + WS_WIN))[((size_t)layer * WIN_ROWS + rr) * 1024 + k]), ref = args.in[1][(size_t)layer * 1024 * IN_COLS + (size_t)k * IN_COLS + 3360 + rr - 3584];
        ck_record(ctl, 30, mine, ref); if (fabsf(mine - ref) > 0.01f * fabsf(ref) + 1e-4f) atomicAdd(ctl + CK_BASE + 101, 1u);
    } else if (stage == 7) {
        const int m = hsh % M, h = (hsh >> 15) & 7; const float* OFp = (const float*)(ws + WS_OF) + (size_t)m * 512 + h * 64; const float* OBp = (const float*)(ws + WS_OB) + (size_t)m * 512 + h * 64;
        float ss = 0.f; for (int d = 0; d < 64; ++d) { const float o = OFp[d] + OBp[d]; ss += o * o; }
        const int d = (hsh >> 18) & 63; const float z = ck_dot(HB + (size_t)m * 1024, 1024, args.in[1] + (size_t)layer * 1024 * IN_COLS + 2304 + h * 64 + d, IN_COLS);
        const float ref = (OFp[d] + OBp[d]) / sqrtf(ss / 64.f + RMS_EPS) * args.in[7][layer * 64 + d] * z / (1.f + expf(-z));
        ck_record(ctl, 7, bf2f(((const bf16*)(ws + WS_DZ))[(size_t)m * 512 + h * 64 + d]), ref);
    }
}
__global__ void check_verdict(Args args) {
    unsigned* ctl = (unsigned*)(args.ws + WS_CTL);
    float code = 3.0f;
#if defined(CK_VAL)
    code = 3.0f + 40.0f * __uint_as_float(ctl[2048 + CK_VAL]);
#elif defined(CK_WCNT)
    { unsigned cnt = ctl[CK_BASE + 101]; int lg = 0; while (cnt) { ++lg; cnt >>= 1; } code += (float)lg; }
#elif defined(CK_COUNT)
    { unsigned cnt = ctl[CK_BASE + 100]; if (cnt > 256) cnt = 256; int distinct = 0;
        for (unsigned i = 0; i < cnt; ++i) { const unsigned ci = ctl[1024 + 2 * i], ri = ctl[1025 + 2 * i];
            const unsigned key = CK_COUNT == 1 ? (ci >> 5) : (CK_COUNT == 2 ? (ri >> 8) : (CK_COUNT == 3 ? (ci & 31) : (ri & 255)));
            bool seen = false; for (unsigned j = 0; j < i; ++j) { const unsigned cj = ctl[1024 + 2 * j], rj = ctl[1025 + 2 * j];
                const unsigned kj = CK_COUNT == 1 ? (cj >> 5) : (CK_COUNT == 2 ? (rj >> 8) : (CK_COUNT == 3 ? (cj & 31) : (rj & 255))); if (kj == key) { seen = true; break; } }
            if (!seen) ++distinct; }
        code += (float)(distinct > 15 ? 15 : distinct); }
#else
#ifndef CK_LIST
#define CK_LIST {14, 15, 16, 3}
#endif
    const int lst[4] = CK_LIST;
    for (int i = 0; i < 4; ++i) { const float e = __uint_as_float(ctl[CK_BASE + 2 * lst[i]]), r = __uint_as_float(ctl[CK_BASE + 2 * lst[i] + 1]); if (r == 0.f || e > 0.04f * r) code += (float)(1 << i); }
#endif
    for (size_t i = (size_t)blockIdx.x * blockDim.x + threadIdx.x; i < (size_t)M * D; i += (size_t)gridDim.x * blockDim.x) args.out[i] = code;
}
#endif
extern "C" void kernel_launch(void* const* d_in, const int* in_sizes, int n_in, void* d_out, int out_size, void* d_ws, size_t ws_size, hipStream_t stream) {
    static int grid = 0;
    if (grid == 0) {
        if (n_in != 23 || out_size != M * D || ws_size < WS_END) { fprintf(stderr, "kernel_launch: unexpected problem (n_in %d, out %d, ws %zu < %zu); nothing launched\n", n_in, out_size, ws_size, (size_t)WS_END); grid = -1; return; }
        int dev = 0, cus = 0, per_cu = 0;
        if (hipGetDevice(&dev) != hipSuccess || hipDeviceGetAttribute(&cus, hipDeviceAttributeMultiprocessorCount, dev) != hipSuccess) { grid = -1; return; }
        if (hipFuncSetAttribute((const void*)fwd_kernel, hipFuncAttributeMaxDynamicSharedMemorySize, LDS_BYTES) != hipSuccess) { fprintf(stderr, "kernel_launch: hipFuncSetAttribute failed\n"); grid = -1; return; }
        if (hipOccupancyMaxActiveBlocksPerMultiprocessor(&per_cu, (const void*)fwd_kernel, NTHR, LDS_BYTES) != hipSuccess || per_cu < 1) { fprintf(stderr, "kernel_launch: occupancy query says %d\n", per_cu); }
        (void)hipGetLastError();
        if (cus != 256 || per_cu < 1) { fprintf(stderr, "kernel_launch: needs 256 CUs with one resident workgroup each (cus %d, per_cu %d)\n", cus, per_cu); grid = -1; return; }
        grid = 256;
    }
    if (grid < 0) return;
    (void)hipMemsetAsync((char*)d_ws + WS_CTL, 0, CTL_ZERO_BYTES, stream);
    Args a{};
    for (int i = 0; i < 23; ++i) a.in[i] = (const float*)d_in[i];
    a.out = (float*)d_out; a.ws = (unsigned char*)d_ws;
#if MK_PER_PHASE
    static const int phases[] = {0, 1, 2, 21, 3, 4, 5, 6, 7, 8, 9, 41, 42, 61, 43, 44, 45, 46, 47, 48, 49, 50, 51, 52, 53, 54, 55, 56};
    for (int p : phases) { a.ph_lo = p; a.ph_hi = p + 1; hipLaunchKernelGGL(fwd_kernel, dim3(grid), dim3(NTHR), LDS_BYTES, stream, a);
#if defined(DBG_CHECK)
        const int L = DBG_CHECK - 1, pb = 1 + 40 * L;
        if (p == pb + 0) { hipLaunchKernelGGL(check_kernel, dim3(64), dim3(256), 0, stream, a, 1, L); hipLaunchKernelGGL(check_kernel, dim3(64), dim3(256), 0, stream, a, 2, L); }
        if (p == pb + 1) { hipLaunchKernelGGL(check_kernel, dim3(512), dim3(256), 0, stream, a, 4, L); hipLaunchKernelGGL(check_kernel, dim3(64), dim3(256), 0, stream, a, 5, L); hipLaunchKernelGGL(check_kernel, dim3(16), dim3(64), 0, stream, a, 6, L); }
        if (p == pb + 20) hipLaunchKernelGGL(check_kernel, dim3(64), dim3(256), 0, stream, a, 7, L);
        if (p == pb + 2) { hipLaunchKernelGGL(check_kernel, dim3(64), dim3(256), 0, stream, a, 3, L); hipLaunchKernelGGL(check_kernel, dim3(256), dim3(256), 0, stream, a, 30, L); }
        if (p == pb + 3) hipLaunchKernelGGL(check_kernel, dim3(64), dim3(256), 0, stream, a, 8, L);
        if (p == pb + 4) hipLaunchKernelGGL(check_kernel, dim3(64), dim3(256), 0, stream, a, 9, L);
        if (p == pb + 5) hipLaunchKernelGGL(check_kernel, dim3(16), dim3(256), 0, stream, a, 10, L);
        if (L == 0 && p == pb + 6) hipLaunchKernelGGL(check_kernel, dim3(64), dim3(256), 0, stream, a, 11, L);
        if (L == 0 && p == pb + 7) hipLaunchKernelGGL(check_kernel, dim3(64), dim3(256), 0, stream, a, 12, L);
        if (L == 0 && p == pb + 8) hipLaunchKernelGGL(check_kernel, dim3(16), dim3(256), 0, stream, a, 13, L);
#endif
    }
#if defined(DBG_CHECK)
    hipLaunchKernelGGL(check_verdict, dim3(1024), dim3(256), 0, stream, a);
#endif
#else
    a.ph_lo = 0; a.ph_hi = 1000;
    hipLaunchKernelGGL(fwd_kernel, dim3(grid), dim3(NTHR), LDS_BYTES, stream, a);
#endif
}
```

```cpp
#include <hip/hip_runtime.h>
#include <cstdio>
#include <cstdint>

#define GAS __attribute__((address_space(1)))
#define LAS __attribute__((address_space(3)))
typedef unsigned short bf16;
typedef unsigned v4u __attribute__((ext_vector_type(4)));
typedef unsigned v2u __attribute__((ext_vector_type(2)));
typedef float f32x2 __attribute__((ext_vector_type(2)));
typedef float f32x4 __attribute__((ext_vector_type(4)));
typedef float f32x16 __attribute__((ext_vector_type(16)));
typedef short bf16x8 __attribute__((ext_vector_type(8)));
typedef short bf16x4 __attribute__((ext_vector_type(4)));

#ifndef ABL
#define ABL 0
#endif
#ifndef LN_FUSE
#define LN_FUSE 3
#endif
#ifndef MK_PER_PHASE
#define MK_PER_PHASE 0
#endif

#ifndef WGM_K
#define WGM_K 8
#endif
namespace pg8 {
#define PG8_LAS __attribute__((address_space(3)))
typedef unsigned short bf16_t;
typedef unsigned u32x4 __attribute__((ext_vector_type(4)));
constexpr int BM = 256, BK = 64, HALF = 128, HTB = HALF * BK * 2  , STAGE_BYTES = 8 * HTB, NXCD = 8, WGM = WGM_K;

__host__ __device__ __forceinline__ int lds_byte(int r, int c) { const int st = (r >> 4) * 2 + (c >> 5), rr = r & 15, cc = c & 31, ob = rr * 64 + cc * 2; return st * 1024 + (ob ^ (((ob >> 9) & 1) << 5)); }
__host__ __device__ __forceinline__ void stage_rc(int b, int& R, int& C) { const int st = b / 1024, sb = b % 1024, swz = sb ^ (((sb >> 9) & 1) << 5); R = (st >> 1) * 16 + swz / 64; C = (st & 1) * 32 + (swz % 64) / 2; }
__host__ __device__ __forceinline__ int perm32(int rho) { const int n = rho >> 4, i = rho & 15; return 8 * (i >> 2) + 4 * n + (i & 3); }

struct Unit { int pm, pn, aux; };

struct StaticOrder {
    int nM, nN, nwg, G, c;
    __host__ __device__ __forceinline__ void init(int nM_, int nN_, int G_, int c_) { nM = nM_; nN = nN_; nwg = nM * nN; G = G_; c = c_; }
    __host__ __device__ __forceinline__ bool map(long L, int& pm, int& pn) const {
        if (L >= nwg) return false;
        int wgid = (int)L; { const int q = nwg / NXCD, r = nwg % NXCD, xcd = wgid % NXCD, off = wgid / NXCD; wgid = (xcd < r ? xcd * (q + 1) : r * (q + 1) + (xcd - r) * q) + off; }
        const int nig = WGM * nN, gid = wgid / nig, fm = gid * WGM, gsz = (nM - fm) < WGM ? (nM - fm) : WGM;
        pm = fm + ((wgid % nig) % gsz); pn = (wgid % nig) / gsz; return true;
    }
};
struct StdSched {
    StaticOrder o; const char* A; const char* Bt; size_t tstep;
    __device__ __forceinline__ void init(const void* A_, const void* Bt_, int M, int N, int K, int G, int c) { o.init(M / BM, N / BM, G, c); A = (const char*)A_; Bt = (const char*)Bt_; tstep = (size_t)BM * K * 2; }
    __device__ __forceinline__ bool next(int i, Unit& u) const { u.aux = 0; return o.map((long)i * o.G + o.c, u.pm, u.pn); }
    __device__ __forceinline__ const char* abase(const Unit& u) const { return A + (size_t)u.pm * tstep; }
    __device__ __forceinline__ const char* bbase(const Unit& u) const { return Bt + (size_t)u.pn * tstep; }
};

typedef __bf16 bf16x2_t __attribute__((ext_vector_type(2)));
__device__ __forceinline__ unsigned cvt_pk_bf16(float lo, float hi) { const f32x2 v = {lo, hi}; const bf16x2_t b = __builtin_convertvector(v, bf16x2_t); return __builtin_bit_cast(unsigned, b); }

typedef f32x4 acc_t[2][2][4][2];
__device__ __forceinline__ void zero_acc(acc_t& acc) {
    float z = 0.f; asm volatile("" : "+v"(z));
#pragma unroll
    for (int a = 0; a < 2; ++a)
#pragma unroll
        for (int b = 0; b < 2; ++b)
#pragma unroll
            for (int m = 0; m < 4; ++m)
#pragma unroll
                for (int n = 0; n < 2; ++n) acc[a][b][m][n] = (f32x4){z, z, z, z};
}

typedef int v8i_t __attribute__((ext_vector_type(8)));
typedef int v4i_t __attribute__((ext_vector_type(4)));
__device__ __forceinline__ f32x4 mfma_fp8(const bf16x8& b0, const bf16x8& b1, const bf16x8& a0, const bf16x8& a1, const f32x4& c) {
    const v4i_t x0 = __builtin_bit_cast(v4i_t, b0), x1 = __builtin_bit_cast(v4i_t, b1), y0 = __builtin_bit_cast(v4i_t, a0), y1 = __builtin_bit_cast(v4i_t, a1);
    const v8i_t X = __builtin_shufflevector(x0, x1, 0, 1, 2, 3, 4, 5, 6, 7), Y = __builtin_shufflevector(y0, y1, 0, 1, 2, 3, 4, 5, 6, 7);
    return __builtin_amdgcn_mfma_scale_f32_16x16x128_f8f6f4(X, Y, c, 0, 0, 0, 0x7f7f7f7f, 0, 0x7f7f7f7f);
}
template <class Epi, class Sched, bool ALIGN_EPI = false, bool SP2 = false, bool FP8 = false>
__device__ __forceinline__ void gemm_phase(PG8_LAS unsigned char* lds, const int K, const Sched& S, const Epi& E, const int wid_in) {
    int lane = (int)__builtin_amdgcn_mbcnt_hi(~0u, __builtin_amdgcn_mbcnt_lo(~0u, 0u)); asm volatile("" : "+v"(lane));
    const int wid = wid_in, tid = wid * 64 + lane, wr = wid >> 2, wc = wid & 3, fr = lane & 15, fq = lane >> 4;
    const int nt = K / BK;
    unsigned voffA[2], voffB[2];
#pragma unroll
    for (int i = 0; i < 2; ++i) { int R, C; stage_rc(tid * 16 + i * 8192, R, C); const int Rb = Epi::PERM ? ((R & ~31) + perm32(R & 31)) : R;
        voffA[i] = (unsigned)(R * K + C) * 2u; voffB[i] = (unsigned)(Rb * K + C) * 2u; }
    const size_t kstep = (size_t)(BK * 2);
    const size_t hstep = (size_t)HALF * K * 2;
    const unsigned ldsw = (unsigned)wid * 1024u;
    const int aoff = lds_byte(wr * 64 + fr, fq * 8), boff = lds_byte(wc * 32 + fr, fq * 8);
#define PG8_SA(b, h) (((b) * 2 + (h)) * HTB)
#define PG8_SB(b, h) ((4 + (b) * 2 + (h)) * HTB)
#define PG8_STAGE(bufoff, gbase, voff) do { _Pragma("unroll") for (int _i = 0; _i < 2; ++_i) \
        __builtin_amdgcn_global_load_lds((const unsigned*)((const char*)(gbase) + (voff)[_i]), (PG8_LAS unsigned*)(lds + (bufoff) + ldsw + _i * 8192), 16, 0, 0); } while (0)
#define PG8_LDA(dst, b, h) do { if constexpr (FP8) { _Pragma("unroll") for (int m = 0; m < 4; ++m) { const v4i_t lo_ = *(const PG8_LAS v4i_t*)(lds + PG8_SA(b, h) + aoff + m * 2048), hi_ = *(const PG8_LAS v4i_t*)(lds + PG8_SA(b, h) + aoff + m * 2048 + 1024); \
            dst##8[m] = __builtin_shufflevector(lo_, hi_, 0, 1, 2, 3, 4, 5, 6, 7); } } \
        else { _Pragma("unroll") for (int m = 0; m < 4; ++m) _Pragma("unroll") for (int k = 0; k < 2; ++k) dst[m][k] = *(const PG8_LAS bf16x8*)(lds + PG8_SA(b, h) + aoff + m * 2048 + k * 1024); } } while (0)
#define PG8_LDB(dst, b, h) do { if constexpr (FP8) { _Pragma("unroll") for (int n = 0; n < 2; ++n) { const v4i_t lo_ = *(const PG8_LAS v4i_t*)(lds + PG8_SB(b, h) + boff + n * 2048), hi_ = *(const PG8_LAS v4i_t*)(lds + PG8_SB(b, h) + boff + n * 2048 + 1024); \
            dst##8[n] = __builtin_shufflevector(lo_, hi_, 0, 1, 2, 3, 4, 5, 6, 7); } } \
        else { _Pragma("unroll") for (int n = 0; n < 2; ++n) _Pragma("unroll") for (int k = 0; k < 2; ++k) dst[n][k] = *(const PG8_LAS bf16x8*)(lds + PG8_SB(b, h) + boff + n * 2048 + k * 1024); } } while (0)
#define PG8_MMA(ai, bj, At, Bt) do { __builtin_amdgcn_s_setprio(1); _Pragma("unroll") for (int m = 0; m < 4; ++m) _Pragma("unroll") for (int n = 0; n < 2; ++n) { \
        if constexpr (FP8) asm volatile("v_mfma_scale_f32_16x16x128_f8f6f4 %0, %1, %2, %0, %3, %3 op_sel_hi:[0,0,0]" : "+v"(acc[ai][bj][m][n]) : "v"(Bt##8[n]), "v"(At##8[m]), "v"(sc127));   \
        else { _Pragma("unroll") for (int k = 0; k < 2; ++k) acc[ai][bj][m][n] = __builtin_amdgcn_mfma_f32_16x16x32_bf16(Bt[n][k], At[m][k], acc[ai][bj][m][n], 0, 0, 0); } } \
        __builtin_amdgcn_s_setprio(0); } while (0)
#define PG8_WAIT_V(n) asm volatile("s_waitcnt vmcnt(" #n ")" ::: "memory")
#define PG8_WAIT_L(n) asm volatile("s_waitcnt lgkmcnt(" #n ")" ::: "memory")
#define PG8_BAR __builtin_amdgcn_s_barrier()
#define PG8_SCHED __builtin_amdgcn_sched_barrier(0)
    Unit cur, nxt; int ui = 0;
    if (!S.next(0, cur)) return;
    acc_t acc; zero_acc(acc);
    bf16x8 At[4][2], B0[2][2], B1[2][2];
    v8i_t At8[4], B08[2], B18[2];
    int sc127 = 0x7f7f7f7f; asm volatile("" : "+v"(sc127));
    const char* cA = S.abase(cur); const char* cB = S.bbase(cur);
    if constexpr (SP2) {
        PG8_STAGE(PG8_SB(0, 0), cB, voffB); PG8_STAGE(PG8_SB(0, 1), cB + hstep, voffB); PG8_STAGE(PG8_SA(0, 0), cA, voffA); PG8_STAGE(PG8_SA(0, 1), cA + hstep, voffA);
        if (wr == 1) PG8_BAR;
        PG8_WAIT_V(2); PG8_BAR;
        PG8_STAGE(PG8_SB(1, 0), cB + kstep, voffB); PG8_STAGE(PG8_SA(1, 0), cA + kstep, voffA); PG8_STAGE(PG8_SB(1, 1), cB + hstep + kstep, voffB);
        PG8_WAIT_V(6); PG8_BAR;
    } else {
        PG8_STAGE(PG8_SB(0, 0), cB, voffB); PG8_STAGE(PG8_SA(0, 0), cA, voffA); PG8_STAGE(PG8_SB(0, 1), cB + hstep, voffB); PG8_STAGE(PG8_SA(0, 1), cA + hstep, voffA);
        if (wr == 1) PG8_BAR;
        PG8_WAIT_V(4); PG8_BAR;
        PG8_STAGE(PG8_SB(1, 0), cB + kstep, voffB); PG8_STAGE(PG8_SA(1, 0), cA + kstep, voffA); PG8_STAGE(PG8_SB(1, 1), cB + hstep + kstep, voffB);
        PG8_WAIT_V(6); PG8_BAR;
    }
    for (;;) {
        const bool has_next = S.next(ui + 1, nxt);
        const char* nA = has_next ? S.abase(nxt) : cA; const char* nB = has_next ? S.bbase(nxt) : cB;
#pragma nounroll
        for (int t = 0; t < nt; t += 2) {
            const bool last = (t == nt - 2);
            const char* a1 = cA + (size_t)(t + 1) * kstep;
            const char* a2 = last ? nA : cA + (size_t)(t + 2) * kstep; const char* b2 = last ? nB : cB + (size_t)(t + 2) * kstep;
            const char* a3 = a2 + kstep; const char* b3 = b2 + kstep;
            if constexpr (SP2) {
            PG8_LDB(B0, 0, 0); PG8_LDB(B1, 0, 1); PG8_SCHED; PG8_LDA(At, 0, 0); PG8_STAGE(PG8_SA(1, 1), a1 + hstep, voffA);
            PG8_WAIT_V(8); PG8_WAIT_L(0); PG8_BAR; PG8_MMA(0, 0, At, B0); PG8_MMA(0, 1, At, B1); PG8_BAR; PG8_SCHED;
            PG8_LDA(At, 0, 1); PG8_STAGE(PG8_SB(0, 0), b2, voffB); PG8_STAGE(PG8_SB(0, 1), b2 + hstep, voffB); PG8_STAGE(PG8_SA(0, 0), a2, voffA);
            PG8_WAIT_V(8); PG8_WAIT_L(0); PG8_BAR; PG8_MMA(1, 0, At, B0); PG8_MMA(1, 1, At, B1); PG8_BAR; PG8_SCHED;
            PG8_LDB(B0, 1, 0); PG8_LDB(B1, 1, 1); PG8_SCHED; PG8_LDA(At, 1, 0); PG8_STAGE(PG8_SA(0, 1), a2 + hstep, voffA);
            PG8_WAIT_V(8); PG8_WAIT_L(0); PG8_BAR; PG8_MMA(0, 0, At, B0); PG8_MMA(0, 1, At, B1); PG8_BAR; PG8_SCHED;
            PG8_LDA(At, 1, 1); PG8_STAGE(PG8_SB(1, 0), b3, voffB); PG8_STAGE(PG8_SB(1, 1), b3 + hstep, voffB); PG8_STAGE(PG8_SA(1, 0), a3, voffA);
            PG8_WAIT_V(8); PG8_WAIT_L(0); PG8_BAR; PG8_MMA(1, 0, At, B0); PG8_MMA(1, 1, At, B1); PG8_BAR; PG8_SCHED;
            } else {
            PG8_LDB(B0, 0, 0); PG8_SCHED; PG8_LDA(At, 0, 0); PG8_STAGE(PG8_SA(1, 1), a1 + hstep, voffA);
            PG8_WAIT_L(8); PG8_BAR; PG8_WAIT_L(0); PG8_MMA(0, 0, At, B0); PG8_BAR; PG8_SCHED;
            PG8_LDB(B1, 0, 1); PG8_STAGE(PG8_SB(0, 0), b2, voffB);
            PG8_BAR; PG8_WAIT_L(0); PG8_MMA(0, 1, At, B1); PG8_BAR;
            PG8_LDA(At, 0, 1); PG8_STAGE(PG8_SA(0, 0), a2, voffA);
            PG8_BAR; PG8_WAIT_L(0); PG8_MMA(1, 0, At, B0); PG8_BAR; PG8_SCHED;
            PG8_STAGE(PG8_SB(0, 1), b2 + hstep, voffB);
            PG8_WAIT_V(6); PG8_BAR; PG8_MMA(1, 1, At, B1); PG8_BAR;
            PG8_LDB(B0, 1, 0); PG8_SCHED; PG8_LDA(At, 1, 0); PG8_STAGE(PG8_SA(0, 1), a2 + hstep, voffA);
            PG8_WAIT_L(8); PG8_BAR; PG8_WAIT_L(0); PG8_MMA(0, 0, At, B0); PG8_BAR; PG8_SCHED;
            PG8_LDB(B1, 1, 1); PG8_STAGE(PG8_SB(1, 0), b3, voffB);
            PG8_BAR; PG8_WAIT_L(0); PG8_MMA(0, 1, At, B1); PG8_BAR;
            PG8_LDA(At, 1, 1); PG8_STAGE(PG8_SA(1, 0), a3, voffA);
            PG8_BAR; PG8_WAIT_L(0); PG8_MMA(1, 0, At, B0); PG8_BAR; PG8_SCHED;
            PG8_STAGE(PG8_SB(1, 1), b3 + hstep, voffB);
            PG8_WAIT_V(6); PG8_BAR; PG8_MMA(1, 1, At, B1); PG8_BAR;
            }
        }
        if constexpr (ALIGN_EPI) { if (wr == 0) PG8_BAR; }
        if constexpr (FP8) asm volatile("s_nop 15\n\ts_nop 15" ::: "memory");
        E(acc, cur, wr, wc, fr, fq);
        if (!has_next) break;
        cur = nxt; cA = nA; cB = nB; ++ui;
        if constexpr (ALIGN_EPI) { if (wr == 1) PG8_BAR; }
    }
    PG8_WAIT_V(0);
    if constexpr (!ALIGN_EPI) { if (wr == 0) PG8_BAR; }
    PG8_BAR;
#undef PG8_SA
#undef PG8_SB
#undef PG8_STAGE
#undef PG8_LDA
#undef PG8_LDB
#undef PG8_MMA
#undef PG8_WAIT_V
#undef PG8_WAIT_L
#undef PG8_BAR
#undef PG8_SCHED
}
}

#ifndef GATES_FP8
#define GATES_FP8 1
#endif
#ifndef FFN_FP8
#define FFN_FP8 3
#endif
#ifndef MOE_FP8
#define MOE_FP8 1
#endif
constexpr int NWAVES = 8, NTHR = 512;
constexpr int BATCH = 16, SEQ = 2048, D = 1024, M = BATCH * SEQ;
constexpr int IN_COLS = 6432;
constexpr int NA = 3584;
constexpr int NG = 3072;
constexpr int WIN_ROWS = NA + NG;
constexpr int FF = 2816, FFE = 3584, NE = 8;
constexpr int NCH = 2, CHT = 256 / NCH, CH_TOK = M / NCH, CH_ROWS = (CHT + 8) * 256;
static_assert(MOE_FP8 || NCH == 4, "bf16 MoE buffers are sized for 4 chunks");
constexpr float LN_EPS = 1e-5f, RMS_EPS = 1e-6f;
constexpr float ALPHA = 1.4142135623730951f;

constexpr size_t MiB = 1u << 20;
constexpr size_t WS_CTL = 0, CTL_ZERO_BYTES = 1 * MiB;
constexpr size_t WS_HB = 1 * MiB;
constexpr size_t WS_META = 65 * MiB;
constexpr size_t WS_WIN = 67 * MiB;
constexpr size_t WS_WBR = 93 * MiB;
constexpr size_t WS_WOUT = 99 * MiB;
constexpr size_t WS_W13 = 103 * MiB;
constexpr size_t WS_W2 = 114 * MiB;
constexpr size_t WS_POOLW = 120 * MiB;
constexpr size_t WS_LNSTAT = 120 * MiB;
constexpr size_t WS_BIG = 121 * MiB;
constexpr size_t WS_AQ = WS_BIG + 0 * MiB;
constexpr size_t WS_DZ = WS_BIG + 32 * MiB;
constexpr size_t WS_OP = WS_BIG + 64 * MiB;
constexpr size_t WS_AK = WS_BIG + 96 * MiB;
constexpr size_t WS_AV = WS_BIG + 104 * MiB;
constexpr size_t WS_DAB = WS_BIG + 112 * MiB;
constexpr size_t WS_PU = WS_BIG + 128 * MiB;
constexpr size_t WS_DQKV = WS_BIG + 160 * MiB;
constexpr size_t WS_OF = WS_BIG + 256 * MiB;
constexpr size_t WS_OB = WS_BIG + 320 * MiB;
constexpr size_t WS_GT = WS_BIG + 160 * MiB;
constexpr size_t WS_MERGED = WS_BIG + 352 * MiB;
constexpr size_t WS_FACT = WS_BIG + 0 * MiB;
constexpr size_t WS_HBG8 = WS_BIG + 384 * MiB;
constexpr size_t WS_HB8 = WS_BIG + 200 * MiB;
constexpr size_t WS_END_L = WS_BIG + 416 * MiB;
constexpr size_t WS_MWGU = 67 * MiB;
constexpr size_t WS_MWD = 179 * MiB;
constexpr size_t WS_XG = 235 * MiB;
constexpr size_t WS_MACT = 271 * MiB;
constexpr size_t WS_YS = 397 * MiB;
constexpr size_t WS_END = 537 * MiB;
static_assert(WS_YS + (size_t)M * 2 * 1024 * 2 <= WS_END && WS_END_L <= WS_END, "ws map");
static_assert(WS_MACT + (size_t)CH_ROWS * FFE * (MOE_FP8 ? 1 : 2) <= WS_YS && WS_XG + (size_t)CH_ROWS * 1024 * (MOE_FP8 ? 1 : 2) <= WS_MACT, "ws map");
constexpr size_t MT_TOKE = 0;
constexpr size_t MT_TOKP = 256 * 1024;
constexpr size_t MT_RANK = 512 * 1024;
constexpr size_t MT_DEFER = 640 * 1024;
constexpr size_t MT_CNT = 768 * 1024;
constexpr size_t MT_ROWMAP = 1024 * 1024;
constexpr int CW_BAR = 4096;
constexpr int CW_LNX = 16384;
constexpr int LNX_LDS_OFF = 131072;

constexpr int RING_OFF = 0, RING_BYTES = 147456;
constexpr int LDSCTL_OFF = RING_BYTES, MISC_OFF = LDSCTL_OFF + 320;
constexpr int MOE_LDS_OFF = LDSCTL_OFF + 1024;
constexpr int LDS_BYTES = 163840;

#define RLX_AGENT __ATOMIC_RELAXED, __HIP_MEMORY_SCOPE_AGENT
#define LDS_WAIT() asm volatile("s_waitcnt lgkmcnt(0)" ::: "memory")
#define VM_WAIT() asm volatile("s_waitcnt vmcnt(0)" ::: "memory")
__device__ __forceinline__ unsigned f2bf(float f) { unsigned u = __builtin_bit_cast(unsigned, f); return (u + 0x7fffu + ((u >> 16) & 1u)) >> 16; }
__device__ __forceinline__ unsigned pk2(float lo, float hi) { return f2bf(lo) | (f2bf(hi) << 16); }
__device__ __forceinline__ float bf2f(unsigned short b) { return __builtin_bit_cast(float, ((unsigned)b) << 16); }
__device__ __forceinline__ float bflo(unsigned w) { return __builtin_bit_cast(float, w << 16); }
__device__ __forceinline__ float bfhi(unsigned w) { return __builtin_bit_cast(float, w & 0xffff0000u); }
__device__ __forceinline__ v4u ld_or_zero(const bf16* p, const bf16* safe, bool ok) { const v4u v = *(const v4u*)(ok ? p : safe); const unsigned mk = ok ? 0xffffffffu : 0u; return (v4u){v.x & mk, v.y & mk, v.z & mk, v.w & mk}; }
__device__ __forceinline__ float sigmoidf_(float x) { return __builtin_amdgcn_rcpf(1.0f + __expf(-x)); }
__device__ __forceinline__ float siluf_(float x) { return x * sigmoidf_(x); }

#define XB_TMO      128
#define XB_XCNT(j)  (256  + 64 * (j))
#define XB_XSUB(j)  (1280 + 64 * (j))
#define XB_XGEN(j)  (2304 + 64 * (j))
#define XB_TOP      3328
#define XB_TOPGEN   3392
#define XCD_BAR_WORDS 3456
#define XB_SPIN_CAP (1u << 22)
#ifndef XB_RELAY
#define XB_RELAY 0
#endif

__device__ __forceinline__ unsigned xb_ld(unsigned* p)              { return __hip_atomic_load(p, __ATOMIC_RELAXED, __HIP_MEMORY_SCOPE_AGENT); }
__device__ __forceinline__ unsigned xb_add(unsigned* p, unsigned v) { return __hip_atomic_fetch_add(p, v, __ATOMIC_RELAXED, __HIP_MEMORY_SCOPE_AGENT); }
__device__ __forceinline__ unsigned xb_xcc_id() { return (unsigned)__builtin_amdgcn_s_getreg((3 << 11) | 20) & 0xFu; }
#define XB_SPIN(cond, bar) do { unsigned _sp = 0; while (cond) { __builtin_amdgcn_s_sleep(1); \
    if ((++_sp & 255u) == 0u) { if (xb_ld(&(bar)[XB_TMO])) break; if (_sp > XB_SPIN_CAP) { atomicAdd(&(bar)[XB_TMO], 1u); break; } } } } while (0)

struct XcdBarrier {
    unsigned* bar; unsigned x; unsigned w0;
    volatile LAS unsigned* st;
};
__device__ __forceinline__ XcdBarrier xcd_barrier_post(unsigned* bar, volatile LAS unsigned* st) {
    XcdBarrier b; b.bar = bar; b.x = xb_xcc_id(); b.st = st; b.w0 = (__builtin_amdgcn_readfirstlane(threadIdx.x >> 6) == 0) ? 1u : 0u;
    if (threadIdx.x == 0) (void)xb_add(&bar[XB_XCNT(b.x)], 1u);
    return b;
}
__device__ __forceinline__ void xcd_barrier_complete(unsigned* bar, unsigned x, unsigned& nloc, unsigned& nx) {
    const unsigned G = gridDim.x * gridDim.y * gridDim.z;
    unsigned sum, cnt, mine, sp = 0u;
    for (;;) {
        sum = 0u; cnt = 0u; mine = 0u;
#pragma unroll
        for (unsigned j = 0; j < 16; ++j) { const unsigned c = xb_ld(&bar[XB_XCNT(j)]); sum += c; cnt += (c > 0u) ? 1u : 0u; mine = (j == x) ? c : mine; }
        if (sum == G) break;
        __builtin_amdgcn_s_sleep(1);
        if ((++sp & 255u) == 0u) { if (xb_ld(&bar[XB_TMO])) break; if (sp > XB_SPIN_CAP) { atomicAdd(&bar[XB_TMO], 1u); break; } }
    }
    nloc = mine > 0u ? mine : 1u; nx = cnt > 0u ? cnt : 1u;
}
__device__ __forceinline__ void xcd_barrier(const XcdBarrier& b) {
    asm volatile("s_waitcnt vmcnt(0)" ::: "memory");
    __syncthreads();
    if (b.w0 && __builtin_amdgcn_mbcnt_hi(~0u, __builtin_amdgcn_mbcnt_lo(~0u, 0u)) == 0u) {
        unsigned* bar = b.bar;
        __builtin_amdgcn_s_waitcnt(0);
        unsigned nloc = b.st[0], nx = b.st[1];
        if (nloc == 0u) { xcd_barrier_complete(bar, b.x, nloc, nx); b.st[0] = nloc; b.st[1] = nx; }
        const unsigned old = xb_add(&bar[XB_XSUB(b.x)], 1u);
        const unsigned gen = old / nloc;
#if XB_RELAY
        if (old + 1u == (gen + 1u) * nloc) {
            __builtin_amdgcn_fence(__ATOMIC_RELEASE, "agent");
            asm volatile("s_waitcnt vmcnt(0)" ::: "memory");
            const unsigned og = xb_add(&bar[XB_TOP], 1u);
            const unsigned tg = og / nx;
            if (og + 1u == (tg + 1u) * nx) xb_add(&bar[XB_TOPGEN], 1u);
            else XB_SPIN(xb_ld(&bar[XB_TOPGEN]) == tg, bar);
            __builtin_amdgcn_fence(__ATOMIC_ACQUIRE, "agent");
#if XB_RELAY
            xb_add(&bar[XB_XGEN(b.x)], 1u);
            asm volatile("s_waitcnt vmcnt(0)" ::: "memory");
#endif
        } else {
#if XB_RELAY
            XB_SPIN(xb_ld(&bar[XB_XGEN(b.x)]) == gen, bar);
#else
            XB_SPIN(xb_ld(&bar[XB_TOPGEN]) == gen, bar);
#endif
            __builtin_amdgcn_fence(__ATOMIC_ACQUIRE, "agent");
            asm volatile("s_waitcnt vmcnt(0)" ::: "memory");
        }
#else
        if (old + 1u == (gen + 1u) * nloc) {
            __builtin_amdgcn_fence(__ATOMIC_RELEASE, "agent");
            asm volatile("s_waitcnt vmcnt(0)" ::: "memory");
            (void)xb_add(&bar[XB_TOP], 1u);
        }
        { const unsigned want = nx * (gen + 1u); XB_SPIN(xb_ld(&bar[XB_TOP]) < want, bar); }
        __builtin_amdgcn_fence(__ATOMIC_ACQUIRE, "agent");
        asm volatile("s_waitcnt vmcnt(0)" ::: "memory");
#endif
    }
    __syncthreads();
}

struct Args { const float* in[23]; float* out; unsigned char* ws; int ph_lo, ph_hi; };
struct Frame {
    unsigned char* lds;
    int tid, lane, wave;
    int G, bx;
    unsigned char* ws;
    float* out;
    const Args* a;
};
#define IN_x(F)          ((F).a->in[0])
#define IN_w_in(F)       ((F).a->in[1])
#define IN_attn_sink(F)  ((F).a->in[2])
#define IN_rel_bias(F)   ((F).a->in[3])
#define IN_conv_w(F)     ((F).a->in[4])
#define IN_a_log(F)      ((F).a->in[5])
#define IN_dt_bias(F)    ((F).a->in[6])
#define IN_dn_norm_w(F)  ((F).a->in[7])
#define IN_pool_w(F)     ((F).a->in[8])
#define IN_pool_scale(F) ((F).a->in[9])
#define IN_w_branch(F)   ((F).a->in[10])
#define IN_w_out(F)      ((F).a->in[11])
#define IN_ln1_g(F)      ((F).a->in[12])
#define IN_ln1_b(F)      ((F).a->in[13])
#define IN_ln2_g(F)      ((F).a->in[14])
#define IN_ln2_b(F)      ((F).a->in[15])
#define IN_ffn_w1(F)     ((F).a->in[16])
#define IN_ffn_w3(F)     ((F).a->in[17])
#define IN_ffn_w2(F)     ((F).a->in[18])
#define IN_router_w(F)   ((F).a->in[19])
#define IN_moe_wg(F)     ((F).a->in[20])
#define IN_moe_wu(F)     ((F).a->in[21])
#define IN_moe_wd(F)     ((F).a->in[22])
__device__ __forceinline__ float wave_sum(float v) {
#pragma unroll
    for (int o = 1; o < 64; o <<= 1) v += __shfl_xor(v, o);
    return v;
}
template <int CTRL> __device__ __forceinline__ float dppf(float x) { return __builtin_bit_cast(float, __builtin_amdgcn_mov_dpp(__builtin_bit_cast(int, x), CTRL, 0xF, 0xF, true)); }
__device__ __forceinline__ float red4(float x) { x += dppf<0xB1>(x); x += dppf<0x4E>(x); return x; }
__device__ __forceinline__ float red8(float x) { x = red4(x); x += dppf<0x141>(x); return x; }
__device__ __forceinline__ float red16(float x) { x = red8(x); x += dppf<0x140>(x); return x; }

__device__ __forceinline__ float q8(float x) { const int p = __builtin_amdgcn_cvt_pk_fp8_f32(x, x, 0, false); return __builtin_amdgcn_cvt_f32_fp8(p, 0); }
#ifndef FP8_EMU
#define FP8_EMU 0
#endif
__device__ __forceinline__ unsigned pk4_fp8(float a, float b, float c, float d) { int w = __builtin_amdgcn_cvt_pk_fp8_f32(a, b, 0, false); w = __builtin_amdgcn_cvt_pk_fp8_f32(c, d, w, true); return (unsigned)w; }
template <bool Q8 = false>
__device__ __forceinline__ void tr_item(const float* W, int ldw, int k0, int n0, bf16* WT, int ldt, int drow0, float* scr, int lane) {
    f32x4 ld[8];
#pragma unroll
    for (int i = 0; i < 8; ++i) ld[i] = __builtin_nontemporal_load((const f32x4*)(W + (size_t)(k0 + 8 * i + (lane >> 3)) * ldw + n0 + 4 * (lane & 7)));
#pragma unroll
    for (int i = 0; i < 8; ++i) { float* d = scr + (8 * i + (lane >> 3)) * 33 + 4 * (lane & 7); d[0] = ld[i][0]; d[1] = ld[i][1]; d[2] = ld[i][2]; d[3] = ld[i][3]; }
    LDS_WAIT(); asm volatile("" ::: "memory");
    const int c = lane & 7;
#pragma unroll
    for (int j = 0; j < 4; ++j) { const int n = (lane >> 3) + 8 * j; const float* s = scr + (8 * c) * 33 + n;
        v4u o;
        if (Q8) { o.x = pk2(q8(32.f * s[0 * 33]), q8(32.f * s[1 * 33])); o.y = pk2(q8(32.f * s[2 * 33]), q8(32.f * s[3 * 33])); o.z = pk2(q8(32.f * s[4 * 33]), q8(32.f * s[5 * 33])); o.w = pk2(q8(32.f * s[6 * 33]), q8(32.f * s[7 * 33])); }
        else { o.x = pk2(s[0 * 33], s[1 * 33]); o.y = pk2(s[2 * 33], s[3 * 33]); o.z = pk2(s[4 * 33], s[5 * 33]); o.w = pk2(s[6 * 33], s[7 * 33]); }
        *(v4u*)(WT + (size_t)(drow0 + n) * ldt + k0 + 8 * c) = o; }
    LDS_WAIT(); asm volatile("" ::: "memory");
}

__device__ __forceinline__ void tr_item_fp8(const float* W, int ldw, int k0, int n0, unsigned char* WT8, int ldt, int drow0, float* scr, int lane) {
    f32x4 ld[8];
#pragma unroll
    for (int i = 0; i < 8; ++i) ld[i] = __builtin_nontemporal_load((const f32x4*)(W + (size_t)(k0 + 8 * i + (lane >> 3)) * ldw + n0 + 4 * (lane & 7)));
#pragma unroll
    for (int i = 0; i < 8; ++i) { float* d = scr + (8 * i + (lane >> 3)) * 33 + 4 * (lane & 7); d[0] = ld[i][0]; d[1] = ld[i][1]; d[2] = ld[i][2]; d[3] = ld[i][3]; }
    LDS_WAIT(); asm volatile("" ::: "memory");
    const int c = lane & 7;
#pragma unroll
    for (int j = 0; j < 4; ++j) { const int n = (lane >> 3) + 8 * j; const float* s = scr + (8 * c) * 33 + n;
        v2u o; o.x = pk4_fp8(32.f * s[0 * 33], 32.f * s[1 * 33], 32.f * s[2 * 33], 32.f * s[3 * 33]); o.y = pk4_fp8(32.f * s[4 * 33], 32.f * s[5 * 33], 32.f * s[6 * 33], 32.f * s[7 * 33]);
        *(v2u*)(WT8 + (size_t)(drow0 + n) * ldt + k0 + 8 * c) = o; }
    LDS_WAIT(); asm volatile("" ::: "memory");
}

struct TrItem { const float* W; int ldw, k0, n0; unsigned char* dst; int ldt, drow, kind; };
__device__ __forceinline__ void tr_load(f32x4 (&ld)[8], const TrItem& t, int lane) {
    if (t.kind == 0) return;
#pragma unroll
    for (int i = 0; i < 8; ++i) ld[i] = __builtin_nontemporal_load((const f32x4*)(t.W + (size_t)(t.k0 + 8 * i + (lane >> 3)) * t.ldw + t.n0 + 4 * (lane & 7)));
}
__device__ __forceinline__ void tr_store(const f32x4 (&ld)[8], const TrItem& t, float* scr, int lane) {
    if (t.kind == 0) return;
#pragma unroll
    for (int i = 0; i < 8; ++i) { float* d = scr + (8 * i + (lane >> 3)) * 33 + 4 * (lane & 7); d[0] = ld[i][0]; d[1] = ld[i][1]; d[2] = ld[i][2]; d[3] = ld[i][3]; }
    LDS_WAIT(); asm volatile("" ::: "memory");
    const int c = lane & 7;
    if (t.kind == 2) {
#pragma unroll
        for (int j = 0; j < 4; ++j) { const int n = (lane >> 3) + 8 * j; const float* s = scr + (8 * c) * 33 + n;
            v2u o; o.x = pk4_fp8(32.f * s[0 * 33], 32.f * s[1 * 33], 32.f * s[2 * 33], 32.f * s[3 * 33]); o.y = pk4_fp8(32.f * s[4 * 33], 32.f * s[5 * 33], 32.f * s[6 * 33], 32.f * s[7 * 33]);
            *(v2u*)(t.dst + (size_t)(t.drow + n) * t.ldt + t.k0 + 8 * c) = o; }
    } else {
#pragma unroll
        for (int j = 0; j < 4; ++j) { const int n = (lane >> 3) + 8 * j; const float* s = scr + (8 * c) * 33 + n;
            v4u o; o.x = pk2(s[0 * 33], s[1 * 33]); o.y = pk2(s[2 * 33], s[3 * 33]); o.z = pk2(s[4 * 33], s[5 * 33]); o.w = pk2(s[6 * 33], s[7 * 33]);
            *(v4u*)((bf16*)t.dst + (size_t)(t.drow + n) * t.ldt + t.k0 + 8 * c) = o; }
    }
    LDS_WAIT(); asm volatile("" ::: "memory");
}
#define TR_PIPELINE(FIRST, COUNT, STRIDE, DEC, scr, lane) do { f32x4 la_[8], lb_[8]; TrItem ta_, tb_; int it_ = (FIRST); \
        if (it_ < (COUNT)) { DEC(it_, ta_); tr_load(la_, ta_, lane); } \
        while (it_ < (COUNT)) { \
            int nx_ = it_ + (STRIDE); if (nx_ < (COUNT)) { DEC(nx_, tb_); tr_load(lb_, tb_, lane); } \
            tr_store(la_, ta_, scr, lane); it_ = nx_; if (it_ >= (COUNT)) break; \
            nx_ = it_ + (STRIDE); if (nx_ < (COUNT)) { DEC(nx_, ta_); tr_load(la_, ta_, lane); } \
            tr_store(lb_, tb_, scr, lane); it_ = nx_; } } while (0)

__device__ __forceinline__ void p0_prologue(Frame& F) {
    float* scr = (float*)(F.lds + F.wave * 16384);
    const int gw = F.bx * NWAVES + F.wave, NGW = F.G * NWAVES;
    constexpr int I_WIN = 16 * 201, I_WBR = 8 * 32, I_WOUT = 16 * 32, I_W1 = 16 * 88, I_W2 = 44 * 32, I_PW = 2 * 4;
    constexpr int NITEMS = 2 * I_WIN + 6 * I_WBR + 2 * I_WOUT + 2 * I_W1 + I_W2 + 8 * I_PW;
    bf16* WIN = (bf16*)(F.ws + WS_WIN); bf16* WBR = (bf16*)(F.ws + WS_WBR); bf16* WOUT = (bf16*)(F.ws + WS_WOUT);
    bf16* W13 = (bf16*)(F.ws + WS_W13); bf16* W2 = (bf16*)(F.ws + WS_W2); bf16* PW = (bf16*)(F.ws + WS_POOLW);
#define P0_DEC(it, t) do { int r = (it); t.kind = 0; \
        if (r < 2 * I_WIN) { const int l = r / I_WIN, q = r % I_WIN, kb = q / 201, n0 = (q % 201) * 32; \
            const int drow = n0 < 2816 ? n0 : (n0 < 2848 ? 3328 + (n0 - 2816) : (n0 < 3360 ? n0 - 32 : 3584 + (n0 - 3360))); \
            t.W = IN_w_in(F) + (size_t)l * 1024 * IN_COLS; t.ldw = IN_COLS; t.k0 = kb * 64; t.n0 = n0; t.ldt = 1024; \
            if (GATES_FP8 && n0 >= 3360) { t.dst = (unsigned char*)(WIN + (size_t)l * WIN_ROWS * 1024 + (size_t)NA * 1024); t.drow = n0 - 3360; t.kind = 2; } \
            else { t.dst = (unsigned char*)(WIN + (size_t)l * WIN_ROWS * 1024); t.drow = drow; t.kind = 1; } } \
        else if ((r -= 2 * I_WIN) < 6 * I_WBR) { const int ln = r / I_WBR, q = r % I_WBR, kb = q / 32, n0 = (q % 32) * 32;        \
            if (ln % 3 != 2) { t.W = IN_w_branch(F) + (size_t)ln * 512 * 1024; t.ldw = 1024; t.k0 = kb * 64; t.n0 = n0; t.dst = (unsigned char*)(WBR + (size_t)ln * 1024 * 512); t.ldt = 512; t.drow = n0; t.kind = 1; } } \
        else if ((r -= 6 * I_WBR) < 2 * I_WOUT) { const int l = r / I_WOUT, q = r % I_WOUT, kb = q / 32, n0 = (q % 32) * 32; \
            t.W = IN_w_out(F) + (size_t)l * 1024 * 1024; t.ldw = 1024; t.k0 = kb * 64; t.n0 = n0; t.dst = (unsigned char*)(WOUT + (size_t)l * 1024 * 1024); t.ldt = 1024; t.drow = n0; t.kind = 1; } \
        else if ((r -= 2 * I_WOUT) < 2 * I_W1) { const int w = r / I_W1, q = r % I_W1, kb = q / 88, n0 = (q % 88) * 32; \
            t.W = w ? IN_ffn_w3(F) : IN_ffn_w1(F); t.ldw = FF; t.k0 = kb * 64; t.n0 = n0; t.dst = (unsigned char*)W13; t.ldt = 1024; t.drow = (n0 >> 7) * 256 + (n0 & 127) + w * 128; t.kind = (FFN_FP8 == 1 || FFN_FP8 == 2) ? 2 : 1; } \
        else if ((r -= 2 * I_W1) < I_W2) { const int kb = r / 32, n0 = (r % 32) * 32; \
            t.W = IN_ffn_w2(F); t.ldw = 1024; t.k0 = kb * 64; t.n0 = n0; t.dst = (unsigned char*)W2; t.ldt = FF; t.drow = n0; t.kind = (FFN_FP8 == 1 || FFN_FP8 == 3) ? 2 : 1; } } while (0)
    (void)PW;
    TR_PIPELINE(gw, NITEMS, NGW, P0_DEC, scr, F.lane);
#undef P0_DEC
    for (int it = gw; it < 2 * 64 * 16; it += NGW) { const int l = it >> 10, cg = (it >> 4) & 63, db = it & 15, g = cg >> 4, c0 = (cg & 15) * 8, d = db * 64 + F.lane;
        const float* pw = IN_pool_w(F) + (((size_t)l * 4 + g) * 128 + c0) * 128; const float* ps = IN_pool_scale(F) + l * 512 + g * 128;
        const float* wb = IN_w_branch(F) + (((size_t)l * 3 + 2) * 512 + g * 128) * 1024 + d;
        float acc[8];
#pragma unroll
        for (int j = 0; j < 8; ++j) acc[j] = 0.f;
#pragma unroll 4
        for (int k = 0; k < 128; ++k) { const float sv = ps[k] * wb[(size_t)k * 1024];
#pragma unroll
            for (int j = 0; j < 8; ++j) acc[j] += pw[j * 128 + k] * sv; }
        v4u o; o.x = pk2(acc[0], acc[1]); o.y = pk2(acc[2], acc[3]); o.z = pk2(acc[4], acc[5]); o.w = pk2(acc[6], acc[7]);
        *(v4u*)(WBR + (((size_t)l * 3 + 2) * 1024 + d) * 512 + g * 128 + c0) = o; }
    bf16* HB = (bf16*)(F.ws + WS_HB);
    const size_t gt = (size_t)F.bx * NTHR + F.tid, NT = (size_t)F.G * NTHR;
    const f32x4* xp = (const f32x4*)IN_x(F);
    for (size_t i0 = gt; i0 < (size_t)M * D / 8; i0 += 4 * NT) {
        f32x4 a[4], b[4];
#pragma unroll
        for (int u = 0; u < 4; ++u) { const size_t i = i0 + u * NT; a[u] = __builtin_nontemporal_load(xp + 2 * i); b[u] = __builtin_nontemporal_load(xp + 2 * i + 1); }
#pragma unroll
        for (int u = 0; u < 4; ++u) { const size_t i = i0 + u * NT; v4u o; o.x = pk2(a[u].x, a[u].y); o.y = pk2(a[u].z, a[u].w); o.z = pk2(b[u].x, b[u].y); o.w = pk2(b[u].z, b[u].w); ((v4u*)HB)[i] = o;
            if (GATES_FP8) { v2u o8; o8.x = pk4_fp8(a[u].x, a[u].y, a[u].z, a[u].w); o8.y = pk4_fp8(b[u].x, b[u].y, b[u].z, b[u].w); ((v2u*)(F.ws + WS_HBG8))[i] = o8; } }
    }
}
__device__ __forceinline__ void moe_weight_convert(Frame& F) {
    float* scr = (float*)(F.lds + F.wave * 16384);
    const int gw = F.bx * NWAVES + F.wave, NGW = F.G * NWAVES;
    constexpr int I_GU = 16 * 112, I_D = 56 * 32;
    constexpr int NITEMS = NE * (2 * I_GU + I_D);
    bf16* MWGU = (bf16*)(F.ws + WS_MWGU); bf16* MWD = (bf16*)(F.ws + WS_MWD);
#if MOE_FP8
#define MOE_DEC(it, t) do { int r = (it); \
        if (r < NE * 2 * I_GU) { const int e = r / (2 * I_GU), q2 = r % (2 * I_GU), w = q2 / I_GU, q = q2 % I_GU, kb = q / 112, n0 = (q % 112) * 32; \
            t.W = (w ? IN_moe_wu(F) : IN_moe_wg(F)) + (size_t)e * 1024 * FFE; t.ldw = FFE; t.k0 = kb * 64; t.n0 = n0; t.dst = (unsigned char*)MWGU; t.ldt = 1024; t.drow = e * 2 * FFE + (n0 >> 7) * 256 + (n0 & 127) + w * 128; t.kind = 2; } \
        else { r -= NE * 2 * I_GU; const int e = r / I_D, q = r % I_D, kb = q / 32, n0 = (q % 32) * 32; \
            t.W = IN_moe_wd(F) + (size_t)e * FFE * 1024; t.ldw = 1024; t.k0 = kb * 64; t.n0 = n0; t.dst = (unsigned char*)MWD + (size_t)e * 1024 * FFE; t.ldt = FFE; t.drow = n0; t.kind = 2; } } while (0)
    TR_PIPELINE(gw, NITEMS, NGW, MOE_DEC, scr, F.lane);
#undef MOE_DEC
#else
    for (int it = gw; it < NITEMS; it += NGW) {
        int r = it;
        if (r < NE * 2 * I_GU) { const int e = r / (2 * I_GU), q2 = r % (2 * I_GU), w = q2 / I_GU, q = q2 % I_GU, kb = q / 112, n0 = (q % 112) * 32;
            const int drow = e * 2 * FFE + (n0 >> 7) * 256 + (n0 & 127) + w * 128;
            tr_item<FP8_EMU != 0>((w ? IN_moe_wu(F) : IN_moe_wg(F)) + (size_t)e * 1024 * FFE, FFE, kb * 64, n0, MWGU, 1024, drow, scr, F.lane);
            continue; }
        r -= NE * 2 * I_GU;
        { const int e = r / I_D, q = r % I_D, kb = q / 32, n0 = (q % 32) * 32;
            tr_item<FP8_EMU != 0>(IN_moe_wd(F) + (size_t)e * FFE * 1024, 1024, kb * 64, n0, MWD + (size_t)e * 1024 * FFE, FFE, n0, scr, F.lane); }
    }
#endif
}

using pg8::acc_t; using pg8::Unit; using pg8::cvt_pk_bf16; using pg8::zero_acc;
__device__ __forceinline__ v4u pack8(const f32x4& v0, const f32x4& v1) { v4u w; w.x = cvt_pk_bf16(v0[0], v0[1]); w.y = cvt_pk_bf16(v0[2], v0[3]); w.z = cvt_pk_bf16(v1[0], v1[1]); w.w = cvt_pk_bf16(v1[2], v1[3]); return w; }

struct EpiInA {
    static constexpr bool PERM = true;
    unsigned char* ws;
    __device__ __forceinline__ void operator()(acc_t& acc, const Unit& u, int wr, int wc, int fr, int fq) const {
        const int pn = u.pn; const size_t row0 = (size_t)u.pm * 256 + wr * 64 + fr;
        if (pn == 13) {
            if (wc == 0) { float* dab = (float*)(ws + WS_DAB);
#pragma unroll
                for (int ai = 0; ai < 2; ++ai)
#pragma unroll
                    for (int m = 0; m < 4; ++m) { float* p = dab + (row0 + ai * 128 + m * 16) * 32 + 8 * fq; *(f32x4*)p = acc[ai][0][m][0]; *(f32x4*)(p + 4) = acc[ai][0][m][1]; } }
        } else {
            bf16* b0; bf16* b1; int ldc;
            if (pn < 2) { ldc = 512; b0 = (bf16*)(ws + WS_AQ) + pn * 256; b1 = b0 + 128; }
            else if (pn == 2) { ldc = 128; b0 = (bf16*)(ws + WS_AK); b1 = (bf16*)(ws + WS_AV); }
            else if (pn < 9) { ldc = 1536; b0 = (bf16*)(ws + WS_DQKV) + (pn - 3) * 256; b1 = b0 + 128; }
            else if (pn < 11) { ldc = 512; b0 = (bf16*)(ws + WS_DZ) + (pn - 9) * 256; b1 = b0 + 128; }
            else { ldc = 512; b0 = (bf16*)(ws + WS_PU) + (pn - 11) * 256; b1 = b0 + 128; }
            const int cl = wc * 32 + 8 * fq;
#pragma unroll
            for (int ai = 0; ai < 2; ++ai)
#pragma unroll
                for (int m = 0; m < 4; ++m) { const size_t ro = (row0 + ai * 128 + m * 16) * ldc + cl;
                    *(v4u*)(b0 + ro) = pack8(acc[ai][0][m][0], acc[ai][0][m][1]);
                    *(v4u*)(b1 + ro) = pack8(acc[ai][1][m][0], acc[ai][1][m][1]); }
        }
        zero_acc(acc);
    }
};
struct EpiGates {
    static constexpr bool PERM = true;
    bf16* GT; float asc;
    __device__ __forceinline__ void operator()(acc_t& acc, const Unit& u, int wr, int wc, int fr, int fq) const {
        const size_t row0 = (size_t)u.pm * 256 + wr * 64 + fr;
        bf16* base = GT + (size_t)(u.pn >> 2) * M * 1024 + (u.pn & 3) * 256 + wc * 32 + 8 * fq;
#pragma unroll
        for (int ai = 0; ai < 2; ++ai)
#pragma unroll
            for (int m = 0; m < 4; ++m)
#pragma unroll
                for (int bj = 0; bj < 2; ++bj) { f32x4 v0 = acc[ai][bj][m][0], v1 = acc[ai][bj][m][1];
#pragma unroll
                    for (int j = 0; j < 4; ++j) { v0[j] = sigmoidf_(v0[j] * asc); v1[j] = sigmoidf_(v1[j] * asc); }
                    *(v4u*)(base + (row0 + ai * 128 + m * 16) * 1024 + bj * 128) = pack8(v0, v1); }
        zero_acc(acc);
    }
};
struct BrSched {
    pg8::StaticOrder o; const char *A0, *B0; size_t tstep;
    __device__ __forceinline__ bool next(int i, Unit& u) const { const int t = i / 3; u.aux = i - 3 * t; return o.map((long)t * o.G + o.c, u.pm, u.pn); }
    __device__ __forceinline__ const char* abase(const Unit& u) const { return A0 + (size_t)u.aux * (32 * MiB) + (size_t)u.pm * tstep; }
    __device__ __forceinline__ const char* bbase(const Unit& u) const { return B0 + (size_t)u.aux * (1024 * 512 * 2) + (size_t)u.pn * tstep; }
};
__device__ __forceinline__ void unpack8(const v4u& w, f32x4& a, f32x4& b) { a[0] = bflo(w.x); a[1] = bfhi(w.x); a[2] = bflo(w.y); a[3] = bfhi(w.y); b[0] = bflo(w.z); b[1] = bfhi(w.z); b[2] = bflo(w.w); b[3] = bfhi(w.w); }
#ifndef GNT
#define GNT 1
#endif
struct EpiBranch {
    static constexpr bool PERM = true;
    const bf16* GT; bf16* MG;
    __device__ __forceinline__ void operator()(acc_t& acc, const Unit& u, int wr, int wc, int fr, int fq) const {
        const unsigned eoff = ((unsigned)u.pm * 256u + (unsigned)(wr * 64 + fr)) * 1024u + (unsigned)(u.pn * 256 + wc * 32 + 8 * fq); const int seg = u.aux;
        const char* gn = (const char*)(GT + (size_t)seg * M * 1024);
        const char* gd = (const char*)(GT + (size_t)(seg < 2 ? seg + 1 : 2) * M * 1024);
#pragma unroll
        for (int ai = 0; ai < 2; ++ai)
#pragma unroll
          for (int mh = 0; mh < 2; ++mh) {
            v4u nb[4], db[4];
#pragma unroll
            for (int mm = 0; mm < 2; ++mm)
#pragma unroll
                for (int bj = 0; bj < 2; ++bj) { const int m = 2 * mh + mm; const size_t off = (size_t)((eoff + (unsigned)((ai * 128 + m * 16) * 1024 + bj * 128)) * 2u);
                    nb[mm * 2 + bj] = GNT ? __builtin_nontemporal_load((const v4u*)(gn + off)) : *(const v4u*)(gn + off);
                    if (seg < 2) db[mm * 2 + bj] = *(const v4u*)(gd + off); }
            __builtin_amdgcn_sched_barrier(0);
#pragma unroll
            for (int mm = 0; mm < 2; ++mm)
#pragma unroll
                for (int bj = 0; bj < 2; ++bj) { const int m = 2 * mh + mm; const size_t off = (size_t)((eoff + (unsigned)((ai * 128 + m * 16) * 1024 + bj * 128)) * 2u);
                    f32x4 n0, n1; unpack8(nb[mm * 2 + bj], n0, n1);
                    if (seg < 2) { f32x4 d0, d1; unpack8(db[mm * 2 + bj], d0, d1);
#pragma unroll
                        for (int j = 0; j < 4; ++j) { n0[j] *= __builtin_amdgcn_rcpf(fmaxf(d0[j], 1e-30f)); n1[j] *= __builtin_amdgcn_rcpf(fmaxf(d1[j], 1e-30f)); } }
                    acc[ai][bj][m][0] *= n0; acc[ai][bj][m][1] *= n1;
                    if (seg == 2) *(v4u*)((char*)MG + off) = pack8(acc[ai][bj][m][0], acc[ai][bj][m][1]); }
            __builtin_amdgcn_sched_barrier(0);
          }
        if (seg == 2) zero_acc(acc);
    }
};
struct EpiBranchRMW {
    static constexpr bool PERM = true;
    const bf16* GT; bf16* MG;
    __device__ __forceinline__ void operator()(acc_t& acc, const Unit& u, int wr, int wc, int fr, int fq) const {
        const size_t row0 = (size_t)u.pm * 256 + wr * 64 + fr; const int col = u.pn * 256 + wc * 32 + 8 * fq; const int seg = u.aux;
        const bf16* gn = GT + (size_t)seg * M * 1024;
#pragma unroll
        for (int ai = 0; ai < 2; ++ai)
#pragma unroll
            for (int m = 0; m < 4; ++m)
#pragma unroll
                for (int bj = 0; bj < 2; ++bj) { const size_t off = (row0 + ai * 128 + m * 16) * 1024 + col + bj * 128;
                    f32x4 n0, n1; unpack8(*(const v4u*)(gn + off), n0, n1);
                    f32x4 r0 = acc[ai][bj][m][0] * n0, r1 = acc[ai][bj][m][1] * n1;
                    if (seg > 0) { f32x4 p0, p1; unpack8(*(const v4u*)(MG + off), p0, p1); r0 += p0; r1 += p1; }
                    *(v4u*)(MG + off) = pack8(r0, r1); }
        zero_acc(acc);
    }
};
struct EpiResid {
    static constexpr bool PERM = true;
    bf16* HBp; float ys;
    __device__ __forceinline__ void operator()(acc_t& acc, const Unit& u, int wr, int wc, int fr, int fq) const {
        const size_t row0 = (size_t)u.pm * 256 + wr * 64 + fr; const int col0 = u.pn * 256 + wc * 32 + 8 * fq;
#pragma unroll
        for (int ai = 0; ai < 2; ++ai)
#pragma unroll
            for (int m = 0; m < 4; ++m) { bf16* rp = HBp + (row0 + ai * 128 + m * 16) * 1024 + col0;
#pragma unroll
                for (int bj = 0; bj < 2; ++bj) { f32x4 h0, h1; unpack8(*(const v4u*)(rp + bj * 128), h0, h1);
                    *(v4u*)(rp + bj * 128) = pack8(h0 * ALPHA + acc[ai][bj][m][0] * ys, h1 * ALPHA + acc[ai][bj][m][1] * ys); } }
        zero_acc(acc);
    }
};
template <int use, bool g8, int LNI  >
struct EpiResidLN {
    static constexpr bool PERM = true;
    unsigned char* ws; const Args* a; LAS unsigned char* ldsl; float ys;
    __device__ __forceinline__ void operator()(acc_t& acc, const Unit& u, int wr, int wc, int fr_in, int fq_in) const {
        int fr = fr_in, fq = fq_in; asm volatile("" : "+v"(fr), "+v"(fq));
        const int tid = (wr * 4 + wc) * 64 + fq * 16 + fr;
        LAS float* part = (LAS float*)(ldsl + LNX_LDS_OFF); LAS float* mr = part + 2048;
        const int rloc = wr * 64 + fr; const int col0 = u.pn * 256 + wc * 32 + 8 * fq;
        const unsigned eoff = ((unsigned)u.pm * 256u + (unsigned)rloc) * 1024u + (unsigned)col0;
        const char* hb = (const char*)(ws + WS_HB);
#pragma unroll
        for (int ai = 0; ai < 2; ++ai) {
            v4u rb[8];
#pragma unroll
            for (int m = 0; m < 4; ++m)
#pragma unroll
                for (int bj = 0; bj < 2; ++bj) rb[m * 2 + bj] = *(const v4u*)(hb + (size_t)((eoff + (unsigned)(ai * 128 + m * 16) * 1024u) * 2u + bj * 256u));
            __builtin_amdgcn_sched_barrier(0);
#pragma unroll
            for (int m = 0; m < 4; ++m) { float a = 0.f, q = 0.f;
#pragma unroll
                for (int bj = 0; bj < 2; ++bj) { f32x4 h0, h1; unpack8(rb[m * 2 + bj], h0, h1);
                    const f32x4 z0 = h0 * ALPHA + acc[ai][bj][m][0] * ys, z1 = h1 * ALPHA + acc[ai][bj][m][1] * ys; acc[ai][bj][m][0] = z0; acc[ai][bj][m][1] = z1;
                    a += ((z0[0] + z0[1]) + (z0[2] + z0[3])) + ((z1[0] + z1[1]) + (z1[2] + z1[3]));
                    q += ((z0[0] * z0[0] + z0[1] * z0[1]) + (z0[2] * z0[2] + z0[3] * z0[3])) + ((z1[0] * z1[0] + z1[1] * z1[1]) + (z1[2] * z1[2] + z1[3] * z1[3])); }
                a += __shfl_xor(a, 16); a += __shfl_xor(a, 32); q += __shfl_xor(q, 16); q += __shfl_xor(q, 32);
                if (fq == 0) { LAS float* d = part + (wc * 256 + rloc + ai * 128 + m * 16) * 2; d[0] = a; d[1] = q; } }
            __builtin_amdgcn_sched_barrier(0);
        }
        __syncthreads();
        float S1 = 0.f, S2 = 0.f;
        float* stat = (float*)(ws + WS_LNSTAT) + (size_t)u.pm * 4 * 512;
        if (tid < 256) {
#pragma unroll
            for (int w = 0; w < 4; ++w) { S1 += part[(w * 256 + tid) * 2]; S2 += part[(w * 256 + tid) * 2 + 1]; }
            __hip_atomic_store(stat + (u.pn * 256 + tid) * 2, S1, RLX_AGENT); __hip_atomic_store(stat + (u.pn * 256 + tid) * 2 + 1, S2, RLX_AGENT); }
        asm volatile("s_waitcnt vmcnt(0)" ::: "memory");
        __syncthreads();
        if (tid == 0) { unsigned* flag = (unsigned*)(ws + WS_CTL) + CW_LNX + use * 128 + u.pm;
            (void)__hip_atomic_fetch_add(flag, 1u, RLX_AGENT);
            unsigned sp = 0u; while (__hip_atomic_load(flag, RLX_AGENT) < 4u && ++sp < (1u << 20)) __builtin_amdgcn_s_sleep(1); }
        __syncthreads();
        if (tid < 256) {
#pragma unroll
            for (int p = 1; p < 4; ++p) { const int pn2 = (u.pn + p) & 3; S1 += __hip_atomic_load(stat + (pn2 * 256 + tid) * 2, RLX_AGENT); S2 += __hip_atomic_load(stat + (pn2 * 256 + tid) * 2 + 1, RLX_AGENT); }
            const float mean = S1 * (1.0f / 1024.0f), var = S2 * (1.0f / 1024.0f) - mean * mean;
            mr[tid * 2] = mean; mr[tid * 2 + 1] = __builtin_amdgcn_rsqf((var > 0.f ? var : 0.f) + LN_EPS); }
        __syncthreads();
        asm volatile("" : "+v"(fr), "+v"(fq));
        const int rloc2 = wr * 64 + fr; const int col2 = u.pn * 256 + wc * 32 + 8 * fq;
        const unsigned eoff2 = ((unsigned)u.pm * 256u + (unsigned)rloc2) * 1024u + (unsigned)col2;
        char* hbw = (char*)(ws + WS_HB); unsigned char* h8 = ws + WS_HBG8; const float* gam = a->in[12 + 2 * LNI]; const float* bet = a->in[13 + 2 * LNI];
#pragma unroll
        for (int bj = 0; bj < 2; ++bj) {
            const f32x4 g0 = *(const f32x4*)(gam + col2 + bj * 128), g1 = *(const f32x4*)(gam + col2 + bj * 128 + 4), b0 = *(const f32x4*)(bet + col2 + bj * 128), b1 = *(const f32x4*)(bet + col2 + bj * 128 + 4);
#pragma unroll
            for (int ai = 0; ai < 2; ++ai)
#pragma unroll
                for (int m = 0; m < 4; ++m) { const int rl = rloc2 + ai * 128 + m * 16; const float mean = mr[rl * 2], rstd = mr[rl * 2 + 1];
                    const unsigned eo = eoff2 + (unsigned)(ai * 128 + m * 16) * 1024u + bj * 128u;
                    const f32x4 v0 = (acc[ai][bj][m][0] - mean) * rstd * g0 + b0, v1 = (acc[ai][bj][m][1] - mean) * rstd * g1 + b1;
                    *(v4u*)(hbw + (size_t)(eo * 2u)) = pack8(v0, v1);
                    if (g8) { v2u o; o.x = pk4_fp8(v0[0], v0[1], v0[2], v0[3]); o.y = pk4_fp8(v1[0], v1[1], v1[2], v1[3]); *(v2u*)(h8 + (size_t)eo) = o; } } }
        zero_acc(acc);
    }
};
struct EpiSwiglu {
    static constexpr bool PERM = true;
    bf16* ACT; int ldc; float asc; int q;
    __device__ __forceinline__ void operator()(acc_t& acc, const Unit& u, int wr, int wc, int fr, int fq) const {
        const size_t row0 = (size_t)u.pm * 256 + wr * 64 + fr; const int col = u.aux * 128 + wc * 32 + 8 * fq;
#pragma unroll
        for (int ai = 0; ai < 2; ++ai)
#pragma unroll
            for (int m = 0; m < 4; ++m) { f32x4 v0, v1;
#pragma unroll
                for (int j = 0; j < 4; ++j) { v0[j] = siluf_(acc[ai][0][m][0][j] * asc) * (acc[ai][1][m][0][j] * asc); v1[j] = siluf_(acc[ai][0][m][1][j] * asc) * (acc[ai][1][m][1][j] * asc); if (q) { v0[j] = q8(v0[j]); v1[j] = q8(v1[j]); } }
                *(v4u*)(ACT + (row0 + ai * 128 + m * 16) * ldc + col) = pack8(v0, v1); }
        zero_acc(acc);
    }
};
struct EpiSwiglu8 {
    static constexpr bool PERM = true;
    unsigned char* ACT; int ldc; float asc;
    __device__ __forceinline__ void operator()(acc_t& acc, const Unit& u, int wr, int wc, int fr, int fq) const {
        const size_t row0 = (size_t)u.pm * 256 + wr * 64 + fr; const int col = u.aux * 128 + wc * 32 + 8 * fq;
#pragma unroll
        for (int ai = 0; ai < 2; ++ai)
#pragma unroll
            for (int m = 0; m < 4; ++m) { float v[8];
#pragma unroll
                for (int j = 0; j < 4; ++j) { v[j] = siluf_(acc[ai][0][m][0][j] * asc) * (acc[ai][1][m][0][j] * asc); v[4 + j] = siluf_(acc[ai][0][m][1][j] * asc) * (acc[ai][1][m][1][j] * asc); }
                v2u o; o.x = pk4_fp8(v[0], v[1], v[2], v[3]); o.y = pk4_fp8(v[4], v[5], v[6], v[7]);
                *(v2u*)(ACT + (row0 + ai * 128 + m * 16) * ldc + col) = o;
                __builtin_amdgcn_sched_barrier(0); }
        zero_acc(acc);
    }
};
struct FfnUpSched {
    pg8::StaticOrder o; const char* A; const char* Bt; size_t tstep;
    __device__ __forceinline__ bool next(int i, Unit& u) const { const bool ok = o.map((long)i * o.G + o.c, u.pm, u.pn); u.aux = u.pn; return ok; }
    __device__ __forceinline__ const char* abase(const Unit& u) const { return A + (size_t)u.pm * tstep; }
    __device__ __forceinline__ const char* bbase(const Unit& u) const { return Bt + (size_t)u.pn * tstep; }
};

constexpr int DN_RAW_OFF = 0;
constexpr int DN_XS_OFF = 26624;
constexpr int DN_OB_OFF = DN_XS_OFF + 49152;
constexpr int DN_AB_OFF = DN_OB_OFF + 16384;
constexpr int DN_CW_OFF = DN_AB_OFF + 512;
static_assert(DN_CW_OFF + 3840 <= RING_BYTES, "delta LDS");
__device__ __forceinline__ void delta_seq(Frame& F, int layer, int seq) {
    const int dir = seq >> 7, b = (seq >> 3) & 15, h = seq & 7;
    bf16* raw = (bf16*)(F.lds + DN_RAW_OFF); float* xs = (float*)(F.lds + DN_XS_OFF); float* ob = (float*)(F.lds + DN_OB_OFF);
    float* ab = (float*)(F.lds + DN_AB_OFF); float* cw = (float*)(F.lds + DN_CW_OFF);
    const bf16* DQKV = (const bf16*)(F.ws + WS_DQKV); const float* DAB = (const float*)(F.ws + WS_DAB);
    float* OUT = (float*)(F.ws + (dir ? WS_OB : WS_OF));
    const int tid = F.tid, lane = F.lane, wave = F.wave, p = lane & 7, j = wave * 8 + (lane >> 3);
    __syncthreads();
    for (int i = tid; i < 5 * 192; i += NTHR) { const int jj = i / 192, ch = i % 192; cw[i] = IN_conv_w(F)[((size_t)layer * 5 + jj) * 1536 + (ch >> 6) * 512 + h * 64 + (ch & 63)]; }
    const float nA = -__expf(IN_a_log(F)[layer * 16 + dir * 8 + h]), dtb = IN_dt_bias(F)[layer * 16 + dir * 8 + h];
    float S[8];
#pragma unroll
    for (int i = 0; i < 8; ++i) S[i] = 0.f;
    for (int blk = 0; blk < SEQ / 64; ++blk) {
        const int tb = dir ? (SEQ / 64 - 1 - blk) : blk, t0 = tb * 64;
        __syncthreads();
        for (int idx = tid; idx < 68 * 24; idx += NTHR) { const int r = idx / 24, pc = idx % 24, sec = pc >> 3, c8 = pc & 7, t = t0 - 2 + r;
            const v4u v = ld_or_zero(DQKV + ((size_t)b * SEQ + t) * 1536 + sec * 512 + h * 64 + c8 * 8, DQKV, t >= 0 && t < SEQ);
            *(v4u*)(raw + r * 192 + sec * 64 + c8 * 8) = v; }
        if (tid < 64) { const size_t m = (size_t)b * SEQ + t0 + tid; const float a = DAB[m * 32 + dir * 8 + h], bq = DAB[m * 32 + 16 + dir * 8 + h];
            const float xx = a + dtb; const float sp = xx > 20.f ? xx : log1pf(__expf(xx));
            ab[tid * 2] = __expf(nA * sp); ab[tid * 2 + 1] = sigmoidf_(bq); }
        __syncthreads();
        for (int idx = tid; idx < 64 * 192; idx += NTHR) { const int tt = idx / 192, ch = idx % 192; float x = 0.f;
#pragma unroll
            for (int jj = 0; jj < 5; ++jj) x += cw[jj * 192 + ch] * bf2f(raw[(tt + jj) * 192 + ch]);
            xs[idx] = siluf_(x); }
        __syncthreads();
        { const int row = tid >> 2, part = tid & 3, tt = row >> 1, sec = row & 1; float* xp = xs + tt * 192 + sec * 64 + part * 16; float ss = 0.f; float v[16];
#pragma unroll
            for (int i = 0; i < 16; ++i) { v[i] = xp[i]; ss += v[i] * v[i]; }
            ss = red4(ss);
            const float sc = __builtin_amdgcn_rsqf(ss + 1e-6f) * (sec == 0 ? 0.125f : 1.0f);
#pragma unroll
            for (int i = 0; i < 16; ++i) xp[i] = v[i] * sc; }
        __syncthreads();
        for (int s = 0; s < 64; ++s) {
            const int tt = dir ? 63 - s : s; const float* xr = xs + tt * 192;
            const f32x4 q0 = *(const f32x4*)(xr + 8 * p), q1 = *(const f32x4*)(xr + 8 * p + 4);
            const f32x4 k0 = *(const f32x4*)(xr + 64 + 8 * p), k1 = *(const f32x4*)(xr + 64 + 8 * p + 4);
            const float v = xr[128 + j], al = ab[tt * 2], be = ab[tt * 2 + 1];
            float part = (S[0] * k0[0] + S[1] * k0[1]) + (S[2] * k0[2] + S[3] * k0[3]) + (S[4] * k1[0] + S[5] * k1[1]) + (S[6] * k1[2] + S[7] * k1[3]);
            part = red8(part);
            const float c = be * (v - al * part);
            S[0] = al * S[0] + k0[0] * c; S[1] = al * S[1] + k0[1] * c; S[2] = al * S[2] + k0[2] * c; S[3] = al * S[3] + k0[3] * c;
            S[4] = al * S[4] + k1[0] * c; S[5] = al * S[5] + k1[1] * c; S[6] = al * S[6] + k1[2] * c; S[7] = al * S[7] + k1[3] * c;
            float op = (S[0] * q0[0] + S[1] * q0[1]) + (S[2] * q0[2] + S[3] * q0[3]) + (S[4] * q1[0] + S[5] * q1[1]) + (S[6] * q1[2] + S[7] * q1[3]);
            op = red8(op);
            if (p == 0) ob[tt * 64 + j] = op;
        }
        __syncthreads();
        for (int idx = tid; idx < 64 * 16; idx += NTHR) { const int tt = idx >> 4, c4 = idx & 15;
            *(f32x4*)(OUT + ((size_t)b * SEQ + t0 + tt) * 512 + h * 64 + c4 * 4) = *(const f32x4*)(ob + tt * 64 + c4 * 4); }
    }
}
__device__ __forceinline__ void delta_post(Frame& F, int layer) {
    const bf16* OFp = (const bf16*)(F.ws + WS_OF); const bf16* OBp = (const bf16*)(F.ws + WS_OB); bf16* DZ = (bf16*)(F.ws + WS_DZ);
    const int d4 = (F.lane & 15) * 4; const f32x4 nw = *(const f32x4*)(IN_dn_norm_w(F) + layer * 64 + d4);
    const size_t gq = ((size_t)F.bx * NTHR + F.tid) >> 4, NQ = ((size_t)F.G * NTHR) >> 4;
    for (size_t pr0 = gq; pr0 < (size_t)M * 8; pr0 += 4 * NQ) {
        v2u ofw[4], obw[4], zw[4];
#pragma unroll
        for (int u = 0; u < 4; ++u) { const size_t off = (pr0 + u * NQ) * 64 + d4; ofw[u] = *(const v2u*)(OFp + off); obw[u] = *(const v2u*)(OBp + off); zw[u] = *(const v2u*)(DZ + off); }
#pragma unroll
        for (int u = 0; u < 4; ++u) { const size_t off = (pr0 + u * NQ) * 64 + d4;
            const f32x4 o = (f32x4){bflo(ofw[u].x) + bflo(obw[u].x), bfhi(ofw[u].x) + bfhi(obw[u].x), bflo(ofw[u].y) + bflo(obw[u].y), bfhi(ofw[u].y) + bfhi(obw[u].y)};
            float ss = (o[0] * o[0] + o[1] * o[1]) + (o[2] * o[2] + o[3] * o[3]); ss = red16(ss);
            const float rs = (ABL == 2) ? 0.f : __builtin_amdgcn_rsqf(ss * (1.0f / 64.0f) + RMS_EPS);
            const float z0 = bflo(zw[u].x), z1 = bfhi(zw[u].x), z2 = bflo(zw[u].y), z3 = bfhi(zw[u].y);
            v2u w; w.x = pk2(o[0] * rs * nw[0] * siluf_(z0), o[1] * rs * nw[1] * siluf_(z1)); w.y = pk2(o[2] * rs * nw[2] * siluf_(z2), o[3] * rs * nw[3] * siluf_(z3));
            *(v2u*)(DZ + off) = w; }
    }
}

typedef short v4i16_t __attribute__((ext_vector_type(4)));
constexpr int AT_K_OFF = 0;
constexpr int AT_V_OFF = 46080;
constexpr int AT_BIAS_OFF = 92160;
static_assert(AT_V_OFF + 46080 <= AT_BIAS_OFF && AT_BIAS_OFF + 8320 <= RING_BYTES, "attn LDS");
__device__ __forceinline__ int t5_bucket(int rel) {
    const int n = rel < 0 ? -rel : rel;
    const int large = 8 + (n >= 12) + (n >= 16) + (n >= 23) + (n >= 32) + (n >= 46) + (n >= 64) + (n >= 91);
    return (rel > 0 ? 16 : 0) + (n < 8 ? n : large);
}
__device__ __forceinline__ void attn_bias_setup(Frame& F) {
    float* bl = (float*)(F.lds + AT_BIAS_OFF);
    for (int i = F.tid; i < 8 * 257; i += NTHR) { const int h = i / 257, r = i % 257; bl[h * 260 + r] = IN_rel_bias(F)[t5_bucket(r - 128) * 8 + h] * 1.44269504f; }
}
__device__ __forceinline__ void attn_load(Frame& F, int unit, v4u (&kr)[5], v4u (&vr)[5], bf16x8 (&qn)[4]) {
    const int b = unit >> 6, kvh = (unit >> 5) & 1, q0 = (unit & 31) * 64;
    const bf16* AK = (const bf16*)(F.ws + WS_AK); const bf16* AV = (const bf16*)(F.ws + WS_AV);
    { const int hq = kvh * 4 + (F.wave & 3), qw = q0 + 32 * (F.wave >> 2), qi = F.lane & 31, hl = F.lane >> 5;
        const bf16* qp = (const bf16*)(F.ws + WS_AQ) + ((size_t)b * SEQ + qw + qi) * 512 + hq * 64 + 8 * hl;
#pragma unroll
        for (int s = 0; s < 4; ++s) qn[s] = *(const bf16x8*)(qp + 16 * s); }
#pragma unroll
    for (int it = 0; it < 5; ++it) { const int idx = F.tid + it * NTHR, i = idx >> 3, d8 = idx & 7, kp = q0 - 128 + i; const bool ok = kp >= 0 && kp < SEQ;
        const size_t off = ((size_t)b * SEQ + kp) * 128 + kvh * 64 + d8 * 8;
        kr[it] = ld_or_zero(AK + off, AK, ok); vr[it] = ld_or_zero(AV + off, AV, ok); }
}
__device__ __forceinline__ void attn_store(Frame& F, const v4u (&kr)[5], const v4u (&vr)[5]) {
    bf16* Kl = (bf16*)(F.lds + AT_K_OFF); bf16* Vl = (bf16*)(F.lds + AT_V_OFF);
#pragma unroll
    for (int it = 0; it < 5; ++it) { const int idx = F.tid + it * NTHR, i = idx >> 3, d8 = idx & 7;
        *(v4u*)(Kl + i * 72 + d8 * 8) = kr[it]; *(v4u*)(Vl + i * 72 + d8 * 8) = vr[it]; }
}
__device__ __forceinline__ void attn_compute(Frame& F, int layer, int unit, bf16* OUT, const bf16x8 (&qf)[4]) {
    const int b = unit >> 6, kvh = (unit >> 5) & 1, qb = unit & 31, q0 = qb * 64;
    const bf16* Kl = (const bf16*)(F.lds + AT_K_OFF); const bf16* Vl = (const bf16*)(F.lds + AT_V_OFF); const float* bl = (const float*)(F.lds + AT_BIAS_OFF);
    bf16* AQ = (bf16*)(F.ws + WS_AQ);
    const int lane = F.lane, wave = F.wave;
    const int hq = kvh * 4 + (wave & 3), half = wave >> 2, qw = q0 + 32 * half, qi = lane & 31, hl = lane >> 5;
    const size_t qrow = ((size_t)b * SEQ + qw + qi) * 512 + hq * 64;
    f32x16 o0, o1;
#pragma unroll
    for (int i = 0; i < 16; ++i) { o0[i] = 0.f; o1[i] = 0.f; }
    float mrun = IN_attn_sink(F)[layer * 8 + hq] * 1.44269504f, lrun = hl == 0 ? 1.0f : 0.0f;
    const bool interior = (qb >= 2) && (qb <= 29);
    const float qsc = 0.125f * 1.44269504f;
    const float* bh = bl + hq * 260;
    for (int kt = 0; kt < 9; ++kt) {
        const int kb = 32 * half + 32 * kt;
        f32x16 sc;
#pragma unroll
        for (int i = 0; i < 16; ++i) sc[i] = 0.f;
#pragma unroll
        for (int s = 0; s < 4; ++s) { const bf16x8 a = *(const bf16x8*)(Kl + (kb + qi) * 72 + 16 * s + 8 * hl); sc = __builtin_amdgcn_mfma_f32_32x32x16_bf16(a, qf[s], sc, 0, 0, 0); }
        float mt = -1e30f;
        if (interior && kt >= 1 && kt <= 7) {
            const float* bp = bh + 32 * kt + 4 * hl - qi;
#pragma unroll
            for (int i = 0; i < 16; ++i) { const float sv = sc[i] * qsc + bp[(i & 3) + 8 * (i >> 2)]; sc[i] = sv; mt = fmaxf(mt, sv); }
        } else {
#pragma unroll
            for (int i = 0; i < 16; ++i) { const int krow = (i & 3) + 8 * (i >> 2) + 4 * hl, kp = q0 - 128 + kb + krow, rel = kp - (qw + qi);
                const bool valid = (kp >= 0) && (kp < SEQ) && (rel >= -128) && (rel <= 128);
                const int ri = rel < -128 ? 0 : (rel > 128 ? 256 : rel + 128);
                const float sv = valid ? sc[i] * qsc + bh[ri] : -1e30f; sc[i] = sv; mt = fmaxf(mt, sv); }
        }
        mt = fmaxf(mt, __shfl_xor(mt, 32));
        const float mnew = fmaxf(mrun, mt), corr = __builtin_amdgcn_exp2f(mrun - mnew); mrun = mnew;
        float ls = 0.f;
#pragma unroll
        for (int i = 0; i < 16; ++i) { const float pv = __builtin_amdgcn_exp2f(sc[i] - mnew); sc[i] = pv; ls += pv; }
        lrun = lrun * corr + ls;
#pragma unroll
        for (int i = 0; i < 16; ++i) { o0[i] *= corr; o1[i] *= corr; }
#pragma unroll
        for (int s2 = 0; s2 < 2; ++s2) {
            v4u pw; pw.x = cvt_pk_bf16(sc[8 * s2 + 0], sc[8 * s2 + 1]); pw.y = cvt_pk_bf16(sc[8 * s2 + 2], sc[8 * s2 + 3]); pw.z = cvt_pk_bf16(sc[8 * s2 + 4], sc[8 * s2 + 5]); pw.w = cvt_pk_bf16(sc[8 * s2 + 6], sc[8 * s2 + 7]);
            const bf16x8 pb = __builtin_bit_cast(bf16x8, pw);
            const bf16* v0p = Vl + (size_t)(kb + 16 * s2 + 4 * hl + ((lane & 15) >> 2)) * 72 + 16 * ((lane >> 4) & 1) + 4 * (lane & 3);
            const v4i16_t a0 = __builtin_amdgcn_ds_read_tr16_b64_v4i16((LAS v4i16_t*)v0p), a1 = __builtin_amdgcn_ds_read_tr16_b64_v4i16((LAS v4i16_t*)(v0p + 8 * 72));
            const v4i16_t c0 = __builtin_amdgcn_ds_read_tr16_b64_v4i16((LAS v4i16_t*)(v0p + 32)), c1 = __builtin_amdgcn_ds_read_tr16_b64_v4i16((LAS v4i16_t*)(v0p + 32 + 8 * 72));
            const bf16x8 va = __builtin_shufflevector(a0, a1, 0, 1, 2, 3, 4, 5, 6, 7), vc = __builtin_shufflevector(c0, c1, 0, 1, 2, 3, 4, 5, 6, 7);
            o0 = __builtin_amdgcn_mfma_f32_32x32x16_bf16(va, pb, o0, 0, 0, 0);
            o1 = __builtin_amdgcn_mfma_f32_32x32x16_bf16(vc, pb, o1, 0, 0, 0);
        }
    }
    const float inv = (ABL == 1) ? 0.f : 1.0f / (lrun + __shfl_xor(lrun, 32));
#pragma unroll
    for (int g = 0; g < 4; ++g) {
        v2u w0, w1; w0.x = cvt_pk_bf16(o0[4 * g] * inv, o0[4 * g + 1] * inv); w0.y = cvt_pk_bf16(o0[4 * g + 2] * inv, o0[4 * g + 3] * inv);
        w1.x = cvt_pk_bf16(o1[4 * g] * inv, o1[4 * g + 1] * inv); w1.y = cvt_pk_bf16(o1[4 * g + 2] * inv, o1[4 * g + 3] * inv);
        bf16* OQ = OUT ? OUT : AQ; *(v2u*)(OQ + qrow + 8 * g + 4 * hl) = w0; *(v2u*)(OQ + qrow + 32 + 8 * g + 4 * hl) = w1; }
}

__device__ __forceinline__ void attn_phase(Frame& F, int layer, bf16* OUT) {
    v4u kr[5], vr[5]; bf16x8 qn[4];
    int u = F.bx;
    if (u < 1024) attn_load(F, u, kr, vr, qn);
    for (; u < 1024; u += F.G) {
        __syncthreads();
        attn_store(F, kr, vr);
        bf16x8 qf[4];
#pragma unroll
        for (int s = 0; s < 4; ++s) qf[s] = qn[s];
        __syncthreads();
        if (u + F.G < 1024) attn_load(F, u + F.G, kr, vr, qn);
        attn_compute(F, layer, u, OUT, qf);
    }
}

constexpr int PL_U_OFF = 0;
constexpr int PL_MX_OFF = 49152;
static_assert(PL_MX_OFF + 32768 <= RING_BYTES, "pool LDS");
__device__ __forceinline__ void pool_unit(Frame& F, int layer, int unit) {
    const int b = unit >> 6, t0 = (unit & 63) * 32;
    bf16* U = (bf16*)(F.lds + PL_U_OFF); bf16* MX = (bf16*)(F.lds + PL_MX_OFF);
    const bf16* PU = (const bf16*)(F.ws + WS_PU); bf16* OP = (bf16*)(F.ws + WS_OP);
    const int tid = F.tid;
    __syncthreads();
    for (int idx = tid; idx < 48 * 64; idx += NTHR) { const int r = idx >> 6, c8 = idx & 63, t = t0 - 8 + r;
        const v4u v = ld_or_zero(PU + ((size_t)b * SEQ + t) * 512 + c8 * 8, PU, t >= 0 && t < SEQ);
        *(v4u*)(U + r * 512 + c8 * 8) = v; }
    __syncthreads();
    { const int chp = tid & 255, tt0 = (tid >> 8) * 16, g = chp >> 6, r = 1 << g;
        const unsigned* Uw = (const unsigned*)U + chp;
        float s0 = 0.f, s1 = 0.f;
        for (int d = -r; d <= r; ++d) { const unsigned w = Uw[(8 + tt0 + d) * 256]; s0 += bflo(w); s1 += bfhi(w); }
        for (int i = 0; i < 16; ++i) { const int tt = tt0 + i, t = t0 + tt; const int lo = t - r < 0 ? 0 : t - r, hi = t + r > SEQ - 1 ? SEQ - 1 : t + r;
            const float rc = __builtin_amdgcn_rcpf((float)(hi - lo + 1)); const unsigned c = Uw[(8 + tt) * 256];
            ((unsigned*)MX)[tt * 256 + chp] = (ABL == 3) ? 0u : pk2(s0 * rc - bflo(c), s1 * rc - bfhi(c));
            if (i < 15) { const unsigned a = Uw[(8 + tt + 1 + r) * 256], sb = Uw[(8 + tt - r) * 256]; s0 += bflo(a) - bflo(sb); s1 += bfhi(a) - bfhi(sb); } } }
    __syncthreads();
    for (int idx = tid; idx < 32 * 64; idx += NTHR) { const int tt = idx >> 6, c8 = idx & 63;
        *(v4u*)(OP + ((size_t)b * SEQ + t0 + tt) * 512 + c8 * 8) = *(const v4u*)(MX + tt * 512 + c8 * 8); }
}

constexpr int DC_QN = 0, DC_KN = 9216, DC_KBT = 18432, DC_KDT = 27648, DC_VBT = 36864;
constexpr int DC_ST = 46080, DC_VNT = 55296, DC_T = 64512, DC_QKM = 73728;
constexpr int DC_AF = 82944;
constexpr int DC_AB = 100352;
constexpr int DC_DT1 = 109568;
constexpr int DC_DTS = 112128;
constexpr int DC_OB = 113664;
constexpr int DC_RAW = 55296;
static_assert(DC_RAW + 52224 <= DC_DT1 && DC_OB + 16384 <= RING_BYTES, "delta chunk LDS");
constexpr int DC_CW = LDSCTL_OFF + 2048;
constexpr int DC_VEC = DC_CW + 3840;
static_assert(DC_VEC + 7 * 256 <= LDS_BYTES, "delta chunk LDS (vectors)");
#ifndef DCREP
#define DCREP 0
#endif
__device__ __forceinline__ f32x4 mfma16(const bf16x8& a, const bf16x8& b, const f32x4& c) { return __builtin_amdgcn_mfma_f32_16x16x32_bf16(a, b, c, 0, 0, 0); }
__device__ __forceinline__ bf16x8 ld8(const bf16* p) { return *(const bf16x8*)p; }
__device__ __forceinline__ int tsw(int row, int col) { return row * 72 + ((((col >> 3) ^ (row >> 3)) & 7) << 3) + (col & 7); }
__device__ __forceinline__ int tswc(int row, int chunk) { return row * 72 + (((chunk ^ (row >> 3)) & 7) << 3); }
__device__ __forceinline__ bf16x8 ld44(const bf16* p0, const bf16* p1) { const v2u a = *(const v2u*)p0, b = *(const v2u*)p1; return __builtin_bit_cast(bf16x8, (v4u){a.x, a.y, b.x, b.y}); }
__device__ __forceinline__ void st4(bf16* p, float a, float b, float c, float d) { v2u w; w.x = cvt_pk_bf16(a, b); w.y = cvt_pk_bf16(c, d); *(v2u*)p = w; }

__device__ __forceinline__ void delta_seq_chunked(Frame& F, int layer, int seq) {
    const int dir = seq >> 7, b = (seq >> 3) & 15, h = seq & 7;
    unsigned char* L = F.lds;
    bf16* Qn = (bf16*)(L + DC_QN); bf16* Kn = (bf16*)(L + DC_KN); bf16* KbT = (bf16*)(L + DC_KBT); bf16* KdT = (bf16*)(L + DC_KDT); bf16* VbT = (bf16*)(L + DC_VBT);
    bf16* St = (bf16*)(L + DC_ST); bf16* VnT = (bf16*)(L + DC_VNT); bf16* T = (bf16*)(L + DC_T); bf16* QKm = (bf16*)(L + DC_QKM);
    float* Af = (float*)(L + DC_AF); bf16* Ab = (bf16*)(L + DC_AB); bf16* DT1 = (bf16*)(L + DC_DT1); bf16* DTs = (bf16*)(L + DC_DTS); float* ob = (float*)(L + DC_OB);
    float* raw = (float*)(L + DC_RAW); float* cw = (float*)(L + DC_CW);
    float* Gs = (float*)(L + DC_VEC); float* gam = Gs + 64; float* del = Gs + 128; float* bet = Gs + 192; float* rq = Gs + 256; float* rk = Gs + 320; float* cdp = Gs + 384;
    const bf16* DQKV = (const bf16*)(F.ws + WS_DQKV); const float* DAB = (const float*)(F.ws + WS_DAB);
    float* OUT = (float*)(F.ws + (dir ? WS_OB : WS_OF));
    const int tid0 = F.tid, wave = F.wave; int tid = tid0, lane = tid0 & 63;
    const int tr = wave >> 1, tc0 = 2 * (wave & 1); int l15 = 0, q4 = 0;
    __syncthreads();
    for (int i = tid; i < 5 * 192; i += NTHR) { const int jj = i / 192, ch = i % 192; cw[i] = IN_conv_w(F)[((size_t)layer * 5 + jj) * 1536 + (ch >> 6) * 512 + h * 64 + (ch & 63)]; }
    for (int i = tid; i < 64 * 72 / 2; i += NTHR) { ((unsigned*)St)[i] = 0u; ((unsigned*)T)[i] = 0u; }
    const float nA = -__expf(IN_a_log(F)[layer * 16 + dir * 8 + h]), dtb = IN_dt_bias(F)[layer * 16 + dir * 8 + h];
    f32x4 Sacc[2];
    Sacc[0] = (f32x4){0.f, 0.f, 0.f, 0.f}; Sacc[1] = Sacc[0];
    v4u pre[4]; float pa = 0.f, pb = 0.f;
    { const int t0n = dir ? SEQ - 64 : 0;
#pragma unroll
        for (int it = 0; it < 4; ++it) { const int idx = tid + it * NTHR; const int r = idx / 24, pc = idx % 24, t = t0n - 2 + r;
            pre[it] = ld_or_zero(DQKV + ((size_t)b * SEQ + t) * 1536 + (pc >> 3) * 512 + h * 64 + (pc & 7) * 8, DQKV, idx < 68 * 24 && t >= 0 && t < SEQ); }
        if (wave == 0) { const size_t m = (size_t)b * SEQ + t0n + (dir ? 63 - lane : lane); pa = DAB[m * 32 + dir * 8 + h]; pb = DAB[m * 32 + 16 + dir * 8 + h]; } }
    for (int blk = 0; blk < SEQ / 64; ++blk) {
        const int tb = dir ? (SEQ / 64 - 1 - blk) : blk, t0 = tb * 64;
        tid = tid0; asm volatile("" : "+v"(tid)); lane = tid & 63;
        __syncthreads();
#pragma unroll
        for (int it = 0; it < 4; ++it) { const int idx = tid + it * NTHR; if (idx < 68 * 24) { const int r = idx / 24, pc = idx % 24; float* rp = raw + r * 192 + (pc >> 3) * 64 + (pc & 7) * 8;
                f32x4 lo, hi; unpack8(pre[it], lo, hi); *(f32x4*)rp = lo; *(f32x4*)(rp + 4) = hi; } }
        if (wave == 0) { const float xx = pa + dtb; const float sp = xx > 20.f ? xx : log1pf(__expf(xx));
            float g = nA * sp;
#pragma unroll
            for (int o = 1; o < 64; o <<= 1) { const float u = __shfl_up(g, o); if (lane >= o) g += u; }
            const float gl = __shfl(g, 63);
            Gs[lane] = g; gam[lane] = __expf(g); del[lane] = __expf(gl - g); bet[lane] = sigmoidf_(pb); if (lane == 63) cdp[0] = __expf(g); }
        if (blk + 1 < SEQ / 64) { const int tbn = dir ? (SEQ / 64 - 2 - blk) : blk + 1, t0n = tbn * 64;
#pragma unroll
            for (int it = 0; it < 4; ++it) { const int idx = tid + it * NTHR; const int r = idx / 24, pc = idx % 24, t = t0n - 2 + r;
                pre[it] = ld_or_zero(DQKV + ((size_t)b * SEQ + t) * 1536 + (pc >> 3) * 512 + h * 64 + (pc & 7) * 8, DQKV, idx < 68 * 24 && t >= 0 && t < SEQ); }
            if (wave == 0) { const size_t m = (size_t)b * SEQ + t0n + (dir ? 63 - lane : lane); pa = DAB[m * 32 + dir * 8 + h]; pb = DAB[m * 32 + 16 + dir * 8 + h]; } }
        __syncthreads();
        for (int rep1 = 0; rep1 < (DCREP == 1 ? 2 : 1); ++rep1)
        { const int tt = tid >> 3, d0 = (tid & 7) * 8, s = dir ? 63 - tt : tt;
            float xv[3][8];
#pragma unroll
            for (int sec = 0; sec < 3; ++sec) {
                f32x2 a2[4];
#pragma unroll
                for (int pq = 0; pq < 4; ++pq) a2[pq] = (f32x2){0.f, 0.f};
#pragma unroll
                for (int jj = 0; jj < 5; ++jj) { const float* rp = raw + (tt + jj) * 192 + sec * 64 + d0; const float* cp = cw + jj * 192 + sec * 64 + d0;
                    const f32x4 r0 = *(const f32x4*)rp, r1 = *(const f32x4*)(rp + 4), c0 = *(const f32x4*)cp, c1 = *(const f32x4*)(cp + 4);
                    a2[0] += (f32x2){c0[0], c0[1]} * (f32x2){r0[0], r0[1]}; a2[1] += (f32x2){c0[2], c0[3]} * (f32x2){r0[2], r0[3]};
                    a2[2] += (f32x2){c1[0], c1[1]} * (f32x2){r1[0], r1[1]}; a2[3] += (f32x2){c1[2], c1[3]} * (f32x2){r1[2], r1[3]}; }
#pragma unroll
                for (int e = 0; e < 8; ++e) xv[sec][e] = siluf_(a2[e >> 1][e & 1]);
                __builtin_amdgcn_sched_barrier(0); }
            float sq = 0.f, sk = 0.f;
#pragma unroll
            for (int e = 0; e < 8; ++e) { sq += xv[0][e] * xv[0][e]; sk += xv[1][e] * xv[1][e]; }
            sq = __builtin_amdgcn_rsqf(red8(sq) + 1e-6f) * 0.125f; sk = __builtin_amdgcn_rsqf(red8(sk) + 1e-6f);
            const float be = bet[s], bg = be * gam[s], dl = del[s];
#pragma unroll
            for (int e = 0; e < 8; ++e) { xv[0][e] *= sq; xv[1][e] *= sk; }
            v4u w; w.x = cvt_pk_bf16(xv[0][0], xv[0][1]); w.y = cvt_pk_bf16(xv[0][2], xv[0][3]); w.z = cvt_pk_bf16(xv[0][4], xv[0][5]); w.w = cvt_pk_bf16(xv[0][6], xv[0][7]); *(v4u*)(Qn + s * 72 + d0) = w;
            w.x = cvt_pk_bf16(xv[1][0], xv[1][1]); w.y = cvt_pk_bf16(xv[1][2], xv[1][3]); w.z = cvt_pk_bf16(xv[1][4], xv[1][5]); w.w = cvt_pk_bf16(xv[1][6], xv[1][7]); *(v4u*)(Kn + s * 72 + d0) = w;
#pragma unroll
            for (int e = 0; e < 8; e += 2) { const int o0 = tsw(d0 + e, s), o1 = tsw(d0 + e + 1, s);
                const unsigned wb = cvt_pk_bf16(xv[1][e] * bg, xv[1][e + 1] * bg), wd = cvt_pk_bf16(xv[1][e] * dl, xv[1][e + 1] * dl), wv = cvt_pk_bf16(xv[2][e] * be, xv[2][e + 1] * be);
                KbT[o0] = (bf16)(wb & 0xffffu); KbT[o1] = (bf16)(wb >> 16); KdT[o0] = (bf16)(wd & 0xffffu); KdT[o1] = (bf16)(wd >> 16); VbT[o0] = (bf16)(wv & 0xffffu); VbT[o1] = (bf16)(wv >> 16); } }
        __syncthreads();
        { int lv = lane; asm volatile("" : "+v"(lv)); l15 = lv & 15; q4 = lv >> 4; }
        for (int rep4 = 0; rep4 < (DCREP == 4 ? 2 : 1); ++rep4)
        { const bf16x8 a0 = ld8(Kn + (16 * tr + l15) * 72 + 8 * q4), a1 = ld8(Kn + (16 * tr + l15) * 72 + 32 + 8 * q4);
            float Gj[4];
#pragma unroll
            for (int r = 0; r < 4; ++r) Gj[r] = Gs[16 * tr + 4 * q4 + r];
#pragma unroll
            for (int tcx = 0; tcx < 2; ++tcx) { const int tc = tc0 + tcx, i = 16 * tc + l15, j0 = 16 * tr + 4 * q4;
                f32x4 ckk = (f32x4){0.f, 0.f, 0.f, 0.f}, cqk = ckk;
                if (tc >= tr) {
                    const bf16x8 bk0 = ld8(Kn + i * 72 + 8 * q4), bk1 = ld8(Kn + i * 72 + 32 + 8 * q4), bq0 = ld8(Qn + i * 72 + 8 * q4), bq1 = ld8(Qn + i * 72 + 32 + 8 * q4);
                    ckk = mfma16(a0, bk0, ckk); ckk = mfma16(a1, bk1, ckk); cqk = mfma16(a0, bq0, cqk); cqk = mfma16(a1, bq1, cqk);
                    const float Gi = Gs[i], bi = bet[i];
#pragma unroll
                    for (int r = 0; r < 4; ++r) { const int j = j0 + r; const float dec = __expf(Gi - Gj[r]); ckk[r] = (i > j) ? ckk[r] * dec * bi : 0.f; cqk[r] = (i >= j) ? cqk[r] * dec : 0.f; } }
#pragma unroll
                for (int r = 0; r < 4; ++r) Af[(j0 + r) * 68 + i] = ckk[r];
                st4(QKm + i * 72 + j0, cqk[0], cqk[1], cqk[2], cqk[3]);
                st4(Ab + i * 72 + j0, ckk[0], ckk[1], ckk[2], ckk[3]); } }
        __syncthreads();
        for (int rep5 = 0; rep5 < (DCREP == 5 ? 2 : 1); ++rep5)
        if (wave == 0) { const int b4 = lane >> 4, c = lane & 15; const float* Ar = Af + (16 * b4) * 68 + 16 * b4;
            float t[16];
#pragma unroll
            for (int i = 0; i < 16; ++i) t[i] = (i == c) ? 1.f : 0.f;
#pragma unroll
            for (int j = 0; j < 15; ++j) {
#pragma unroll
                for (int i4 = (j + 1) / 4; i4 < 4; ++i4) { const f32x4 a = *(const f32x4*)(Ar + j * 68 + 4 * i4);
#pragma unroll
                    for (int e = 0; e < 4; ++e) if (4 * i4 + e > j) t[4 * i4 + e] -= a[e] * t[j]; } }
#pragma unroll
            for (int i = 0; i < 16; ++i) T[(16 * b4 + i) * 72 + 16 * b4 + c] = (bf16)f2bf(t[i]);
            { v4u w0, w1; w0.x = cvt_pk_bf16(t[0], t[1]); w0.y = cvt_pk_bf16(t[2], t[3]); w0.z = cvt_pk_bf16(t[4], t[5]); w0.w = cvt_pk_bf16(t[6], t[7]);
                w1.x = cvt_pk_bf16(t[8], t[9]); w1.y = cvt_pk_bf16(t[10], t[11]); w1.z = cvt_pk_bf16(t[12], t[13]); w1.w = cvt_pk_bf16(t[14], t[15]);
                const v4u z = (v4u){0u, 0u, 0u, 0u};
                if ((b4 & 1) == 0) { *(v4u*)(DTs + ((b4 >> 1) * 16 + c) * 24) = w0; *(v4u*)(DTs + ((b4 >> 1) * 16 + c) * 24 + 8) = w1; }
                if (b4 == 0) { *(v4u*)(DT1 + c * 40) = w0; *(v4u*)(DT1 + c * 40 + 8) = w1; }
                if (b4 == 1) { *(v4u*)(DT1 + (16 + c) * 40 + 16) = w0; *(v4u*)(DT1 + (16 + c) * 40 + 24) = w1; *(v4u*)(DT1 + (16 + c) * 40) = z; *(v4u*)(DT1 + (16 + c) * 40 + 8) = z; }
                if (lane < 32) { *(v4u*)(T + lane * 72 + 32) = z; *(v4u*)(T + lane * 72 + 40) = z; *(v4u*)(T + lane * 72 + 48) = z; *(v4u*)(T + lane * 72 + 56) = z; }
                if (lane < 16) { *(v4u*)(T + lane * 72 + 16) = z; *(v4u*)(T + lane * 72 + 24) = z; }
                if (lane >= 32 && lane < 48) { *(v4u*)(T + lane * 72 + 48) = z; *(v4u*)(T + lane * 72 + 56) = z; } }
            LDS_WAIT(); asm volatile("" ::: "memory");
            const int m15 = lane & 15, qq = lane >> 4;
#pragma unroll
            for (int p = 0; p < 2; ++p) { const int b0 = 2 * p, b1 = 2 * p + 1;
                const v4u zz = (v4u){0u, 0u, 0u, 0u};
                v4u av = zz, bv = zz;
                if (qq < 2) { av = *(const v4u*)(Ab + (16 * b1 + m15) * 72 + 16 * b0 + 8 * qq); bv = *(const v4u*)(DTs + (p * 16 + m15) * 24 + 8 * qq); }
                f32x4 X4 = (f32x4){0.f, 0.f, 0.f, 0.f};
                X4 = mfma16(__builtin_bit_cast(bf16x8, av), __builtin_bit_cast(bf16x8, bv), X4);
                v4u xa = zz; xa.x = cvt_pk_bf16(X4[0], X4[1]); xa.y = cvt_pk_bf16(X4[2], X4[3]);
                const v2u dr = *(const v2u*)(T + (16 * b1 + m15) * 72 + 16 * b1 + 4 * qq);
                v4u db = zz; db.x = dr.x; db.y = dr.y;
                f32x4 Z4 = (f32x4){0.f, 0.f, 0.f, 0.f};
                Z4 = mfma16(__builtin_bit_cast(bf16x8, xa), __builtin_bit_cast(bf16x8, db), Z4);
                st4(T + (16 * b1 + m15) * 72 + 16 * b0 + 4 * qq, -Z4[0], -Z4[1], -Z4[2], -Z4[3]);
                if (p == 0) {
#pragma unroll
                    for (int r = 0; r < 4; ++r) DT1[(4 * qq + r) * 40 + 16 + m15] = (bf16)f2bf(-Z4[r]); } }
            LDS_WAIT(); asm volatile("" ::: "memory");
            const int r31 = lane & 31, hh = lane >> 5;
            f32x16 X;
#pragma unroll
            for (int i = 0; i < 16; ++i) X[i] = 0.f;
#pragma unroll
            for (int ks = 0; ks < 2; ++ks) X = __builtin_amdgcn_mfma_f32_32x32x16_bf16(ld8(Ab + (32 + r31) * 72 + 16 * ks + 8 * hh), ld8(DT1 + r31 * 40 + 16 * ks + 8 * hh), X, 0, 0, 0);
            f32x16 Z;
#pragma unroll
            for (int i = 0; i < 16; ++i) Z[i] = 0.f;
#pragma unroll
            for (int ks = 0; ks < 2; ++ks) { v4u pw; pw.x = cvt_pk_bf16(X[8 * ks + 0], X[8 * ks + 1]); pw.y = cvt_pk_bf16(X[8 * ks + 2], X[8 * ks + 3]); pw.z = cvt_pk_bf16(X[8 * ks + 4], X[8 * ks + 5]); pw.w = cvt_pk_bf16(X[8 * ks + 6], X[8 * ks + 7]);
                const bf16* d2 = T + (32 + r31) * 72 + 32 + 16 * ks + 4 * hh;
                Z = __builtin_amdgcn_mfma_f32_32x32x16_bf16(__builtin_bit_cast(bf16x8, pw), ld44(d2, d2 + 8), Z, 0, 0, 0); }
#pragma unroll
            for (int g = 0; g < 4; ++g) st4(T + (32 + r31) * 72 + 8 * g + 4 * hh, -Z[4 * g], -Z[4 * g + 1], -Z[4 * g + 2], -Z[4 * g + 3]); }
        __syncthreads();
        { int lv = lane; asm volatile("" : "+v"(lv)); l15 = lv & 15; q4 = lv >> 4; }
        for (int rep7 = 0; rep7 < (DCREP == 7 ? 2 : 1); ++rep7)
        { const bf16x8 ti0 = ld8(T + (16 * tr + l15) * 72 + 8 * q4), ti1 = ld8(T + (16 * tr + l15) * 72 + 32 + 8 * q4);
            f32x4 wt[4];
#pragma unroll
            for (int dt = 0; dt < 4; ++dt) { wt[dt] = (f32x4){0.f, 0.f, 0.f, 0.f};
                wt[dt] = mfma16(ld8(KbT + tswc(16 * dt + l15, q4)), ti0, wt[dt]); wt[dt] = mfma16(ld8(KbT + tswc(16 * dt + l15, 4 + q4)), ti1, wt[dt]); }
            v4u wa0, wa1;
            wa0.x = cvt_pk_bf16(-wt[0][0], -wt[0][1]); wa0.y = cvt_pk_bf16(-wt[0][2], -wt[0][3]); wa0.z = cvt_pk_bf16(-wt[1][0], -wt[1][1]); wa0.w = cvt_pk_bf16(-wt[1][2], -wt[1][3]);
            wa1.x = cvt_pk_bf16(-wt[2][0], -wt[2][1]); wa1.y = cvt_pk_bf16(-wt[2][2], -wt[2][3]); wa1.z = cvt_pk_bf16(-wt[3][0], -wt[3][1]); wa1.w = cvt_pk_bf16(-wt[3][2], -wt[3][3]);
#pragma unroll
            for (int tcx = 0; tcx < 2; ++tcx) { const int e = 16 * (tc0 + tcx) + l15;
                f32x4 u = (f32x4){0.f, 0.f, 0.f, 0.f};
                u = mfma16(ti0, ld8(VbT + tswc(e, q4)), u); u = mfma16(ti1, ld8(VbT + tswc(e, 4 + q4)), u);
                const bf16* sp = St + e * 72 + 4 * q4;
                u = mfma16(__builtin_bit_cast(bf16x8, wa0), ld44(sp, sp + 16), u); u = mfma16(__builtin_bit_cast(bf16x8, wa1), ld44(sp + 32, sp + 48), u);
                st4(VnT + e * 72 + 16 * tr + 4 * q4, u[0], u[1], u[2], u[3]); } }
        __syncthreads();
        { int lv = lane; asm volatile("" : "+v"(lv)); l15 = lv & 15; q4 = lv >> 4; }
        { const bf16x8 qa0 = ld8(Qn + (16 * tr + l15) * 72 + 8 * q4), qa1 = ld8(Qn + (16 * tr + l15) * 72 + 32 + 8 * q4);
            const bf16x8 ma0 = ld8(QKm + (16 * tr + l15) * 72 + 8 * q4), ma1 = ld8(QKm + (16 * tr + l15) * 72 + 32 + 8 * q4);
            const bf16x8 ka0 = ld8(KdT + tswc(16 * tr + l15, q4)), ka1 = ld8(KdT + tswc(16 * tr + l15, 4 + q4));
            const float cd = cdp[0]; float gi[4];
#pragma unroll
            for (int r = 0; r < 4; ++r) gi[r] = gam[16 * tr + 4 * q4 + r];
#pragma unroll
            for (int tcx = 0; tcx < 2; ++tcx) { const int e = 16 * (tc0 + tcx) + l15;
                const bf16x8 s0 = ld8(St + e * 72 + 8 * q4), s1 = ld8(St + e * 72 + 32 + 8 * q4), n0 = ld8(VnT + e * 72 + 8 * q4), n1 = ld8(VnT + e * 72 + 32 + 8 * q4);
                f32x4 o = (f32x4){0.f, 0.f, 0.f, 0.f};
                o = mfma16(qa0, s0, o); o = mfma16(qa1, s1, o);
#pragma unroll
                for (int r = 0; r < 4; ++r) o[r] *= gi[r];
                o = mfma16(ma0, n0, o); o = mfma16(ma1, n1, o);
#pragma unroll
                for (int r = 0; r < 4; ++r) ob[(16 * tr + 4 * q4 + r) * 64 + e] = o[r];
                Sacc[tcx] = Sacc[tcx] * cd; Sacc[tcx] = mfma16(ka0, n0, Sacc[tcx]); Sacc[tcx] = mfma16(ka1, n1, Sacc[tcx]); } }
        __syncthreads();
#pragma unroll
        for (int tcx = 0; tcx < 2; ++tcx) { const int e = 16 * (tc0 + tcx) + l15; st4(St + e * 72 + 16 * tr + 4 * q4, Sacc[tcx][0], Sacc[tcx][1], Sacc[tcx][2], Sacc[tcx][3]); }
        for (int idx = tid; idx < 64 * 16; idx += NTHR) { const int s = idx >> 4, c4 = idx & 15; const int t = t0 + (dir ? 63 - s : s);
            const f32x4 ov = *(const f32x4*)(ob + s * 64 + c4 * 4); v2u ow; ow.x = cvt_pk_bf16(ov[0], ov[1]); ow.y = cvt_pk_bf16(ov[2], ov[3]);
            *(v2u*)((bf16*)OUT + ((size_t)b * SEQ + t) * 512 + h * 64 + c4 * 4) = ow; }
    }
}

#ifndef DPREP
#define DPREP 0
#endif
constexpr int DP_QN = 0, DP_KD = 18432;
constexpr int DP_KN = 36864, DP_KBT = 46080, DP_VBT = 55296, DP_ST = 64512, DP_VNT = 73728, DP_T = 82944, DP_QKM = 92160, DP_AB = 101376;
constexpr int DP_AF4 = 110592;
constexpr int DP_DT1 = 115712, DP_DTS = 118272;
constexpr int DP_RAW = 119808;
static_assert(DP_RAW + 26112 <= RING_BYTES, "pipelined delta LDS");

__device__ __forceinline__ bf16x8 ldtr8(const bf16* img, int ks, int c, int lane) {
    const int q = lane >> 4, qq = (lane & 15) >> 2, p = lane & 3;
    const bf16* a0 = img + (32 * ks + 8 * q + qq) * 72 + 16 * c + 4 * p;
    const v4i16_t lo = __builtin_amdgcn_ds_read_tr16_b64_v4i16((LAS v4i16_t*)a0), hi = __builtin_amdgcn_ds_read_tr16_b64_v4i16((LAS v4i16_t*)(a0 + 4 * 72));
    return __builtin_shufflevector(lo, hi, 0, 1, 2, 3, 4, 5, 6, 7);
}
typedef __bf16 bf16x2v_t __attribute__((ext_vector_type(2)));
__device__ __forceinline__ float dot2bf(unsigned a, unsigned b, float c) { return __builtin_amdgcn_fdot2_f32_bf16(__builtin_bit_cast(bf16x2v_t, a), __builtin_bit_cast(bf16x2v_t, b), c, false); }
__device__ __forceinline__ void delta_seq_pipe(Frame& F, int layer, int seq) {
    const int dir = seq >> 7, b = (seq >> 3) & 15, h = seq & 7;
    unsigned char* L = F.lds;
    bf16* Qn2 = (bf16*)(L + DP_QN); bf16* Kd2 = (bf16*)(L + DP_KD); bf16* Kn = (bf16*)(L + DP_KN); bf16* KbT = (bf16*)(L + DP_KBT); bf16* VbT = (bf16*)(L + DP_VBT);
    bf16* St = (bf16*)(L + DP_ST); bf16* VnT = (bf16*)(L + DP_VNT); bf16* T = (bf16*)(L + DP_T); bf16* QKm = (bf16*)(L + DP_QKM); bf16* Ab = (bf16*)(L + DP_AB);
    float* Af4 = (float*)(L + DP_AF4); bf16* DT1 = (bf16*)(L + DP_DT1); bf16* DTs = (bf16*)(L + DP_DTS); bf16* raw = (bf16*)(L + DP_RAW);
    float* cw = (float*)(L + DC_CW); float* vec0 = (float*)(L + DC_VEC);
    const bf16* DQKV = (const bf16*)(F.ws + WS_DQKV); const float* DAB = (const float*)(F.ws + WS_DAB);
    bf16* OUT = (bf16*)(F.ws + (dir ? WS_OB : WS_OF));
    const int tid0 = F.tid, wave = F.wave; int tid = tid0, lane = tid0 & 63, l15 = 0, q4 = 0;
    const int tr = wave >> 1, tc0 = 2 * (wave & 1);
    __syncthreads();
    for (int i = tid; i < 5 * 192; i += NTHR) { const int jj = i / 192, ch = i % 192; const unsigned wb = f2bf(IN_conv_w(F)[((size_t)layer * 5 + jj) * 1536 + (ch >> 6) * 512 + h * 64 + (ch & 63)]); ((unsigned*)cw)[i] = (ch & 1) ? (wb << 16) : wb; }
    for (int i = tid; i < 64 * 72 / 2; i += NTHR) ((unsigned*)St)[i] = 0u;
    const float nA = -__expf(IN_a_log(F)[layer * 16 + dir * 8 + h]), dtb = IN_dt_bias(F)[layer * 16 + dir * 8 + h];
    f32x4 Sacc[2];
    Sacc[0] = (f32x4){0.f, 0.f, 0.f, 0.f}; Sacc[1] = Sacc[0];
    v4u pre[4]; float pa = 0.f, pb = 0.f;
    v4u kbw = (v4u){0u, 0u, 0u, 0u}, vbw = kbw;

#define DP_LANE() do { tid = tid0; asm volatile("" : "+v"(tid)); lane = tid & 63; l15 = lane & 15; q4 = lane >> 4; } while (0)
#define DP_T0(NB) ((dir ? (SEQ / 64 - 1 - (NB)) : (NB)) * 64)
#define DP_PREFETCH(NB) do { const int t0n_ = DP_T0(NB); \
        _Pragma("unroll") for (int it = 0; it < 4; ++it) { const int idx = tid + it * NTHR; const int r = idx / 24, pc = idx % 24, t = t0n_ - 2 + r; \
            pre[it] = ld_or_zero(DQKV + ((size_t)b * SEQ + t) * 1536 + (pc >> 3) * 512 + h * 64 + (pc & 7) * 8, DQKV, idx < 68 * 24 && t >= 0 && t < SEQ); } \
        if (wave == 0) { const size_t m_ = (size_t)b * SEQ + t0n_ + (dir ? 63 - lane : lane); pa = DAB[m_ * 32 + dir * 8 + h]; pb = DAB[m_ * 32 + 16 + dir * 8 + h]; } } while (0)
#define DP_S0(NB) do { const int nb_ = (NB); \
        _Pragma("unroll") for (int it = 0; it < 4; ++it) { const int idx = tid + it * NTHR; if (idx < 68 * 24) { const int r = idx / 24, pc = idx % 24; *(v4u*)(raw + r * 192 + (pc >> 3) * 64 + (pc & 7) * 8) = pre[it]; } } \
        if (wave == 0) { float* vd_ = vec0 + (nb_ & 1) * 448; const float xx_ = pa + dtb; const float sp_ = xx_ > 20.f ? xx_ : log1pf(__expf(xx_)); float g_ = nA * sp_; \
            _Pragma("unroll") for (int o_ = 1; o_ < 64; o_ <<= 1) { const float u_ = __shfl_up(g_, o_); if (lane >= o_) g_ += u_; } \
            const float gl_ = __shfl(g_, 63); vd_[lane] = g_; vd_[64 + lane] = __expf(g_); vd_[128 + lane] = __expf(gl_ - g_); vd_[192 + lane] = sigmoidf_(pb); if (lane == 63) vd_[256] = __expf(g_); } \
        if (nb_ + 1 < SEQ / 64) DP_PREFETCH(nb_ + 1); } while (0)
#define DP_S1A(NB) do { const int nb_ = (NB); const float* vd_ = vec0 + (nb_ & 1) * 448; bf16* Qn_ = Qn2 + (nb_ & 1) * 4608; bf16* Kd_ = Kd2 + (nb_ & 1) * 4608; \
        const int tt = tid >> 3, d0 = (tid & 7) * 8, s = dir ? 63 - tt : tt; \
        float xv[3][8]; \
        _Pragma("unroll") for (int sec = 0; sec < 3; ++sec) { float a1[8]; \
            _Pragma("unroll") for (int e = 0; e < 8; ++e) a1[e] = 0.f; \
            _Pragma("unroll") for (int jj = 0; jj < 5; ++jj) { const v4u rw = *(const v4u*)(raw + (tt + jj) * 192 + sec * 64 + d0); const float* cp = cw + jj * 192 + sec * 64 + d0; \
                const v4u c0 = *(const v4u*)cp, c1 = *(const v4u*)(cp + 4); \
                a1[0] = dot2bf(rw.x, c0.x, a1[0]); a1[1] = dot2bf(rw.x, c0.y, a1[1]); a1[2] = dot2bf(rw.y, c0.z, a1[2]); a1[3] = dot2bf(rw.y, c0.w, a1[3]); \
                a1[4] = dot2bf(rw.z, c1.x, a1[4]); a1[5] = dot2bf(rw.z, c1.y, a1[5]); a1[6] = dot2bf(rw.w, c1.z, a1[6]); a1[7] = dot2bf(rw.w, c1.w, a1[7]); } \
            _Pragma("unroll") for (int e = 0; e < 8; ++e) xv[sec][e] = siluf_(a1[e]); \
            __builtin_amdgcn_sched_barrier(0); } \
        float sq = 0.f, sk = 0.f; \
        _Pragma("unroll") for (int e = 0; e < 8; ++e) { sq += xv[0][e] * xv[0][e]; sk += xv[1][e] * xv[1][e]; } \
        sq = __builtin_amdgcn_rsqf(red8(sq) + 1e-6f) * 0.125f; sk = __builtin_amdgcn_rsqf(red8(sk) + 1e-6f); \
        const float be = vd_[192 + s], bg = be * vd_[64 + s], dl = vd_[128 + s]; \
        _Pragma("unroll") for (int e = 0; e < 8; ++e) { xv[0][e] *= sq; xv[1][e] *= sk; } \
        v4u w; w.x = cvt_pk_bf16(xv[0][0], xv[0][1]); w.y = cvt_pk_bf16(xv[0][2], xv[0][3]); w.z = cvt_pk_bf16(xv[0][4], xv[0][5]); w.w = cvt_pk_bf16(xv[0][6], xv[0][7]); *(v4u*)(Qn_ + s * 72 + d0) = w; \
        w.x = cvt_pk_bf16(xv[1][0], xv[1][1]); w.y = cvt_pk_bf16(xv[1][2], xv[1][3]); w.z = cvt_pk_bf16(xv[1][4], xv[1][5]); w.w = cvt_pk_bf16(xv[1][6], xv[1][7]); *(v4u*)(Kn + s * 72 + d0) = w; \
        w.x = cvt_pk_bf16(xv[1][0] * bg, xv[1][1] * bg); w.y = cvt_pk_bf16(xv[1][2] * bg, xv[1][3] * bg); w.z = cvt_pk_bf16(xv[1][4] * bg, xv[1][5] * bg); w.w = cvt_pk_bf16(xv[1][6] * bg, xv[1][7] * bg); kbw = w; \
        w.x = cvt_pk_bf16(xv[1][0] * dl, xv[1][1] * dl); w.y = cvt_pk_bf16(xv[1][2] * dl, xv[1][3] * dl); w.z = cvt_pk_bf16(xv[1][4] * dl, xv[1][5] * dl); w.w = cvt_pk_bf16(xv[1][6] * dl, xv[1][7] * dl); *(v4u*)(Kd_ + s * 72 + d0) = w; \
        w.x = cvt_pk_bf16(xv[2][0] * be, xv[2][1] * be); w.y = cvt_pk_bf16(xv[2][2] * be, xv[2][3] * be); w.z = cvt_pk_bf16(xv[2][4] * be, xv[2][5] * be); w.w = cvt_pk_bf16(xv[2][6] * be, xv[2][7] * be); vbw = w; } while (0)
#define DP_S1B() do { const int tt = tid >> 3, d0 = (tid & 7) * 8, s = dir ? 63 - tt : tt; *(v4u*)(KbT + s * 72 + d0) = kbw; *(v4u*)(VbT + s * 72 + d0) = vbw; } while (0)
#define DP_S4(NB) do { const int nb_ = (NB); const float* vd_ = vec0 + (nb_ & 1) * 448; const bf16* Qn_ = Qn2 + (nb_ & 1) * 4608; \
        const bf16x8 a0 = ld8(Kn + (16 * tr + l15) * 72 + 8 * q4), a1 = ld8(Kn + (16 * tr + l15) * 72 + 32 + 8 * q4); \
        float Gj[4]; \
        _Pragma("unroll") for (int r = 0; r < 4; ++r) Gj[r] = vd_[16 * tr + 4 * q4 + r]; \
        _Pragma("unroll") for (int tcx = 0; tcx < 2; ++tcx) { const int tc = tc0 + tcx, i = 16 * tc + l15, j0 = 16 * tr + 4 * q4; \
            f32x4 ckk = (f32x4){0.f, 0.f, 0.f, 0.f}, cqk = ckk; \
            if (tc >= tr) { \
                const bf16x8 bk0 = ld8(Kn + i * 72 + 8 * q4), bk1 = ld8(Kn + i * 72 + 32 + 8 * q4), bq0 = ld8(Qn_ + i * 72 + 8 * q4), bq1 = ld8(Qn_ + i * 72 + 32 + 8 * q4); \
                ckk = mfma16(a0, bk0, ckk); ckk = mfma16(a1, bk1, ckk); cqk = mfma16(a0, bq0, cqk); cqk = mfma16(a1, bq1, cqk); \
                const float Gi = vd_[i], bi = vd_[192 + i]; \
                _Pragma("unroll") for (int r = 0; r < 4; ++r) { const int j = j0 + r; const float dec = __expf(Gi - Gj[r]); ckk[r] = (i > j) ? ckk[r] * dec * bi : 0.f; cqk[r] = (i >= j) ? cqk[r] * dec : 0.f; } } \
            if (tc == tr) { _Pragma("unroll") for (int r = 0; r < 4; ++r) Af4[tr * 320 + (4 * q4 + r) * 20 + l15] = ckk[r]; } \
            st4(QKm + i * 72 + j0, cqk[0], cqk[1], cqk[2], cqk[3]); \
            st4(Ab + i * 72 + j0, ckk[0], ckk[1], ckk[2], ckk[3]); } } while (0)
#define DP_S5() do { if (wave == 0) { const int b4 = lane >> 4, c = lane & 15; const float* Ar = Af4 + b4 * 320; \
        f32x4 ar[15][4];                                            \
        _Pragma("unroll") for (int j = 0; j < 15; ++j) { _Pragma("unroll") for (int i4 = (j + 1) / 4; i4 < 4; ++i4) ar[j][i4] = *(const f32x4*)(Ar + j * 20 + 4 * i4); } \
        float t[16]; \
        _Pragma("unroll") for (int i = 0; i < 16; ++i) t[i] = (i == c) ? 1.f : 0.f; \
        _Pragma("unroll") for (int j = 0; j < 15; ++j) { \
            _Pragma("unroll") for (int i4 = (j + 1) / 4; i4 < 4; ++i4) { \
                _Pragma("unroll") for (int e = 0; e < 4; ++e) if (4 * i4 + e > j) t[4 * i4 + e] -= ar[j][i4][e] * t[j]; } } \
        _Pragma("unroll") for (int i = 0; i < 16; ++i) T[(16 * b4 + i) * 72 + 16 * b4 + c] = (bf16)f2bf(t[i]); \
        { v4u w0, w1; w0.x = cvt_pk_bf16(t[0], t[1]); w0.y = cvt_pk_bf16(t[2], t[3]); w0.z = cvt_pk_bf16(t[4], t[5]); w0.w = cvt_pk_bf16(t[6], t[7]); \
            w1.x = cvt_pk_bf16(t[8], t[9]); w1.y = cvt_pk_bf16(t[10], t[11]); w1.z = cvt_pk_bf16(t[12], t[13]); w1.w = cvt_pk_bf16(t[14], t[15]); \
            const v4u z = (v4u){0u, 0u, 0u, 0u}; \
            if ((b4 & 1) == 0) { *(v4u*)(DTs + ((b4 >> 1) * 16 + c) * 24) = w0; *(v4u*)(DTs + ((b4 >> 1) * 16 + c) * 24 + 8) = w1; } \
            if (b4 == 0) { *(v4u*)(DT1 + c * 40) = w0; *(v4u*)(DT1 + c * 40 + 8) = w1; } \
            if (b4 == 1) { *(v4u*)(DT1 + (16 + c) * 40 + 16) = w0; *(v4u*)(DT1 + (16 + c) * 40 + 24) = w1; *(v4u*)(DT1 + (16 + c) * 40) = z; *(v4u*)(DT1 + (16 + c) * 40 + 8) = z; } \
            if (lane < 32) { *(v4u*)(T + lane * 72 + 32) = z; *(v4u*)(T + lane * 72 + 40) = z; *(v4u*)(T + lane * 72 + 48) = z; *(v4u*)(T + lane * 72 + 56) = z; } \
            if (lane < 16) { *(v4u*)(T + lane * 72 + 16) = z; *(v4u*)(T + lane * 72 + 24) = z; } \
            if (lane >= 32 && lane < 48) { *(v4u*)(T + lane * 72 + 48) = z; *(v4u*)(T + lane * 72 + 56) = z; } } \
        asm volatile("" ::: "memory");                              \
        const int m15 = lane & 15, qq = lane >> 4; \
        { const v4u zz = (v4u){0u, 0u, 0u, 0u}; v4u av[2], bv[2]; v2u dr[2]; \
            _Pragma("unroll") for (int p = 0; p < 2; ++p) { const int b0 = 2 * p, b1 = 2 * p + 1; av[p] = zz; bv[p] = zz; \
                if (qq < 2) { av[p] = *(const v4u*)(Ab + (16 * b1 + m15) * 72 + 16 * b0 + 8 * qq); bv[p] = *(const v4u*)(DTs + (p * 16 + m15) * 24 + 8 * qq); } \
                dr[p] = *(const v2u*)(T + (16 * b1 + m15) * 72 + 16 * b1 + 4 * qq); } \
            f32x4 Z4[2]; \
            _Pragma("unroll") for (int p = 0; p < 2; ++p) { \
                f32x4 X4 = (f32x4){0.f, 0.f, 0.f, 0.f}; X4 = mfma16(__builtin_bit_cast(bf16x8, av[p]), __builtin_bit_cast(bf16x8, bv[p]), X4); \
                v4u xa = zz; xa.x = cvt_pk_bf16(X4[0], X4[1]); xa.y = cvt_pk_bf16(X4[2], X4[3]); \
                v4u db = zz; db.x = dr[p].x; db.y = dr[p].y; \
                Z4[p] = (f32x4){0.f, 0.f, 0.f, 0.f}; Z4[p] = mfma16(__builtin_bit_cast(bf16x8, xa), __builtin_bit_cast(bf16x8, db), Z4[p]); } \
            _Pragma("unroll") for (int p = 0; p < 2; ++p) { const int b0 = 2 * p, b1 = 2 * p + 1; \
                st4(T + (16 * b1 + m15) * 72 + 16 * b0 + 4 * qq, -Z4[p][0], -Z4[p][1], -Z4[p][2], -Z4[p][3]); \
                if (p == 0) { _Pragma("unroll") for (int r = 0; r < 4; ++r) DT1[(4 * qq + r) * 40 + 16 + m15] = (bf16)f2bf(-Z4[p][r]); } } } \
        asm volatile("" ::: "memory"); \
        const int r31 = lane & 31, hh = lane >> 5; \
        f32x16 X; _Pragma("unroll") for (int i = 0; i < 16; ++i) X[i] = 0.f; \
        _Pragma("unroll") for (int ks = 0; ks < 2; ++ks) X = __builtin_amdgcn_mfma_f32_32x32x16_bf16(ld8(Ab + (32 + r31) * 72 + 16 * ks + 8 * hh), ld8(DT1 + r31 * 40 + 16 * ks + 8 * hh), X, 0, 0, 0); \
        f32x16 Z; _Pragma("unroll") for (int i = 0; i < 16; ++i) Z[i] = 0.f; \
        _Pragma("unroll") for (int ks = 0; ks < 2; ++ks) { v4u pw; pw.x = cvt_pk_bf16(X[8 * ks + 0], X[8 * ks + 1]); pw.y = cvt_pk_bf16(X[8 * ks + 2], X[8 * ks + 3]); pw.z = cvt_pk_bf16(X[8 * ks + 4], X[8 * ks + 5]); pw.w = cvt_pk_bf16(X[8 * ks + 6], X[8 * ks + 7]); \
            const bf16* d2 = T + (32 + r31) * 72 + 32 + 16 * ks + 4 * hh; \
            Z = __builtin_amdgcn_mfma_f32_32x32x16_bf16(__builtin_bit_cast(bf16x8, pw), ld44(d2, d2 + 8), Z, 0, 0, 0); } \
        _Pragma("unroll") for (int g = 0; g < 4; ++g) st4(T + (32 + r31) * 72 + 8 * g + 4 * hh, -Z[4 * g], -Z[4 * g + 1], -Z[4 * g + 2], -Z[4 * g + 3]); } } while (0)
#define DP_S7() do { const bf16x8 ti0 = ld8(T + (16 * tr + l15) * 72 + 8 * q4), ti1 = ld8(T + (16 * tr + l15) * 72 + 32 + 8 * q4); \
        f32x4 wt[4]; \
        _Pragma("unroll") for (int dt = 0; dt < 4; ++dt) { wt[dt] = (f32x4){0.f, 0.f, 0.f, 0.f}; \
            wt[dt] = mfma16(ldtr8(KbT, 0, dt, lane), ti0, wt[dt]); wt[dt] = mfma16(ldtr8(KbT, 1, dt, lane), ti1, wt[dt]); } \
        v4u wa0, wa1; \
        wa0.x = cvt_pk_bf16(-wt[0][0], -wt[0][1]); wa0.y = cvt_pk_bf16(-wt[0][2], -wt[0][3]); wa0.z = cvt_pk_bf16(-wt[1][0], -wt[1][1]); wa0.w = cvt_pk_bf16(-wt[1][2], -wt[1][3]); \
        wa1.x = cvt_pk_bf16(-wt[2][0], -wt[2][1]); wa1.y = cvt_pk_bf16(-wt[2][2], -wt[2][3]); wa1.z = cvt_pk_bf16(-wt[3][0], -wt[3][1]); wa1.w = cvt_pk_bf16(-wt[3][2], -wt[3][3]); \
        _Pragma("unroll") for (int tcx = 0; tcx < 2; ++tcx) { const int e = 16 * (tc0 + tcx) + l15; \
            f32x4 u = (f32x4){0.f, 0.f, 0.f, 0.f}; \
            u = mfma16(ti0, ldtr8(VbT, 0, tc0 + tcx, lane), u); u = mfma16(ti1, ldtr8(VbT, 1, tc0 + tcx, lane), u); \
            const bf16* sp = St + e * 72 + 4 * q4; \
            u = mfma16(__builtin_bit_cast(bf16x8, wa0), ld44(sp, sp + 16), u); u = mfma16(__builtin_bit_cast(bf16x8, wa1), ld44(sp + 32, sp + 48), u); \
            st4(VnT + e * 72 + 16 * tr + 4 * q4, u[0], u[1], u[2], u[3]); } } while (0)
#define DP_S8(NB) do { const int nb_ = (NB); const float* vd_ = vec0 + (nb_ & 1) * 448; const bf16* Qn_ = Qn2 + (nb_ & 1) * 4608; const bf16* Kd_ = Kd2 + (nb_ & 1) * 4608; const int t0_ = DP_T0(nb_); \
        const bf16x8 sa0 = ld8(St + (16 * tr + l15) * 72 + 8 * q4), sa1 = ld8(St + (16 * tr + l15) * 72 + 32 + 8 * q4); \
        const bf16x8 va0 = ld8(VnT + (16 * tr + l15) * 72 + 8 * q4), va1 = ld8(VnT + (16 * tr + l15) * 72 + 32 + 8 * q4); \
        const bf16x8 ka0 = ldtr8(Kd_, 0, tr, lane), ka1 = ldtr8(Kd_, 1, tr, lane); \
        const float cd = vd_[256]; \
        _Pragma("unroll") for (int tcx = 0; tcx < 2; ++tcx) { const int i = 16 * (tc0 + tcx) + l15; \
            f32x4 o = (f32x4){0.f, 0.f, 0.f, 0.f}; \
            o = mfma16(sa0, ld8(Qn_ + i * 72 + 8 * q4), o); o = mfma16(sa1, ld8(Qn_ + i * 72 + 32 + 8 * q4), o); \
            o = o * vd_[64 + i]; \
            o = mfma16(va0, ld8(QKm + i * 72 + 8 * q4), o); o = mfma16(va1, ld8(QKm + i * 72 + 32 + 8 * q4), o); \
            const int t = t0_ + (dir ? 63 - i : i); \
            st4(OUT + ((size_t)b * SEQ + t) * 512 + h * 64 + 16 * tr + 4 * q4, o[0], o[1], o[2], o[3]); \
            const int e = 16 * (tc0 + tcx) + l15; \
            Sacc[tcx] = Sacc[tcx] * cd; Sacc[tcx] = mfma16(ka0, ld8(VnT + e * 72 + 8 * q4), Sacc[tcx]); Sacc[tcx] = mfma16(ka1, ld8(VnT + e * 72 + 32 + 8 * q4), Sacc[tcx]); } } while (0)
#define DP_STW() do { _Pragma("unroll") for (int tcx = 0; tcx < 2; ++tcx) { const int e = 16 * (tc0 + tcx) + l15; st4(St + e * 72 + 16 * tr + 4 * q4, Sacc[tcx][0], Sacc[tcx][1], Sacc[tcx][2], Sacc[tcx][3]); } } while (0)

    constexpr int NCK = SEQ / 64;
    DP_LANE(); DP_PREFETCH(0);
    __syncthreads();
    DP_S0(0);
    __syncthreads();
    DP_S1A(0); DP_S1B();
    __syncthreads();
    DP_LANE(); DP_S4(0); DP_S0(1);
    __syncthreads();
    DP_LANE(); DP_S5(); DP_S1A(1);
    __syncthreads();
#pragma nounroll
    for (int n = 0; n < NCK; ++n) {
        const bool has1 = n + 1 < NCK, has2 = n + 2 < NCK;
        DP_LANE(); DP_S7();
        __syncthreads();
        DP_LANE(); DP_S8(n); if (has1) DP_S1B();
        __syncthreads();
        DP_LANE(); DP_STW(); if (has1) DP_S4(n + 1); if (has2) DP_S0(n + 2);
        __syncthreads();
        DP_LANE(); if (has1) DP_S5(); if (has2) DP_S1A(n + 2);
        __syncthreads();
    }
#undef DP_LANE
#undef DP_T0
#undef DP_PREFETCH
#undef DP_S0
#undef DP_S1A
#undef DP_S1B
#undef DP_S4
#undef DP_S5
#undef DP_S7
#undef DP_S8
#undef DP_STW
}

constexpr int LN_CNT_OFF = LDSCTL_OFF + 512;
template <int MODE, bool W8 = false, bool G8 = false>
__device__ __forceinline__ void ln_phase(Frame& F, const float* gam, const float* bet) {
    float* out = F.out; bf16* HB = (bf16*)(F.ws + WS_HB);
    unsigned* lcnt = (unsigned*)(F.lds + LN_CNT_OFF);
    unsigned* TOKE = (unsigned*)(F.ws + WS_META + MT_TOKE); float* TOKP = (float*)(F.ws + WS_META + MT_TOKP); unsigned short* RANK = (unsigned short*)(F.ws + WS_META + MT_RANK);
    unsigned* CNT = (unsigned*)(F.ws + WS_META + MT_CNT); const bf16* YS = (const bf16*)(F.ws + WS_YS);
    const int lane = F.lane;
    LAS f32x4* RW0 = (LAS f32x4*)((LAS unsigned char*)F.lds); LAS f32x4* RW1 = RW0 + 1024;
    if (MODE == 1) { if (F.tid < 8) lcnt[F.tid] = 0u;
        for (int i = F.tid; i < 1024; i += NTHR) { const int jc = i >> 6, ln = i & 63; const float* rw = IN_router_w(F) + (size_t)(ln * 4 + 256 * (jc >> 2) + (jc & 3)) * 8;
            RW0[i] = *(const f32x4*)rw; RW1[i] = *(const f32x4*)(rw + 4); }
        __syncthreads(); }
    f32x4 gv[4], bv[4];
#pragma unroll
    for (int j = 0; j < 4; ++j) { gv[j] = *(const f32x4*)(gam + lane * 4 + 256 * j); bv[j] = *(const f32x4*)(bet + lane * 4 + 256 * j); }
    v2u nx[2][4];
    { const bf16* h0 = HB + ((size_t)F.bx * 128 + F.wave * 16) * 1024 + lane * 4;
#pragma unroll
        for (int u = 0; u < 2; ++u)
#pragma unroll
            for (int j = 0; j < 4; ++j) nx[u][j] = *(const v2u*)(h0 + u * 1024 + 256 * j); }
    for (int i2 = 0; i2 < 16; i2 += 2) {
      v2u cur[2][4];
#pragma unroll
      for (int u = 0; u < 2; ++u)
#pragma unroll
          for (int j = 0; j < 4; ++j) cur[u][j] = nx[u][j];
      if (i2 + 2 < 16) { const bf16* h0 = HB + ((size_t)F.bx * 128 + F.wave * 16 + i2 + 2) * 1024 + lane * 4;
#pragma unroll
          for (int u = 0; u < 2; ++u)
#pragma unroll
              for (int j = 0; j < 4; ++j) nx[u][j] = *(const v2u*)(h0 + u * 1024 + 256 * j); }
#pragma unroll
      for (int u = 0; u < 2; ++u) {
        const int i = i2 + u;
        const size_t m = (size_t)F.bx * 128 + F.wave * 16 + i;
        float* zr = out + m * 1024 + lane * 4; bf16* hr = HB + m * 1024 + lane * 4;
        f32x4 v[4];
#pragma unroll
        for (int j = 0; j < 4; ++j) v[j] = (f32x4){bflo(cur[u][j].x), bfhi(cur[u][j].x), bflo(cur[u][j].y), bfhi(cur[u][j].y)};
        if (MODE == 2) {
            const float p1 = (ABL == 5) ? 0.f : TOKP[m * 2], p2 = (ABL == 5) ? 0.f : TOKP[m * 2 + 1];
            const bf16* y1 = YS + m * 2048 + lane * 4; const bf16* y2 = y1 + 1024;
#pragma unroll
            for (int j = 0; j < 4; ++j) { const v2u a = *(const v2u*)(y1 + 256 * j), b = *(const v2u*)(y2 + 256 * j);
                v[j][0] = v[j][0] * ALPHA + p1 * bflo(a.x) + p2 * bflo(b.x); v[j][1] = v[j][1] * ALPHA + p1 * bfhi(a.x) + p2 * bfhi(b.x);
                v[j][2] = v[j][2] * ALPHA + p1 * bflo(a.y) + p2 * bflo(b.y); v[j][3] = v[j][3] * ALPHA + p1 * bfhi(a.y) + p2 * bfhi(b.y); }
        }
        float s = 0.f;
#pragma unroll
        for (int j = 0; j < 4; ++j) s += (v[j][0] + v[j][1]) + (v[j][2] + v[j][3]);
        const float mean = wave_sum(s) * (1.0f / 1024.0f);
        float q = 0.f;
#pragma unroll
        for (int j = 0; j < 4; ++j) { v[j] = v[j] - mean; q += (v[j][0] * v[j][0] + v[j][1] * v[j][1]) + (v[j][2] * v[j][2] + v[j][3] * v[j][3]); }
        const float rstd = __builtin_amdgcn_rsqf(wave_sum(q) * (1.0f / 1024.0f) + LN_EPS);
#pragma unroll
        for (int j = 0; j < 4; ++j) { v[j] = v[j] * rstd * gv[j] + bv[j]; if (MODE == 2) *(f32x4*)(zr + 256 * j) = v[j]; }
        if (MODE != 2) {
#pragma unroll
            for (int j = 0; j < 4; ++j) { v2u w; w.x = pk2(v[j][0], v[j][1]); w.y = pk2(v[j][2], v[j][3]); *(v2u*)(hr + 256 * j) = w; }
        }
        if (G8) { unsigned char* h8 = F.ws + WS_HBG8 + m * 1024 + lane * 4;
#pragma unroll
            for (int j = 0; j < 4; ++j) *(unsigned*)(h8 + 256 * j) = pk4_fp8(v[j][0], v[j][1], v[j][2], v[j][3]); }
        if (W8) { unsigned char* h8 = F.ws + WS_HB8 + m * 1024 + lane * 4;
#pragma unroll
            for (int j = 0; j < 4; ++j) *(unsigned*)(h8 + 256 * j) = pk4_fp8(v[j][0], v[j][1], v[j][2], v[j][3]); }
        if (MODE == 1) {
            float lg[8];
#pragma unroll
            for (int e = 0; e < 8; ++e) lg[e] = 0.f;
#pragma unroll
            for (int j = 0; j < 4; ++j)
#pragma unroll
                for (int c = 0; c < 4; ++c) { const f32x4 r0 = RW0[(j * 4 + c) * 64 + lane], r1 = RW1[(j * 4 + c) * 64 + lane]; const float hv = v[j][c];
                    lg[0] += hv * r0[0]; lg[1] += hv * r0[1]; lg[2] += hv * r0[2]; lg[3] += hv * r0[3]; lg[4] += hv * r1[0]; lg[5] += hv * r1[1]; lg[6] += hv * r1[2]; lg[7] += hv * r1[3]; }
#pragma unroll
            for (int e = 0; e < 8; ++e) lg[e] = wave_sum(lg[e]);
            int e1 = 0; float l1 = lg[0];
#pragma unroll
            for (int e = 1; e < 8; ++e) if (lg[e] > l1) { l1 = lg[e]; e1 = e; }
            int e2 = -1; float l2 = -3.0e38f;
#pragma unroll
            for (int e = 0; e < 8; ++e) if (e != e1 && lg[e] > l2) { l2 = lg[e]; e2 = e; }
            if (lane == 0) {
                const float p1 = 1.0f / (1.0f + __expf(l2 - l1));
                TOKE[m] = (unsigned)e1 | ((unsigned)e2 << 8); TOKP[m * 2] = p1; TOKP[m * 2 + 1] = 1.0f - p1; (F.ws + WS_META + MT_DEFER)[m] = 0;
                RANK[m * 2] = (unsigned short)atomicAdd(&lcnt[e1], 1u); RANK[m * 2 + 1] = (unsigned short)atomicAdd(&lcnt[e2], 1u);
            }
        }
      }
    }
    if (MODE == 1) { __syncthreads(); if (F.tid < 8) CNT[F.bx * 8 + F.tid] = lcnt[F.tid]; }
}

constexpr int MT_BASE = 288, MT_TOT = 304, MT_NT = 312, MT_PRE = 320;
constexpr int TAIL_U0 = 512, TAIL_ROW0 = (CHT * (NCH - 1) + TAIL_U0 / 4) * 256;
__device__ __forceinline__ void moe_meta(Frame& F, int ln_wg  ) {
    int* mt = (int*)(F.lds + MOE_LDS_OFF); const unsigned* CNT = (const unsigned*)(F.ws + WS_META + MT_CNT);
    __syncthreads();
    { const int e = F.wave; int tot = 0, pre = 0;
#pragma unroll
        for (int k = 0; k < 4; ++k) { const int w = F.lane + 64 * k; const int v = (int)CNT[w * 8 + e]; tot += v; if (w < ln_wg) pre += v; }
#pragma unroll
        for (int o = 1; o < 64; o <<= 1) { tot += __shfl_xor(tot, o); pre += __shfl_xor(pre, o); }
        if (F.lane == 0) { mt[MT_TOT + e] = tot; mt[MT_PRE + e] = pre; } }
    __syncthreads();
    if (F.tid == 0) { int base = 0;
        for (int e = 0; e < 8; ++e) { mt[MT_BASE + e] = base; const int nt = (mt[MT_TOT + e] + 255) >> 8; for (int t = 0; t < nt; ++t) mt[(base >> 8) + t] = e; base += nt << 8; }
        mt[MT_BASE + 8] = base; mt[MT_NT] = base >> 8; }
    __syncthreads();
}
__device__ __forceinline__ int moe_chunk_tiles(const int* mt, int c) { return c < NCH - 1 ? CHT : mt[MT_NT] - CHT * (NCH - 1); }
__device__ __forceinline__ void moe_gather(Frame& F, int c) {
    if (MK_PER_PHASE || c == 0) moe_meta(F, F.bx);
    const int* mt = (const int*)(F.lds + MOE_LDS_OFF);
    const unsigned* TOKE = (const unsigned*)(F.ws + WS_META + MT_TOKE); const unsigned short* RANK = (const unsigned short*)(F.ws + WS_META + MT_RANK);
    unsigned* ROWMAP = (unsigned*)(F.ws + WS_META + MT_ROWMAP);
    const bf16* HB = (const bf16*)(F.ws + WS_HB); bf16* XG = (bf16*)(F.ws + WS_XG);
    const int lane = F.lane, li = lane & 31; const size_t mbase = (size_t)F.bx * 128 + F.wave * 16;
    int pos; bool mine;
    { const size_t m = mbase + (li >> 1); const int slot = li & 1;
        const int e = (int)((TOKE[m] >> (8 * slot)) & 0xffu);
        pos = mt[MT_BASE + e] + mt[MT_PRE + e] + (int)RANK[m * 2 + slot];
        int cc = pos / (CHT * 256); if (cc > NCH - 1) cc = NCH - 1;
        mine = lane < 32 && cc == c;
        if (mine) { ROWMAP[pos] = (unsigned)(m * 2 + slot); if (c == NCH - 1 && pos >= TAIL_ROW0) (F.ws + WS_META + MT_DEFER)[m] = 1; } }
    unsigned mask = (unsigned)__ballot(mine);
    while (mask) {
        int id[4];
#pragma unroll
        for (int k = 0; k < 4; ++k) { if (mask) { id[k] = __builtin_ctz(mask); mask &= mask - 1u; } else id[k] = -1; }
        v4u a[4], b[4];
#pragma unroll
        for (int k = 0; k < 4; ++k) if (id[k] >= 0) { const bf16* src = HB + (mbase + (id[k] >> 1)) * 1024 + lane * 16; a[k] = *(const v4u*)src; b[k] = *(const v4u*)(src + 8); }
#pragma unroll
        for (int k = 0; k < 4; ++k) if (id[k] >= 0) {
            const size_t lr = (size_t)(__builtin_amdgcn_readlane(pos, id[k]) - CHT * 256 * c);
            if (MOE_FP8) { f32x4 t0, t1, t2, t3; unpack8(a[k], t0, t1); unpack8(b[k], t2, t3);
                v4u o; o.x = pk4_fp8(t0[0], t0[1], t0[2], t0[3]); o.y = pk4_fp8(t1[0], t1[1], t1[2], t1[3]); o.z = pk4_fp8(t2[0], t2[1], t2[2], t2[3]); o.w = pk4_fp8(t3[0], t3[1], t3[2], t3[3]);
                *(v4u*)((unsigned char*)XG + lr * 1024 + lane * 16) = o; }
            else { *(v4u*)(XG + lr * 1024 + lane * 16) = a[k]; *(v4u*)(XG + lr * 1024 + lane * 16 + 8) = b[k]; }
        }
    }
}
template <int PASS>
__device__ __forceinline__ void ln_final(Frame& F, const float* gam, const float* bet, int nskip) {
    float* out = F.out; const bf16* HB = (const bf16*)(F.ws + WS_HB);
    const float* TOKP = (const float*)(F.ws + WS_META + MT_TOKP); const bf16* YS = (const bf16*)(F.ws + WS_YS); const unsigned char* DEFER = F.ws + WS_META + MT_DEFER;
    const int lane = F.lane;
    f32x4 gv[4], bv[4];
#pragma unroll
    for (int j = 0; j < 4; ++j) { gv[j] = *(const f32x4*)(gam + lane * 4 + 256 * j); bv[j] = *(const f32x4*)(bet + lane * 4 + 256 * j); }
    int r0, r1; unsigned long long dmask = 0ull;
    if (PASS == 1) { const int nw = (F.G - nskip) * NWAVES, wv = (F.bx - nskip) * NWAVES + F.wave; r0 = (int)(((long)wv * M) / nw); r1 = (int)(((long)(wv + 1) * M) / nw); }
    else { r0 = F.bx * 128 + F.wave * 16; r1 = r0 + 16; dmask = __ballot(lane < 16 && DEFER[r0 + (lane & 15)] != 0); }
    v2u nx[4], ny1[4], ny2[4]; unsigned nfl = 0u; float np1 = 0.f, np2 = 0.f;
    if (PASS == 1 && r0 < r1) { const bf16* h0 = HB + (size_t)r0 * 1024 + lane * 4; const bf16* y0 = YS + (size_t)r0 * 2048 + lane * 4; nfl = DEFER[r0]; np1 = TOKP[(size_t)r0 * 2]; np2 = TOKP[(size_t)r0 * 2 + 1];
#pragma unroll
        for (int j = 0; j < 4; ++j) { nx[j] = *(const v2u*)(h0 + 256 * j); ny1[j] = *(const v2u*)(y0 + 256 * j); ny2[j] = *(const v2u*)(y0 + 1024 + 256 * j); } }
    for (int m_ = r0; m_ < r1; ++m_) {
        const size_t m = (size_t)m_;
        float* zr = out + m * 1024 + lane * 4; const bf16* hr = HB + m * 1024 + lane * 4;
        const bf16* y1 = YS + m * 2048 + lane * 4; const bf16* y2 = y1 + 1024;
        f32x4 v[4]; v2u ya[4], yb[4]; float p1, p2; bool skip;
        if (PASS == 1) {
#pragma unroll
            for (int j = 0; j < 4; ++j) { v[j] = (f32x4){bflo(nx[j].x), bfhi(nx[j].x), bflo(nx[j].y), bfhi(nx[j].y)}; ya[j] = ny1[j]; yb[j] = ny2[j]; }
            p1 = np1; p2 = np2;
            skip = __builtin_amdgcn_readfirstlane(nfl) != 0u;
            if (m_ + 1 < r1) { nfl = DEFER[m + 1]; np1 = TOKP[m * 2 + 2]; np2 = TOKP[m * 2 + 3];
#pragma unroll
                for (int j = 0; j < 4; ++j) { nx[j] = *(const v2u*)(hr + 1024 + 256 * j); ny1[j] = *(const v2u*)(y1 + 2048 + 256 * j); ny2[j] = *(const v2u*)(y2 + 2048 + 256 * j); } }
        } else {
            skip = ((dmask >> (m_ - r0)) & 1ull) == 0ull;
            if (!skip) { p1 = TOKP[m * 2]; p2 = TOKP[m * 2 + 1];
#pragma unroll
                for (int j = 0; j < 4; ++j) { const v2u w = *(const v2u*)(hr + 256 * j); v[j] = (f32x4){bflo(w.x), bfhi(w.x), bflo(w.y), bfhi(w.y)}; ya[j] = *(const v2u*)(y1 + 256 * j); yb[j] = *(const v2u*)(y2 + 256 * j); } }
        }
        if (skip) continue;
        if (ABL == 5) { p1 = 0.f; p2 = 0.f; }
#pragma unroll
        for (int j = 0; j < 4; ++j) { const v2u a = ya[j], b = yb[j];
            v[j][0] = v[j][0] * ALPHA + p1 * bflo(a.x) + p2 * bflo(b.x); v[j][1] = v[j][1] * ALPHA + p1 * bfhi(a.x) + p2 * bfhi(b.x);
            v[j][2] = v[j][2] * ALPHA + p1 * bflo(a.y) + p2 * bflo(b.y); v[j][3] = v[j][3] * ALPHA + p1 * bfhi(a.y) + p2 * bfhi(b.y); }
        float s = 0.f;
#pragma unroll
        for (int j = 0; j < 4; ++j) s += (v[j][0] + v[j][1]) + (v[j][2] + v[j][3]);
        const float mean = wave_sum(s) * (1.0f / 1024.0f);
        float q = 0.f;
#pragma unroll
        for (int j = 0; j < 4; ++j) { v[j] = v[j] - mean; q += (v[j][0] * v[j][0] + v[j][1] * v[j][1]) + (v[j][2] * v[j][2] + v[j][3] * v[j][3]); }
        const float rstd = __builtin_amdgcn_rsqf(wave_sum(q) * (1.0f / 1024.0f) + LN_EPS);
#pragma unroll
        for (int j = 0; j < 4; ++j) { v[j] = v[j] * rstd * gv[j] + bv[j]; *(f32x4*)(zr + 256 * j) = v[j]; }
    }
}
struct MoeSched {
    int G, c, NJ, nunits, t0; const int* mt; const char* A; const char* B; size_t tsA, tsB; int off = 0;
    __device__ __forceinline__ bool next(int i, Unit& u) const { const int L = i * G + c + off; if (L >= nunits) return false; u.pm = L / NJ; u.aux = L - u.pm * NJ; u.pn = mt[t0 + u.pm] * NJ + u.aux; return true; }
    __device__ __forceinline__ const char* abase(const Unit& u) const { return A + (size_t)u.pm * tsA; }
    __device__ __forceinline__ const char* bbase(const Unit& u) const { return B + (size_t)u.pn * tsB; }
};
struct EpiMoeDown {
    static constexpr bool PERM = true;
    bf16* YS; const unsigned* rowmap; const int* mt; int t0;
    __device__ __forceinline__ void operator()(acc_t& acc, const Unit& u, int wr, int wc, int fr, int fq) const {
        const int tg = t0 + u.pm, e = mt[tg], lim = mt[MT_BASE + e] + mt[MT_TOT + e]; const int row0 = tg * 256 + wr * 64 + fr; const int col = u.aux * 256 + wc * 32 + 8 * fq;
#pragma unroll
        for (int ai = 0; ai < 2; ++ai)
#pragma unroll
            for (int m = 0; m < 4; ++m) { const int r = row0 + ai * 128 + m * 16;
                if (r < lim) { const size_t pr = rowmap[r]; bf16* dst = YS + pr * 1024 + col;
                    const float ds = (FP8_EMU || MOE_FP8) ? (1.0f / 32.0f) : 1.0f;
                    *(v4u*)(dst) = pack8(acc[ai][0][m][0] * ds, acc[ai][0][m][1] * ds); *(v4u*)(dst + 128) = pack8(acc[ai][1][m][0] * ds, acc[ai][1][m][1] * ds); } }
        zero_acc(acc);
    }
};

__global__ void __launch_bounds__(NTHR, 2) fwd_kernel(Args args) {
    extern __shared__ __attribute__((aligned(16))) unsigned char lds[];
    Frame F0;
    F0.lds = lds;
    F0.tid = threadIdx.x; F0.lane = F0.tid & 63; F0.wave = __builtin_amdgcn_readfirstlane(F0.tid >> 6);
    F0.G = gridDim.x; F0.bx = blockIdx.x;
    F0.ws = args.ws; F0.out = args.out;
    F0.a = &args;
    { LAS unsigned char* ldsl0 = (LAS unsigned char*)lds;
    for (int u = F0.tid; u < (LDS_BYTES - LDSCTL_OFF) / 4; u += NTHR) ((LAS unsigned*)(ldsl0 + LDSCTL_OFF))[u] = 0u; }
    __syncthreads();
    unsigned* ctl = (unsigned*)(F0.ws + WS_CTL);
    XcdBarrier bar; bar.bar = ctl + CW_BAR; bar.x = 0; bar.st = nullptr; bar.w0 = 0;
    if (!MK_PER_PHASE) bar = xcd_barrier_post(ctl + CW_BAR, (volatile LAS unsigned*)((LAS unsigned char*)lds + MISC_OFF) + 8);
    const int lo = args.ph_lo, hi = args.ph_hi;
#ifndef PHASE_MASK
#define PHASE_MASK 0xFFFFFFFFu
#endif
#define EN(b) (((PHASE_MASK) >> (b)) & 1u)
#ifndef SP2K
#define SP2K 0
#endif
#ifndef ALN
#define ALN 14
#endif
#ifndef DBL
#define DBL 0
#endif
#define REP(k) for (int rep_ = 0; rep_ < ((DBL) == (k) ? 2 : 1); ++rep_)
#define IN(k) (lo <= (k) && (k) < hi)
#define GRID_BAR() do { if (!MK_PER_PHASE) xcd_barrier(bar); } while (0)
#define PH_BEGIN() Frame P = F0; asm volatile("" : "+s"(P.ws), "+s"(P.out), "+s"(P.G), "+s"(P.bx)); P.lane = (int)__builtin_amdgcn_mbcnt_hi(~0u, __builtin_amdgcn_mbcnt_lo(~0u, 0u)); asm volatile("" : "+v"(P.lane)); P.tid = P.wave * 64 + P.lane; Frame& F = P; LAS unsigned char* ldsl = (LAS unsigned char*)P.lds;

    if (EN(0) && IN(0)) { PH_BEGIN(); REP(100) p0_prologue(F); }
    GRID_BAR();
#if defined(XBAR)
    for (int xb_ = 0; xb_ < XBAR; ++xb_) GRID_BAR();
#endif

#pragma nounroll
    for (int layer = 0; layer < 2; ++layer) {
        const int pb = 1 + 40 * layer;
        if (EN(1) && IN(pb + 0)) { PH_BEGIN(); const bf16* HB = (const bf16*)(F.ws + WS_HB); const bf16* WIN = (const bf16*)(F.ws + WS_WIN) + (size_t)layer * WIN_ROWS * 1024;
            pg8::StdSched S; S.init(HB, WIN, M, NA, 1024, F.G, F.bx);
            EpiInA E{F.ws};
            REP(1) pg8::gemm_phase<EpiInA, pg8::StdSched, (ALN & 8) == 0, true>(ldsl + RING_OFF, 1024, S, E, F.wave);
        }
        GRID_BAR();
        if (EN(2) && IN(pb + 1)) { PH_BEGIN();
#if defined(DELTA_RECURRENT)
            REP(21) for (int s = F.bx; s < 256; s += F.G) delta_seq(F, layer, s);
#else
#if defined(DELTA_NOPIPE)
            REP(21) for (int s = F.bx; s < 256; s += F.G) delta_seq_chunked(F, layer, s);
#else
            REP(21) for (int s = F.bx; s < 256; s += F.G) delta_seq_pipe(F, layer, s);
#endif
#endif
            __syncthreads();
            attn_bias_setup(F);
            if (DBL == 22) attn_phase(F, layer, (bf16*)(F.ws + WS_OP));
            attn_phase(F, layer, nullptr);
            REP(23) for (int u = F.bx; u < 1024; u += F.G) pool_unit(F, layer, u);
        }
        GRID_BAR();
        if (EN(3) && IN(pb + 20)) { PH_BEGIN(); delta_post(F, layer); }
        GRID_BAR();
        if (EN(3) && IN(pb + 2)) { PH_BEGIN(); const bf16* HB = (const bf16*)(F.ws + WS_HB); const bf16* WIN = (const bf16*)(F.ws + WS_WIN) + (size_t)layer * WIN_ROWS * 1024;
#if GATES_FP8
            pg8::StdSched S; S.init(F.ws + WS_HBG8, WIN + (size_t)NA * 1024, M, NG, 512, F.G, F.bx); (void)HB;
            EpiGates E{(bf16*)(F.ws + WS_GT), 1.0f / 32.0f};
            REP(3) pg8::gemm_phase<EpiGates, pg8::StdSched, (ALN & 2) == 0, (SP2K & 2) == 0, true>(ldsl + RING_OFF, 512, S, E, F.wave);
#else
            pg8::StdSched S; S.init(HB, WIN + (size_t)NA * 1024, M, NG, 1024, F.G, F.bx);
            EpiGates E{(bf16*)(F.ws + WS_GT), 1.0f};
            REP(3) pg8::gemm_phase<EpiGates, pg8::StdSched, true, true>(ldsl + RING_OFF, 1024, S, E, F.wave);
#endif
        }
        GRID_BAR();
        if (EN(4) && IN(pb + 3)) { PH_BEGIN();
#if defined(BRSKEW)
            if (F.bx & 1) { for (int i_ = 0; i_ < BRSKEW; ++i_) __builtin_amdgcn_s_sleep(127); }
#endif
            BrSched S; S.o.init(M / 256, 4, F.G, F.bx); S.A0 = (const char*)(F.ws + WS_AQ); static_assert(WS_DZ == WS_AQ + 32 * MiB && WS_OP == WS_AQ + 64 * MiB, "branch planes");
            S.B0 = (const char*)(F.ws + WS_WBR) + (size_t)layer * 3 * 1024 * 512 * 2; S.tstep = (size_t)256 * 512 * 2;
#if defined(BR_RMW)
            EpiBranchRMW E{(const bf16*)(F.ws + WS_GT), (bf16*)(F.ws + WS_MERGED)};
            pg8::gemm_phase<EpiBranchRMW, BrSched, false, true>(ldsl + RING_OFF, 512, S, E, F.wave);
#else
            EpiBranch E{(const bf16*)(F.ws + WS_GT), (bf16*)(F.ws + WS_MERGED)};
            REP(4) pg8::gemm_phase<EpiBranch, BrSched, (ALN & 16) == 0, true>(ldsl + RING_OFF, 512, S, E, F.wave);
#endif
        }
        GRID_BAR();
        if (EN(5) && IN(pb + 4)) { PH_BEGIN();
            pg8::StdSched S; S.init(F.ws + WS_MERGED, (const bf16*)(F.ws + WS_WOUT) + (size_t)layer * 1024 * 1024, M, 1024, 1024, F.G, F.bx);
#if (LN_FUSE & 1)
            if (layer == 0) { EpiResidLN<0, false, 0> E{F.ws, F.a, ldsl, 1.0f};
                pg8::gemm_phase<EpiResidLN<0, false, 0>, pg8::StdSched, true, true>(ldsl + RING_OFF, 1024, S, E, F.wave); }
            else
#endif
            { EpiResid E{(bf16*)(F.ws + WS_HB), 1.0f};
            pg8::gemm_phase<EpiResid, pg8::StdSched, (ALN & 32) == 0, true>(ldsl + RING_OFF, 1024, S, E, F.wave); }
        }
        GRID_BAR();
        if (EN(6) && IN(pb + 5) && !((LN_FUSE & 1) && layer == 0)) { PH_BEGIN();
            if (layer == 0) ln_phase<0, FFN_FP8 == 1 || FFN_FP8 == 2>(F, IN_ln1_g(F), IN_ln1_b(F));
            else { ln_phase<1>(F, IN_ln1_g(F) + 1024, IN_ln1_b(F) + 1024); REP(101) moe_weight_convert(F); }
        }
        if (!((LN_FUSE & 1) && layer == 0)) GRID_BAR();
        if (layer == 0) {
            if (EN(7) && IN(pb + 6)) { PH_BEGIN(); const bf16* HB = (const bf16*)(F.ws + WS_HB);
#if FFN_FP8 == 2
                FfnUpSched S; S.o.init(M / 256, FF / 128, F.G, F.bx); S.A = (const char*)(F.ws + WS_HB8); S.Bt = (const char*)(F.ws + WS_W13); S.tstep = (size_t)256 * 1024; (void)HB;
                EpiSwiglu E{(bf16*)(F.ws + WS_FACT), FF, 1.0f / 32.0f, 0};
                REP(7) pg8::gemm_phase<EpiSwiglu, FfnUpSched, true, true, true>(ldsl + RING_OFF, 512, S, E, F.wave);
#elif FFN_FP8 == 1
                FfnUpSched S; S.o.init(M / 256, FF / 128, F.G, F.bx); S.A = (const char*)(F.ws + WS_HB8); S.Bt = (const char*)(F.ws + WS_W13); S.tstep = (size_t)256 * 1024; (void)HB;
                EpiSwiglu8 E{(unsigned char*)(F.ws + WS_FACT), FF, 1.0f / 32.0f};
                REP(7) pg8::gemm_phase<EpiSwiglu8, FfnUpSched, true, true, true>(ldsl + RING_OFF, 512, S, E, F.wave);
#elif FFN_FP8 == 3
                FfnUpSched S; S.o.init(M / 256, FF / 128, F.G, F.bx); S.A = (const char*)HB; S.Bt = (const char*)(F.ws + WS_W13); S.tstep = (size_t)256 * 1024 * 2;
                EpiSwiglu8 E{(unsigned char*)(F.ws + WS_FACT), FF, 1.0f};
                REP(7) pg8::gemm_phase<EpiSwiglu8, FfnUpSched, (ALN & 4) == 0, true>(ldsl + RING_OFF, 1024, S, E, F.wave);
#else
                FfnUpSched S; S.o.init(M / 256, FF / 128, F.G, F.bx); S.A = (const char*)HB; S.Bt = (const char*)(F.ws + WS_W13); S.tstep = (size_t)256 * 1024 * 2;
                EpiSwiglu E{(bf16*)(F.ws + WS_FACT), FF, 1.0f, 0};
                REP(7) pg8::gemm_phase<EpiSwiglu, FfnUpSched, (ALN & 4) == 0, true>(ldsl + RING_OFF, 1024, S, E, F.wave);
#endif
            }
            GRID_BAR();
            if (EN(8) && IN(pb + 7)) { PH_BEGIN();
#if FFN_FP8 == 1 || FFN_FP8 == 3
                pg8::StdSched S; S.init(F.ws + WS_FACT, F.ws + WS_W2, M, 1024, FF / 2, F.G, F.bx);
#if (LN_FUSE & 2)
                EpiResidLN<1, GATES_FP8 != 0, 1> E{F.ws, F.a, ldsl, (ABL == 4) ? 0.f : (1.0f / 32.0f)};
                pg8::gemm_phase<EpiResidLN<1, GATES_FP8 != 0, 1>, pg8::StdSched, true, true, true>(ldsl + RING_OFF, FF / 2, S, E, F.wave);
#else
                EpiResid E{(bf16*)(F.ws + WS_HB), (ABL == 4) ? 0.f : (1.0f / 32.0f)};
                pg8::gemm_phase<EpiResid, pg8::StdSched, true, true, true>(ldsl + RING_OFF, FF / 2, S, E, F.wave);
#endif
#else
                pg8::StdSched S; S.init(F.ws + WS_FACT, F.ws + WS_W2, M, 1024, FF, F.G, F.bx);
                EpiResid E{(bf16*)(F.ws + WS_HB), (ABL == 4) ? 0.f : 1.0f};
                pg8::gemm_phase<EpiResid, pg8::StdSched, (ALN & 64) == 0, true>(ldsl + RING_OFF, FF, S, E, F.wave);
#endif
            }
            GRID_BAR();
#if !((LN_FUSE & 2) && (FFN_FP8 == 1 || FFN_FP8 == 3))
            if (EN(9) && IN(pb + 8)) { PH_BEGIN(); ln_phase<0, false, GATES_FP8 != 0>(F, IN_ln2_g(F), IN_ln2_b(F)); }
            GRID_BAR();
#endif
        } else {
            if (EN(10) && IN(pb + 6)) { PH_BEGIN(); moe_gather(F, 0); }
            GRID_BAR();
#pragma nounroll
            for (int c = 0; c < NCH; ++c) {
                if (EN(11) && IN(pb + 7 + 2 * c)) { PH_BEGIN(); const int* mt = (const int*)(F.lds + MOE_LDS_OFF);
                    if (MK_PER_PHASE) moe_meta(F, -1);
                    MoeSched S; S.G = F.G; S.c = F.bx; S.NJ = FFE / 128; S.t0 = CHT * c; S.nunits = moe_chunk_tiles(mt, c) * S.NJ; S.mt = mt; S.A = (const char*)(F.ws + WS_XG); S.B = (const char*)(F.ws + WS_MWGU);
                    S.tsA = (size_t)256 * 1024 * (MOE_FP8 ? 1 : 2); S.tsB = S.tsA;
#if MOE_FP8
                    EpiSwiglu8 E{(unsigned char*)(F.ws + WS_MACT), FFE, 1.0f / 32.0f};
                    REP(11) pg8::gemm_phase<EpiSwiglu8, MoeSched, (ALN & 1) == 0, (SP2K & 1) == 0, true>(ldsl + RING_OFF, 512, S, E, F.wave);
#else
                    EpiSwiglu E{(bf16*)(F.ws + WS_MACT), FFE, FP8_EMU ? (1.0f / 32.0f) : 1.0f, FP8_EMU};
                    REP(11) pg8::gemm_phase<EpiSwiglu, MoeSched, true, true>(ldsl + RING_OFF, 1024, S, E, F.wave);
#endif
                }
                GRID_BAR();
                if (EN(12) && IN(pb + 8 + 2 * c)) { PH_BEGIN(); const int* mt = (const int*)(F.lds + MOE_LDS_OFF);
                    if (MK_PER_PHASE) moe_meta(F, -1);
                    MoeSched S; S.G = F.G; S.c = F.bx; S.NJ = 4; S.t0 = CHT * c; S.nunits = moe_chunk_tiles(mt, c) * 4; if (c == NCH - 1 && S.nunits > TAIL_U0) S.nunits = TAIL_U0; S.mt = mt; S.A = (const char*)(F.ws + WS_MACT); S.B = (const char*)(F.ws + WS_MWD);
                    S.tsA = (size_t)256 * FFE * (MOE_FP8 ? 1 : 2); S.tsB = S.tsA;
                    EpiMoeDown E{(bf16*)(F.ws + WS_YS), (const unsigned*)(F.ws + WS_META + MT_ROWMAP), mt, CHT * c};
#if MOE_FP8
                    REP(12) pg8::gemm_phase<EpiMoeDown, MoeSched, (ALN & 128) == 0, (SP2K & 4) == 0, true>(ldsl + RING_OFF, FFE / 2, S, E, F.wave);
#else
                    REP(12) pg8::gemm_phase<EpiMoeDown, MoeSched, true, true>(ldsl + RING_OFF, FFE, S, E, F.wave);
#endif
                }
                if (EN(12) && IN(pb + 8 + 2 * c) && c + 1 < NCH) { PH_BEGIN(); moe_gather(F, c + 1); }
                GRID_BAR();
            }
            if (EN(13) && IN(pb + 13)) { PH_BEGIN(); const int* mt = (const int*)(F.lds + MOE_LDS_OFF);
                if (MK_PER_PHASE) moe_meta(F, -1);
                const int total = moe_chunk_tiles(mt, NCH - 1) * 4, ntail = total > TAIL_U0 ? total - TAIL_U0 : 0;
                if (F.bx < ntail) {
                    MoeSched S; S.G = F.G; S.c = F.bx; S.NJ = 4; S.t0 = CHT * (NCH - 1); S.nunits = total; S.off = TAIL_U0; S.mt = mt; S.A = (const char*)(F.ws + WS_MACT); S.B = (const char*)(F.ws + WS_MWD);
                    S.tsA = (size_t)256 * FFE * (MOE_FP8 ? 1 : 2); S.tsB = S.tsA;
                    EpiMoeDown E{(bf16*)(F.ws + WS_YS), (const unsigned*)(F.ws + WS_META + MT_ROWMAP), mt, CHT * (NCH - 1)};
#if MOE_FP8
                    pg8::gemm_phase<EpiMoeDown, MoeSched, true, true, true>(ldsl + RING_OFF, FFE / 2, S, E, F.wave);
#else
                    pg8::gemm_phase<EpiMoeDown, MoeSched, true, true>(ldsl + RING_OFF, FFE, S, E, F.wave);
#endif
                } else ln_final<1>(F, IN_ln2_g(F) + 1024, IN_ln2_b(F) + 1024, ntail);
            }
            GRID_BAR();
            if (EN(13) && IN(pb + 15)) { PH_BEGIN(); ln_final<2>(F, IN_ln2_g(F) + 1024, IN_ln2_b(F) + 1024, 0); }
        }
    }
#undef IN
#undef GRID_BAR
}


#if defined(DBG_CHECK)
constexpr int CK_BASE = 512;
__device__ __forceinline__ unsigned ck_hash(unsigned x) { x ^= x >> 16; x *= 0x7feb352du; x ^= x >> 15; x *= 0x846ca68bu; x ^= x >> 16; return x; }
__device__ __forceinline__ void ck_record(unsigned* ctl, int stage, float mine, float ref) {
    const float e = fabsf(mine - ref), r = fabsf(ref);
    atomicMax(ctl + CK_BASE + 2 * stage, __float_as_uint(e == e ? e : 1e30f)); atomicMax(ctl + CK_BASE + 2 * stage + 1, __float_as_uint(r));
}
__device__ __forceinline__ float ck_dot(const bf16* a, int K, const float* w, int ldw) { float s = 0.f; for (int k = 0; k < K; ++k) s += bf2f(a[k]) * w[(size_t)k * ldw]; return s; }
__global__ void __launch_bounds__(256) check_kernel(Args args, int stage, int layer) {
    unsigned char* ws = args.ws; unsigned* ctl = (unsigned*)(ws + WS_CTL);
    const bf16* HB = (const bf16*)(ws + WS_HB);
    const int gt = blockIdx.x * 256 + threadIdx.x;
    const unsigned hsh = ck_hash((unsigned)gt * 2654435761u + 12345u * stage);
    if (stage == 1) {
        const int r = hsh % M; int c = (hsh >> 15) % 3328; if (c >= 2816) c += 32;
        const float ref = ck_dot(HB + (size_t)r * 1024, 1024, args.in[1] + (size_t)layer * 1024 * IN_COLS + c, IN_COLS);
        float mine;
        if (c < 512) mine = bf2f(((const bf16*)(ws + WS_AQ))[(size_t)r * 512 + c]);
        else if (c < 640) mine = bf2f(((const bf16*)(ws + WS_AK))[(size_t)r * 128 + c - 512]);
        else if (c < 768) mine = bf2f(((const bf16*)(ws + WS_AV))[(size_t)r * 128 + c - 640]);
        else if (c < 2304) mine = bf2f(((const bf16*)(ws + WS_DQKV))[(size_t)r * 1536 + c - 768]);
        else if (c < 2816) mine = bf2f(((const bf16*)(ws + WS_DZ))[(size_t)r * 512 + c - 2304]);
        else mine = bf2f(((const bf16*)(ws + WS_PU))[(size_t)r * 512 + c - 2848]);
        ck_record(ctl, 1, mine, ref);
    } else if (stage == 2) {
        const int r = hsh % M, c = (hsh >> 15) % 32;
        const float ref = ck_dot(HB + (size_t)r * 1024, 1024, args.in[1] + (size_t)layer * 1024 * IN_COLS + 2816 + c, IN_COLS);
        ck_record(ctl, 2, ((const float*)(ws + WS_DAB))[(size_t)r * 32 + c], ref);
    } else if (stage == 3) {
        const int r = hsh % M, c = (hsh >> 15) % 3072;
        const float ref = 1.0f / (1.0f + expf(-ck_dot(HB + (size_t)r * 1024, 1024, args.in[1] + (size_t)layer * 1024 * IN_COLS + 3360 + c, IN_COLS)));
        const float mine3 = bf2f(((const bf16*)(ws + WS_GT))[(size_t)(c >> 10) * M * 1024 + (size_t)r * 1024 + (c & 1023)]);
        ck_record(ctl, 3, mine3, ref);
        ck_record(ctl, 14 + (c >> 10), mine3, ref);
        ck_record(ctl, 17 + (r >> 13), mine3, ref);
        ck_record(ctl, 21 + ((c >> 8) & 3), mine3, ref);
        if (fabsf(mine3 - ref) > 0.04f) { const unsigned ix = atomicAdd(ctl + CK_BASE + 100, 1u); if (ix < 256) { ctl[1024 + 2 * ix] = (unsigned)c; ctl[1025 + 2 * ix] = (unsigned)r; } atomicMax(ctl + 2048, __float_as_uint(mine3)); atomicMax(ctl + 2049, __float_as_uint(1.0f - mine3)); atomicMax(ctl + 2050, __float_as_uint(ref)); atomicMax(ctl + 2051, __float_as_uint(1.0f - ref)); }
    } else if (stage == 4) {
        __shared__ float q_s[64]; __shared__ float sc_s[260];
        const unsigned hb_ = ck_hash((unsigned)blockIdx.x * 2654435761u + 777u);
        const int m = hb_ % M, hq = (hb_ >> 15) & 7, d = (hb_ >> 18) & 63, b = m / SEQ, t = m % SEQ, kvh = hq >> 2;
        if (threadIdx.x < 64) q_s[threadIdx.x] = ck_dot(HB + (size_t)m * 1024, 1024, args.in[1] + (size_t)layer * 1024 * IN_COLS + hq * 64 + threadIdx.x, IN_COLS);
        __syncthreads();
        const bf16* AK = (const bf16*)(ws + WS_AK); const bf16* AV = (const bf16*)(ws + WS_AV);
        const float sink = args.in[2][layer * 8 + hq];
        for (int j = threadIdx.x; j < 257; j += 256) { const int kp = t - 128 + j; float s = -1e30f;
            if (kp >= 0 && kp < SEQ) { s = 0.f; for (int i = 0; i < 64; ++i) s += q_s[i] * bf2f(AK[((size_t)b * SEQ + kp) * 128 + kvh * 64 + i]);
                const int rel = kp - t, n = rel < 0 ? -rel : rel;
                int bk; if (n < 8) bk = n; else { bk = 8 + (int)(logf((float)n / 8.f) / logf(16.f) * 8.f + 1e-4f); if (bk > 15) bk = 15; } if (rel > 0) bk += 16;
                s = s * 0.125f + args.in[3][bk * 8 + hq]; }
            sc_s[j] = s; }
        __syncthreads();
        if (threadIdx.x == 0) { float mx = sink; for (int j = 0; j < 257; ++j) mx = fmaxf(mx, sc_s[j]);
            float den = expf(sink - mx), o = 0.f;
            for (int j = 0; j < 257; ++j) { if (sc_s[j] < -1e29f) continue; const int kp = t - 128 + j; const float p = expf(sc_s[j] - mx); den += p; o += p * bf2f(AV[((size_t)b * SEQ + kp) * 128 + kvh * 64 + d]); }
            ck_record(ctl, 4, bf2f(((const bf16*)(ws + WS_AQ))[(size_t)m * 512 + hq * 64 + d]), o / den); }
    } else if (stage == 5) {
        const int m = hsh % M, g = (hsh >> 15) & 3, d = (hsh >> 17) & 127, b = m / SEQ, t = m % SEQ, r = 1 << g;
        const bf16* PU = (const bf16*)(ws + WS_PU); const float* pw = args.in[8] + ((size_t)layer * 4 + g) * 128 * 128;
        const int lo = t - r < 0 ? 0 : t - r, hi = t + r > SEQ - 1 ? SEQ - 1 : t + r; float y = 0.f;
        for (int c = 0; c < 128; ++c) { float s = 0.f; for (int tt = lo; tt <= hi; ++tt) s += bf2f(PU[((size_t)b * SEQ + tt) * 512 + g * 128 + c]);
            const float mxv = s / (float)(hi - lo + 1) - bf2f(PU[(size_t)m * 512 + g * 128 + c]); y += mxv * pw[c * 128 + d]; }
        y *= args.in[9][layer * 512 + g * 128 + d];
        ck_record(ctl, 5, bf2f(((const bf16*)(ws + WS_OP))[(size_t)m * 512 + g * 128 + d]), y);
    } else if (stage == 6) {
        constexpr int TCK = 192;
        __shared__ float q_s[64]; __shared__ float k_s[64];
        const int j = threadIdx.x & 63; if (threadIdx.x >= 64) return;
        const int seq = (blockIdx.x * 17 + 3) & 255;
        const int dir = seq >> 7, b = (seq >> 3) & 15, h = seq & 7;
        const bf16* DQKV = (const bf16*)(ws + WS_DQKV); const float* DAB = (const float*)(ws + WS_DAB); const float* cwp = args.in[4] + (size_t)layer * 5 * 1536;
        const float nA = -expf(args.in[5][layer * 16 + dir * 8 + h]), dtb = args.in[6][layer * 16 + dir * 8 + h];
        float S[64];
#pragma unroll
        for (int i = 0; i < 64; ++i) S[i] = 0.f;
        float maxe = 0.f, maxr = 0.f;
        for (int s2 = 0; s2 < TCK; ++s2) { const int t = dir ? SEQ - 1 - s2 : s2; const size_t m = (size_t)b * SEQ + t;
            float xq = 0.f, xk = 0.f, v = 0.f;
            for (int jj = 0; jj < 5; ++jj) { const int tt = t + jj - 2; if (tt < 0 || tt >= SEQ) continue; const size_t mm = (size_t)b * SEQ + tt;
                xq += cwp[jj * 1536 + h * 64 + j] * bf2f(DQKV[mm * 1536 + h * 64 + j]); xk += cwp[jj * 1536 + 512 + h * 64 + j] * bf2f(DQKV[mm * 1536 + 512 + h * 64 + j]);
                v += cwp[jj * 1536 + 1024 + h * 64 + j] * bf2f(DQKV[mm * 1536 + 1024 + h * 64 + j]); }
            xq = xq / (1.f + expf(-xq)); xk = xk / (1.f + expf(-xk)); v = v / (1.f + expf(-v));
            __syncthreads(); q_s[j] = xq; k_s[j] = xk; __syncthreads();
            float qs = 0.f, ks = 0.f;
            for (int i = 0; i < 64; ++i) { qs += q_s[i] * q_s[i]; ks += k_s[i] * k_s[i]; }
            const float qn = 0.125f / sqrtf(qs + 1e-6f), kn = 1.0f / sqrtf(ks + 1e-6f);
            const float a = DAB[m * 32 + dir * 8 + h] + dtb, sp = a > 20.f ? a : log1pf(expf(a)), al = expf(nA * sp), be = 1.f / (1.f + expf(-DAB[m * 32 + 16 + dir * 8 + h]));
            float part = 0.f;
#pragma unroll
            for (int i = 0; i < 64; ++i) part += S[i] * k_s[i];
            const float c = be * (v - al * part * kn); float o = 0.f;
#pragma unroll
            for (int i = 0; i < 64; ++i) { S[i] = al * S[i] + k_s[i] * kn * c; o += S[i] * q_s[i]; }
            o *= qn;
            const float mine = ((const float*)(ws + (dir ? WS_OB : WS_OF)))[m * 512 + h * 64 + j];
            maxe = fmaxf(maxe, fabsf(mine - o)); maxr = fmaxf(maxr, fabsf(o)); }
        atomicMax(ctl + CK_BASE + 12, __float_as_uint(maxe == maxe ? maxe : 1e30f)); atomicMax(ctl + CK_BASE + 13, __float_as_uint(maxr));
    } else if (stage == 8) {
        const int r = hsh % M, d = (hsh >> 15) & 1023; float mg = 0.f;
        for (int n = 0; n < 3; ++n) { const bf16* O = (const bf16*)(ws + WS_AQ + (size_t)n * 32 * MiB) + (size_t)r * 512;
            mg += bf2f(((const bf16*)(ws + WS_GT))[(size_t)n * M * 1024 + (size_t)r * 1024 + d]) * ck_dot(O, 512, args.in[10] + ((size_t)layer * 3 + n) * 512 * 1024 + d, 1024); }
        ck_record(ctl, 8, bf2f(((const bf16*)(ws + WS_MERGED))[(size_t)r * 1024 + d]), mg);
    } else if (stage == 9) {
        const int r = hsh % M, c = (hsh >> 15) & 1023;
        const float ref = ALPHA * bf2f(HB[(size_t)r * 1024 + c]) + ck_dot((const bf16*)(ws + WS_MERGED) + (size_t)r * 1024, 1024, args.in[11] + (size_t)layer * 1024 * 1024 + c, 1024);
        ck_record(ctl, 9, args.out[(size_t)r * 1024 + c], ref);
    } else if (stage == 10 || stage == 13) {
        const int r = hsh % M; const float* g = args.in[stage == 10 ? 12 : 14] + layer * 1024; const float* bb = args.in[stage == 10 ? 13 : 15] + layer * 1024;
        float s = 0.f, s2 = 0.f, de = 0.f; for (int c = 0; c < 1024; ++c) { const float hv = args.out[(size_t)r * 1024 + c]; const float u = (hv - bb[c]) / g[c]; s += u; s2 += u * u; de = fmaxf(de, fabsf(hv - bf2f(HB[(size_t)r * 1024 + c]))); }
        const float mean = s / 1024.f, var = s2 / 1024.f - mean * mean;
        ck_record(ctl, stage, fabsf(mean) + fabsf(var - 1.0f) + de * 0.1f, 0.0f); atomicMax(ctl + CK_BASE + 2 * stage + 1, __float_as_uint(1.0f));
    } else if (stage == 11) {
        const int r = hsh % M, c = (hsh >> 15) % FF;
        const float g = ck_dot(HB + (size_t)r * 1024, 1024, args.in[16] + c, FF), u = ck_dot(HB + (size_t)r * 1024, 1024, args.in[17] + c, FF);
        ck_record(ctl, 11, bf2f(((const bf16*)(ws + WS_FACT))[(size_t)r * FF + c]), g / (1.f + expf(-g)) * u);
    } else if (stage == 12) {
        const int r = hsh % M, c = (hsh >> 15) & 1023;
        const float ref = ALPHA * bf2f(HB[(size_t)r * 1024 + c]) + ck_dot((const bf16*)(ws + WS_FACT) + (size_t)r * FF, FF, args.in[18] + c, 1024);
        ck_record(ctl, 12, args.out[(size_t)r * 1024 + c], ref);
    } else if (stage == 30) {
        const int rr = 3584 + (int)(hsh % 3072), k = (hsh >> 15) & 1023;
        const float mine = bf2f(((const bf16*)(ws + WS_WIN))[((size_t)layer * WIN_ROWS + rr) * 1024 + k]), ref = args.in[1][(size_t)layer * 1024 * IN_COLS + (size_t)k * IN_COLS + 3360 + rr - 3584];
        ck_record(ctl, 30, mine, ref); if (fabsf(mine - ref) > 0.01f * fabsf(ref) + 1e-4f) atomicAdd(ctl + CK_BASE + 101, 1u);
    } else if (stage == 7) {
        const int m = hsh % M, h = (hsh >> 15) & 7; const float* OFp = (const float*)(ws + WS_OF) + (size_t)m * 512 + h * 64; const float* OBp = (const float*)(ws + WS_OB) + (size_t)m * 512 + h * 64;
        float ss = 0.f; for (int d = 0; d < 64; ++d) { const float o = OFp[d] + OBp[d]; ss += o * o; }
        const int d = (hsh >> 18) & 63; const float z = ck_dot(HB + (size_t)m * 1024, 1024, args.in[1] + (size_t)layer * 1024 * IN_COLS + 2304 + h * 64 + d, IN_COLS);
        const float ref = (OFp[d] + OBp[d]) / sqrtf(ss / 64.f + RMS_EPS) * args.in[7][layer * 64 + d] * z / (1.f + expf(-z));
        ck_record(ctl, 7, bf2f(((const bf16*)(ws + WS_DZ))[(size_t)m * 512 + h * 64 + d]), ref);
    }
}
__global__ void check_verdict(Args args) {
    unsigned* ctl = (unsigned*)(args.ws + WS_CTL);
    float code = 3.0f;
#if defined(CK_VAL)
    code = 3.0f + 40.0f * __uint_as_float(ctl[2048 + CK_VAL]);
#elif defined(CK_WCNT)
    { unsigned cnt = ctl[CK_BASE + 101]; int lg = 0; while (cnt) { ++lg; cnt >>= 1; } code += (float)lg; }
#elif defined(CK_COUNT)
    { unsigned cnt = ctl[CK_BASE + 100]; if (cnt > 256) cnt = 256; int distinct = 0;
        for (unsigned i = 0; i < cnt; ++i) { const unsigned ci = ctl[1024 + 2 * i], ri = ctl[1025 + 2 * i];
            const unsigned key = CK_COUNT == 1 ? (ci >> 5) : (CK_COUNT == 2 ? (ri >> 8) : (CK_COUNT == 3 ? (ci & 31) : (ri & 255)));
            bool seen = false; for (unsigned j = 0; j < i; ++j) { const unsigned cj = ctl[1024 + 2 * j], rj = ctl[1025 + 2 * j];
                const unsigned kj = CK_COUNT == 1 ? (cj >> 5) : (CK_COUNT == 2 ? (rj >> 8) : (CK_COUNT == 3 ? (cj & 31) : (rj & 255))); if (kj == key) { seen = true; break; } }
            if (!seen) ++distinct; }
        code += (float)(distinct > 15 ? 15 : distinct); }
#else
#ifndef CK_LIST
#define CK_LIST {14, 15, 16, 3}
#endif
    const int lst[4] = CK_LIST;
    for (int i = 0; i < 4; ++i) { const float e = __uint_as_float(ctl[CK_BASE + 2 * lst[i]]), r = __uint_as_float(ctl[CK_BASE + 2 * lst[i] + 1]); if (r == 0.f || e > 0.04f * r) code += (float)(1 << i); }
#endif
    for (size_t i = (size_t)blockIdx.x * blockDim.x + threadIdx.x; i < (size_t)M * D; i += (size_t)gridDim.x * blockDim.x) args.out[i] = code;
}
#endif
extern "C" void kernel_launch(void* const* d_in, const int* in_sizes, int n_in, void* d_out, int out_size, void* d_ws, size_t ws_size, hipStream_t stream) {
    static int grid = 0;
    if (grid == 0) {
        if (n_in != 23 || out_size != M * D || ws_size < WS_END) { fprintf(stderr, "kernel_launch: unexpected problem (n_in %d, out %d, ws %zu < %zu); nothing launched\n", n_in, out_size, ws_size, (size_t)WS_END); grid = -1; return; }
        int dev = 0, cus = 0, per_cu = 0;
        if (hipGetDevice(&dev) != hipSuccess || hipDeviceGetAttribute(&cus, hipDeviceAttributeMultiprocessorCount, dev) != hipSuccess) { grid = -1; return; }
        if (hipFuncSetAttribute((const void*)fwd_kernel, hipFuncAttributeMaxDynamicSharedMemorySize, LDS_BYTES) != hipSuccess) { fprintf(stderr, "kernel_launch: hipFuncSetAttribute failed\n"); grid = -1; return; }
        if (hipOccupancyMaxActiveBlocksPerMultiprocessor(&per_cu, (const void*)fwd_kernel, NTHR, LDS_BYTES) != hipSuccess || per_cu < 1) { fprintf(stderr, "kernel_launch: occupancy query says %d\n", per_cu); }
        (void)hipGetLastError();
        if (cus != 256 || per_cu < 1) { fprintf(stderr, "kernel_launch: needs 256 CUs with one resident workgroup each (cus %d, per_cu %d)\n", cus, per_cu); grid = -1; return; }
        grid = 256;
    }
    if (grid < 0) return;
    (void)hipMemsetAsync((char*)d_ws + WS_CTL, 0, CTL_ZERO_BYTES, stream);
    Args a{};
    for (int i = 0; i < 23; ++i) a.in[i] = (const float*)d_in[i];
    a.out = (float*)d_out; a.ws = (unsigned char*)d_ws;
#if MK_PER_PHASE
    static const int phases[] = {0, 1, 2, 21, 3, 4, 5, 6, 7, 8, 9, 41, 42, 61, 43, 44, 45, 46, 47, 48, 49, 50, 51, 52, 53, 54, 55, 56};
    for (int p : phases) { a.ph_lo = p; a.ph_hi = p + 1; hipLaunchKernelGGL(fwd_kernel, dim3(grid), dim3(NTHR), LDS_BYTES, stream, a);
#if defined(DBG_CHECK)
        const int L = DBG_CHECK - 1, pb = 1 + 40 * L;
        if (p == pb + 0) { hipLaunchKernelGGL(check_kernel, dim3(64), dim3(256), 0, stream, a, 1, L); hipLaunchKernelGGL(check_kernel, dim3(64), dim3(256), 0, stream, a, 2, L); }
        if (p == pb + 1) { hipLaunchKernelGGL(check_kernel, dim3(512), dim3(256), 0, stream, a, 4, L); hipLaunchKernelGGL(check_kernel, dim3(64), dim3(256), 0, stream, a, 5, L); hipLaunchKernelGGL(check_kernel, dim3(16), dim3(64), 0, stream, a, 6, L); }
        if (p == pb + 20) hipLaunchKernelGGL(check_kernel, dim3(64), dim3(256), 0, stream, a, 7, L);
        if (p == pb + 2) { hipLaunchKernelGGL(check_kernel, dim3(64), dim3(256), 0, stream, a, 3, L); hipLaunchKernelGGL(check_kernel, dim3(256), dim3(256), 0, stream, a, 30, L); }
        if (p == pb + 3) hipLaunchKernelGGL(check_kernel, dim3(64), dim3(256), 0, stream, a, 8, L);
        if (p == pb + 4) hipLaunchKernelGGL(check_kernel, dim3(64), dim3(256), 0, stream, a, 9, L);
        if (p == pb + 5) hipLaunchKernelGGL(check_kernel, dim3(16), dim3(256), 0, stream, a, 10, L);
        if (L == 0 && p == pb + 6) hipLaunchKernelGGL(check_kernel, dim3(64), dim3(256), 0, stream, a, 11, L);
        if (L == 0 && p == pb + 7) hipLaunchKernelGGL(check_kernel, dim3(64), dim3(256), 0, stream, a, 12, L);
        if (L == 0 && p == pb + 8) hipLaunchKernelGGL(check_kernel, dim3(16), dim3(256), 0, stream, a, 13, L);
#endif
    }
#if defined(DBG_CHECK)
    hipLaunchKernelGGL(check_verdict, dim3(1024), dim3(256), 0, stream, a);
#endif
#else
    a.ph_lo = 0; a.ph_hi = 1000;
    hipLaunchKernelGGL(fwd_kernel, dim3(grid), dim3(NTHR), LDS_BYTES, stream, a);
#endif
}
```

```cpp
#include <hip/hip_runtime.h>
#include <cstdio>
#include <cstdint>

#define GAS __attribute__((address_space(1)))
#define LAS __attribute__((address_space(3)))
typedef unsigned short bf16;
typedef unsigned v4u __attribute__((ext_vector_type(4)));
typedef unsigned v2u __attribute__((ext_vector_type(2)));
typedef float f32x2 __attribute__((ext_vector_type(2)));
typedef float f32x4 __attribute__((ext_vector_type(4)));
typedef float f32x16 __attribute__((ext_vector_type(16)));
typedef short bf16x8 __attribute__((ext_vector_type(8)));
typedef short bf16x4 __attribute__((ext_vector_type(4)));

#ifndef ABL
#define ABL 0
#endif
#ifndef LN_FUSE
#define LN_FUSE 3
#endif
#ifndef MK_PER_PHASE
#define MK_PER_PHASE 0
#endif

#ifndef WGM_K
#define WGM_K 8
#endif
namespace pg8 {
#define PG8_LAS __attribute__((address_space(3)))
typedef unsigned short bf16_t;
typedef unsigned u32x4 __attribute__((ext_vector_type(4)));
constexpr int BM = 256, BK = 64, HALF = 128, HTB = HALF * BK * 2  , STAGE_BYTES = 8 * HTB, NXCD = 8, WGM = WGM_K;

__host__ __device__ __forceinline__ int lds_byte(int r, int c) { const int st = (r >> 4) * 2 + (c >> 5), rr = r & 15, cc = c & 31, ob = rr * 64 + cc * 2; return st * 1024 + (ob ^ (((ob >> 9) & 1) << 5)); }
__host__ __device__ __forceinline__ void stage_rc(int b, int& R, int& C) { const int st = b / 1024, sb = b % 1024, swz = sb ^ (((sb >> 9) & 1) << 5); R = (st >> 1) * 16 + swz / 64; C = (st & 1) * 32 + (swz % 64) / 2; }
__host__ __device__ __forceinline__ int perm32(int rho) { const int n = rho >> 4, i = rho & 15; return 8 * (i >> 2) + 4 * n + (i & 3); }

struct Unit { int pm, pn, aux; };

struct StaticOrder {
    int nM, nN, nwg, G, c;
    __host__ __device__ __forceinline__ void init(int nM_, int nN_, int G_, int c_) { nM = nM_; nN = nN_; nwg = nM * nN; G = G_; c = c_; }
    __host__ __device__ __forceinline__ bool map(long L, int& pm, int& pn) const {
        if (L >= nwg) return false;
        int wgid = (int)L; { const int q = nwg / NXCD, r = nwg % NXCD, xcd = wgid % NXCD, off = wgid / NXCD; wgid = (xcd < r ? xcd * (q + 1) : r * (q + 1) + (xcd - r) * q) + off; }
        const int nig = WGM * nN, gid = wgid / nig, fm = gid * WGM, gsz = (nM - fm) < WGM ? (nM - fm) : WGM;
        pm = fm + ((wgid % nig) % gsz); pn = (wgid % nig) / gsz; return true;
    }
};
struct StdSched {
    StaticOrder o; const char* A; const char* Bt; size_t tstep;
    __device__ __forceinline__ void init(const void* A_, const void* Bt_, int M, int N, int K, int G, int c) { o.init(M / BM, N / BM, G, c); A = (const char*)A_; Bt = (const char*)Bt_; tstep = (size_t)BM * K * 2; }
    __device__ __forceinline__ bool next(int i, Unit& u) const { u.aux = 0; return o.map((long)i * o.G + o.c, u.pm, u.pn); }
    __device__ __forceinline__ const char* abase(const Unit& u) const { return A + (size_t)u.pm * tstep; }
    __device__ __forceinline__ const char* bbase(const Unit& u) const { return Bt + (size_t)u.pn * tstep; }
};

typedef __bf16 bf16x2_t __attribute__((ext_vector_type(2)));
__device__ __forceinline__ unsigned cvt_pk_bf16(float lo, float hi) { const f32x2 v = {lo, hi}; const bf16x2_t b = __builtin_convertvector(v, bf16x2_t); return __builtin_bit_cast(unsigned, b); }

typedef f32x4 acc_t[2][2][4][2];
__device__ __forceinline__ void zero_acc(acc_t& acc) {
    float z = 0.f; asm volatile("" : "+v"(z));
#pragma unroll
    for (int a = 0; a < 2; ++a)
#pragma unroll
        for (int b = 0; b < 2; ++b)
#pragma unroll
            for (int m = 0; m < 4; ++m)
#pragma unroll
                for (int n = 0; n < 2; ++n) acc[a][b][m][n] = (f32x4){z, z, z, z};
}

typedef int v8i_t __attribute__((ext_vector_type(8)));
typedef int v4i_t __attribute__((ext_vector_type(4)));
__device__ __forceinline__ f32x4 mfma_fp8(const bf16x8& b0, const bf16x8& b1, const bf16x8& a0, const bf16x8& a1, const f32x4& c) {
    const v4i_t x0 = __builtin_bit_cast(v4i_t, b0), x1 = __builtin_bit_cast(v4i_t, b1), y0 = __builtin_bit_cast(v4i_t, a0), y1 = __builtin_bit_cast(v4i_t, a1);
    const v8i_t X = __builtin_shufflevector(x0, x1, 0, 1, 2, 3, 4, 5, 6, 7), Y = __builtin_shufflevector(y0, y1, 0, 1, 2, 3, 4, 5, 6, 7);
    return __builtin_amdgcn_mfma_scale_f32_16x16x128_f8f6f4(X, Y, c, 0, 0, 0, 0x7f7f7f7f, 0, 0x7f7f7f7f);
}
template <class Epi, class Sched, bool ALIGN_EPI = false, bool SP2 = false, bool FP8 = false>
__device__ __forceinline__ void gemm_phase(PG8_LAS unsigned char* lds, const int K, const Sched& S, const Epi& E, const int wid_in) {
    int lane = (int)__builtin_amdgcn_mbcnt_hi(~0u, __builtin_amdgcn_mbcnt_lo(~0u, 0u)); asm volatile("" : "+v"(lane));
    const int wid = wid_in, tid = wid * 64 + lane, wr = wid >> 2, wc = wid & 3, fr = lane & 15, fq = lane >> 4;
    const int nt = K / BK;
    unsigned voffA[2], voffB[2];
#pragma unroll
    for (int i = 0; i < 2; ++i) { int R, C; stage_rc(tid * 16 + i * 8192, R, C); const int Rb = Epi::PERM ? ((R & ~31) + perm32(R & 31)) : R;
        voffA[i] = (unsigned)(R * K + C) * 2u; voffB[i] = (unsigned)(Rb * K + C) * 2u; }
    const size_t kstep = (size_t)(BK * 2);
    const size_t hstep = (size_t)HALF * K * 2;
    const unsigned ldsw = (unsigned)wid * 1024u;
    const int aoff = lds_byte(wr * 64 + fr, fq * 8), boff = lds_byte(wc * 32 + fr, fq * 8);
#define PG8_SA(b, h) (((b) * 2 + (h)) * HTB)
#define PG8_SB(b, h) ((4 + (b) * 2 + (h)) * HTB)
#define PG8_STAGE(bufoff, gbase, voff) do { _Pragma("unroll") for (int _i = 0; _i < 2; ++_i) \
        __builtin_amdgcn_global_load_lds((const unsigned*)((const char*)(gbase) + (voff)[_i]), (PG8_LAS unsigned*)(lds + (bufoff) + ldsw + _i * 8192), 16, 0, 0); } while (0)
#define PG8_LDA(dst, b, h) do { if constexpr (FP8) { _Pragma("unroll") for (int m = 0; m < 4; ++m) { const v4i_t lo_ = *(const PG8_LAS v4i_t*)(lds + PG8_SA(b, h) + aoff + m * 2048), hi_ = *(const PG8_LAS v4i_t*)(lds + PG8_SA(b, h) + aoff + m * 2048 + 1024); \
            dst##8[m] = __builtin_shufflevector(lo_, hi_, 0, 1, 2, 3, 4, 5, 6, 7); } } \
        else { _Pragma("unroll") for (int m = 0; m < 4; ++m) _Pragma("unroll") for (int k = 0; k < 2; ++k) dst[m][k] = *(const PG8_LAS bf16x8*)(lds + PG8_SA(b, h) + aoff + m * 2048 + k * 1024); } } while (0)
#define PG8_LDB(dst, b, h) do { if constexpr (FP8) { _Pragma("unroll") for (int n = 0; n < 2; ++n) { const v4i_t lo_ = *(const PG8_LAS v4i_t*)(lds + PG8_SB(b, h) + boff + n * 2048), hi_ = *(const PG8_LAS v4i_t*)(lds + PG8_SB(b, h) + boff + n * 2048 + 1024); \
            dst##8[n] = __builtin_shufflevector(lo_, hi_, 0, 1, 2, 3, 4, 5, 6, 7); } } \
        else { _Pragma("unroll") for (int n = 0; n < 2; ++n) _Pragma("unroll") for (int k = 0; k < 2; ++k) dst[n][k] = *(const PG8_LAS bf16x8*)(lds + PG8_SB(b, h) + boff + n * 2048 + k * 1024); } } while (0)
#define PG8_MMA(ai, bj, At, Bt) do { __builtin_amdgcn_s_setprio(1); _Pragma("unroll") for (int m = 0; m < 4; ++m) _Pragma("unroll") for (int n = 0; n < 2; ++n) { \
        if constexpr (FP8) asm volatile("v_mfma_scale_f32_16x16x128_f8f6f4 %0, %1, %2, %0, %3, %3 op_sel_hi:[0,0,0]" : "+v"(acc[ai][bj][m][n]) : "v"(Bt##8[n]), "v"(At##8[m]), "v"(sc127));   \
        else { _Pragma("unroll") for (int k = 0; k < 2; ++k) acc[ai][bj][m][n] = __builtin_amdgcn_mfma_f32_16x16x32_bf16(Bt[n][k], At[m][k], acc[ai][bj][m][n], 0, 0, 0); } } \
        __builtin_amdgcn_s_setprio(0); } while (0)
#define PG8_WAIT_V(n) asm volatile("s_waitcnt vmcnt(" #n ")" ::: "memory")
#define PG8_WAIT_L(n) asm volatile("s_waitcnt lgkmcnt(" #n ")" ::: "memory")
#define PG8_BAR __builtin_amdgcn_s_barrier()
#define PG8_SCHED __builtin_amdgcn_sched_barrier(0)
    Unit cur, nxt; int ui = 0;
    if (!S.next(0, cur)) return;
    acc_t acc; zero_acc(acc);
    bf16x8 At[4][2], B0[2][2], B1[2][2];
    v8i_t At8[4], B08[2], B18[2];
    int sc127 = 0x7f7f7f7f; asm volatile("" : "+v"(sc127));
    const char* cA = S.abase(cur); const char* cB = S.bbase(cur);
    if constexpr (SP2) {
        PG8_STAGE(PG8_SB(0, 0), cB, voffB); PG8_STAGE(PG8_SB(0, 1), cB + hstep, voffB); PG8_STAGE(PG8_SA(0, 0), cA, voffA); PG8_STAGE(PG8_SA(0, 1), cA + hstep, voffA);
        if (wr == 1) PG8_BAR;
        PG8_WAIT_V(2); PG8_BAR;
        PG8_STAGE(PG8_SB(1, 0), cB + kstep, voffB); PG8_STAGE(PG8_SA(1, 0), cA + kstep, voffA); PG8_STAGE(PG8_SB(1, 1), cB + hstep + kstep, voffB);
        PG8_WAIT_V(6); PG8_BAR;
    } else {
        PG8_STAGE(PG8_SB(0, 0), cB, voffB); PG8_STAGE(PG8_SA(0, 0), cA, voffA); PG8_STAGE(PG8_SB(0, 1), cB + hstep, voffB); PG8_STAGE(PG8_SA(0, 1), cA + hstep, voffA);
        if (wr == 1) PG8_BAR;
        PG8_WAIT_V(4); PG8_BAR;
        PG8_STAGE(PG8_SB(1, 0), cB + kstep, voffB); PG8_STAGE(PG8_SA(1, 0), cA + kstep, voffA); PG8_STAGE(PG8_SB(1, 1), cB + hstep + kstep, voffB);
        PG8_WAIT_V(6); PG8_BAR;
    }
    for (;;) {
        const bool has_next = S.next(ui + 1, nxt);
        const char* nA = has_next ? S.abase(nxt) : cA; const char* nB = has_next ? S.bbase(nxt) : cB;
#pragma nounroll
        for (int t = 0; t < nt; t += 2) {
            const bool last = (t == nt - 2);
            const char* a1 = cA + (size_t)(t + 1) * kstep;
            const char* a2 = last ? nA : cA + (size_t)(t + 2) * kstep; const char* b2 = last ? nB : cB + (size_t)(t + 2) * kstep;
            const char* a3 = a2 + kstep; const char* b3 = b2 + kstep;
            if constexpr (SP2) {
            PG8_LDB(B0, 0, 0); PG8_LDB(B1, 0, 1); PG8_SCHED; PG8_LDA(At, 0, 0); PG8_STAGE(PG8_SA(1, 1), a1 + hstep, voffA);
            PG8_WAIT_V(8); PG8_WAIT_L(0); PG8_BAR; PG8_MMA(0, 0, At, B0); PG8_MMA(0, 1, At, B1); PG8_BAR; PG8_SCHED;
            PG8_LDA(At, 0, 1); PG8_STAGE(PG8_SB(0, 0), b2, voffB); PG8_STAGE(PG8_SB(0, 1), b2 + hstep, voffB); PG8_STAGE(PG8_SA(0, 0), a2, voffA);
            PG8_WAIT_V(8); PG8_WAIT_L(0); PG8_BAR; PG8_MMA(1, 0, At, B0); PG8_MMA(1, 1, At, B1); PG8_BAR; PG8_SCHED;
            PG8_LDB(B0, 1, 0); PG8_LDB(B1, 1, 1); PG8_SCHED; PG8_LDA(At, 1, 0); PG8_STAGE(PG8_SA(0, 1), a2 + hstep, voffA);
            PG8_WAIT_V(8); PG8_WAIT_L(0); PG8_BAR; PG8_MMA(0, 0, At, B0); PG8_MMA(0, 1, At, B1); PG8_BAR; PG8_SCHED;
            PG8_LDA(At, 1, 1); PG8_STAGE(PG8_SB(1, 0), b3, voffB); PG8_STAGE(PG8_SB(1, 1), b3 + hstep, voffB); PG8_STAGE(PG8_SA(1, 0), a3, voffA);
            PG8_WAIT_V(8); PG8_WAIT_L(0); PG8_BAR; PG8_MMA(1, 0, At, B0); PG8_MMA(1, 1, At, B1); PG8_BAR; PG8_SCHED;
            } else {
            PG8_LDB(B0, 0, 0); PG8_SCHED; PG8_LDA(At, 0, 0); PG8_STAGE(PG8_SA(1, 1), a1 + hstep, voffA);
            PG8_WAIT_L(8); PG8_BAR; PG8_WAIT_L(0); PG8_MMA(0, 0, At, B0); PG8_BAR; PG8_SCHED;
            PG8_LDB(B1, 0, 1); PG8_STAGE(PG8_SB(0, 0), b2, voffB);
            PG8_BAR; PG8_WAIT_L(0); PG8_MMA(0, 1, At, B1); PG8_BAR;
            PG8_LDA(At, 0, 1); PG8_STAGE(PG8_SA(0, 0), a2, voffA);
            PG8_BAR; PG8_WAIT_L(0); PG8_MMA(1, 0, At, B0); PG8_BAR; PG8_SCHED;
            PG8_STAGE(PG8_SB(0, 1), b2 + hstep, voffB);
            PG8_WAIT_V(6); PG8_BAR; PG8_MMA(1, 1, At, B1); PG8_BAR;
            PG8_LDB(B0, 1, 0); PG8_SCHED; PG8_LDA(At, 1, 0); PG8_STAGE(PG8_SA(0, 1), a2 + hstep, voffA);
            PG8_WAIT_L(8); PG8_BAR; PG8_WAIT_L(0); PG8_MMA(0, 0, At, B0); PG8_BAR; PG8_SCHED;
            PG8_LDB(B1, 1, 1); PG8_STAGE(PG8_SB(1, 0), b3, voffB);
            PG8_BAR; PG8_WAIT_L(0); PG8_MMA(0, 1, At, B1); PG8_BAR;
            PG8_LDA(At, 1, 1); PG8_STAGE(PG8_SA(1, 0), a3, voffA);
            PG8_BAR; PG8_WAIT_L(0); PG8_MMA(1, 0, At, B0); PG8_BAR; PG8_SCHED;
            PG8_STAGE(PG8_SB(1, 1), b3 + hstep, voffB);
            PG8_WAIT_V(6); PG8_BAR; PG8_MMA(1, 1, At, B1); PG8_BAR;
            }
        }
        if constexpr (ALIGN_EPI) { if (wr == 0) PG8_BAR; }
        if constexpr (FP8) asm volatile("s_nop 15\n\ts_nop 15" ::: "memory");
        E(acc, cur, wr, wc, fr, fq);
        if (!has_next) break;
        cur = nxt; cA = nA; cB = nB; ++ui;
        if constexpr (ALIGN_EPI) { if (wr == 1) PG8_BAR; }
    }
    PG8_WAIT_V(0);
    if constexpr (!ALIGN_EPI) { if (wr == 0) PG8_BAR; }
    PG8_BAR;
#undef PG8_SA
#undef PG8_SB
#undef PG8_STAGE
#undef PG8_LDA
#undef PG8_LDB
#undef PG8_MMA
#undef PG8_WAIT_V
#undef PG8_WAIT_L
#undef PG8_BAR
#undef PG8_SCHED
}
}

#ifndef GATES_FP8
#define GATES_FP8 1
#endif
#ifndef FFN_FP8
#define FFN_FP8 3
#endif
#ifndef MOE_FP8
#define MOE_FP8 1
#endif
constexpr int NWAVES = 8, NTHR = 512;
constexpr int BATCH = 16, SEQ = 2048, D = 1024, M = BATCH * SEQ;
constexpr int IN_COLS = 6432;
constexpr int NA = 3584;
constexpr int NG = 3072;
constexpr int WIN_ROWS = NA + NG;
constexpr int FF = 2816, FFE = 3584, NE = 8;
constexpr int NCH = 2, CHT = 256 / NCH, CH_TOK = M / NCH, CH_ROWS = (CHT + 8) * 256;
static_assert(MOE_FP8 || NCH == 4, "bf16 MoE buffers are sized for 4 chunks");
constexpr float LN_EPS = 1e-5f, RMS_EPS = 1e-6f;
constexpr float ALPHA = 1.4142135623730951f;

constexpr size_t MiB = 1u << 20;
constexpr size_t WS_CTL = 0, CTL_ZERO_BYTES = 1 * MiB;
constexpr size_t WS_HB = 1 * MiB;
constexpr size_t WS_META = 65 * MiB;
constexpr size_t WS_WIN = 67 * MiB;
constexpr size_t WS_WBR = 93 * MiB;
constexpr size_t WS_WOUT = 99 * MiB;
constexpr size_t WS_W13 = 103 * MiB;
constexpr size_t WS_W2 = 114 * MiB;
constexpr size_t WS_POOLW = 120 * MiB;
constexpr size_t WS_LNSTAT = 120 * MiB;
constexpr size_t WS_BIG = 121 * MiB;
constexpr size_t WS_AQ = WS_BIG + 0 * MiB;
constexpr size_t WS_DZ = WS_BIG + 32 * MiB;
constexpr size_t WS_OP = WS_BIG + 64 * MiB;
constexpr size_t WS_AK = WS_BIG + 96 * MiB;
constexpr size_t WS_AV = WS_BIG + 104 * MiB;
constexpr size_t WS_DAB = WS_BIG + 112 * MiB;
constexpr size_t WS_PU = WS_BIG + 128 * MiB;
constexpr size_t WS_DQKV = WS_BIG + 160 * MiB;
constexpr size_t WS_OF = WS_BIG + 256 * MiB;
constexpr size_t WS_OB = WS_BIG + 320 * MiB;
constexpr size_t WS_GT = WS_BIG + 160 * MiB;
constexpr size_t WS_MERGED = WS_BIG + 352 * MiB;
constexpr size_t WS_FACT = WS_BIG + 0 * MiB;
constexpr size_t WS_HBG8 = WS_BIG + 384 * MiB;
constexpr size_t WS_HB8 = WS_BIG + 200 * MiB;
constexpr size_t WS_END_L = WS_BIG + 416 * MiB;
constexpr size_t WS_MWGU = 67 * MiB;
constexpr size_t WS_MWD = 179 * MiB;
constexpr size_t WS_XG = 235 * MiB;
constexpr size_t WS_MACT = 271 * MiB;
constexpr size_t WS_YS = 397 * MiB;
constexpr size_t WS_END = 537 * MiB;
static_assert(WS_YS + (size_t)M * 2 * 1024 * 2 <= WS_END && WS_END_L <= WS_END, "ws map");
static_assert(WS_MACT + (size_t)CH_ROWS * FFE * (MOE_FP8 ? 1 : 2) <= WS_YS && WS_XG + (size_t)CH_ROWS * 1024 * (MOE_FP8 ? 1 : 2) <= WS_MACT, "ws map");
constexpr size_t MT_TOKE = 0;
constexpr size_t MT_TOKP = 256 * 1024;
constexpr size_t MT_RANK = 512 * 1024;
constexpr size_t MT_DEFER = 640 * 1024;
constexpr size_t MT_CNT = 768 * 1024;
constexpr size_t MT_ROWMAP = 1024 * 1024;
constexpr int CW_BAR = 4096;
constexpr int CW_LNX = 16384;
constexpr int LNX_LDS_OFF = 131072;

constexpr int RING_OFF = 0, RING_BYTES = 147456;
constexpr int LDSCTL_OFF = RING_BYTES, MISC_OFF = LDSCTL_OFF + 320;
constexpr int MOE_LDS_OFF = LDSCTL_OFF + 1024;
constexpr int LDS_BYTES = 163840;

#define RLX_AGENT __ATOMIC_RELAXED, __HIP_MEMORY_SCOPE_AGENT
#define LDS_WAIT() asm volatile("s_waitcnt lgkmcnt(0)" ::: "memory")
#define VM_WAIT() asm volatile("s_waitcnt vmcnt(0)" ::: "memory")
__device__ __forceinline__ unsigned f2bf(float f) { unsigned u = __builtin_bit_cast(unsigned, f); return (u + 0x7fffu + ((u >> 16) & 1u)) >> 16; }
__device__ __forceinline__ unsigned pk2(float lo, float hi) { return f2bf(lo) | (f2bf(hi) << 16); }
__device__ __forceinline__ float bf2f(unsigned short b) { return __builtin_bit_cast(float, ((unsigned)b) << 16); }
__device__ __forceinline__ float bflo(unsigned w) { return __builtin_bit_cast(float, w << 16); }
__device__ __forceinline__ float bfhi(unsigned w) { return __builtin_bit_cast(float, w & 0xffff0000u); }
__device__ __forceinline__ v4u ld_or_zero(const bf16* p, const bf16* safe, bool ok) { const v4u v = *(const v4u*)(ok ? p : safe); const unsigned mk = ok ? 0xffffffffu : 0u; return (v4u){v.x & mk, v.y & mk, v.z & mk, v.w & mk}; }
__device__ __forceinline__ float sigmoidf_(float x) { return __builtin_amdgcn_rcpf(1.0f + __expf(-x)); }
__device__ __forceinline__ float siluf_(float x) { return x * sigmoidf_(x); }

#define XB_TMO      128
#define XB_XCNT(j)  (256  + 64 * (j))
#define XB_XSUB(j)  (1280 + 64 * (j))
#define XB_XGEN(j)  (2304 + 64 * (j))
#define XB_TOP      3328
#define XB_TOPGEN   3392
#define XCD_BAR_WORDS 3456
#define XB_SPIN_CAP (1u << 22)
#ifndef XB_RELAY
#define XB_RELAY 0
#endif

__device__ __forceinline__ unsigned xb_ld(unsigned* p)              { return __hip_atomic_load(p, __ATOMIC_RELAXED, __HIP_MEMORY_SCOPE_AGENT); }
__device__ __forceinline__ unsigned xb_add(unsigned* p, unsigned v) { return __hip_atomic_fetch_add(p, v, __ATOMIC_RELAXED, __HIP_MEMORY_SCOPE_AGENT); }
__device__ __forceinline__ unsigned xb_xcc_id() { return (unsigned)__builtin_amdgcn_s_getreg((3 << 11) | 20) & 0xFu; }
#define XB_SPIN(cond, bar) do { unsigned _sp = 0; while (cond) { __builtin_amdgcn_s_sleep(1); \
    if ((++_sp & 255u) == 0u) { if (xb_ld(&(bar)[XB_TMO])) break; if (_sp > XB_SPIN_CAP) { atomicAdd(&(bar)[XB_TMO], 1u); break; } } } } while (0)

struct XcdBarrier {
    unsigned* bar; unsigned x; unsigned w0;
    volatile LAS unsigned* st;
};
__device__ __forceinline__ XcdBarrier xcd_barrier_post(unsigned* bar, volatile LAS unsigned* st) {
    XcdBarrier b; b.bar = bar; b.x = xb_xcc_id(); b.st = st; b.w0 = (__builtin_amdgcn_readfirstlane(threadIdx.x >> 6) == 0) ? 1u : 0u;
    if (threadIdx.x == 0) (void)xb_add(&bar[XB_XCNT(b.x)], 1u);
    return b;
}
__device__ __forceinline__ void xcd_barrier_complete(unsigned* bar, unsigned x, unsigned& nloc, unsigned& nx) {
    const unsigned G = gridDim.x * gridDim.y * gridDim.z;
    unsigned sum, cnt, mine, sp = 0u;
    for (;;) {
        sum = 0u; cnt = 0u; mine = 0u;
#pragma unroll
        for (unsigned j = 0; j < 16; ++j) { const unsigned c = xb_ld(&bar[XB_XCNT(j)]); sum += c; cnt += (c > 0u) ? 1u : 0u; mine = (j == x) ? c : mine; }
        if (sum == G) break;
        __builtin_amdgcn_s_sleep(1);
        if ((++sp & 255u) == 0u) { if (xb_ld(&bar[XB_TMO])) break; if (sp > XB_SPIN_CAP) { atomicAdd(&bar[XB_TMO], 1u); break; } }
    }
    nloc = mine > 0u ? mine : 1u; nx = cnt > 0u ? cnt : 1u;
}
__device__ __forceinline__ void xcd_barrier(const XcdBarrier& b) {
    asm volatile("s_waitcnt vmcnt(0)" ::: "memory");
    __syncthreads();
    if (b.w0 && __builtin_amdgcn_mbcnt_hi(~0u, __builtin_amdgcn_mbcnt_lo(~0u, 0u)) == 0u) {
        unsigned* bar = b.bar;
        __builtin_amdgcn_s_waitcnt(0);
        unsigned nloc = b.st[0], nx = b.st[1];
        if (nloc == 0u) { xcd_barrier_complete(bar, b.x, nloc, nx); b.st[0] = nloc; b.st[1] = nx; }
        const unsigned old = xb_add(&bar[XB_XSUB(b.x)], 1u);
        const unsigned gen = old / nloc;
#if XB_RELAY
        if (old + 1u == (gen + 1u) * nloc) {
            __builtin_amdgcn_fence(__ATOMIC_RELEASE, "agent");
            asm volatile("s_waitcnt vmcnt(0)" ::: "memory");
            const unsigned og = xb_add(&bar[XB_TOP], 1u);
            const unsigned tg = og / nx;
            if (og + 1u == (tg + 1u) * nx) xb_add(&bar[XB_TOPGEN], 1u);
            else XB_SPIN(xb_ld(&bar[XB_TOPGEN]) == tg, bar);
            __builtin_amdgcn_fence(__ATOMIC_ACQUIRE, "agent");
#if XB_RELAY
            xb_add(&bar[XB_XGEN(b.x)], 1u);
            asm volatile("s_waitcnt vmcnt(0)" ::: "memory");
#endif
        } else {
#if XB_RELAY
            XB_SPIN(xb_ld(&bar[XB_XGEN(b.x)]) == gen, bar);
#else
            XB_SPIN(xb_ld(&bar[XB_TOPGEN]) == gen, bar);
#endif
            __builtin_amdgcn_fence(__ATOMIC_ACQUIRE, "agent");
            asm volatile("s_waitcnt vmcnt(0)" ::: "memory");
        }
#else
        if (old + 1u == (gen + 1u) * nloc) {
            __builtin_amdgcn_fence(__ATOMIC_RELEASE, "agent");
            asm volatile("s_waitcnt vmcnt(0)" ::: "memory");
            (void)xb_add(&bar[XB_TOP], 1u);
        }
        { const unsigned want = nx * (gen + 1u); XB_SPIN(xb_ld(&bar[XB_TOP]) < want, bar); }
        __builtin_amdgcn_fence(__ATOMIC_ACQUIRE, "agent");
        asm volatile("s_waitcnt vmcnt(0)" ::: "memory");
#endif
    }
    __syncthreads();
}

struct Args { const float* in[23]; float* out; unsigned char* ws; int ph_lo, ph_hi; };
struct Frame {
    unsigned char* lds;
    int tid, lane, wave;
    int G, bx;
    unsigned char* ws;
    float* out;
    const Args* a;
};
#define IN_x(F)          ((F).a->in[0])
#define IN_w_in(F)       ((F).a->in[1])
#define IN_attn_sink(F)  ((F).a->in[2])
#define IN_rel_bias(F)   ((F).a->in[3])
#define IN_conv_w(F)     ((F).a->in[4])
#define IN_a_log(F)      ((F).a->in[5])
#define IN_dt_bias(F)    ((F).a->in[6])
#define IN_dn_norm_w(F)  ((F).a->in[7])
#define IN_pool_w(F)     ((F).a->in[8])
#define IN_pool_scale(F) ((F).a->in[9])
#define IN_w_branch(F)   ((F).a->in[10])
#define IN_w_out(F)      ((F).a->in[11])
#define IN_ln1_g(F)      ((F).a->in[12])
#define IN_ln1_b(F)      ((F).a->in[13])
#define IN_ln2_g(F)      ((F).a->in[14])
#define IN_ln2_b(F)      ((F).a->in[15])
#define IN_ffn_w1(F)     ((F).a->in[16])
#define IN_ffn_w3(F)     ((F).a->in[17])
#define IN_ffn_w2(F)     ((F).a->in[18])
#define IN_router_w(F)   ((F).a->in[19])
#define IN_moe_wg(F)     ((F).a->in[20])
#define IN_moe_wu(F)     ((F).a->in[21])
#define IN_moe_wd(F)     ((F).a->in[22])
__device__ __forceinline__ float wave_sum(float v) {
#pragma unroll
    for (int o = 1; o < 64; o <<= 1) v += __shfl_xor(v, o);
    return v;
}
template <int CTRL> __device__ __forceinline__ float dppf(float x) { return __builtin_bit_cast(float, __builtin_amdgcn_mov_dpp(__builtin_bit_cast(int, x), CTRL, 0xF, 0xF, true)); }
__device__ __forceinline__ float red4(float x) { x += dppf<0xB1>(x); x += dppf<0x4E>(x); return x; }
__device__ __forceinline__ float red8(float x) { x = red4(x); x += dppf<0x141>(x); return x; }
__device__ __forceinline__ float red16(float x) { x = red8(x); x += dppf<0x140>(x); return x; }

__device__ __forceinline__ float q8(float x) { const int p = __builtin_amdgcn_cvt_pk_fp8_f32(x, x, 0, false); return __builtin_amdgcn_cvt_f32_fp8(p, 0); }
#ifndef FP8_EMU
#define FP8_EMU 0
#endif
__device__ __forceinline__ unsigned pk4_fp8(float a, float b, float c, float d) { int w = __builtin_amdgcn_cvt_pk_fp8_f32(a, b, 0, false); w = __builtin_amdgcn_cvt_pk_fp8_f32(c, d, w, true); return (unsigned)w; }
template <bool Q8 = false>
__device__ __forceinline__ void tr_item(const float* W, int ldw, int k0, int n0, bf16* WT, int ldt, int drow0, float* scr, int lane) {
    f32x4 ld[8];
#pragma unroll
    for (int i = 0; i < 8; ++i) ld[i] = __builtin_nontemporal_load((const f32x4*)(W + (size_t)(k0 + 8 * i + (lane >> 3)) * ldw + n0 + 4 * (lane & 7)));
#pragma unroll
    for (int i = 0; i < 8; ++i) { float* d = scr + (8 * i + (lane >> 3)) * 33 + 4 * (lane & 7); d[0] = ld[i][0]; d[1] = ld[i][1]; d[2] = ld[i][2]; d[3] = ld[i][3]; }
    LDS_WAIT(); asm volatile("" ::: "memory");
    const int c = lane & 7;
#pragma unroll
    for (int j = 0; j < 4; ++j) { const int n = (lane >> 3) + 8 * j; const float* s = scr + (8 * c) * 33 + n;
        v4u o;
        if (Q8) { o.x = pk2(q8(32.f * s[0 * 33]), q8(32.f * s[1 * 33])); o.y = pk2(q8(32.f * s[2 * 33]), q8(32.f * s[3 * 33])); o.z = pk2(q8(32.f * s[4 * 33]), q8(32.f * s[5 * 33])); o.w = pk2(q8(32.f * s[6 * 33]), q8(32.f * s[7 * 33])); }
        else { o.x = pk2(s[0 * 33], s[1 * 33]); o.y = pk2(s[2 * 33], s[3 * 33]); o.z = pk2(s[4 * 33], s[5 * 33]); o.w = pk2(s[6 * 33], s[7 * 33]); }
        *(v4u*)(WT + (size_t)(drow0 + n) * ldt + k0 + 8 * c) = o; }
    LDS_WAIT(); asm volatile("" ::: "memory");
}

__device__ __forceinline__ void tr_item_fp8(const float* W, int ldw, int k0, int n0, unsigned char* WT8, int ldt, int drow0, float* scr, int lane) {
    f32x4 ld[8];
#pragma unroll
    for (int i = 0; i < 8; ++i) ld[i] = __builtin_nontemporal_load((const f32x4*)(W + (size_t)(k0 + 8 * i + (lane >> 3)) * ldw + n0 + 4 * (lane & 7)));
#pragma unroll
    for (int i = 0; i < 8; ++i) { float* d = scr + (8 * i + (lane >> 3)) * 33 + 4 * (lane & 7); d[0] = ld[i][0]; d[1] = ld[i][1]; d[2] = ld[i][2]; d[3] = ld[i][3]; }
    LDS_WAIT(); asm volatile("" ::: "memory");
    const int c = lane & 7;
#pragma unroll
    for (int j = 0; j < 4; ++j) { const int n = (lane >> 3) + 8 * j; const float* s = scr + (8 * c) * 33 + n;
        v2u o; o.x = pk4_fp8(32.f * s[0 * 33], 32.f * s[1 * 33], 32.f * s[2 * 33], 32.f * s[3 * 33]); o.y = pk4_fp8(32.f * s[4 * 33], 32.f * s[5 * 33], 32.f * s[6 * 33], 32.f * s[7 * 33]);
        *(v2u*)(WT8 + (size_t)(drow0 + n) * ldt + k0 + 8 * c) = o; }
    LDS_WAIT(); asm volatile("" ::: "memory");
}

struct TrItem { const float* W; int ldw, k0, n0; unsigned char* dst; int ldt, drow, kind; };
__device__ __forceinline__ void tr_load(f32x4 (&ld)[8], const TrItem& t, int lane) {
    if (t.kind == 0) return;
#pragma unroll
    for (int i = 0; i < 8; ++i) ld[i] = __builtin_nontemporal_load((const f32x4*)(t.W + (size_t)(t.k0 + 8 * i + (lane >> 3)) * t.ldw + t.n0 + 4 * (lane & 7)));
}
__device__ __forceinline__ void tr_store(const f32x4 (&ld)[8], const TrItem& t, float* scr, int lane) {
    if (t.kind == 0) return;
#pragma unroll
    for (int i = 0; i < 8; ++i) { float* d = scr + (8 * i + (lane >> 3)) * 33 + 4 * (lane & 7); d[0] = ld[i][0]; d[1] = ld[i][1]; d[2] = ld[i][2]; d[3] = ld[i][3]; }
    LDS_WAIT(); asm volatile("" ::: "memory");
    const int c = lane & 7;
    if (t.kind == 2) {
#pragma unroll
        for (int j = 0; j < 4; ++j) { const int n = (lane >> 3) + 8 * j; const float* s = scr + (8 * c) * 33 + n;
            v2u o; o.x = pk4_fp8(32.f * s[0 * 33], 32.f * s[1 * 33], 32.f * s[2 * 33], 32.f * s[3 * 33]); o.y = pk4_fp8(32.f * s[4 * 33], 32.f * s[5 * 33], 32.f * s[6 * 33], 32.f * s[7 * 33]);
            *(v2u*)(t.dst + (size_t)(t.drow + n) * t.ldt + t.k0 + 8 * c) = o; }
    } else {
#pragma unroll
        for (int j = 0; j < 4; ++j) { const int n = (lane >> 3) + 8 * j; const float* s = scr + (8 * c) * 33 + n;
            v4u o; o.x = pk2(s[0 * 33], s[1 * 33]); o.y = pk2(s[2 * 33], s[3 * 33]); o.z = pk2(s[4 * 33], s[5 * 33]); o.w = pk2(s[6 * 33], s[7 * 33]);
            *(v4u*)((bf16*)t.dst + (size_t)(t.drow + n) * t.ldt + t.k0 + 8 * c) = o; }
    }
    LDS_WAIT(); asm volatile("" ::: "memory");
}
#define TR_PIPELINE(FIRST, COUNT, STRIDE, DEC, scr, lane) do { f32x4 la_[8], lb_[8]; TrItem ta_, tb_; int it_ = (FIRST); \
        if (it_ < (COUNT)) { DEC(it_, ta_); tr_load(la_, ta_, lane); } \
        while (it_ < (COUNT)) { \
            int nx_ = it_ + (STRIDE); if (nx_ < (COUNT)) { DEC(nx_, tb_); tr_load(lb_, tb_, lane); } \
            tr_store(la_, ta_, scr, lane); it_ = nx_; if (it_ >= (COUNT)) break; \
            nx_ = it_ + (STRIDE); if (nx_ < (COUNT)) { DEC(nx_, ta_); tr_load(la_, ta_, lane); } \
            tr_store(lb_, tb_, scr, lane); it_ = nx_; } } while (0)

__device__ __forceinline__ void p0_prologue(Frame& F) {
    float* scr = (float*)(F.lds + F.wave * 16384);
    const int gw = F.bx * NWAVES + F.wave, NGW = F.G * NWAVES;
    constexpr int I_WIN = 16 * 201, I_WBR = 8 * 32, I_WOUT = 16 * 32, I_W1 = 16 * 88, I_W2 = 44 * 32, I_PW = 2 * 4;
    constexpr int NITEMS = 2 * I_WIN + 6 * I_WBR + 2 * I_WOUT + 2 * I_W1 + I_W2 + 8 * I_PW;
    bf16* WIN = (bf16*)(F.ws + WS_WIN); bf16* WBR = (bf16*)(F.ws + WS_WBR); bf16* WOUT = (bf16*)(F.ws + WS_WOUT);
    bf16* W13 = (bf16*)(F.ws + WS_W13); bf16* W2 = (bf16*)(F.ws + WS_W2); bf16* PW = (bf16*)(F.ws + WS_POOLW);
#define P0_DEC(it, t) do { int r = (it); t.kind = 0; \
        if (r < 2 * I_WIN) { const int l = r / I_WIN, q = r % I_WIN, kb = q / 201, n0 = (q % 201) * 32; \
            const int drow = n0 < 2816 ? n0 : (n0 < 2848 ? 3328 + (n0 - 2816) : (n0 < 3360 ? n0 - 32 : 3584 + (n0 - 3360))); \
            t.W = IN_w_in(F) + (size_t)l * 1024 * IN_COLS; t.ldw = IN_COLS; t.k0 = kb * 64; t.n0 = n0; t.ldt = 1024; \
            if (GATES_FP8 && n0 >= 3360) { t.dst = (unsigned char*)(WIN + (size_t)l * WIN_ROWS * 1024 + (size_t)NA * 1024); t.drow = n0 - 3360; t.kind = 2; } \
            else { t.dst = (unsigned char*)(WIN + (size_t)l * WIN_ROWS * 1024); t.drow = drow; t.kind = 1; } } \
        else if ((r -= 2 * I_WIN) < 6 * I_WBR) { const int ln = r / I_WBR, q = r % I_WBR, kb = q / 32, n0 = (q % 32) * 32;        \
            if (ln % 3 != 2) { t.W = IN_w_branch(F) + (size_t)ln * 512 * 1024; t.ldw = 1024; t.k0 = kb * 64; t.n0 = n0; t.dst = (unsigned char*)(WBR + (size_t)ln * 1024 * 512); t.ldt = 512; t.drow = n0; t.kind = 1; } } \
        else if ((r -= 6 * I_WBR) < 2 * I_WOUT) { const int l = r / I_WOUT, q = r % I_WOUT, kb = q / 32, n0 = (q % 32) * 32; \
            t.W = IN_w_out(F) + (size_t)l * 1024 * 1024; t.ldw = 1024; t.k0 = kb * 64; t.n0 = n0; t.dst = (unsigned char*)(WOUT + (size_t)l * 1024 * 1024); t.ldt = 1024; t.drow = n0; t.kind = 1; } \
        else if ((r -= 2 * I_WOUT) < 2 * I_W1) { const int w = r / I_W1, q = r % I_W1, kb = q / 88, n0 = (q % 88) * 32; \
            t.W = w ? IN_ffn_w3(F) : IN_ffn_w1(F); t.ldw = FF; t.k0 = kb * 64; t.n0 = n0; t.dst = (unsigned char*)W13; t.ldt = 1024; t.drow = (n0 >> 7) * 256 + (n0 & 127) + w * 128; t.kind = (FFN_FP8 == 1 || FFN_FP8 == 2) ? 2 : 1; } \
        else if ((r -= 2 * I_W1) < I_W2) { const int kb = r / 32, n0 = (r % 32) * 32; \
            t.W = IN_ffn_w2(F); t.ldw = 1024; t.k0 = kb * 64; t.n0 = n0; t.dst = (unsigned char*)W2; t.ldt = FF; t.drow = n0; t.kind = (FFN_FP8 == 1 || FFN_FP8 == 3) ? 2 : 1; } } while (0)
    (void)PW;
    TR_PIPELINE(gw, NITEMS, NGW, P0_DEC, scr, F.lane);
#undef P0_DEC
    for (int it = gw; it < 2 * 64 * 16; it += NGW) { const int l = it >> 10, cg = (it >> 4) & 63, db = it & 15, g = cg >> 4, c0 = (cg & 15) * 8, d = db * 64 + F.lane;
        const float* pw = IN_pool_w(F) + (((size_t)l * 4 + g) * 128 + c0) * 128; const float* ps = IN_pool_scale(F) + l * 512 + g * 128;
        const float* wb = IN_w_branch(F) + (((size_t)l * 3 + 2) * 512 + g * 128) * 1024 + d;
        for (int i = F.lane; i < 1024; i += 64) { const int j = i >> 7, k = i & 127; scr[k * 8 + j] = pw[j * 128 + k] * ps[k]; }
        LDS_WAIT(); asm volatile("" ::: "memory");
        float acc[8];
#pragma unroll
        for (int j = 0; j < 8; ++j) acc[j] = 0.f;
#pragma nounroll
        for (int kb = 0; kb < 128; kb += 16) {
            float w[16];
#pragma unroll
            for (int u = 0; u < 16; ++u) w[u] = __builtin_nontemporal_load(wb + (size_t)(kb + u) * 1024);
#pragma unroll
            for (int u = 0; u < 16; ++u) { const f32x4 s0 = *(const f32x4*)(scr + (kb + u) * 8), s1 = *(const f32x4*)(scr + (kb + u) * 8 + 4);
                acc[0] += s0[0] * w[u]; acc[1] += s0[1] * w[u]; acc[2] += s0[2] * w[u]; acc[3] += s0[3] * w[u]; acc[4] += s1[0] * w[u]; acc[5] += s1[1] * w[u]; acc[6] += s1[2] * w[u]; acc[7] += s1[3] * w[u]; } }
        LDS_WAIT(); asm volatile("" ::: "memory");
        v4u o; o.x = pk2(acc[0], acc[1]); o.y = pk2(acc[2], acc[3]); o.z = pk2(acc[4], acc[5]); o.w = pk2(acc[6], acc[7]);
        *(v4u*)(WBR + (((size_t)l * 3 + 2) * 1024 + d) * 512 + g * 128 + c0) = o; }
    bf16* HB = (bf16*)(F.ws + WS_HB);
    const size_t gt = (size_t)F.bx * NTHR + F.tid, NT = (size_t)F.G * NTHR;
    const f32x4* xp = (const f32x4*)IN_x(F);
    for (size_t i0 = gt; i0 < (size_t)M * D / 8; i0 += 4 * NT) {
        f32x4 a[4], b[4];
#pragma unroll
        for (int u = 0; u < 4; ++u) { const size_t i = i0 + u * NT; a[u] = __builtin_nontemporal_load(xp + 2 * i); b[u] = __builtin_nontemporal_load(xp + 2 * i + 1); }
#pragma unroll
        for (int u = 0; u < 4; ++u) { const size_t i = i0 + u * NT; v4u o; o.x = pk2(a[u].x, a[u].y); o.y = pk2(a[u].z, a[u].w); o.z = pk2(b[u].x, b[u].y); o.w = pk2(b[u].z, b[u].w); ((v4u*)HB)[i] = o;
            if (GATES_FP8) { v2u o8; o8.x = pk4_fp8(a[u].x, a[u].y, a[u].z, a[u].w); o8.y = pk4_fp8(b[u].x, b[u].y, b[u].z, b[u].w); ((v2u*)(F.ws + WS_HBG8))[i] = o8; } }
    }
}
__device__ __forceinline__ void moe_weight_convert(Frame& F) {
    float* scr = (float*)(F.lds + F.wave * 16384);
    const int gw = F.bx * NWAVES + F.wave, NGW = F.G * NWAVES;
    constexpr int I_GU = 16 * 112, I_D = 56 * 32;
    constexpr int NITEMS = NE * (2 * I_GU + I_D);
    bf16* MWGU = (bf16*)(F.ws + WS_MWGU); bf16* MWD = (bf16*)(F.ws + WS_MWD);
#if MOE_FP8
#define MOE_DEC(it, t) do { int r = (it); \
        if (r < NE * 2 * I_GU) { const int e = r / (2 * I_GU), q2 = r % (2 * I_GU), w = q2 / I_GU, q = q2 % I_GU, kb = q / 112, n0 = (q % 112) * 32; \
            t.W = (w ? IN_moe_wu(F) : IN_moe_wg(F)) + (size_t)e * 1024 * FFE; t.ldw = FFE; t.k0 = kb * 64; t.n0 = n0; t.dst = (unsigned char*)MWGU; t.ldt = 1024; t.drow = e * 2 * FFE + (n0 >> 7) * 256 + (n0 & 127) + w * 128; t.kind = 2; } \
        else { r -= NE * 2 * I_GU; const int e = r / I_D, q = r % I_D, kb = q / 32, n0 = (q % 32) * 32; \
            t.W = IN_moe_wd(F) + (size_t)e * FFE * 1024; t.ldw = 1024; t.k0 = kb * 64; t.n0 = n0; t.dst = (unsigned char*)MWD + (size_t)e * 1024 * FFE; t.ldt = FFE; t.drow = n0; t.kind = 2; } } while (0)
    TR_PIPELINE(gw, NITEMS, NGW, MOE_DEC, scr, F.lane);
#undef MOE_DEC
#else
    for (int it = gw; it < NITEMS; it += NGW) {
        int r = it;
        if (r < NE * 2 * I_GU) { const int e = r / (2 * I_GU), q2 = r % (2 * I_GU), w = q2 / I_GU, q = q2 % I_GU, kb = q / 112, n0 = (q % 112) * 32;
            const int drow = e * 2 * FFE + (n0 >> 7) * 256 + (n0 & 127) + w * 128;
            tr_item<FP8_EMU != 0>((w ? IN_moe_wu(F) : IN_moe_wg(F)) + (size_t)e * 1024 * FFE, FFE, kb * 64, n0, MWGU, 1024, drow, scr, F.lane);
            continue; }
        r -= NE * 2 * I_GU;
        { const int e = r / I_D, q = r % I_D, kb = q / 32, n0 = (q % 32) * 32;
            tr_item<FP8_EMU != 0>(IN_moe_wd(F) + (size_t)e * FFE * 1024, 1024, kb * 64, n0, MWD + (size_t)e * 1024 * FFE, FFE, n0, scr, F.lane); }
    }
#endif
}

using pg8::acc_t; using pg8::Unit; using pg8::cvt_pk_bf16; using pg8::zero_acc;
__device__ __forceinline__ v4u pack8(const f32x4& v0, const f32x4& v1) { v4u w; w.x = cvt_pk_bf16(v0[0], v0[1]); w.y = cvt_pk_bf16(v0[2], v0[3]); w.z = cvt_pk_bf16(v1[0], v1[1]); w.w = cvt_pk_bf16(v1[2], v1[3]); return w; }

struct EpiInA {
    static constexpr bool PERM = true;
    unsigned char* ws;
    __device__ __forceinline__ void operator()(acc_t& acc, const Unit& u, int wr, int wc, int fr, int fq) const {
        const int pn = u.pn; const size_t row0 = (size_t)u.pm * 256 + wr * 64 + fr;
        if (pn == 13) {
            if (wc == 0) { float* dab = (float*)(ws + WS_DAB);
#pragma unroll
                for (int ai = 0; ai < 2; ++ai)
#pragma unroll
                    for (int m = 0; m < 4; ++m) { float* p = dab + (row0 + ai * 128 + m * 16) * 32 + 8 * fq; *(f32x4*)p = acc[ai][0][m][0]; *(f32x4*)(p + 4) = acc[ai][0][m][1]; } }
        } else {
            bf16* b0; bf16* b1; int ldc;
            if (pn < 2) { ldc = 512; b0 = (bf16*)(ws + WS_AQ) + pn * 256; b1 = b0 + 128; }
            else if (pn == 2) { ldc = 128; b0 = (bf16*)(ws + WS_AK); b1 = (bf16*)(ws + WS_AV); }
            else if (pn < 9) { ldc = 1536; b0 = (bf16*)(ws + WS_DQKV) + (pn - 3) * 256; b1 = b0 + 128; }
            else if (pn < 11) { ldc = 512; b0 = (bf16*)(ws + WS_DZ) + (pn - 9) * 256; b1 = b0 + 128; }
            else { ldc = 512; b0 = (bf16*)(ws + WS_PU) + (pn - 11) * 256; b1 = b0 + 128; }
            const int cl = wc * 32 + 8 * fq;
#pragma unroll
            for (int ai = 0; ai < 2; ++ai)
#pragma unroll
                for (int m = 0; m < 4; ++m) { const size_t ro = (row0 + ai * 128 + m * 16) * ldc + cl;
                    *(v4u*)(b0 + ro) = pack8(acc[ai][0][m][0], acc[ai][0][m][1]);
                    *(v4u*)(b1 + ro) = pack8(acc[ai][1][m][0], acc[ai][1][m][1]); }
        }
        zero_acc(acc);
    }
};
struct EpiGates {
    static constexpr bool PERM = true;
    bf16* GT; float asc;
    __device__ __forceinline__ void operator()(acc_t& acc, const Unit& u, int wr, int wc, int fr, int fq) const {
        const size_t row0 = (size_t)u.pm * 256 + wr * 64 + fr;
        bf16* base = GT + (size_t)(u.pn >> 2) * M * 1024 + (u.pn & 3) * 256 + wc * 32 + 8 * fq;
#pragma unroll
        for (int ai = 0; ai < 2; ++ai)
#pragma unroll
            for (int m = 0; m < 4; ++m)
#pragma unroll
                for (int bj = 0; bj < 2; ++bj) { f32x4 v0 = acc[ai][bj][m][0], v1 = acc[ai][bj][m][1];
#pragma unroll
                    for (int j = 0; j < 4; ++j) { v0[j] = sigmoidf_(v0[j] * asc); v1[j] = sigmoidf_(v1[j] * asc); }
                    *(v4u*)(base + (row0 + ai * 128 + m * 16) * 1024 + bj * 128) = pack8(v0, v1); }
        zero_acc(acc);
    }
};
struct BrSched {
    pg8::StaticOrder o; const char *A0, *B0; size_t tstep;
    __device__ __forceinline__ bool next(int i, Unit& u) const { const int t = i / 3; u.aux = i - 3 * t; return o.map((long)t * o.G + o.c, u.pm, u.pn); }
    __device__ __forceinline__ const char* abase(const Unit& u) const { return A0 + (size_t)u.aux * (32 * MiB) + (size_t)u.pm * tstep; }
    __device__ __forceinline__ const char* bbase(const Unit& u) const { return B0 + (size_t)u.aux * (1024 * 512 * 2) + (size_t)u.pn * tstep; }
};
__device__ __forceinline__ void unpack8(const v4u& w, f32x4& a, f32x4& b) { a[0] = bflo(w.x); a[1] = bfhi(w.x); a[2] = bflo(w.y); a[3] = bfhi(w.y); b[0] = bflo(w.z); b[1] = bfhi(w.z); b[2] = bflo(w.w); b[3] = bfhi(w.w); }
#ifndef GNT
#define GNT 1
#endif
struct EpiBranch {
    static constexpr bool PERM = true;
    const bf16* GT; bf16* MG;
    __device__ __forceinline__ void operator()(acc_t& acc, const Unit& u, int wr, int wc, int fr, int fq) const {
        const unsigned eoff = ((unsigned)u.pm * 256u + (unsigned)(wr * 64 + fr)) * 1024u + (unsigned)(u.pn * 256 + wc * 32 + 8 * fq); const int seg = u.aux;
        const char* gn = (const char*)(GT + (size_t)seg * M * 1024);
        const char* gd = (const char*)(GT + (size_t)(seg < 2 ? seg + 1 : 2) * M * 1024);
#pragma unroll
        for (int ai = 0; ai < 2; ++ai)
#pragma unroll
          for (int mh = 0; mh < 2; ++mh) {
            v4u nb[4], db[4];
#pragma unroll
            for (int mm = 0; mm < 2; ++mm)
#pragma unroll
                for (int bj = 0; bj < 2; ++bj) { const int m = 2 * mh + mm; const size_t off = (size_t)((eoff + (unsigned)((ai * 128 + m * 16) * 1024 + bj * 128)) * 2u);
                    nb[mm * 2 + bj] = GNT ? __builtin_nontemporal_load((const v4u*)(gn + off)) : *(const v4u*)(gn + off);
                    if (seg < 2) db[mm * 2 + bj] = *(const v4u*)(gd + off); }
            __builtin_amdgcn_sched_barrier(0);
#pragma unroll
            for (int mm = 0; mm < 2; ++mm)
#pragma unroll
                for (int bj = 0; bj < 2; ++bj) { const int m = 2 * mh + mm; const size_t off = (size_t)((eoff + (unsigned)((ai * 128 + m * 16) * 1024 + bj * 128)) * 2u);
                    f32x4 n0, n1; unpack8(nb[mm * 2 + bj], n0, n1);
                    if (seg < 2) { f32x4 d0, d1; unpack8(db[mm * 2 + bj], d0, d1);
#pragma unroll
                        for (int j = 0; j < 4; ++j) { n0[j] *= __builtin_amdgcn_rcpf(fmaxf(d0[j], 1e-30f)); n1[j] *= __builtin_amdgcn_rcpf(fmaxf(d1[j], 1e-30f)); } }
                    acc[ai][bj][m][0] *= n0; acc[ai][bj][m][1] *= n1;
                    if (seg == 2) *(v4u*)((char*)MG + off) = pack8(acc[ai][bj][m][0], acc[ai][bj][m][1]); }
            __builtin_amdgcn_sched_barrier(0);
          }
        if (seg == 2) zero_acc(acc);
    }
};
struct EpiBranchRMW {
    static constexpr bool PERM = true;
    const bf16* GT; bf16* MG;
    __device__ __forceinline__ void operator()(acc_t& acc, const Unit& u, int wr, int wc, int fr, int fq) const {
        const size_t row0 = (size_t)u.pm * 256 + wr * 64 + fr; const int col = u.pn * 256 + wc * 32 + 8 * fq; const int seg = u.aux;
        const bf16* gn = GT + (size_t)seg * M * 1024;
#pragma unroll
        for (int ai = 0; ai < 2; ++ai)
#pragma unroll
            for (int m = 0; m < 4; ++m)
#pragma unroll
                for (int bj = 0; bj < 2; ++bj) { const size_t off = (row0 + ai * 128 + m * 16) * 1024 + col + bj * 128;
                    f32x4 n0, n1; unpack8(*(const v4u*)(gn + off), n0, n1);
                    f32x4 r0 = acc[ai][bj][m][0] * n0, r1 = acc[ai][bj][m][1] * n1;
                    if (seg > 0) { f32x4 p0, p1; unpack8(*(const v4u*)(MG + off), p0, p1); r0 += p0; r1 += p1; }
                    *(v4u*)(MG + off) = pack8(r0, r1); }
        zero_acc(acc);
    }
};
struct EpiResid {
    static constexpr bool PERM = true;
    bf16* HBp; float ys;
    __device__ __forceinline__ void operator()(acc_t& acc, const Unit& u, int wr, int wc, int fr, int fq) const {
        const size_t row0 = (size_t)u.pm * 256 + wr * 64 + fr; const int col0 = u.pn * 256 + wc * 32 + 8 * fq;
#pragma unroll
        for (int ai = 0; ai < 2; ++ai)
#pragma unroll
            for (int m = 0; m < 4; ++m) { bf16* rp = HBp + (row0 + ai * 128 + m * 16) * 1024 + col0;
#pragma unroll
                for (int bj = 0; bj < 2; ++bj) { f32x4 h0, h1; unpack8(*(const v4u*)(rp + bj * 128), h0, h1);
                    *(v4u*)(rp + bj * 128) = pack8(h0 * ALPHA + acc[ai][bj][m][0] * ys, h1 * ALPHA + acc[ai][bj][m][1] * ys); } }
        zero_acc(acc);
    }
};
template <int use, bool g8, int LNI  >
struct EpiResidLN {
    static constexpr bool PERM = true;
    unsigned char* ws; const Args* a; LAS unsigned char* ldsl; float ys;
    __device__ __forceinline__ void operator()(acc_t& acc, const Unit& u, int wr, int wc, int fr_in, int fq_in) const {
        int fr = fr_in, fq = fq_in; asm volatile("" : "+v"(fr), "+v"(fq));
        const int tid = (wr * 4 + wc) * 64 + fq * 16 + fr;
        LAS float* part = (LAS float*)(ldsl + LNX_LDS_OFF); LAS float* mr = part + 2048;
        const int rloc = wr * 64 + fr; const int col0 = u.pn * 256 + wc * 32 + 8 * fq;
        const unsigned eoff = ((unsigned)u.pm * 256u + (unsigned)rloc) * 1024u + (unsigned)col0;
        const char* hb = (const char*)(ws + WS_HB);
#pragma unroll
        for (int ai = 0; ai < 2; ++ai) {
            v4u rb[8];
#pragma unroll
            for (int m = 0; m < 4; ++m)
#pragma unroll
                for (int bj = 0; bj < 2; ++bj) rb[m * 2 + bj] = *(const v4u*)(hb + (size_t)((eoff + (unsigned)(ai * 128 + m * 16) * 1024u) * 2u + bj * 256u));
            __builtin_amdgcn_sched_barrier(0);
#pragma unroll
            for (int m = 0; m < 4; ++m) { float a = 0.f, q = 0.f;
#pragma unroll
                for (int bj = 0; bj < 2; ++bj) { f32x4 h0, h1; unpack8(rb[m * 2 + bj], h0, h1);
                    const f32x4 z0 = h0 * ALPHA + acc[ai][bj][m][0] * ys, z1 = h1 * ALPHA + acc[ai][bj][m][1] * ys; acc[ai][bj][m][0] = z0; acc[ai][bj][m][1] = z1;
                    a += ((z0[0] + z0[1]) + (z0[2] + z0[3])) + ((z1[0] + z1[1]) + (z1[2] + z1[3]));
                    q += ((z0[0] * z0[0] + z0[1] * z0[1]) + (z0[2] * z0[2] + z0[3] * z0[3])) + ((z1[0] * z1[0] + z1[1] * z1[1]) + (z1[2] * z1[2] + z1[3] * z1[3])); }
                a += __shfl_xor(a, 16); a += __shfl_xor(a, 32); q += __shfl_xor(q, 16); q += __shfl_xor(q, 32);
                if (fq == 0) { LAS float* d = part + (wc * 256 + rloc + ai * 128 + m * 16) * 2; d[0] = a; d[1] = q; } }
            __builtin_amdgcn_sched_barrier(0);
        }
        __syncthreads();
        float S1 = 0.f, S2 = 0.f;
        float* stat = (float*)(ws + WS_LNSTAT) + (size_t)u.pm * 4 * 512;
        if (tid < 256) {
#pragma unroll
            for (int w = 0; w < 4; ++w) { S1 += part[(w * 256 + tid) * 2]; S2 += part[(w * 256 + tid) * 2 + 1]; }
            __hip_atomic_store(stat + (u.pn * 256 + tid) * 2, S1, RLX_AGENT); __hip_atomic_store(stat + (u.pn * 256 + tid) * 2 + 1, S2, RLX_AGENT); }
        asm volatile("s_waitcnt vmcnt(0)" ::: "memory");
        __syncthreads();
        if (tid == 0) { unsigned* flag = (unsigned*)(ws + WS_CTL) + CW_LNX + use * 128 + u.pm;
            (void)__hip_atomic_fetch_add(flag, 1u, RLX_AGENT);
            unsigned sp = 0u; while (__hip_atomic_load(flag, RLX_AGENT) < 4u && ++sp < (1u << 20)) __builtin_amdgcn_s_sleep(1); }
        __syncthreads();
        if (tid < 256) {
#pragma unroll
            for (int p = 1; p < 4; ++p) { const int pn2 = (u.pn + p) & 3; S1 += __hip_atomic_load(stat + (pn2 * 256 + tid) * 2, RLX_AGENT); S2 += __hip_atomic_load(stat + (pn2 * 256 + tid) * 2 + 1, RLX_AGENT); }
            const float mean = S1 * (1.0f / 1024.0f), var = S2 * (1.0f / 1024.0f) - mean * mean;
            mr[tid * 2] = mean; mr[tid * 2 + 1] = __builtin_amdgcn_rsqf((var > 0.f ? var : 0.f) + LN_EPS); }
        __syncthreads();
        asm volatile("" : "+v"(fr), "+v"(fq));
        const int rloc2 = wr * 64 + fr; const int col2 = u.pn * 256 + wc * 32 + 8 * fq;
        const unsigned eoff2 = ((unsigned)u.pm * 256u + (unsigned)rloc2) * 1024u + (unsigned)col2;
        char* hbw = (char*)(ws + WS_HB); unsigned char* h8 = ws + WS_HBG8; const float* gam = a->in[12 + 2 * LNI]; const float* bet = a->in[13 + 2 * LNI];
#pragma unroll
        for (int bj = 0; bj < 2; ++bj) {
            const f32x4 g0 = *(const f32x4*)(gam + col2 + bj * 128), g1 = *(const f32x4*)(gam + col2 + bj * 128 + 4), b0 = *(const f32x4*)(bet + col2 + bj * 128), b1 = *(const f32x4*)(bet + col2 + bj * 128 + 4);
#pragma unroll
            for (int ai = 0; ai < 2; ++ai)
#pragma unroll
                for (int m = 0; m < 4; ++m) { const int rl = rloc2 + ai * 128 + m * 16; const float mean = mr[rl * 2], rstd = mr[rl * 2 + 1];
                    const unsigned eo = eoff2 + (unsigned)(ai * 128 + m * 16) * 1024u + bj * 128u;
                    const f32x4 v0 = (acc[ai][bj][m][0] - mean) * rstd * g0 + b0, v1 = (acc[ai][bj][m][1] - mean) * rstd * g1 + b1;
                    *(v4u*)(hbw + (size_t)(eo * 2u)) = pack8(v0, v1);
                    if (g8) { v2u o; o.x = pk4_fp8(v0[0], v0[1], v0[2], v0[3]); o.y = pk4_fp8(v1[0], v1[1], v1[2], v1[3]); *(v2u*)(h8 + (size_t)eo) = o; } } }
        zero_acc(acc);
    }
};
struct EpiSwiglu {
    static constexpr bool PERM = true;
    bf16* ACT; int ldc; float asc; int q;
    __device__ __forceinline__ void operator()(acc_t& acc, const Unit& u, int wr, int wc, int fr, int fq) const {
        const size_t row0 = (size_t)u.pm * 256 + wr * 64 + fr; const int col = u.aux * 128 + wc * 32 + 8 * fq;
#pragma unroll
        for (int ai = 0; ai < 2; ++ai)
#pragma unroll
            for (int m = 0; m < 4; ++m) { f32x4 v0, v1;
#pragma unroll
                for (int j = 0; j < 4; ++j) { v0[j] = siluf_(acc[ai][0][m][0][j] * asc) * (acc[ai][1][m][0][j] * asc); v1[j] = siluf_(acc[ai][0][m][1][j] * asc) * (acc[ai][1][m][1][j] * asc); if (q) { v0[j] = q8(v0[j]); v1[j] = q8(v1[j]); } }
                *(v4u*)(ACT + (row0 + ai * 128 + m * 16) * ldc + col) = pack8(v0, v1); }
        zero_acc(acc);
    }
};
struct EpiSwiglu8 {
    static constexpr bool PERM = true;
    unsigned char* ACT; int ldc; float asc;
    __device__ __forceinline__ void operator()(acc_t& acc, const Unit& u, int wr, int wc, int fr, int fq) const {
        const size_t row0 = (size_t)u.pm * 256 + wr * 64 + fr; const int col = u.aux * 128 + wc * 32 + 8 * fq;
#pragma unroll
        for (int ai = 0; ai < 2; ++ai)
#pragma unroll
            for (int m = 0; m < 4; ++m) { float v[8];
#pragma unroll
                for (int j = 0; j < 4; ++j) { v[j] = siluf_(acc[ai][0][m][0][j] * asc) * (acc[ai][1][m][0][j] * asc); v[4 + j] = siluf_(acc[ai][0][m][1][j] * asc) * (acc[ai][1][m][1][j] * asc); }
                v2u o; o.x = pk4_fp8(v[0], v[1], v[2], v[3]); o.y = pk4_fp8(v[4], v[5], v[6], v[7]);
                *(v2u*)(ACT + (row0 + ai * 128 + m * 16) * ldc + col) = o;
                __builtin_amdgcn_sched_barrier(0); }
        zero_acc(acc);
    }
};
struct FfnUpSched {
    pg8::StaticOrder o; const char* A; const char* Bt; size_t tstep;
    __device__ __forceinline__ bool next(int i, Unit& u) const { const bool ok = o.map((long)i * o.G + o.c, u.pm, u.pn); u.aux = u.pn; return ok; }
    __device__ __forceinline__ const char* abase(const Unit& u) const { return A + (size_t)u.pm * tstep; }
    __device__ __forceinline__ const char* bbase(const Unit& u) const { return Bt + (size_t)u.pn * tstep; }
};

constexpr int DN_RAW_OFF = 0;
constexpr int DN_XS_OFF = 26624;
constexpr int DN_OB_OFF = DN_XS_OFF + 49152;
constexpr int DN_AB_OFF = DN_OB_OFF + 16384;
constexpr int DN_CW_OFF = DN_AB_OFF + 512;
static_assert(DN_CW_OFF + 3840 <= RING_BYTES, "delta LDS");
__device__ __forceinline__ void delta_seq(Frame& F, int layer, int seq) {
    const int dir = seq >> 7, b = (seq >> 3) & 15, h = seq & 7;
    bf16* raw = (bf16*)(F.lds + DN_RAW_OFF); float* xs = (float*)(F.lds + DN_XS_OFF); float* ob = (float*)(F.lds + DN_OB_OFF);
    float* ab = (float*)(F.lds + DN_AB_OFF); float* cw = (float*)(F.lds + DN_CW_OFF);
    const bf16* DQKV = (const bf16*)(F.ws + WS_DQKV); const float* DAB = (const float*)(F.ws + WS_DAB);
    float* OUT = (float*)(F.ws + (dir ? WS_OB : WS_OF));
    const int tid = F.tid, lane = F.lane, wave = F.wave, p = lane & 7, j = wave * 8 + (lane >> 3);
    __syncthreads();
    for (int i = tid; i < 5 * 192; i += NTHR) { const int jj = i / 192, ch = i % 192; cw[i] = IN_conv_w(F)[((size_t)layer * 5 + jj) * 1536 + (ch >> 6) * 512 + h * 64 + (ch & 63)]; }
    const float nA = -__expf(IN_a_log(F)[layer * 16 + dir * 8 + h]), dtb = IN_dt_bias(F)[layer * 16 + dir * 8 + h];
    float S[8];
#pragma unroll
    for (int i = 0; i < 8; ++i) S[i] = 0.f;
    for (int blk = 0; blk < SEQ / 64; ++blk) {
        const int tb = dir ? (SEQ / 64 - 1 - blk) : blk, t0 = tb * 64;
        __syncthreads();
        for (int idx = tid; idx < 68 * 24; idx += NTHR) { const int r = idx / 24, pc = idx % 24, sec = pc >> 3, c8 = pc & 7, t = t0 - 2 + r;
            const v4u v = ld_or_zero(DQKV + ((size_t)b * SEQ + t) * 1536 + sec * 512 + h * 64 + c8 * 8, DQKV, t >= 0 && t < SEQ);
            *(v4u*)(raw + r * 192 + sec * 64 + c8 * 8) = v; }
        if (tid < 64) { const size_t m = (size_t)b * SEQ + t0 + tid; const float a = DAB[m * 32 + dir * 8 + h], bq = DAB[m * 32 + 16 + dir * 8 + h];
            const float xx = a + dtb; const float sp = xx > 20.f ? xx : log1pf(__expf(xx));
            ab[tid * 2] = __expf(nA * sp); ab[tid * 2 + 1] = sigmoidf_(bq); }
        __syncthreads();
        for (int idx = tid; idx < 64 * 192; idx += NTHR) { const int tt = idx / 192, ch = idx % 192; float x = 0.f;
#pragma unroll
            for (int jj = 0; jj < 5; ++jj) x += cw[jj * 192 + ch] * bf2f(raw[(tt + jj) * 192 + ch]);
            xs[idx] = siluf_(x); }
        __syncthreads();
        { const int row = tid >> 2, part = tid & 3, tt = row >> 1, sec = row & 1; float* xp = xs + tt * 192 + sec * 64 + part * 16; float ss = 0.f; float v[16];
#pragma unroll
            for (int i = 0; i < 16; ++i) { v[i] = xp[i]; ss += v[i] * v[i]; }
            ss = red4(ss);
            const float sc = __builtin_amdgcn_rsqf(ss + 1e-6f) * (sec == 0 ? 0.125f : 1.0f);
#pragma unroll
            for (int i = 0; i < 16; ++i) xp[i] = v[i] * sc; }
        __syncthreads();
        for (int s = 0; s < 64; ++s) {
            const int tt = dir ? 63 - s : s; const float* xr = xs + tt * 192;
            const f32x4 q0 = *(const f32x4*)(xr + 8 * p), q1 = *(const f32x4*)(xr + 8 * p + 4);
            const f32x4 k0 = *(const f32x4*)(xr + 64 + 8 * p), k1 = *(const f32x4*)(xr + 64 + 8 * p + 4);
            const float v = xr[128 + j], al = ab[tt * 2], be = ab[tt * 2 + 1];
            float part = (S[0] * k0[0] + S[1] * k0[1]) + (S[2] * k0[2] + S[3] * k0[3]) + (S[4] * k1[0] + S[5] * k1[1]) + (S[6] * k1[2] + S[7] * k1[3]);
            part = red8(part);
            const float c = be * (v - al * part);
            S[0] = al * S[0] + k0[0] * c; S[1] = al * S[1] + k0[1] * c; S[2] = al * S[2] + k0[2] * c; S[3] = al * S[3] + k0[3] * c;
            S[4] = al * S[4] + k1[0] * c; S[5] = al * S[5] + k1[1] * c; S[6] = al * S[6] + k1[2] * c; S[7] = al * S[7] + k1[3] * c;
            float op = (S[0] * q0[0] + S[1] * q0[1]) + (S[2] * q0[2] + S[3] * q0[3]) + (S[4] * q1[0] + S[5] * q1[1]) + (S[6] * q1[2] + S[7] * q1[3]);
            op = red8(op);
            if (p == 0) ob[tt * 64 + j] = op;
        }
        __syncthreads();
        for (int idx = tid; idx < 64 * 16; idx += NTHR) { const int tt = idx >> 4, c4 = idx & 15;
            *(f32x4*)(OUT + ((size_t)b * SEQ + t0 + tt) * 512 + h * 64 + c4 * 4) = *(const f32x4*)(ob + tt * 64 + c4 * 4); }
    }
}
__device__ __forceinline__ void delta_post(Frame& F, int layer) {
    const bf16* OFp = (const bf16*)(F.ws + WS_OF); const bf16* OBp = (const bf16*)(F.ws + WS_OB); bf16* DZ = (bf16*)(F.ws + WS_DZ);
    const int d4 = (F.lane & 15) * 4; const f32x4 nw = *(const f32x4*)(IN_dn_norm_w(F) + layer * 64 + d4);
    const size_t gq = ((size_t)F.bx * NTHR + F.tid) >> 4, NQ = ((size_t)F.G * NTHR) >> 4;
    for (size_t pr0 = gq; pr0 < (size_t)M * 8; pr0 += 4 * NQ) {
        v2u ofw[4], obw[4], zw[4];
#pragma unroll
        for (int u = 0; u < 4; ++u) { const size_t off = (pr0 + u * NQ) * 64 + d4; ofw[u] = *(const v2u*)(OFp + off); obw[u] = *(const v2u*)(OBp + off); zw[u] = *(const v2u*)(DZ + off); }
#pragma unroll
        for (int u = 0; u < 4; ++u) { const size_t off = (pr0 + u * NQ) * 64 + d4;
            const f32x4 o = (f32x4){bflo(ofw[u].x) + bflo(obw[u].x), bfhi(ofw[u].x) + bfhi(obw[u].x), bflo(ofw[u].y) + bflo(obw[u].y), bfhi(ofw[u].y) + bfhi(obw[u].y)};
            float ss = (o[0] * o[0] + o[1] * o[1]) + (o[2] * o[2] + o[3] * o[3]); ss = red16(ss);
            const float rs = (ABL == 2) ? 0.f : __builtin_amdgcn_rsqf(ss * (1.0f / 64.0f) + RMS_EPS);
            const float z0 = bflo(zw[u].x), z1 = bfhi(zw[u].x), z2 = bflo(zw[u].y), z3 = bfhi(zw[u].y);
            v2u w; w.x = pk2(o[0] * rs * nw[0] * siluf_(z0), o[1] * rs * nw[1] * siluf_(z1)); w.y = pk2(o[2] * rs * nw[2] * siluf_(z2), o[3] * rs * nw[3] * siluf_(z3));
            *(v2u*)(DZ + off) = w; }
    }
}

typedef short v4i16_t __attribute__((ext_vector_type(4)));
constexpr int AT_K_OFF = 0;
constexpr int AT_V_OFF = 46080;
constexpr int AT_BIAS_OFF = 92160;
static_assert(AT_V_OFF + 46080 <= AT_BIAS_OFF && AT_BIAS_OFF + 8320 <= RING_BYTES, "attn LDS");
__device__ __forceinline__ int t5_bucket(int rel) {
    const int n = rel < 0 ? -rel : rel;
    const int large = 8 + (n >= 12) + (n >= 16) + (n >= 23) + (n >= 32) + (n >= 46) + (n >= 64) + (n >= 91);
    return (rel > 0 ? 16 : 0) + (n < 8 ? n : large);
}
__device__ __forceinline__ void attn_bias_setup(Frame& F) {
    float* bl = (float*)(F.lds + AT_BIAS_OFF);
    for (int i = F.tid; i < 8 * 257; i += NTHR) { const int h = i / 257, r = i % 257; bl[h * 260 + r] = IN_rel_bias(F)[t5_bucket(r - 128) * 8 + h] * 1.44269504f; }
}
__device__ __forceinline__ void attn_load(Frame& F, int unit, v4u (&kr)[5], v4u (&vr)[5], bf16x8 (&qn)[4]) {
    const int b = unit >> 6, kvh = (unit >> 5) & 1, q0 = (unit & 31) * 64;
    const bf16* AK = (const bf16*)(F.ws + WS_AK); const bf16* AV = (const bf16*)(F.ws + WS_AV);
    { const int hq = kvh * 4 + (F.wave & 3), qw = q0 + 32 * (F.wave >> 2), qi = F.lane & 31, hl = F.lane >> 5;
        const bf16* qp = (const bf16*)(F.ws + WS_AQ) + ((size_t)b * SEQ + qw + qi) * 512 + hq * 64 + 8 * hl;
#pragma unroll
        for (int s = 0; s < 4; ++s) qn[s] = *(const bf16x8*)(qp + 16 * s); }
#pragma unroll
    for (int it = 0; it < 5; ++it) { const int idx = F.tid + it * NTHR, i = idx >> 3, d8 = idx & 7, kp = q0 - 128 + i; const bool ok = kp >= 0 && kp < SEQ;
        const size_t off = ((size_t)b * SEQ + kp) * 128 + kvh * 64 + d8 * 8;
        kr[it] = ld_or_zero(AK + off, AK, ok); vr[it] = ld_or_zero(AV + off, AV, ok); }
}
__device__ __forceinline__ void attn_store(Frame& F, const v4u (&kr)[5], const v4u (&vr)[5]) {
    bf16* Kl = (bf16*)(F.lds + AT_K_OFF); bf16* Vl = (bf16*)(F.lds + AT_V_OFF);
#pragma unroll
    for (int it = 0; it < 5; ++it) { const int idx = F.tid + it * NTHR, i = idx >> 3, d8 = idx & 7;
        *(v4u*)(Kl + i * 72 + d8 * 8) = kr[it]; *(v4u*)(Vl + i * 72 + d8 * 8) = vr[it]; }
}
__device__ __forceinline__ void attn_compute(Frame& F, int layer, int unit, bf16* OUT, const bf16x8 (&qf)[4]) {
    const int b = unit >> 6, kvh = (unit >> 5) & 1, qb = unit & 31, q0 = qb * 64;
    const bf16* Kl = (const bf16*)(F.lds + AT_K_OFF); const bf16* Vl = (const bf16*)(F.lds + AT_V_OFF); const float* bl = (const float*)(F.lds + AT_BIAS_OFF);
    bf16* AQ = (bf16*)(F.ws + WS_AQ);
    const int lane = F.lane, wave = F.wave;
    const int hq = kvh * 4 + (wave & 3), half = wave >> 2, qw = q0 + 32 * half, qi = lane & 31, hl = lane >> 5;
    const size_t qrow = ((size_t)b * SEQ + qw + qi) * 512 + hq * 64;
    f32x16 o0, o1;
#pragma unroll
    for (int i = 0; i < 16; ++i) { o0[i] = 0.f; o1[i] = 0.f; }
    float mrun = IN_attn_sink(F)[layer * 8 + hq] * 1.44269504f, lrun = hl == 0 ? 1.0f : 0.0f;
    const bool interior = (qb >= 2) && (qb <= 29);
    const float qsc = 0.125f * 1.44269504f;
    const float* bh = bl + hq * 260;
    for (int kt = 0; kt < 9; ++kt) {
        const int kb = 32 * half + 32 * kt;
        f32x16 sc;
#pragma unroll
        for (int i = 0; i < 16; ++i) sc[i] = 0.f;
#pragma unroll
        for (int s = 0; s < 4; ++s) { const bf16x8 a = *(const bf16x8*)(Kl + (kb + qi) * 72 + 16 * s + 8 * hl); sc = __builtin_amdgcn_mfma_f32_32x32x16_bf16(a, qf[s], sc, 0, 0, 0); }
        float mt = -1e30f;
        if (interior && kt >= 1 && kt <= 7) {
            const float* bp = bh + 32 * kt + 4 * hl - qi;
#pragma unroll
            for (int i = 0; i < 16; ++i) { const float sv = sc[i] * qsc + bp[(i & 3) + 8 * (i >> 2)]; sc[i] = sv; mt = fmaxf(mt, sv); }
        } else {
#pragma unroll
            for (int i = 0; i < 16; ++i) { const int krow = (i & 3) + 8 * (i >> 2) + 4 * hl, kp = q0 - 128 + kb + krow, rel = kp - (qw + qi);
                const bool valid = (kp >= 0) && (kp < SEQ) && (rel >= -128) && (rel <= 128);
                const int ri = rel < -128 ? 0 : (rel > 128 ? 256 : rel + 128);
                const float sv = valid ? sc[i] * qsc + bh[ri] : -1e30f; sc[i] = sv; mt = fmaxf(mt, sv); }
        }
        mt = fmaxf(mt, __shfl_xor(mt, 32));
        const float mnew = fmaxf(mrun, mt), corr = __builtin_amdgcn_exp2f(mrun - mnew); mrun = mnew;
        float ls = 0.f;
#pragma unroll
        for (int i = 0; i < 16; ++i) { const float pv = __builtin_amdgcn_exp2f(sc[i] - mnew); sc[i] = pv; ls += pv; }
        lrun = lrun * corr + ls;
#pragma unroll
        for (int i = 0; i < 16; ++i) { o0[i] *= corr; o1[i] *= corr; }
#pragma unroll
        for (int s2 = 0; s2 < 2; ++s2) {
            v4u pw; pw.x = cvt_pk_bf16(sc[8 * s2 + 0], sc[8 * s2 + 1]); pw.y = cvt_pk_bf16(sc[8 * s2 + 2], sc[8 * s2 + 3]); pw.z = cvt_pk_bf16(sc[8 * s2 + 4], sc[8 * s2 + 5]); pw.w = cvt_pk_bf16(sc[8 * s2 + 6], sc[8 * s2 + 7]);
            const bf16x8 pb = __builtin_bit_cast(bf16x8, pw);
            const bf16* v0p = Vl + (size_t)(kb + 16 * s2 + 4 * hl + ((lane & 15) >> 2)) * 72 + 16 * ((lane >> 4) & 1) + 4 * (lane & 3);
            const v4i16_t a0 = __builtin_amdgcn_ds_read_tr16_b64_v4i16((LAS v4i16_t*)v0p), a1 = __builtin_amdgcn_ds_read_tr16_b64_v4i16((LAS v4i16_t*)(v0p + 8 * 72));
            const v4i16_t c0 = __builtin_amdgcn_ds_read_tr16_b64_v4i16((LAS v4i16_t*)(v0p + 32)), c1 = __builtin_amdgcn_ds_read_tr16_b64_v4i16((LAS v4i16_t*)(v0p + 32 + 8 * 72));
            const bf16x8 va = __builtin_shufflevector(a0, a1, 0, 1, 2, 3, 4, 5, 6, 7), vc = __builtin_shufflevector(c0, c1, 0, 1, 2, 3, 4, 5, 6, 7);
            o0 = __builtin_amdgcn_mfma_f32_32x32x16_bf16(va, pb, o0, 0, 0, 0);
            o1 = __builtin_amdgcn_mfma_f32_32x32x16_bf16(vc, pb, o1, 0, 0, 0);
        }
    }
    const float inv = (ABL == 1) ? 0.f : 1.0f / (lrun + __shfl_xor(lrun, 32));
#pragma unroll
    for (int g = 0; g < 4; ++g) {
        v2u w0, w1; w0.x = cvt_pk_bf16(o0[4 * g] * inv, o0[4 * g + 1] * inv); w0.y = cvt_pk_bf16(o0[4 * g + 2] * inv, o0[4 * g + 3] * inv);
        w1.x = cvt_pk_bf16(o1[4 * g] * inv, o1[4 * g + 1] * inv); w1.y = cvt_pk_bf16(o1[4 * g + 2] * inv, o1[4 * g + 3] * inv);
        bf16* OQ = OUT ? OUT : AQ; *(v2u*)(OQ + qrow + 8 * g + 4 * hl) = w0; *(v2u*)(OQ + qrow + 32 + 8 * g + 4 * hl) = w1; }
}

__device__ __forceinline__ void attn_phase(Frame& F, int layer, bf16* OUT) {
    v4u kr[5], vr[5]; bf16x8 qn[4];
    int u = F.bx;
    if (u < 1024) attn_load(F, u, kr, vr, qn);
    for (; u < 1024; u += F.G) {
        __syncthreads();
        attn_store(F, kr, vr);
        bf16x8 qf[4];
#pragma unroll
        for (int s = 0; s < 4; ++s) qf[s] = qn[s];
        __syncthreads();
        if (u + F.G < 1024) attn_load(F, u + F.G, kr, vr, qn);
        attn_compute(F, layer, u, OUT, qf);
    }
}

constexpr int PL_U_OFF = 0;
constexpr int PL_MX_OFF = 49152;
static_assert(PL_MX_OFF + 32768 <= RING_BYTES, "pool LDS");
__device__ __forceinline__ void pool_unit(Frame& F, int layer, int unit) {
    const int b = unit >> 6, t0 = (unit & 63) * 32;
    bf16* U = (bf16*)(F.lds + PL_U_OFF); bf16* MX = (bf16*)(F.lds + PL_MX_OFF);
    const bf16* PU = (const bf16*)(F.ws + WS_PU); bf16* OP = (bf16*)(F.ws + WS_OP);
    const int tid = F.tid;
    __syncthreads();
    for (int idx = tid; idx < 48 * 64; idx += NTHR) { const int r = idx >> 6, c8 = idx & 63, t = t0 - 8 + r;
        const v4u v = ld_or_zero(PU + ((size_t)b * SEQ + t) * 512 + c8 * 8, PU, t >= 0 && t < SEQ);
        *(v4u*)(U + r * 512 + c8 * 8) = v; }
    __syncthreads();
    { const int chp = tid & 255, tt0 = (tid >> 8) * 16, g = chp >> 6, r = 1 << g;
        const unsigned* Uw = (const unsigned*)U + chp;
        float s0 = 0.f, s1 = 0.f;
        for (int d = -r; d <= r; ++d) { const unsigned w = Uw[(8 + tt0 + d) * 256]; s0 += bflo(w); s1 += bfhi(w); }
        for (int i = 0; i < 16; ++i) { const int tt = tt0 + i, t = t0 + tt; const int lo = t - r < 0 ? 0 : t - r, hi = t + r > SEQ - 1 ? SEQ - 1 : t + r;
            const float rc = __builtin_amdgcn_rcpf((float)(hi - lo + 1)); const unsigned c = Uw[(8 + tt) * 256];
            ((unsigned*)MX)[tt * 256 + chp] = (ABL == 3) ? 0u : pk2(s0 * rc - bflo(c), s1 * rc - bfhi(c));
            if (i < 15) { const unsigned a = Uw[(8 + tt + 1 + r) * 256], sb = Uw[(8 + tt - r) * 256]; s0 += bflo(a) - bflo(sb); s1 += bfhi(a) - bfhi(sb); } } }
    __syncthreads();
    for (int idx = tid; idx < 32 * 64; idx += NTHR) { const int tt = idx >> 6, c8 = idx & 63;
        *(v4u*)(OP + ((size_t)b * SEQ + t0 + tt) * 512 + c8 * 8) = *(const v4u*)(MX + tt * 512 + c8 * 8); }
}

constexpr int DC_QN = 0, DC_KN = 9216, DC_KBT = 18432, DC_KDT = 27648, DC_VBT = 36864;
constexpr int DC_ST = 46080, DC_VNT = 55296, DC_T = 64512, DC_QKM = 73728;
constexpr int DC_AF = 82944;
constexpr int DC_AB = 100352;
constexpr int DC_DT1 = 109568;
constexpr int DC_DTS = 112128;
constexpr int DC_OB = 113664;
constexpr int DC_RAW = 55296;
static_assert(DC_RAW + 52224 <= DC_DT1 && DC_OB + 16384 <= RING_BYTES, "delta chunk LDS");
constexpr int DC_CW = LDSCTL_OFF + 2048;
constexpr int DC_VEC = DC_CW + 3840;
static_assert(DC_VEC + 7 * 256 <= LDS_BYTES, "delta chunk LDS (vectors)");
#ifndef DCREP
#define DCREP 0
#endif
__device__ __forceinline__ f32x4 mfma16(const bf16x8& a, const bf16x8& b, const f32x4& c) { return __builtin_amdgcn_mfma_f32_16x16x32_bf16(a, b, c, 0, 0, 0); }
__device__ __forceinline__ bf16x8 ld8(const bf16* p) { return *(const bf16x8*)p; }
__device__ __forceinline__ int tsw(int row, int col) { return row * 72 + ((((col >> 3) ^ (row >> 3)) & 7) << 3) + (col & 7); }
__device__ __forceinline__ int tswc(int row, int chunk) { return row * 72 + (((chunk ^ (row >> 3)) & 7) << 3); }
__device__ __forceinline__ bf16x8 ld44(const bf16* p0, const bf16* p1) { const v2u a = *(const v2u*)p0, b = *(const v2u*)p1; return __builtin_bit_cast(bf16x8, (v4u){a.x, a.y, b.x, b.y}); }
__device__ __forceinline__ void st4(bf16* p, float a, float b, float c, float d) { v2u w; w.x = cvt_pk_bf16(a, b); w.y = cvt_pk_bf16(c, d); *(v2u*)p = w; }

__device__ __forceinline__ void delta_seq_chunked(Frame& F, int layer, int seq) {
    const int dir = seq >> 7, b = (seq >> 3) & 15, h = seq & 7;
    unsigned char* L = F.lds;
    bf16* Qn = (bf16*)(L + DC_QN); bf16* Kn = (bf16*)(L + DC_KN); bf16* KbT = (bf16*)(L + DC_KBT); bf16* KdT = (bf16*)(L + DC_KDT); bf16* VbT = (bf16*)(L + DC_VBT);
    bf16* St = (bf16*)(L + DC_ST); bf16* VnT = (bf16*)(L + DC_VNT); bf16* T = (bf16*)(L + DC_T); bf16* QKm = (bf16*)(L + DC_QKM);
    float* Af = (float*)(L + DC_AF); bf16* Ab = (bf16*)(L + DC_AB); bf16* DT1 = (bf16*)(L + DC_DT1); bf16* DTs = (bf16*)(L + DC_DTS); float* ob = (float*)(L + DC_OB);
    float* raw = (float*)(L + DC_RAW); float* cw = (float*)(L + DC_CW);
    float* Gs = (float*)(L + DC_VEC); float* gam = Gs + 64; float* del = Gs + 128; float* bet = Gs + 192; float* rq = Gs + 256; float* rk = Gs + 320; float* cdp = Gs + 384;
    const bf16* DQKV = (const bf16*)(F.ws + WS_DQKV); const float* DAB = (const float*)(F.ws + WS_DAB);
    float* OUT = (float*)(F.ws + (dir ? WS_OB : WS_OF));
    const int tid0 = F.tid, wave = F.wave; int tid = tid0, lane = tid0 & 63;
    const int tr = wave >> 1, tc0 = 2 * (wave & 1); int l15 = 0, q4 = 0;
    __syncthreads();
    for (int i = tid; i < 5 * 192; i += NTHR) { const int jj = i / 192, ch = i % 192; cw[i] = IN_conv_w(F)[((size_t)layer * 5 + jj) * 1536 + (ch >> 6) * 512 + h * 64 + (ch & 63)]; }
    for (int i = tid; i < 64 * 72 / 2; i += NTHR) { ((unsigned*)St)[i] = 0u; ((unsigned*)T)[i] = 0u; }
    const float nA = -__expf(IN_a_log(F)[layer * 16 + dir * 8 + h]), dtb = IN_dt_bias(F)[layer * 16 + dir * 8 + h];
    f32x4 Sacc[2];
    Sacc[0] = (f32x4){0.f, 0.f, 0.f, 0.f}; Sacc[1] = Sacc[0];
    v4u pre[4]; float pa = 0.f, pb = 0.f;
    { const int t0n = dir ? SEQ - 64 : 0;
#pragma unroll
        for (int it = 0; it < 4; ++it) { const int idx = tid + it * NTHR; const int r = idx / 24, pc = idx % 24, t = t0n - 2 + r;
            pre[it] = ld_or_zero(DQKV + ((size_t)b * SEQ + t) * 1536 + (pc >> 3) * 512 + h * 64 + (pc & 7) * 8, DQKV, idx < 68 * 24 && t >= 0 && t < SEQ); }
        if (wave == 0) { const size_t m = (size_t)b * SEQ + t0n + (dir ? 63 - lane : lane); pa = DAB[m * 32 + dir * 8 + h]; pb = DAB[m * 32 + 16 + dir * 8 + h]; } }
    for (int blk = 0; blk < SEQ / 64; ++blk) {
        const int tb = dir ? (SEQ / 64 - 1 - blk) : blk, t0 = tb * 64;
        tid = tid0; asm volatile("" : "+v"(tid)); lane = tid & 63;
        __syncthreads();
#pragma unroll
        for (int it = 0; it < 4; ++it) { const int idx = tid + it * NTHR; if (idx < 68 * 24) { const int r = idx / 24, pc = idx % 24; float* rp = raw + r * 192 + (pc >> 3) * 64 + (pc & 7) * 8;
                f32x4 lo, hi; unpack8(pre[it], lo, hi); *(f32x4*)rp = lo; *(f32x4*)(rp + 4) = hi; } }
        if (wave == 0) { const float xx = pa + dtb; const float sp = xx > 20.f ? xx : log1pf(__expf(xx));
            float g = nA * sp;
#pragma unroll
            for (int o = 1; o < 64; o <<= 1) { const float u = __shfl_up(g, o); if (lane >= o) g += u; }
            const float gl = __shfl(g, 63);
            Gs[lane] = g; gam[lane] = __expf(g); del[lane] = __expf(gl - g); bet[lane] = sigmoidf_(pb); if (lane == 63) cdp[0] = __expf(g); }
        if (blk + 1 < SEQ / 64) { const int tbn = dir ? (SEQ / 64 - 2 - blk) : blk + 1, t0n = tbn * 64;
#pragma unroll
            for (int it = 0; it < 4; ++it) { const int idx = tid + it * NTHR; const int r = idx / 24, pc = idx % 24, t = t0n - 2 + r;
                pre[it] = ld_or_zero(DQKV + ((size_t)b * SEQ + t) * 1536 + (pc >> 3) * 512 + h * 64 + (pc & 7) * 8, DQKV, idx < 68 * 24 && t >= 0 && t < SEQ); }
            if (wave == 0) { const size_t m = (size_t)b * SEQ + t0n + (dir ? 63 - lane : lane); pa = DAB[m * 32 + dir * 8 + h]; pb = DAB[m * 32 + 16 + dir * 8 + h]; } }
        __syncthreads();
        for (int rep1 = 0; rep1 < (DCREP == 1 ? 2 : 1); ++rep1)
        { const int tt = tid >> 3, d0 = (tid & 7) * 8, s = dir ? 63 - tt : tt;
            float xv[3][8];
#pragma unroll
            for (int sec = 0; sec < 3; ++sec) {
                f32x2 a2[4];
#pragma unroll
                for (int pq = 0; pq < 4; ++pq) a2[pq] = (f32x2){0.f, 0.f};
#pragma unroll
                for (int jj = 0; jj < 5; ++jj) { const float* rp = raw + (tt + jj) * 192 + sec * 64 + d0; const float* cp = cw + jj * 192 + sec * 64 + d0;
                    const f32x4 r0 = *(const f32x4*)rp, r1 = *(const f32x4*)(rp + 4), c0 = *(const f32x4*)cp, c1 = *(const f32x4*)(cp + 4);
                    a2[0] += (f32x2){c0[0], c0[1]} * (f32x2){r0[0], r0[1]}; a2[1] += (f32x2){c0[2], c0[3]} * (f32x2){r0[2], r0[3]};
                    a2[2] += (f32x2){c1[0], c1[1]} * (f32x2){r1[0], r1[1]}; a2[3] += (f32x2){c1[2], c1[3]} * (f32x2){r1[2], r1[3]}; }
#pragma unroll
                for (int e = 0; e < 8; ++e) xv[sec][e] = siluf_(a2[e >> 1][e & 1]);
                __builtin_amdgcn_sched_barrier(0); }
            float sq = 0.f, sk = 0.f;
#pragma unroll
            for (int e = 0; e < 8; ++e) { sq += xv[0][e] * xv[0][e]; sk += xv[1][e] * xv[1][e]; }
            sq = __builtin_amdgcn_rsqf(red8(sq) + 1e-6f) * 0.125f; sk = __builtin_amdgcn_rsqf(red8(sk) + 1e-6f);
            const float be = bet[s], bg = be * gam[s], dl = del[s];
#pragma unroll
            for (int e = 0; e < 8; ++e) { xv[0][e] *= sq; xv[1][e] *= sk; }
            v4u w; w.x = cvt_pk_bf16(xv[0][0], xv[0][1]); w.y = cvt_pk_bf16(xv[0][2], xv[0][3]); w.z = cvt_pk_bf16(xv[0][4], xv[0][5]); w.w = cvt_pk_bf16(xv[0][6], xv[0][7]); *(v4u*)(Qn + s * 72 + d0) = w;
            w.x = cvt_pk_bf16(xv[1][0], xv[1][1]); w.y = cvt_pk_bf16(xv[1][2], xv[1][3]); w.z = cvt_pk_bf16(xv[1][4], xv[1][5]); w.w = cvt_pk_bf16(xv[1][6], xv[1][7]); *(v4u*)(Kn + s * 72 + d0) = w;
#pragma unroll
            for (int e = 0; e < 8; e += 2) { const int o0 = tsw(d0 + e, s), o1 = tsw(d0 + e + 1, s);
                const unsigned wb = cvt_pk_bf16(xv[1][e] * bg, xv[1][e + 1] * bg), wd = cvt_pk_bf16(xv[1][e] * dl, xv[1][e + 1] * dl), wv = cvt_pk_bf16(xv[2][e] * be, xv[2][e + 1] * be);
                KbT[o0] = (bf16)(wb & 0xffffu); KbT[o1] = (bf16)(wb >> 16); KdT[o0] = (bf16)(wd & 0xffffu); KdT[o1] = (bf16)(wd >> 16); VbT[o0] = (bf16)(wv & 0xffffu); VbT[o1] = (bf16)(wv >> 16); } }
        __syncthreads();
        { int lv = lane; asm volatile("" : "+v"(lv)); l15 = lv & 15; q4 = lv >> 4; }
        for (int rep4 = 0; rep4 < (DCREP == 4 ? 2 : 1); ++rep4)
        { const bf16x8 a0 = ld8(Kn + (16 * tr + l15) * 72 + 8 * q4), a1 = ld8(Kn + (16 * tr + l15) * 72 + 32 + 8 * q4);
            float Gj[4];
#pragma unroll
            for (int r = 0; r < 4; ++r) Gj[r] = Gs[16 * tr + 4 * q4 + r];
#pragma unroll
            for (int tcx = 0; tcx < 2; ++tcx) { const int tc = tc0 + tcx, i = 16 * tc + l15, j0 = 16 * tr + 4 * q4;
                f32x4 ckk = (f32x4){0.f, 0.f, 0.f, 0.f}, cqk = ckk;
                if (tc >= tr) {
                    const bf16x8 bk0 = ld8(Kn + i * 72 + 8 * q4), bk1 = ld8(Kn + i * 72 + 32 + 8 * q4), bq0 = ld8(Qn + i * 72 + 8 * q4), bq1 = ld8(Qn + i * 72 + 32 + 8 * q4);
                    ckk = mfma16(a0, bk0, ckk); ckk = mfma16(a1, bk1, ckk); cqk = mfma16(a0, bq0, cqk); cqk = mfma16(a1, bq1, cqk);
                    const float Gi = Gs[i], bi = bet[i];
#pragma unroll
                    for (int r = 0; r < 4; ++r) { const int j = j0 + r; const float dec = __expf(Gi - Gj[r]); ckk[r] = (i > j) ? ckk[r] * dec * bi : 0.f; cqk[r] = (i >= j) ? cqk[r] * dec : 0.f; } }
#pragma unroll
                for (int r = 0; r < 4; ++r) Af[(j0 + r) * 68 + i] = ckk[r];
                st4(QKm + i * 72 + j0, cqk[0], cqk[1], cqk[2], cqk[3]);
                st4(Ab + i * 72 + j0, ckk[0], ckk[1], ckk[2], ckk[3]); } }
        __syncthreads();
        for (int rep5 = 0; rep5 < (DCREP == 5 ? 2 : 1); ++rep5)
        if (wave == 0) { const int b4 = lane >> 4, c = lane & 15; const float* Ar = Af + (16 * b4) * 68 + 16 * b4;
            float t[16];
#pragma unroll
            for (int i = 0; i < 16; ++i) t[i] = (i == c) ? 1.f : 0.f;
#pragma unroll
            for (int j = 0; j < 15; ++j) {
#pragma unroll
                for (int i4 = (j + 1) / 4; i4 < 4; ++i4) { const f32x4 a = *(const f32x4*)(Ar + j * 68 + 4 * i4);
#pragma unroll
                    for (int e = 0; e < 4; ++e) if (4 * i4 + e > j) t[4 * i4 + e] -= a[e] * t[j]; } }
#pragma unroll
            for (int i = 0; i < 16; ++i) T[(16 * b4 + i) * 72 + 16 * b4 + c] = (bf16)f2bf(t[i]);
            { v4u w0, w1; w0.x = cvt_pk_bf16(t[0], t[1]); w0.y = cvt_pk_bf16(t[2], t[3]); w0.z = cvt_pk_bf16(t[4], t[5]); w0.w = cvt_pk_bf16(t[6], t[7]);
                w1.x = cvt_pk_bf16(t[8], t[9]); w1.y = cvt_pk_bf16(t[10], t[11]); w1.z = cvt_pk_bf16(t[12], t[13]); w1.w = cvt_pk_bf16(t[14], t[15]);
                const v4u z = (v4u){0u, 0u, 0u, 0u};
                if ((b4 & 1) == 0) { *(v4u*)(DTs + ((b4 >> 1) * 16 + c) * 24) = w0; *(v4u*)(DTs + ((b4 >> 1) * 16 + c) * 24 + 8) = w1; }
                if (b4 == 0) { *(v4u*)(DT1 + c * 40) = w0; *(v4u*)(DT1 + c * 40 + 8) = w1; }
                if (b4 == 1) { *(v4u*)(DT1 + (16 + c) * 40 + 16) = w0; *(v4u*)(DT1 + (16 + c) * 40 + 24) = w1; *(v4u*)(DT1 + (16 + c) * 40) = z; *(v4u*)(DT1 + (16 + c) * 40 + 8) = z; }
                if (lane < 32) { *(v4u*)(T + lane * 72 + 32) = z; *(v4u*)(T + lane * 72 + 40) = z; *(v4u*)(T + lane * 72 + 48) = z; *(v4u*)(T + lane * 72 + 56) = z; }
                if (lane < 16) { *(v4u*)(T + lane * 72 + 16) = z; *(v4u*)(T + lane * 72 + 24) = z; }
                if (lane >= 32 && lane < 48) { *(v4u*)(T + lane * 72 + 48) = z; *(v4u*)(T + lane * 72 + 56) = z; } }
            LDS_WAIT(); asm volatile("" ::: "memory");
            const int m15 = lane & 15, qq = lane >> 4;
#pragma unroll
            for (int p = 0; p < 2; ++p) { const int b0 = 2 * p, b1 = 2 * p + 1;
                const v4u zz = (v4u){0u, 0u, 0u, 0u};
                v4u av = zz, bv = zz;
                if (qq < 2) { av = *(const v4u*)(Ab + (16 * b1 + m15) * 72 + 16 * b0 + 8 * qq); bv = *(const v4u*)(DTs + (p * 16 + m15) * 24 + 8 * qq); }
                f32x4 X4 = (f32x4){0.f, 0.f, 0.f, 0.f};
                X4 = mfma16(__builtin_bit_cast(bf16x8, av), __builtin_bit_cast(bf16x8, bv), X4);
                v4u xa = zz; xa.x = cvt_pk_bf16(X4[0], X4[1]); xa.y = cvt_pk_bf16(X4[2], X4[3]);
                const v2u dr = *(const v2u*)(T + (16 * b1 + m15) * 72 + 16 * b1 + 4 * qq);
                v4u db = zz; db.x = dr.x; db.y = dr.y;
                f32x4 Z4 = (f32x4){0.f, 0.f, 0.f, 0.f};
                Z4 = mfma16(__builtin_bit_cast(bf16x8, xa), __builtin_bit_cast(bf16x8, db), Z4);
                st4(T + (16 * b1 + m15) * 72 + 16 * b0 + 4 * qq, -Z4[0], -Z4[1], -Z4[2], -Z4[3]);
                if (p == 0) {
#pragma unroll
                    for (int r = 0; r < 4; ++r) DT1[(4 * qq + r) * 40 + 16 + m15] = (bf16)f2bf(-Z4[r]); } }
            LDS_WAIT(); asm volatile("" ::: "memory");
            const int r31 = lane & 31, hh = lane >> 5;
            f32x16 X;
#pragma unroll
            for (int i = 0; i < 16; ++i) X[i] = 0.f;
#pragma unroll
            for (int ks = 0; ks < 2; ++ks) X = __builtin_amdgcn_mfma_f32_32x32x16_bf16(ld8(Ab + (32 + r31) * 72 + 16 * ks + 8 * hh), ld8(DT1 + r31 * 40 + 16 * ks + 8 * hh), X, 0, 0, 0);
            f32x16 Z;
#pragma unroll
            for (int i = 0; i < 16; ++i) Z[i] = 0.f;
#pragma unroll
            for (int ks = 0; ks < 2; ++ks) { v4u pw; pw.x = cvt_pk_bf16(X[8 * ks + 0], X[8 * ks + 1]); pw.y = cvt_pk_bf16(X[8 * ks + 2], X[8 * ks + 3]); pw.z = cvt_pk_bf16(X[8 * ks + 4], X[8 * ks + 5]); pw.w = cvt_pk_bf16(X[8 * ks + 6], X[8 * ks + 7]);
                const bf16* d2 = T + (32 + r31) * 72 + 32 + 16 * ks + 4 * hh;
                Z = __builtin_amdgcn_mfma_f32_32x32x16_bf16(__builtin_bit_cast(bf16x8, pw), ld44(d2, d2 + 8), Z, 0, 0, 0); }
#pragma unroll
            for (int g = 0; g < 4; ++g) st4(T + (32 + r31) * 72 + 8 * g + 4 * hh, -Z[4 * g], -Z[4 * g + 1], -Z[4 * g + 2], -Z[4 * g + 3]); }
        __syncthreads();
        { int lv = lane; asm volatile("" : "+v"(lv)); l15 = lv & 15; q4 = lv >> 4; }
        for (int rep7 = 0; rep7 < (DCREP == 7 ? 2 : 1); ++rep7)
        { const bf16x8 ti0 = ld8(T + (16 * tr + l15) * 72 + 8 * q4), ti1 = ld8(T + (16 * tr + l15) * 72 + 32 + 8 * q4);
            f32x4 wt[4];
#pragma unroll
            for (int dt = 0; dt < 4; ++dt) { wt[dt] = (f32x4){0.f, 0.f, 0.f, 0.f};
                wt[dt] = mfma16(ld8(KbT + tswc(16 * dt + l15, q4)), ti0, wt[dt]); wt[dt] = mfma16(ld8(KbT + tswc(16 * dt + l15, 4 + q4)), ti1, wt[dt]); }
            v4u wa0, wa1;
            wa0.x = cvt_pk_bf16(-wt[0][0], -wt[0][1]); wa0.y = cvt_pk_bf16(-wt[0][2], -wt[0][3]); wa0.z = cvt_pk_bf16(-wt[1][0], -wt[1][1]); wa0.w = cvt_pk_bf16(-wt[1][2], -wt[1][3]);
            wa1.x = cvt_pk_bf16(-wt[2][0], -wt[2][1]); wa1.y = cvt_pk_bf16(-wt[2][2], -wt[2][3]); wa1.z = cvt_pk_bf16(-wt[3][0], -wt[3][1]); wa1.w = cvt_pk_bf16(-wt[3][2], -wt[3][3]);
#pragma unroll
            for (int tcx = 0; tcx < 2; ++tcx) { const int e = 16 * (tc0 + tcx) + l15;
                f32x4 u = (f32x4){0.f, 0.f, 0.f, 0.f};
                u = mfma16(ti0, ld8(VbT + tswc(e, q4)), u); u = mfma16(ti1, ld8(VbT + tswc(e, 4 + q4)), u);
                const bf16* sp = St + e * 72 + 4 * q4;
                u = mfma16(__builtin_bit_cast(bf16x8, wa0), ld44(sp, sp + 16), u); u = mfma16(__builtin_bit_cast(bf16x8, wa1), ld44(sp + 32, sp + 48), u);
                st4(VnT + e * 72 + 16 * tr + 4 * q4, u[0], u[1], u[2], u[3]); } }
        __syncthreads();
        { int lv = lane; asm volatile("" : "+v"(lv)); l15 = lv & 15; q4 = lv >> 4; }
        { const bf16x8 qa0 = ld8(Qn + (16 * tr + l15) * 72 + 8 * q4), qa1 = ld8(Qn + (16 * tr + l15) * 72 + 32 + 8 * q4);
            const bf16x8 ma0 = ld8(QKm + (16 * tr + l15) * 72 + 8 * q4), ma1 = ld8(QKm + (16 * tr + l15) * 72 + 32 + 8 * q4);
            const bf16x8 ka0 = ld8(KdT + tswc(16 * tr + l15, q4)), ka1 = ld8(KdT + tswc(16 * tr + l15, 4 + q4));
            const float cd = cdp[0]; float gi[4];
#pragma unroll
            for (int r = 0; r < 4; ++r) gi[r] = gam[16 * tr + 4 * q4 + r];
#pragma unroll
            for (int tcx = 0; tcx < 2; ++tcx) { const int e = 16 * (tc0 + tcx) + l15;
                const bf16x8 s0 = ld8(St + e * 72 + 8 * q4), s1 = ld8(St + e * 72 + 32 + 8 * q4), n0 = ld8(VnT + e * 72 + 8 * q4), n1 = ld8(VnT + e * 72 + 32 + 8 * q4);
                f32x4 o = (f32x4){0.f, 0.f, 0.f, 0.f};
                o = mfma16(qa0, s0, o); o = mfma16(qa1, s1, o);
#pragma unroll
                for (int r = 0; r < 4; ++r) o[r] *= gi[r];
                o = mfma16(ma0, n0, o); o = mfma16(ma1, n1, o);
#pragma unroll
                for (int r = 0; r < 4; ++r) ob[(16 * tr + 4 * q4 + r) * 64 + e] = o[r];
                Sacc[tcx] = Sacc[tcx] * cd; Sacc[tcx] = mfma16(ka0, n0, Sacc[tcx]); Sacc[tcx] = mfma16(ka1, n1, Sacc[tcx]); } }
        __syncthreads();
#pragma unroll
        for (int tcx = 0; tcx < 2; ++tcx) { const int e = 16 * (tc0 + tcx) + l15; st4(St + e * 72 + 16 * tr + 4 * q4, Sacc[tcx][0], Sacc[tcx][1], Sacc[tcx][2], Sacc[tcx][3]); }
        for (int idx = tid; idx < 64 * 16; idx += NTHR) { const int s = idx >> 4, c4 = idx & 15; const int t = t0 + (dir ? 63 - s : s);
            const f32x4 ov = *(const f32x4*)(ob + s * 64 + c4 * 4); v2u ow; ow.x = cvt_pk_bf16(ov[0], ov[1]); ow.y = cvt_pk_bf16(ov[2], ov[3]);
            *(v2u*)((bf16*)OUT + ((size_t)b * SEQ + t) * 512 + h * 64 + c4 * 4) = ow; }
    }
}

#ifndef DPREP
#define DPREP 0
#endif
constexpr int DP_QN = 0, DP_KD = 18432;
constexpr int DP_KN = 36864, DP_KBT = 46080, DP_VBT = 55296, DP_ST = 64512, DP_VNT = 73728, DP_T = 82944, DP_QKM = 92160, DP_AB = 101376;
constexpr int DP_AF4 = 110592;
constexpr int DP_DT1 = 115712, DP_DTS = 118272;
constexpr int DP_RAW = 119808;
static_assert(DP_RAW + 26112 <= RING_BYTES, "pipelined delta LDS");

__device__ __forceinline__ bf16x8 ldtr8(const bf16* img, int ks, int c, int lane) {
    const int q = lane >> 4, qq = (lane & 15) >> 2, p = lane & 3;
    const bf16* a0 = img + (32 * ks + 8 * q + qq) * 72 + 16 * c + 4 * p;
    const v4i16_t lo = __builtin_amdgcn_ds_read_tr16_b64_v4i16((LAS v4i16_t*)a0), hi = __builtin_amdgcn_ds_read_tr16_b64_v4i16((LAS v4i16_t*)(a0 + 4 * 72));
    return __builtin_shufflevector(lo, hi, 0, 1, 2, 3, 4, 5, 6, 7);
}
typedef __bf16 bf16x2v_t __attribute__((ext_vector_type(2)));
__device__ __forceinline__ float dot2bf(unsigned a, unsigned b, float c) { return __builtin_amdgcn_fdot2_f32_bf16(__builtin_bit_cast(bf16x2v_t, a), __builtin_bit_cast(bf16x2v_t, b), c, false); }
__device__ __forceinline__ void delta_seq_pipe(Frame& F, int layer, int seq) {
    const int dir = seq >> 7, b = (seq >> 3) & 15, h = seq & 7;
    unsigned char* L = F.lds;
    bf16* Qn2 = (bf16*)(L + DP_QN); bf16* Kd2 = (bf16*)(L + DP_KD); bf16* Kn = (bf16*)(L + DP_KN); bf16* KbT = (bf16*)(L + DP_KBT); bf16* VbT = (bf16*)(L + DP_VBT);
    bf16* St = (bf16*)(L + DP_ST); bf16* VnT = (bf16*)(L + DP_VNT); bf16* T = (bf16*)(L + DP_T); bf16* QKm = (bf16*)(L + DP_QKM); bf16* Ab = (bf16*)(L + DP_AB);
    float* Af4 = (float*)(L + DP_AF4); bf16* DT1 = (bf16*)(L + DP_DT1); bf16* DTs = (bf16*)(L + DP_DTS); bf16* raw = (bf16*)(L + DP_RAW);
    float* cw = (float*)(L + DC_CW); float* vec0 = (float*)(L + DC_VEC);
    const bf16* DQKV = (const bf16*)(F.ws + WS_DQKV); const float* DAB = (const float*)(F.ws + WS_DAB);
    bf16* OUT = (bf16*)(F.ws + (dir ? WS_OB : WS_OF));
    const int tid0 = F.tid, wave = F.wave; int tid = tid0, lane = tid0 & 63, l15 = 0, q4 = 0;
    const int tr = wave >> 1, tc0 = 2 * (wave & 1);
    __syncthreads();
    for (int i = tid; i < 5 * 192; i += NTHR) { const int jj = i / 192, ch = i % 192; const unsigned wb = f2bf(IN_conv_w(F)[((size_t)layer * 5 + jj) * 1536 + (ch >> 6) * 512 + h * 64 + (ch & 63)]); ((unsigned*)cw)[i] = (ch & 1) ? (wb << 16) : wb; }
    for (int i = tid; i < 64 * 72 / 2; i += NTHR) ((unsigned*)St)[i] = 0u;
    const float nA = -__expf(IN_a_log(F)[layer * 16 + dir * 8 + h]), dtb = IN_dt_bias(F)[layer * 16 + dir * 8 + h];
    f32x4 Sacc[2];
    Sacc[0] = (f32x4){0.f, 0.f, 0.f, 0.f}; Sacc[1] = Sacc[0];
    v4u pre[4]; float pa = 0.f, pb = 0.f;
    v4u kbw = (v4u){0u, 0u, 0u, 0u}, vbw = kbw;

#define DP_LANE() do { tid = tid0; asm volatile("" : "+v"(tid)); lane = tid & 63; l15 = lane & 15; q4 = lane >> 4; } while (0)
#define DP_T0(NB) ((dir ? (SEQ / 64 - 1 - (NB)) : (NB)) * 64)
#define DP_PREFETCH(NB) do { const int t0n_ = DP_T0(NB); \
        _Pragma("unroll") for (int it = 0; it < 4; ++it) { const int idx = tid + it * NTHR; const int r = idx / 24, pc = idx % 24, t = t0n_ - 2 + r; \
            pre[it] = ld_or_zero(DQKV + ((size_t)b * SEQ + t) * 1536 + (pc >> 3) * 512 + h * 64 + (pc & 7) * 8, DQKV, idx < 68 * 24 && t >= 0 && t < SEQ); } \
        if (wave == 0) { const size_t m_ = (size_t)b * SEQ + t0n_ + (dir ? 63 - lane : lane); pa = DAB[m_ * 32 + dir * 8 + h]; pb = DAB[m_ * 32 + 16 + dir * 8 + h]; } } while (0)
#define DP_S0(NB) do { const int nb_ = (NB); \
        _Pragma("unroll") for (int it = 0; it < 4; ++it) { const int idx = tid + it * NTHR; if (idx < 68 * 24) { const int r = idx / 24, pc = idx % 24; *(v4u*)(raw + r * 192 + (pc >> 3) * 64 + (pc & 7) * 8) = pre[it]; } } \
        if (wave == 0) { float* vd_ = vec0 + (nb_ & 1) * 448; const float xx_ = pa + dtb; const float sp_ = xx_ > 20.f ? xx_ : log1pf(__expf(xx_)); float g_ = nA * sp_; \
            _Pragma("unroll") for (int o_ = 1; o_ < 64; o_ <<= 1) { const float u_ = __shfl_up(g_, o_); if (lane >= o_) g_ += u_; } \
            const float gl_ = __shfl(g_, 63); vd_[lane] = g_; vd_[64 + lane] = __expf(g_); vd_[128 + lane] = __expf(gl_ - g_); vd_[192 + lane] = sigmoidf_(pb); if (lane == 63) vd_[256] = __expf(g_); } \
        if (nb_ + 1 < SEQ / 64) DP_PREFETCH(nb_ + 1); } while (0)
#define DP_S1A(NB) do { const int nb_ = (NB); const float* vd_ = vec0 + (nb_ & 1) * 448; bf16* Qn_ = Qn2 + (nb_ & 1) * 4608; bf16* Kd_ = Kd2 + (nb_ & 1) * 4608; \
        const int tt = tid >> 3, d0 = (tid & 7) * 8, s = dir ? 63 - tt : tt; \
        float xv[3][8]; \
        _Pragma("unroll") for (int sec = 0; sec < 3; ++sec) { float a1[8]; \
            _Pragma("unroll") for (int e = 0; e < 8; ++e) a1[e] = 0.f; \
            _Pragma("unroll") for (int jj = 0; jj < 5; ++jj) { const v4u rw = *(const v4u*)(raw + (tt + jj) * 192 + sec * 64 + d0); const float* cp = cw + jj * 192 + sec * 64 + d0; \
                const v4u c0 = *(const v4u*)cp, c1 = *(const v4u*)(cp + 4); \
                a1[0] = dot2bf(rw.x, c0.x, a1[0]); a1[1] = dot2bf(rw.x, c0.y, a1[1]); a1[2] = dot2bf(rw.y, c0.z, a1[2]); a1[3] = dot2bf(rw.y, c0.w, a1[3]); \
                a1[4] = dot2bf(rw.z, c1.x, a1[4]); a1[5] = dot2bf(rw.z, c1.y, a1[5]); a1[6] = dot2bf(rw.w, c1.z, a1[6]); a1[7] = dot2bf(rw.w, c1.w, a1[7]); } \
            _Pragma("unroll") for (int e = 0; e < 8; ++e) xv[sec][e] = siluf_(a1[e]); \
            __builtin_amdgcn_sched_barrier(0); } \
        float sq = 0.f, sk = 0.f; \
        _Pragma("unroll") for (int e = 0; e < 8; ++e) { sq += xv[0][e] * xv[0][e]; sk += xv[1][e] * xv[1][e]; } \
        sq = __builtin_amdgcn_rsqf(red8(sq) + 1e-6f) * 0.125f; sk = __builtin_amdgcn_rsqf(red8(sk) + 1e-6f); \
        const float be = vd_[192 + s], bg = be * vd_[64 + s], dl = vd_[128 + s]; \
        _Pragma("unroll") for (int e = 0; e < 8; ++e) { xv[0][e] *= sq; xv[1][e] *= sk; } \
        v4u w; w.x = cvt_pk_bf16(xv[0][0], xv[0][1]); w.y = cvt_pk_bf16(xv[0][2], xv[0][3]); w.z = cvt_pk_bf16(xv[0][4], xv[0][5]); w.w = cvt_pk_bf16(xv[0][6], xv[0][7]); *(v4u*)(Qn_ + s * 72 + d0) = w; \
        w.x = cvt_pk_bf16(xv[1][0], xv[1][1]); w.y = cvt_pk_bf16(xv[1][2], xv[1][3]); w.z = cvt_pk_bf16(xv[1][4], xv[1][5]); w.w = cvt_pk_bf16(xv[1][6], xv[1][7]); *(v4u*)(Kn + s * 72 + d0) = w; \
        w.x = cvt_pk_bf16(xv[1][0] * bg, xv[1][1] * bg); w.y = cvt_pk_bf16(xv[1][2] * bg, xv[1][3] * bg); w.z = cvt_pk_bf16(xv[1][4] * bg, xv[1][5] * bg); w.w = cvt_pk_bf16(xv[1][6] * bg, xv[1][7] * bg); kbw = w; \
        w.x = cvt_pk_bf16(xv[1][0] * dl, xv[1][1] * dl); w.y = cvt_pk_bf16(xv[1][2] * dl, xv[1][3] * dl); w.z = cvt_pk_bf16(xv[1][4] * dl, xv[1][5] * dl); w.w = cvt_pk_bf16(xv[1][6] * dl, xv[1][7] * dl); *(v4u*)(Kd_ + s * 72 + d0) = w; \
        w.x = cvt_pk_bf16(xv[2][0] * be, xv[2][1] * be); w.y = cvt_pk_bf16(xv[2][2] * be, xv[2][3] * be); w.z = cvt_pk_bf16(xv[2][4] * be, xv[2][5] * be); w.w = cvt_pk_bf16(xv[2][6] * be, xv[2][7] * be); vbw = w; } while (0)
#define DP_S1B() do { const int tt = tid >> 3, d0 = (tid & 7) * 8, s = dir ? 63 - tt : tt; *(v4u*)(KbT + s * 72 + d0) = kbw; *(v4u*)(VbT + s * 72 + d0) = vbw; } while (0)
#define DP_S4(NB) do { const int nb_ = (NB); const float* vd_ = vec0 + (nb_ & 1) * 448; const bf16* Qn_ = Qn2 + (nb_ & 1) * 4608; \
        const bf16x8 a0 = ld8(Kn + (16 * tr + l15) * 72 + 8 * q4), a1 = ld8(Kn + (16 * tr + l15) * 72 + 32 + 8 * q4); \
        float Gj[4]; \
        _Pragma("unroll") for (int r = 0; r < 4; ++r) Gj[r] = vd_[16 * tr + 4 * q4 + r]; \
        _Pragma("unroll") for (int tcx = 0; tcx < 2; ++tcx) { const int tc = tc0 + tcx, i = 16 * tc + l15, j0 = 16 * tr + 4 * q4; \
            f32x4 ckk = (f32x4){0.f, 0.f, 0.f, 0.f}, cqk = ckk; \
            if (tc >= tr) { \
                const bf16x8 bk0 = ld8(Kn + i * 72 + 8 * q4), bk1 = ld8(Kn + i * 72 + 32 + 8 * q4), bq0 = ld8(Qn_ + i * 72 + 8 * q4), bq1 = ld8(Qn_ + i * 72 + 32 + 8 * q4); \
                ckk = mfma16(a0, bk0, ckk); ckk = mfma16(a1, bk1, ckk); cqk = mfma16(a0, bq0, cqk); cqk = mfma16(a1, bq1, cqk); \
                const float Gi = vd_[i], bi = vd_[192 + i]; \
                _Pragma("unroll") for (int r = 0; r < 4; ++r) { const int j = j0 + r; const float dec = __expf(Gi - Gj[r]); ckk[r] = (i > j) ? ckk[r] * dec * bi : 0.f; cqk[r] = (i >= j) ? cqk[r] * dec : 0.f; } } \
            if (tc == tr) { _Pragma("unroll") for (int r = 0; r < 4; ++r) Af4[tr * 320 + (4 * q4 + r) * 20 + l15] = ckk[r]; } \
            st4(QKm + i * 72 + j0, cqk[0], cqk[1], cqk[2], cqk[3]); \
            st4(Ab + i * 72 + j0, ckk[0], ckk[1], ckk[2], ckk[3]); } } while (0)
#define DP_S5() do { if (wave == 0) { const int b4 = lane >> 4, c = lane & 15; const float* Ar = Af4 + b4 * 320; \
        f32x4 ar[15][4];                                            \
        _Pragma("unroll") for (int j = 0; j < 15; ++j) { _Pragma("unroll") for (int i4 = (j + 1) / 4; i4 < 4; ++i4) ar[j][i4] = *(const f32x4*)(Ar + j * 20 + 4 * i4); } \
        float t[16]; \
        _Pragma("unroll") for (int i = 0; i < 16; ++i) t[i] = (i == c) ? 1.f : 0.f; \
        _Pragma("unroll") for (int j = 0; j < 15; ++j) { \
            _Pragma("unroll") for (int i4 = (j + 1) / 4; i4 < 4; ++i4) { \
                _Pragma("unroll") for (int e = 0; e < 4; ++e) if (4 * i4 + e > j) t[4 * i4 + e] -= ar[j][i4][e] * t[j]; } } \
        _Pragma("unroll") for (int i = 0; i < 16; ++i) T[(16 * b4 + i) * 72 + 16 * b4 + c] = (bf16)f2bf(t[i]); \
        { v4u w0, w1; w0.x = cvt_pk_bf16(t[0], t[1]); w0.y = cvt_pk_bf16(t[2], t[3]); w0.z = cvt_pk_bf16(t[4], t[5]); w0.w = cvt_pk_bf16(t[6], t[7]); \
            w1.x = cvt_pk_bf16(t[8], t[9]); w1.y = cvt_pk_bf16(t[10], t[11]); w1.z = cvt_pk_bf16(t[12], t[13]); w1.w = cvt_pk_bf16(t[14], t[15]); \
            const v4u z = (v4u){0u, 0u, 0u, 0u}; \
            if ((b4 & 1) == 0) { *(v4u*)(DTs + ((b4 >> 1) * 16 + c) * 24) = w0; *(v4u*)(DTs + ((b4 >> 1) * 16 + c) * 24 + 8) = w1; } \
            if (b4 == 0) { *(v4u*)(DT1 + c * 40) = w0; *(v4u*)(DT1 + c * 40 + 8) = w1; } \
            if (b4 == 1) { *(v4u*)(DT1 + (16 + c) * 40 + 16) = w0; *(v4u*)(DT1 + (16 + c) * 40 + 24) = w1; *(v4u*)(DT1 + (16 + c) * 40) = z; *(v4u*)(DT1 + (16 + c) * 40 + 8) = z; } \
            if (lane < 32) { *(v4u*)(T + lane * 72 + 32) = z; *(v4u*)(T + lane * 72 + 40) = z; *(v4u*)(T + lane * 72 + 48) = z; *(v4u*)(T + lane * 72 + 56) = z; } \
            if (lane < 16) { *(v4u*)(T + lane * 72 + 16) = z; *(v4u*)(T + lane * 72 + 24) = z; } \
            if (lane >= 32 && lane < 48) { *(v4u*)(T + lane * 72 + 48) = z; *(v4u*)(T + lane * 72 + 56) = z; } } \
        asm volatile("" ::: "memory");                              \
        const int m15 = lane & 15, qq = lane >> 4; \
        { const v4u zz = (v4u){0u, 0u, 0u, 0u}; v4u av[2], bv[2]; v2u dr[2]; \
            _Pragma("unroll") for (int p = 0; p < 2; ++p) { const int b0 = 2 * p, b1 = 2 * p + 1; av[p] = zz; bv[p] = zz; \
                if (qq < 2) { av[p] = *(const v4u*)(Ab + (16 * b1 + m15) * 72 + 16 * b0 + 8 * qq); bv[p] = *(const v4u*)(DTs + (p * 16 + m15) * 24 + 8 * qq); } \
                dr[p] = *(const v2u*)(T + (16 * b1 + m15) * 72 + 16 * b1 + 4 * qq); } \
            f32x4 Z4[2]; \
            _Pragma("unroll") for (int p = 0; p < 2; ++p) { \
                f32x4 X4 = (f32x4){0.f, 0.f, 0.f, 0.f}; X4 = mfma16(__builtin_bit_cast(bf16x8, av[p]), __builtin_bit_cast(bf16x8, bv[p]), X4); \
                v4u xa = zz; xa.x = cvt_pk_bf16(X4[0], X4[1]); xa.y = cvt_pk_bf16(X4[2], X4[3]); \
                v4u db = zz; db.x = dr[p].x; db.y = dr[p].y; \
                Z4[p] = (f32x4){0.f, 0.f, 0.f, 0.f}; Z4[p] = mfma16(__builtin_bit_cast(bf16x8, xa), __builtin_bit_cast(bf16x8, db), Z4[p]); } \
            _Pragma("unroll") for (int p = 0; p < 2; ++p) { const int b0 = 2 * p, b1 = 2 * p + 1; \
                st4(T + (16 * b1 + m15) * 72 + 16 * b0 + 4 * qq, -Z4[p][0], -Z4[p][1], -Z4[p][2], -Z4[p][3]); \
                if (p == 0) { _Pragma("unroll") for (int r = 0; r < 4; ++r) DT1[(4 * qq + r) * 40 + 16 + m15] = (bf16)f2bf(-Z4[p][r]); } } } \
        asm volatile("" ::: "memory"); \
        const int r31 = lane & 31, hh = lane >> 5; \
        f32x16 X; _Pragma("unroll") for (int i = 0; i < 16; ++i) X[i] = 0.f; \
        _Pragma("unroll") for (int ks = 0; ks < 2; ++ks) X = __builtin_amdgcn_mfma_f32_32x32x16_bf16(ld8(Ab + (32 + r31) * 72 + 16 * ks + 8 * hh), ld8(DT1 + r31 * 40 + 16 * ks + 8 * hh), X, 0, 0, 0); \
        f32x16 Z; _Pragma("unroll") for (int i = 0; i < 16; ++i) Z[i] = 0.f; \
        _Pragma("unroll") for (int ks = 0; ks < 2; ++ks) { v4u pw; pw.x = cvt_pk_bf16(X[8 * ks + 0], X[8 * ks + 1]); pw.y = cvt_pk_bf16(X[8 * ks + 2], X[8 * ks + 3]); pw.z = cvt_pk_bf16(X[8 * ks + 4], X[8 * ks + 5]); pw.w = cvt_pk_bf16(X[8 * ks + 6], X[8 * ks + 7]); \
            const bf16* d2 = T + (32 + r31) * 72 + 32 + 16 * ks + 4 * hh; \
            Z = __builtin_amdgcn_mfma_f32_32x32x16_bf16(__builtin_bit_cast(bf16x8, pw), ld44(d2, d2 + 8), Z, 0, 0, 0); } \
        _Pragma("unroll") for (int g = 0; g < 4; ++g) st4(T + (32 + r31) * 72 + 8 * g + 4 * hh, -Z[4 * g], -Z[4 * g + 1], -Z[4 * g + 2], -Z[4 * g + 3]); } } while (0)
#define DP_S7() do { const bf16x8 ti0 = ld8(T + (16 * tr + l15) * 72 + 8 * q4), ti1 = ld8(T + (16 * tr + l15) * 72 + 32 + 8 * q4); \
        f32x4 wt[4]; \
        _Pragma("unroll") for (int dt = 0; dt < 4; ++dt) { wt[dt] = (f32x4){0.f, 0.f, 0.f, 0.f}; \
            wt[dt] = mfma16(ldtr8(KbT, 0, dt, lane), ti0, wt[dt]); wt[dt] = mfma16(ldtr8(KbT, 1, dt, lane), ti1, wt[dt]); } \
        v4u wa0, wa1; \
        wa0.x = cvt_pk_bf16(-wt[0][0], -wt[0][1]); wa0.y = cvt_pk_bf16(-wt[0][2], -wt[0][3]); wa0.z = cvt_pk_bf16(-wt[1][0], -wt[1][1]); wa0.w = cvt_pk_bf16(-wt[1][2], -wt[1][3]); \
        wa1.x = cvt_pk_bf16(-wt[2][0], -wt[2][1]); wa1.y = cvt_pk_bf16(-wt[2][2], -wt[2][3]); wa1.z = cvt_pk_bf16(-wt[3][0], -wt[3][1]); wa1.w = cvt_pk_bf16(-wt[3][2], -wt[3][3]); \
        _Pragma("unroll") for (int tcx = 0; tcx < 2; ++tcx) { const int e = 16 * (tc0 + tcx) + l15; \
            f32x4 u = (f32x4){0.f, 0.f, 0.f, 0.f}; \
            u = mfma16(ti0, ldtr8(VbT, 0, tc0 + tcx, lane), u); u = mfma16(ti1, ldtr8(VbT, 1, tc0 + tcx, lane), u); \
            const bf16* sp = St + e * 72 + 4 * q4; \
            u = mfma16(__builtin_bit_cast(bf16x8, wa0), ld44(sp, sp + 16), u); u = mfma16(__builtin_bit_cast(bf16x8, wa1), ld44(sp + 32, sp + 48), u); \
            st4(VnT + e * 72 + 16 * tr + 4 * q4, u[0], u[1], u[2], u[3]); } } while (0)
#define DP_S8(NB) do { const int nb_ = (NB); const float* vd_ = vec0 + (nb_ & 1) * 448; const bf16* Qn_ = Qn2 + (nb_ & 1) * 4608; const bf16* Kd_ = Kd2 + (nb_ & 1) * 4608; const int t0_ = DP_T0(nb_); \
        const bf16x8 sa0 = ld8(St + (16 * tr + l15) * 72 + 8 * q4), sa1 = ld8(St + (16 * tr + l15) * 72 + 32 + 8 * q4); \
        const bf16x8 va0 = ld8(VnT + (16 * tr + l15) * 72 + 8 * q4), va1 = ld8(VnT + (16 * tr + l15) * 72 + 32 + 8 * q4); \
        const bf16x8 ka0 = ldtr8(Kd_, 0, tr, lane), ka1 = ldtr8(Kd_, 1, tr, lane); \
        const float cd = vd_[256]; \
        _Pragma("unroll") for (int tcx = 0; tcx < 2; ++tcx) { const int i = 16 * (tc0 + tcx) + l15; \
            f32x4 o = (f32x4){0.f, 0.f, 0.f, 0.f}; \
            o = mfma16(sa0, ld8(Qn_ + i * 72 + 8 * q4), o); o = mfma16(sa1, ld8(Qn_ + i * 72 + 32 + 8 * q4), o); \
            o = o * vd_[64 + i]; \
            o = mfma16(va0, ld8(QKm + i * 72 + 8 * q4), o); o = mfma16(va1, ld8(QKm + i * 72 + 32 + 8 * q4), o); \
            const int t = t0_ + (dir ? 63 - i : i); \
            st4(OUT + ((size_t)b * SEQ + t) * 512 + h * 64 + 16 * tr + 4 * q4, o[0], o[1], o[2], o[3]); \
            const int e = 16 * (tc0 + tcx) + l15; \
            Sacc[tcx] = Sacc[tcx] * cd; Sacc[tcx] = mfma16(ka0, ld8(VnT + e * 72 + 8 * q4), Sacc[tcx]); Sacc[tcx] = mfma16(ka1, ld8(VnT + e * 72 + 32 + 8 * q4), Sacc[tcx]); } } while (0)
#define DP_STW() do { _Pragma("unroll") for (int tcx = 0; tcx < 2; ++tcx) { const int e = 16 * (tc0 + tcx) + l15; st4(St + e * 72 + 16 * tr + 4 * q4, Sacc[tcx][0], Sacc[tcx][1], Sacc[tcx][2], Sacc[tcx][3]); } } while (0)

    constexpr int NCK = SEQ / 64;
    DP_LANE(); DP_PREFETCH(0);
    __syncthreads();
    DP_S0(0);
    __syncthreads();
    DP_S1A(0); DP_S1B();
    __syncthreads();
    DP_LANE(); DP_S4(0); DP_S0(1);
    __syncthreads();
    DP_LANE(); DP_S5(); DP_S1A(1);
    __syncthreads();
#pragma nounroll
    for (int n = 0; n < NCK; ++n) {
        const bool has1 = n + 1 < NCK, has2 = n + 2 < NCK;
        DP_LANE(); DP_S7();
        __syncthreads();
        DP_LANE(); DP_S8(n); if (has1) DP_S1B();
        __syncthreads();
        DP_LANE(); DP_STW(); if (has1) DP_S4(n + 1); if (has2) DP_S0(n + 2);
        __syncthreads();
        DP_LANE(); if (has1) DP_S5(); if (has2) DP_S1A(n + 2);
        __syncthreads();
    }
#undef DP_LANE
#undef DP_T0
#undef DP_PREFETCH
#undef DP_S0
#undef DP_S1A
#undef DP_S1B
#undef DP_S4
#undef DP_S5
#undef DP_S7
#undef DP_S8
#undef DP_STW
}

constexpr int LN_CNT_OFF = LDSCTL_OFF + 512;
template <int MODE, bool W8 = false, bool G8 = false>
__device__ __forceinline__ void ln_phase(Frame& F, const float* gam, const float* bet) {
    float* out = F.out; bf16* HB = (bf16*)(F.ws + WS_HB);
    unsigned* lcnt = (unsigned*)(F.lds + LN_CNT_OFF);
    unsigned* TOKE = (unsigned*)(F.ws + WS_META + MT_TOKE); float* TOKP = (float*)(F.ws + WS_META + MT_TOKP); unsigned short* RANK = (unsigned short*)(F.ws + WS_META + MT_RANK);
    unsigned* CNT = (unsigned*)(F.ws + WS_META + MT_CNT); const bf16* YS = (const bf16*)(F.ws + WS_YS);
    const int lane = F.lane;
    LAS f32x4* RW0 = (LAS f32x4*)((LAS unsigned char*)F.lds); LAS f32x4* RW1 = RW0 + 1024;
    if (MODE == 1) { if (F.tid < 8) lcnt[F.tid] = 0u;
        for (int i = F.tid; i < 1024; i += NTHR) { const int jc = i >> 6, ln = i & 63; const float* rw = IN_router_w(F) + (size_t)(ln * 4 + 256 * (jc >> 2) + (jc & 3)) * 8;
            RW0[i] = *(const f32x4*)rw; RW1[i] = *(const f32x4*)(rw + 4); }
        __syncthreads(); }
    f32x4 gv[4], bv[4];
#pragma unroll
    for (int j = 0; j < 4; ++j) { gv[j] = *(const f32x4*)(gam + lane * 4 + 256 * j); bv[j] = *(const f32x4*)(bet + lane * 4 + 256 * j); }
    v2u nx[2][4];
    { const bf16* h0 = HB + ((size_t)F.bx * 128 + F.wave * 16) * 1024 + lane * 4;
#pragma unroll
        for (int u = 0; u < 2; ++u)
#pragma unroll
            for (int j = 0; j < 4; ++j) nx[u][j] = *(const v2u*)(h0 + u * 1024 + 256 * j); }
    for (int i2 = 0; i2 < 16; i2 += 2) {
      v2u cur[2][4];
#pragma unroll
      for (int u = 0; u < 2; ++u)
#pragma unroll
          for (int j = 0; j < 4; ++j) cur[u][j] = nx[u][j];
      if (i2 + 2 < 16) { const bf16* h0 = HB + ((size_t)F.bx * 128 + F.wave * 16 + i2 + 2) * 1024 + lane * 4;
#pragma unroll
          for (int u = 0; u < 2; ++u)
#pragma unroll
              for (int j = 0; j < 4; ++j) nx[u][j] = *(const v2u*)(h0 + u * 1024 + 256 * j); }
#pragma unroll
      for (int u = 0; u < 2; ++u) {
        const int i = i2 + u;
        const size_t m = (size_t)F.bx * 128 + F.wave * 16 + i;
        float* zr = out + m * 1024 + lane * 4; bf16* hr = HB + m * 1024 + lane * 4;
        f32x4 v[4];
#pragma unroll
        for (int j = 0; j < 4; ++j) v[j] = (f32x4){bflo(cur[u][j].x), bfhi(cur[u][j].x), bflo(cur[u][j].y), bfhi(cur[u][j].y)};
        if (MODE == 2) {
            const float p1 = (ABL == 5) ? 0.f : TOKP[m * 2], p2 = (ABL == 5) ? 0.f : TOKP[m * 2 + 1];
            const bf16* y1 = YS + m * 2048 + lane * 4; const bf16* y2 = y1 + 1024;
#pragma unroll
            for (int j = 0; j < 4; ++j) { const v2u a = *(const v2u*)(y1 + 256 * j), b = *(const v2u*)(y2 + 256 * j);
                v[j][0] = v[j][0] * ALPHA + p1 * bflo(a.x) + p2 * bflo(b.x); v[j][1] = v[j][1] * ALPHA + p1 * bfhi(a.x) + p2 * bfhi(b.x);
                v[j][2] = v[j][2] * ALPHA + p1 * bflo(a.y) + p2 * bflo(b.y); v[j][3] = v[j][3] * ALPHA + p1 * bfhi(a.y) + p2 * bfhi(b.y); }
        }
        float s = 0.f;
#pragma unroll
        for (int j = 0; j < 4; ++j) s += (v[j][0] + v[j][1]) + (v[j][2] + v[j][3]);
        const float mean = wave_sum(s) * (1.0f / 1024.0f);
        float q = 0.f;
#pragma unroll
        for (int j = 0; j < 4; ++j) { v[j] = v[j] - mean; q += (v[j][0] * v[j][0] + v[j][1] * v[j][1]) + (v[j][2] * v[j][2] + v[j][3] * v[j][3]); }
        const float rstd = __builtin_amdgcn_rsqf(wave_sum(q) * (1.0f / 1024.0f) + LN_EPS);
#pragma unroll
        for (int j = 0; j < 4; ++j) { v[j] = v[j] * rstd * gv[j] + bv[j]; if (MODE == 2) *(f32x4*)(zr + 256 * j) = v[j]; }
        if (MODE != 2) {
#pragma unroll
            for (int j = 0; j < 4; ++j) { v2u w; w.x = pk2(v[j][0], v[j][1]); w.y = pk2(v[j][2], v[j][3]); *(v2u*)(hr + 256 * j) = w; }
        }
        if (G8) { unsigned char* h8 = F.ws + WS_HBG8 + m * 1024 + lane * 4;
#pragma unroll
            for (int j = 0; j < 4; ++j) *(unsigned*)(h8 + 256 * j) = pk4_fp8(v[j][0], v[j][1], v[j][2], v[j][3]); }
        if (W8) { unsigned char* h8 = F.ws + WS_HB8 + m * 1024 + lane * 4;
#pragma unroll
            for (int j = 0; j < 4; ++j) *(unsigned*)(h8 + 256 * j) = pk4_fp8(v[j][0], v[j][1], v[j][2], v[j][3]); }
        if (MODE == 1) {
            float lg[8];
#pragma unroll
            for (int e = 0; e < 8; ++e) lg[e] = 0.f;
#pragma unroll
            for (int j = 0; j < 4; ++j)
#pragma unroll
                for (int c = 0; c < 4; ++c) { const f32x4 r0 = RW0[(j * 4 + c) * 64 + lane], r1 = RW1[(j * 4 + c) * 64 + lane]; const float hv = v[j][c];
                    lg[0] += hv * r0[0]; lg[1] += hv * r0[1]; lg[2] += hv * r0[2]; lg[3] += hv * r0[3]; lg[4] += hv * r1[0]; lg[5] += hv * r1[1]; lg[6] += hv * r1[2]; lg[7] += hv * r1[3]; }
#pragma unroll
            for (int e = 0; e < 8; ++e) lg[e] = wave_sum(lg[e]);
            int e1 = 0; float l1 = lg[0];
#pragma unroll
            for (int e = 1; e < 8; ++e) if (lg[e] > l1) { l1 = lg[e]; e1 = e; }
            int e2 = -1; float l2 = -3.0e38f;
#pragma unroll
            for (int e = 0; e < 8; ++e) if (e != e1 && lg[e] > l2) { l2 = lg[e]; e2 = e; }
            if (lane == 0) {
                const float p1 = 1.0f / (1.0f + __expf(l2 - l1));
                TOKE[m] = (unsigned)e1 | ((unsigned)e2 << 8); TOKP[m * 2] = p1; TOKP[m * 2 + 1] = 1.0f - p1; (F.ws + WS_META + MT_DEFER)[m] = 0;
                RANK[m * 2] = (unsigned short)atomicAdd(&lcnt[e1], 1u); RANK[m * 2 + 1] = (unsigned short)atomicAdd(&lcnt[e2], 1u);
            }
        }
      }
    }
    if (MODE == 1) { __syncthreads(); if (F.tid < 8) CNT[F.bx * 8 + F.tid] = lcnt[F.tid]; }
}

constexpr int MT_BASE = 288, MT_TOT = 304, MT_NT = 312, MT_PRE = 320;
constexpr int TAIL_U0 = 512, TAIL_ROW0 = (CHT * (NCH - 1) + TAIL_U0 / 4) * 256;
__device__ __forceinline__ void moe_meta(Frame& F, int ln_wg  ) {
    int* mt = (int*)(F.lds + MOE_LDS_OFF); const unsigned* CNT = (const unsigned*)(F.ws + WS_META + MT_CNT);
    __syncthreads();
    { const int e = F.wave; int tot = 0, pre = 0;
#pragma unroll
        for (int k = 0; k < 4; ++k) { const int w = F.lane + 64 * k; const int v = (int)CNT[w * 8 + e]; tot += v; if (w < ln_wg) pre += v; }
#pragma unroll
        for (int o = 1; o < 64; o <<= 1) { tot += __shfl_xor(tot, o); pre += __shfl_xor(pre, o); }
        if (F.lane == 0) { mt[MT_TOT + e] = tot; mt[MT_PRE + e] = pre; } }
    __syncthreads();
    if (F.tid == 0) { int base = 0;
        for (int e = 0; e < 8; ++e) { mt[MT_BASE + e] = base; const int nt = (mt[MT_TOT + e] + 255) >> 8; for (int t = 0; t < nt; ++t) mt[(base >> 8) + t] = e; base += nt << 8; }
        mt[MT_BASE + 8] = base; mt[MT_NT] = base >> 8; }
    __syncthreads();
}
__device__ __forceinline__ int moe_chunk_tiles(const int* mt, int c) { return c < NCH - 1 ? CHT : mt[MT_NT] - CHT * (NCH - 1); }
__device__ __forceinline__ void moe_gather(Frame& F, int c) {
    if (MK_PER_PHASE || c == 0) moe_meta(F, F.bx);
    const int* mt = (const int*)(F.lds + MOE_LDS_OFF);
    const unsigned* TOKE = (const unsigned*)(F.ws + WS_META + MT_TOKE); const unsigned short* RANK = (const unsigned short*)(F.ws + WS_META + MT_RANK);
    unsigned* ROWMAP = (unsigned*)(F.ws + WS_META + MT_ROWMAP);
    const bf16* HB = (const bf16*)(F.ws + WS_HB); bf16* XG = (bf16*)(F.ws + WS_XG);
    const int lane = F.lane, li = lane & 31; const size_t mbase = (size_t)F.bx * 128 + F.wave * 16;
    int pos; bool mine;
    { const size_t m = mbase + (li >> 1); const int slot = li & 1;
        const int e = (int)((TOKE[m] >> (8 * slot)) & 0xffu);
        pos = mt[MT_BASE + e] + mt[MT_PRE + e] + (int)RANK[m * 2 + slot];
        int cc = pos / (CHT * 256); if (cc > NCH - 1) cc = NCH - 1;
        mine = lane < 32 && cc == c;
        if (mine) { ROWMAP[pos] = (unsigned)(m * 2 + slot); if (c == NCH - 1 && pos >= TAIL_ROW0) (F.ws + WS_META + MT_DEFER)[m] = 1; } }
    unsigned mask = (unsigned)__ballot(mine);
    while (mask) {
        int id[4];
#pragma unroll
        for (int k = 0; k < 4; ++k) { if (mask) { id[k] = __builtin_ctz(mask); mask &= mask - 1u; } else id[k] = -1; }
        v4u a[4], b[4];
#pragma unroll
        for (int k = 0; k < 4; ++k) if (id[k] >= 0) { const bf16* src = HB + (mbase + (id[k] >> 1)) * 1024 + lane * 16; a[k] = *(const v4u*)src; b[k] = *(const v4u*)(src + 8); }
#pragma unroll
        for (int k = 0; k < 4; ++k) if (id[k] >= 0) {
            const size_t lr = (size_t)(__builtin_amdgcn_readlane(pos, id[k]) - CHT * 256 * c);
            if (MOE_FP8) { f32x4 t0, t1, t2, t3; unpack8(a[k], t0, t1); unpack8(b[k], t2, t3);
                v4u o; o.x = pk4_fp8(t0[0], t0[1], t0[2], t0[3]); o.y = pk4_fp8(t1[0], t1[1], t1[2], t1[3]); o.z = pk4_fp8(t2[0], t2[1], t2[2], t2[3]); o.w = pk4_fp8(t3[0], t3[1], t3[2], t3[3]);
                *(v4u*)((unsigned char*)XG + lr * 1024 + lane * 16) = o; }
            else { *(v4u*)(XG + lr * 1024 + lane * 16) = a[k]; *(v4u*)(XG + lr * 1024 + lane * 16 + 8) = b[k]; }
        }
    }
}
template <int PASS>
__device__ __forceinline__ void ln_final(Frame& F, const float* gam, const float* bet, int nskip) {
    float* out = F.out; const bf16* HB = (const bf16*)(F.ws + WS_HB);
    const float* TOKP = (const float*)(F.ws + WS_META + MT_TOKP); const bf16* YS = (const bf16*)(F.ws + WS_YS); const unsigned char* DEFER = F.ws + WS_META + MT_DEFER;
    const int lane = F.lane;
    f32x4 gv[4], bv[4];
#pragma unroll
    for (int j = 0; j < 4; ++j) { gv[j] = *(const f32x4*)(gam + lane * 4 + 256 * j); bv[j] = *(const f32x4*)(bet + lane * 4 + 256 * j); }
    int r0, r1; unsigned long long dmask = 0ull;
    if (PASS == 1) { const int nw = (F.G - nskip) * NWAVES, wv = (F.bx - nskip) * NWAVES + F.wave; r0 = (int)(((long)wv * M) / nw); r1 = (int)(((long)(wv + 1) * M) / nw); }
    else { r0 = F.bx * 128 + F.wave * 16; r1 = r0 + 16; dmask = __ballot(lane < 16 && DEFER[r0 + (lane & 15)] != 0); }
    v2u nx[4], ny1[4], ny2[4]; unsigned nfl = 0u; float np1 = 0.f, np2 = 0.f;
    if (PASS == 1 && r0 < r1) { const bf16* h0 = HB + (size_t)r0 * 1024 + lane * 4; const bf16* y0 = YS + (size_t)r0 * 2048 + lane * 4; nfl = DEFER[r0]; np1 = TOKP[(size_t)r0 * 2]; np2 = TOKP[(size_t)r0 * 2 + 1];
#pragma unroll
        for (int j = 0; j < 4; ++j) { nx[j] = *(const v2u*)(h0 + 256 * j); ny1[j] = *(const v2u*)(y0 + 256 * j); ny2[j] = *(const v2u*)(y0 + 1024 + 256 * j); } }
    for (int m_ = r0; m_ < r1; ++m_) {
        const size_t m = (size_t)m_;
        float* zr = out + m * 1024 + lane * 4; const bf16* hr = HB + m * 1024 + lane * 4;
        const bf16* y1 = YS + m * 2048 + lane * 4; const bf16* y2 = y1 + 1024;
        f32x4 v[4]; v2u ya[4], yb[4]; float p1, p2; bool skip;
        if (PASS == 1) {
#pragma unroll
            for (int j = 0; j < 4; ++j) { v[j] = (f32x4){bflo(nx[j].x), bfhi(nx[j].x), bflo(nx[j].y), bfhi(nx[j].y)}; ya[j] = ny1[j]; yb[j] = ny2[j]; }
            p1 = np1; p2 = np2;
            skip = __builtin_amdgcn_readfirstlane(nfl) != 0u;
            if (m_ + 1 < r1) { nfl = DEFER[m + 1]; np1 = TOKP[m * 2 + 2]; np2 = TOKP[m * 2 + 3];
#pragma unroll
                for (int j = 0; j < 4; ++j) { nx[j] = *(const v2u*)(hr + 1024 + 256 * j); ny1[j] = *(const v2u*)(y1 + 2048 + 256 * j); ny2[j] = *(const v2u*)(y2 + 2048 + 256 * j); } }
        } else {
            skip = ((dmask >> (m_ - r0)) & 1ull) == 0ull;
            if (!skip) { p1 = TOKP[m * 2]; p2 = TOKP[m * 2 + 1];
#pragma unroll
                for (int j = 0; j < 4; ++j) { const v2u w = *(const v2u*)(hr + 256 * j); v[j] = (f32x4){bflo(w.x), bfhi(w.x), bflo(w.y), bfhi(w.y)}; ya[j] = *(const v2u*)(y1 + 256 * j); yb[j] = *(const v2u*)(y2 + 256 * j); } }
        }
        if (skip) continue;
        if (ABL == 5) { p1 = 0.f; p2 = 0.f; }
#pragma unroll
        for (int j = 0; j < 4; ++j) { const v2u a = ya[j], b = yb[j];
            v[j][0] = v[j][0] * ALPHA + p1 * bflo(a.x) + p2 * bflo(b.x); v[j][1] = v[j][1] * ALPHA + p1 * bfhi(a.x) + p2 * bfhi(b.x);
            v[j][2] = v[j][2] * ALPHA + p1 * bflo(a.y) + p2 * bflo(b.y); v[j][3] = v[j][3] * ALPHA + p1 * bfhi(a.y) + p2 * bfhi(b.y); }
        float s = 0.f;
#pragma unroll
        for (int j = 0; j < 4; ++j) s += (v[j][0] + v[j][1]) + (v[j][2] + v[j][3]);
        const float mean = wave_sum(s) * (1.0f / 1024.0f);
        float q = 0.f;
#pragma unroll
        for (int j = 0; j < 4; ++j) { v[j] = v[j] - mean; q += (v[j][0] * v[j][0] + v[j][1] * v[j][1]) + (v[j][2] * v[j][2] + v[j][3] * v[j][3]); }
        const float rstd = __builtin_amdgcn_rsqf(wave_sum(q) * (1.0f / 1024.0f) + LN_EPS);
#pragma unroll
        for (int j = 0; j < 4; ++j) { v[j] = v[j] * rstd * gv[j] + bv[j]; *(f32x4*)(zr + 256 * j) = v[j]; }
    }
}
struct MoeSched {
    int G, c, NJ, nunits, t0; const int* mt; const char* A; const char* B; size_t tsA, tsB; int off = 0;
    __device__ __forceinline__ bool next(int i, Unit& u) const { const int L = i * G + c + off; if (L >= nunits) return false; u.pm = L / NJ; u.aux = L - u.pm * NJ; u.pn = mt[t0 + u.pm] * NJ + u.aux; return true; }
    __device__ __forceinline__ const char* abase(const Unit& u) const { return A + (size_t)u.pm * tsA; }
    __device__ __forceinline__ const char* bbase(const Unit& u) const { return B + (size_t)u.pn * tsB; }
};
struct EpiMoeDown {
    static constexpr bool PERM = true;
    bf16* YS; const unsigned* rowmap; const int* mt; int t0;
    __device__ __forceinline__ void operator()(acc_t& acc, const Unit& u, int wr, int wc, int fr, int fq) const {
        const int tg = t0 + u.pm, e = mt[tg], lim = mt[MT_BASE + e] + mt[MT_TOT + e]; const int row0 = tg * 256 + wr * 64 + fr; const int col = u.aux * 256 + wc * 32 + 8 * fq;
#pragma unroll
        for (int ai = 0; ai < 2; ++ai)
#pragma unroll
            for (int m = 0; m < 4; ++m) { const int r = row0 + ai * 128 + m * 16;
                if (r < lim) { const size_t pr = rowmap[r]; bf16* dst = YS + pr * 1024 + col;
                    const float ds = (FP8_EMU || MOE_FP8) ? (1.0f / 32.0f) : 1.0f;
                    *(v4u*)(dst) = pack8(acc[ai][0][m][0] * ds, acc[ai][0][m][1] * ds); *(v4u*)(dst + 128) = pack8(acc[ai][1][m][0] * ds, acc[ai][1][m][1] * ds); } }
        zero_acc(acc);
    }
};

__global__ void __launch_bounds__(NTHR, 2) fwd_kernel(Args args) {
    extern __shared__ __attribute__((aligned(16))) unsigned char lds[];
    Frame F0;
    F0.lds = lds;
    F0.tid = threadIdx.x; F0.lane = F0.tid & 63; F0.wave = __builtin_amdgcn_readfirstlane(F0.tid >> 6);
    F0.G = gridDim.x; F0.bx = blockIdx.x;
    F0.ws = args.ws; F0.out = args.out;
    F0.a = &args;
    { LAS unsigned char* ldsl0 = (LAS unsigned char*)lds;
    for (int u = F0.tid; u < (LDS_BYTES - LDSCTL_OFF) / 4; u += NTHR) ((LAS unsigned*)(ldsl0 + LDSCTL_OFF))[u] = 0u; }
    __syncthreads();
    unsigned* ctl = (unsigned*)(F0.ws + WS_CTL);
    XcdBarrier bar; bar.bar = ctl + CW_BAR; bar.x = 0; bar.st = nullptr; bar.w0 = 0;
    if (!MK_PER_PHASE) bar = xcd_barrier_post(ctl + CW_BAR, (volatile LAS unsigned*)((LAS unsigned char*)lds + MISC_OFF) + 8);
    const int lo = args.ph_lo, hi = args.ph_hi;
#ifndef PHASE_MASK
#define PHASE_MASK 0xFFFFFFFFu
#endif
#define EN(b) (((PHASE_MASK) >> (b)) & 1u)
#ifndef SP2K
#define SP2K 0
#endif
#ifndef ALN
#define ALN 14
#endif
#ifndef DBL
#define DBL 0
#endif
#define REP(k) for (int rep_ = 0; rep_ < ((DBL) == (k) ? 2 : 1); ++rep_)
#define IN(k) (lo <= (k) && (k) < hi)
#define GRID_BAR() do { if (!MK_PER_PHASE) xcd_barrier(bar); } while (0)
#define PH_BEGIN() Frame P = F0; asm volatile("" : "+s"(P.ws), "+s"(P.out), "+s"(P.G), "+s"(P.bx)); P.lane = (int)__builtin_amdgcn_mbcnt_hi(~0u, __builtin_amdgcn_mbcnt_lo(~0u, 0u)); asm volatile("" : "+v"(P.lane)); P.tid = P.wave * 64 + P.lane; Frame& F = P; LAS unsigned char* ldsl = (LAS unsigned char*)P.lds;

    if (EN(0) && IN(0)) { PH_BEGIN(); REP(100) p0_prologue(F); }
    GRID_BAR();
#if defined(XBAR)
    for (int xb_ = 0; xb_ < XBAR; ++xb_) GRID_BAR();
#endif

#pragma nounroll
    for (int layer = 0; layer < 2; ++layer) {
        const int pb = 1 + 40 * layer;
        if (EN(1) && IN(pb + 0)) { PH_BEGIN(); const bf16* HB = (const bf16*)(F.ws + WS_HB); const bf16* WIN = (const bf16*)(F.ws + WS_WIN) + (size_t)layer * WIN_ROWS * 1024;
            pg8::StdSched S; S.init(HB, WIN, M, NA, 1024, F.G, F.bx);
            EpiInA E{F.ws};
            REP(1) pg8::gemm_phase<EpiInA, pg8::StdSched, (ALN & 8) == 0, true>(ldsl + RING_OFF, 1024, S, E, F.wave);
        }
        GRID_BAR();
        if (EN(2) && IN(pb + 1)) { PH_BEGIN();
#if defined(DELTA_RECURRENT)
            REP(21) for (int s = F.bx; s < 256; s += F.G) delta_seq(F, layer, s);
#else
#if defined(DELTA_NOPIPE)
            REP(21) for (int s = F.bx; s < 256; s += F.G) delta_seq_chunked(F, layer, s);
#else
            REP(21) for (int s = F.bx; s < 256; s += F.G) delta_seq_pipe(F, layer, s);
#endif
#endif
            __syncthreads();
            attn_bias_setup(F);
            if (DBL == 22) attn_phase(F, layer, (bf16*)(F.ws + WS_OP));
            attn_phase(F, layer, nullptr);
            REP(23) for (int u = F.bx; u < 1024; u += F.G) pool_unit(F, layer, u);
        }
        GRID_BAR();
        if (EN(3) && IN(pb + 20)) { PH_BEGIN(); delta_post(F, layer); }
        GRID_BAR();
        if (EN(3) && IN(pb + 2)) { PH_BEGIN(); const bf16* HB = (const bf16*)(F.ws + WS_HB); const bf16* WIN = (const bf16*)(F.ws + WS_WIN) + (size_t)layer * WIN_ROWS * 1024;
#if GATES_FP8
            pg8::StdSched S; S.init(F.ws + WS_HBG8, WIN + (size_t)NA * 1024, M, NG, 512, F.G, F.bx); (void)HB;
            EpiGates E{(bf16*)(F.ws + WS_GT), 1.0f / 32.0f};
            REP(3) pg8::gemm_phase<EpiGates, pg8::StdSched, (ALN & 2) == 0, (SP2K & 2) == 0, true>(ldsl + RING_OFF, 512, S, E, F.wave);
#else
            pg8::StdSched S; S.init(HB, WIN + (size_t)NA * 1024, M, NG, 1024, F.G, F.bx);
            EpiGates E{(bf16*)(F.ws + WS_GT), 1.0f};
            REP(3) pg8::gemm_phase<EpiGates, pg8::StdSched, true, true>(ldsl + RING_OFF, 1024, S, E, F.wave);
#endif
        }
        GRID_BAR();
        if (EN(4) && IN(pb + 3)) { PH_BEGIN();
#if defined(BRSKEW)
            if (F.bx & 1) { for (int i_ = 0; i_ < BRSKEW; ++i_) __builtin_amdgcn_s_sleep(127); }
#endif
            BrSched S; S.o.init(M / 256, 4, F.G, F.bx); S.A0 = (const char*)(F.ws + WS_AQ); static_assert(WS_DZ == WS_AQ + 32 * MiB && WS_OP == WS_AQ + 64 * MiB, "branch planes");
            S.B0 = (const char*)(F.ws + WS_WBR) + (size_t)layer * 3 * 1024 * 512 * 2; S.tstep = (size_t)256 * 512 * 2;
#if defined(BR_RMW)
            EpiBranchRMW E{(const bf16*)(F.ws + WS_GT), (bf16*)(F.ws + WS_MERGED)};
            pg8::gemm_phase<EpiBranchRMW, BrSched, false, true>(ldsl + RING_OFF, 512, S, E, F.wave);
#else
            EpiBranch E{(const bf16*)(F.ws + WS_GT), (bf16*)(F.ws + WS_MERGED)};
            REP(4) pg8::gemm_phase<EpiBranch, BrSched, (ALN & 16) == 0, true>(ldsl + RING_OFF, 512, S, E, F.wave);
#endif
        }
        GRID_BAR();
        if (EN(5) && IN(pb + 4)) { PH_BEGIN();
            pg8::StdSched S; S.init(F.ws + WS_MERGED, (const bf16*)(F.ws + WS_WOUT) + (size_t)layer * 1024 * 1024, M, 1024, 1024, F.G, F.bx);
#if (LN_FUSE & 1)
            if (layer == 0) { EpiResidLN<0, false, 0> E{F.ws, F.a, ldsl, 1.0f};
                pg8::gemm_phase<EpiResidLN<0, false, 0>, pg8::StdSched, true, true>(ldsl + RING_OFF, 1024, S, E, F.wave); }
            else
#endif
            { EpiResid E{(bf16*)(F.ws + WS_HB), 1.0f};
            pg8::gemm_phase<EpiResid, pg8::StdSched, (ALN & 32) == 0, true>(ldsl + RING_OFF, 1024, S, E, F.wave); }
        }
        GRID_BAR();
        if (EN(6) && IN(pb + 5) && !((LN_FUSE & 1) && layer == 0)) { PH_BEGIN();
            if (layer == 0) ln_phase<0, FFN_FP8 == 1 || FFN_FP8 == 2>(F, IN_ln1_g(F), IN_ln1_b(F));
            else { ln_phase<1>(F, IN_ln1_g(F) + 1024, IN_ln1_b(F) + 1024); REP(101) moe_weight_convert(F); }
        }
        if (!((LN_FUSE & 1) && layer == 0)) GRID_BAR();
        if (layer == 0) {
            if (EN(7) && IN(pb + 6)) { PH_BEGIN(); const bf16* HB = (const bf16*)(F.ws + WS_HB);
#if FFN_FP8 == 2
                FfnUpSched S; S.o.init(M / 256, FF / 128, F.G, F.bx); S.A = (const char*)(F.ws + WS_HB8); S.Bt = (const char*)(F.ws + WS_W13); S.tstep = (size_t)256 * 1024; (void)HB;
                EpiSwiglu E{(bf16*)(F.ws + WS_FACT), FF, 1.0f / 32.0f, 0};
                REP(7) pg8::gemm_phase<EpiSwiglu, FfnUpSched, true, true, true>(ldsl + RING_OFF, 512, S, E, F.wave);
#elif FFN_FP8 == 1
                FfnUpSched S; S.o.init(M / 256, FF / 128, F.G, F.bx); S.A = (const char*)(F.ws + WS_HB8); S.Bt = (const char*)(F.ws + WS_W13); S.tstep = (size_t)256 * 1024; (void)HB;
                EpiSwiglu8 E{(unsigned char*)(F.ws + WS_FACT), FF, 1.0f / 32.0f};
                REP(7) pg8::gemm_phase<EpiSwiglu8, FfnUpSched, true, true, true>(ldsl + RING_OFF, 512, S, E, F.wave);
#elif FFN_FP8 == 3
                FfnUpSched S; S.o.init(M / 256, FF / 128, F.G, F.bx); S.A = (const char*)HB; S.Bt = (const char*)(F.ws + WS_W13); S.tstep = (size_t)256 * 1024 * 2;
                EpiSwiglu8 E{(unsigned char*)(F.ws + WS_FACT), FF, 1.0f};
                REP(7) pg8::gemm_phase<EpiSwiglu8, FfnUpSched, (ALN & 4) == 0, true>(ldsl + RING_OFF, 1024, S, E, F.wave);
#else
                FfnUpSched S; S.o.init(M / 256, FF / 128, F.G, F.bx); S.A = (const char*)HB; S.Bt = (const char*)(F.ws + WS_W13); S.tstep = (size_t)256 * 1024 * 2;
                EpiSwiglu E{(bf16*)(F.ws + WS_FACT), FF, 1.0f, 0};
                REP(7) pg8::gemm_phase<EpiSwiglu, FfnUpSched, (ALN & 4) == 0, true>(ldsl + RING_OFF, 1024, S, E, F.wave);
#endif
            }
            GRID_BAR();
            if (EN(8) && IN(pb + 7)) { PH_BEGIN();
#if FFN_FP8 == 1 || FFN_FP8 == 3
                pg8::StdSched S; S.init(F.ws + WS_FACT, F.ws + WS_W2, M, 1024, FF / 2, F.G, F.bx);
#if (LN_FUSE & 2)
                EpiResidLN<1, GATES_FP8 != 0, 1> E{F.ws, F.a, ldsl, (ABL == 4) ? 0.f : (1.0f / 32.0f)};
                pg8::gemm_phase<EpiResidLN<1, GATES_FP8 != 0, 1>, pg8::StdSched, true, true, true>(ldsl + RING_OFF, FF / 2, S, E, F.wave);
#else
                EpiResid E{(bf16*)(F.ws + WS_HB), (ABL == 4) ? 0.f : (1.0f / 32.0f)};
                pg8::gemm_phase<EpiResid, pg8::StdSched, true, true, true>(ldsl + RING_OFF, FF / 2, S, E, F.wave);
#endif
#else
                pg8::StdSched S; S.init(F.ws + WS_FACT, F.ws + WS_W2, M, 1024, FF, F.G, F.bx);
                EpiResid E{(bf16*)(F.ws + WS_HB), (ABL == 4) ? 0.f : 1.0f};
                pg8::gemm_phase<EpiResid, pg8::StdSched, (ALN & 64) == 0, true>(ldsl + RING_OFF, FF, S, E, F.wave);
#endif
            }
            GRID_BAR();
#if !((LN_FUSE & 2) && (FFN_FP8 == 1 || FFN_FP8 == 3))
            if (EN(9) && IN(pb + 8)) { PH_BEGIN(); ln_phase<0, false, GATES_FP8 != 0>(F, IN_ln2_g(F), IN_ln2_b(F)); }
            GRID_BAR();
#endif
        } else {
            if (EN(10) && IN(pb + 6)) { PH_BEGIN(); moe_gather(F, 0); }
            GRID_BAR();
#pragma nounroll
            for (int c = 0; c < NCH; ++c) {
                if (EN(11) && IN(pb + 7 + 2 * c)) { PH_BEGIN(); const int* mt = (const int*)(F.lds + MOE_LDS_OFF);
                    if (MK_PER_PHASE) moe_meta(F, -1);
                    MoeSched S; S.G = F.G; S.c = F.bx; S.NJ = FFE / 128; S.t0 = CHT * c; S.nunits = moe_chunk_tiles(mt, c) * S.NJ; S.mt = mt; S.A = (const char*)(F.ws + WS_XG); S.B = (const char*)(F.ws + WS_MWGU);
                    S.tsA = (size_t)256 * 1024 * (MOE_FP8 ? 1 : 2); S.tsB = S.tsA;
#if MOE_FP8
                    EpiSwiglu8 E{(unsigned char*)(F.ws + WS_MACT), FFE, 1.0f / 32.0f};
                    REP(11) pg8::gemm_phase<EpiSwiglu8, MoeSched, (ALN & 1) == 0, (SP2K & 1) == 0, true>(ldsl + RING_OFF, 512, S, E, F.wave);
#else
                    EpiSwiglu E{(bf16*)(F.ws + WS_MACT), FFE, FP8_EMU ? (1.0f / 32.0f) : 1.0f, FP8_EMU};
                    REP(11) pg8::gemm_phase<EpiSwiglu, MoeSched, true, true>(ldsl + RING_OFF, 1024, S, E, F.wave);
#endif
                }
                GRID_BAR();
                if (EN(12) && IN(pb + 8 + 2 * c)) { PH_BEGIN(); const int* mt = (const int*)(F.lds + MOE_LDS_OFF);
                    if (MK_PER_PHASE) moe_meta(F, -1);
                    MoeSched S; S.G = F.G; S.c = F.bx; S.NJ = 4; S.t0 = CHT * c; S.nunits = moe_chunk_tiles(mt, c) * 4; if (c == NCH - 1 && S.nunits > TAIL_U0) S.nunits = TAIL_U0; S.mt = mt; S.A = (const char*)(F.ws + WS_MACT); S.B = (const char*)(F.ws + WS_MWD);
                    S.tsA = (size_t)256 * FFE * (MOE_FP8 ? 1 : 2); S.tsB = S.tsA;
                    EpiMoeDown E{(bf16*)(F.ws + WS_YS), (const unsigned*)(F.ws + WS_META + MT_ROWMAP), mt, CHT * c};
#if MOE_FP8
                    REP(12) pg8::gemm_phase<EpiMoeDown, MoeSched, (ALN & 128) == 0, (SP2K & 4) == 0, true>(ldsl + RING_OFF, FFE / 2, S, E, F.wave);
#else
                    REP(12) pg8::gemm_phase<EpiMoeDown, MoeSched, true, true>(ldsl + RING_OFF, FFE, S, E, F.wave);
#endif
                }
                if (EN(12) && IN(pb + 8 + 2 * c) && c + 1 < NCH) { PH_BEGIN(); moe_gather(F, c + 1); }
                GRID_BAR();
            }
            if (EN(13) && IN(pb + 13)) { PH_BEGIN(); const int* mt = (const int*)(F.lds + MOE_LDS_OFF);
                if (MK_PER_PHASE) moe_meta(F, -1);
                const int total = moe_chunk_tiles(mt, NCH - 1) * 4, ntail = total > TAIL_U0 ? total - TAIL_U0 : 0;
                if (F.bx < ntail) {
                    MoeSched S; S.G = F.G; S.c = F.bx; S.NJ = 4; S.t0 = CHT * (NCH - 1); S.nunits = total; S.off = TAIL_U0; S.mt = mt; S.A = (const char*)(F.ws + WS_MACT); S.B = (const char*)(F.ws + WS_MWD);
                    S.tsA = (size_t)256 * FFE * (MOE_FP8 ? 1 : 2); S.tsB = S.tsA;
                    EpiMoeDown E{(bf16*)(F.ws + WS_YS), (const unsigned*)(F.ws + WS_META + MT_ROWMAP), mt, CHT * (NCH - 1)};
#if MOE_FP8
                    pg8::gemm_phase<EpiMoeDown, MoeSched, true, true, true>(ldsl + RING_OFF, FFE / 2, S, E, F.wave);
#else
                    pg8::gemm_phase<EpiMoeDown, MoeSched, true, true>(ldsl + RING_OFF, FFE, S, E, F.wave);
#endif
                } else ln_final<1>(F, IN_ln2_g(F) + 1024, IN_ln2_b(F) + 1024, ntail);
            }
            GRID_BAR();
            if (EN(13) && IN(pb + 15)) { PH_BEGIN(); ln_final<2>(F, IN_ln2_g(F) + 1024, IN_ln2_b(F) + 1024, 0); }
        }
    }
#undef IN
#undef GRID_BAR
}


#if defined(DBG_CHECK)
constexpr int CK_BASE = 512;
__device__ __forceinline__ unsigned ck_hash(unsigned x) { x ^= x >> 16; x *= 0x7feb352du; x ^= x >> 15; x *= 0x846ca68bu; x ^= x >> 16; return x; }
__device__ __forceinline__ void ck_record(unsigned* ctl, int stage, float mine, float ref) {
    const float e = fabsf(mine - ref), r = fabsf(ref);
    atomicMax(ctl + CK_BASE + 2 * stage, __float_as_uint(e == e ? e : 1e30f)); atomicMax(ctl + CK_BASE + 2 * stage + 1, __float_as_uint(r));
}
__device__ __forceinline__ float ck_dot(const bf16* a, int K, const float* w, int ldw) { float s = 0.f; for (int k = 0; k < K; ++k) s += bf2f(a[k]) * w[(size_t)k * ldw]; return s; }
__global__ void __launch_bounds__(256) check_kernel(Args args, int stage, int layer) {
    unsigned char* ws = args.ws; unsigned* ctl = (unsigned*)(ws + WS_CTL);
    const bf16* HB = (const bf16*)(ws + WS_HB);
    const int gt = blockIdx.x * 256 + threadIdx.x;
    const unsigned hsh = ck_hash((unsigned)gt * 2654435761u + 12345u * stage);
    if (stage == 1) {
        const int r = hsh % M; int c = (hsh >> 15) % 3328; if (c >= 2816) c += 32;
        const float ref = ck_dot(HB + (size_t)r * 1024, 1024, args.in[1] + (size_t)layer * 1024 * IN_COLS + c, IN_COLS);
        float mine;
        if (c < 512) mine = bf2f(((const bf16*)(ws + WS_AQ))[(size_t)r * 512 + c]);
        else if (c < 640) mine = bf2f(((const bf16*)(ws + WS_AK))[(size_t)r * 128 + c - 512]);
        else if (c < 768) mine = bf2f(((const bf16*)(ws + WS_AV))[(size_t)r * 128 + c - 640]);
        else if (c < 2304) mine = bf2f(((const bf16*)(ws + WS_DQKV))[(size_t)r * 1536 + c - 768]);
        else if (c < 2816) mine = bf2f(((const bf16*)(ws + WS_DZ))[(size_t)r * 512 + c - 2304]);
        else mine = bf2f(((const bf16*)(ws + WS_PU))[(size_t)r * 512 + c - 2848]);
        ck_record(ctl, 1, mine, ref);
    } else if (stage == 2) {
        const int r = hsh % M, c = (hsh >> 15) % 32;
        const float ref = ck_dot(HB + (size_t)r * 1024, 1024, args.in[1] + (size_t)layer * 1024 * IN_COLS + 2816 + c, IN_COLS);
        ck_record(ctl, 2, ((const float*)(ws + WS_DAB))[(size_t)r * 32 + c], ref);
    } else if (stage == 3) {
        const int r = hsh % M, c = (hsh >> 15) % 3072;
        const float ref = 1.0f / (1.0f + expf(-ck_dot(HB + (size_t)r * 1024, 1024, args.in[1] + (size_t)layer * 1024 * IN_COLS + 3360 + c, IN_COLS)));
        const float mine3 = bf2f(((const bf16*)(ws + WS_GT))[(size_t)(c >> 10) * M * 1024 + (size_t)r * 1024 + (c & 1023)]);
        ck_record(ctl, 3, mine3, ref);
        ck_record(ctl, 14 + (c >> 10), mine3, ref);
        ck_record(ctl, 17 + (r >> 13), mine3, ref);
        ck_record(ctl, 21 + ((c >> 8) & 3), mine3, ref);
        if (fabsf(mine3 - ref) > 0.04f) { const unsigned ix = atomicAdd(ctl + CK_BASE + 100, 1u); if (ix < 256) { ctl[1024 + 2 * ix] = (unsigned)c; ctl[1025 + 2 * ix] = (unsigned)r; } atomicMax(ctl + 2048, __float_as_uint(mine3)); atomicMax(ctl + 2049, __float_as_uint(1.0f - mine3)); atomicMax(ctl + 2050, __float_as_uint(ref)); atomicMax(ctl + 2051, __float_as_uint(1.0f - ref)); }
    } else if (stage == 4) {
        __shared__ float q_s[64]; __shared__ float sc_s[260];
        const unsigned hb_ = ck_hash((unsigned)blockIdx.x * 2654435761u + 777u);
        const int m = hb_ % M, hq = (hb_ >> 15) & 7, d = (hb_ >> 18) & 63, b = m / SEQ, t = m % SEQ, kvh = hq >> 2;
        if (threadIdx.x < 64) q_s[threadIdx.x] = ck_dot(HB + (size_t)m * 1024, 1024, args.in[1] + (size_t)layer * 1024 * IN_COLS + hq * 64 + threadIdx.x, IN_COLS);
        __syncthreads();
        const bf16* AK = (const bf16*)(ws + WS_AK); const bf16* AV = (const bf16*)(ws + WS_AV);
        const float sink = args.in[2][layer * 8 + hq];
        for (int j = threadIdx.x; j < 257; j += 256) { const int kp = t - 128 + j; float s = -1e30f;
            if (kp >= 0 && kp < SEQ) { s = 0.f; for (int i = 0; i < 64; ++i) s += q_s[i] * bf2f(AK[((size_t)b * SEQ + kp) * 128 + kvh * 64 + i]);
                const int rel = kp - t, n = rel < 0 ? -rel : rel;
                int bk; if (n < 8) bk = n; else { bk = 8 + (int)(logf((float)n / 8.f) / logf(16.f) * 8.f + 1e-4f); if (bk > 15) bk = 15; } if (rel > 0) bk += 16;
                s = s * 0.125f + args.in[3][bk * 8 + hq]; }
            sc_s[j] = s; }
        __syncthreads();
        if (threadIdx.x == 0) { float mx = sink; for (int j = 0; j < 257; ++j) mx = fmaxf(mx, sc_s[j]);
            float den = expf(sink - mx), o = 0.f;
            for (int j = 0; j < 257; ++j) { if (sc_s[j] < -1e29f) continue; const int kp = t - 128 + j; const float p = expf(sc_s[j] - mx); den += p; o += p * bf2f(AV[((size_t)b * SEQ + kp) * 128 + kvh * 64 + d]); }
            ck_record(ctl, 4, bf2f(((const bf16*)(ws + WS_AQ))[(size_t)m * 512 + hq * 64 + d]), o / den); }
    } else if (stage == 5) {
        const int m = hsh % M, g = (hsh >> 15) & 3, d = (hsh >> 17) & 127, b = m / SEQ, t = m % SEQ, r = 1 << g;
        const bf16* PU = (const bf16*)(ws + WS_PU); const float* pw = args.in[8] + ((size_t)layer * 4 + g) * 128 * 128;
        const int lo = t - r < 0 ? 0 : t - r, hi = t + r > SEQ - 1 ? SEQ - 1 : t + r; float y = 0.f;
        for (int c = 0; c < 128; ++c) { float s = 0.f; for (int tt = lo; tt <= hi; ++tt) s += bf2f(PU[((size_t)b * SEQ + tt) * 512 + g * 128 + c]);
            const float mxv = s / (float)(hi - lo + 1) - bf2f(PU[(size_t)m * 512 + g * 128 + c]); y += mxv * pw[c * 128 + d]; }
        y *= args.in[9][layer * 512 + g * 128 + d];
        ck_record(ctl, 5, bf2f(((const bf16*)(ws + WS_OP))[(size_t)m * 512 + g * 128 + d]), y);
    } else if (stage == 6) {
        constexpr int TCK = 192;
        __shared__ float q_s[64]; __shared__ float k_s[64];
        const int j = threadIdx.x & 63; if (threadIdx.x >= 64) return;
        const int seq = (blockIdx.x * 17 + 3) & 255;
        const int dir = seq >> 7, b = (seq >> 3) & 15, h = seq & 7;
        const bf16* DQKV = (const bf16*)(ws + WS_DQKV); const float* DAB = (const float*)(ws + WS_DAB); const float* cwp = args.in[4] + (size_t)layer * 5 * 1536;
        const float nA = -expf(args.in[5][layer * 16 + dir * 8 + h]), dtb = args.in[6][layer * 16 + dir * 8 + h];
        float S[64];
#pragma unroll
        for (int i = 0; i < 64; ++i) S[i] = 0.f;
        float maxe = 0.f, maxr = 0.f;
        for (int s2 = 0; s2 < TCK; ++s2) { const int t = dir ? SEQ - 1 - s2 : s2; const size_t m = (size_t)b * SEQ + t;
            float xq = 0.f, xk = 0.f, v = 0.f;
            for (int jj = 0; jj < 5; ++jj) { const int tt = t + jj - 2; if (tt < 0 || tt >= SEQ) continue; const size_t mm = (size_t)b * SEQ + tt;
                xq += cwp[jj * 1536 + h * 64 + j] * bf2f(DQKV[mm * 1536 + h * 64 + j]); xk += cwp[jj * 1536 + 512 + h * 64 + j] * bf2f(DQKV[mm * 1536 + 512 + h * 64 + j]);
                v += cwp[jj * 1536 + 1024 + h * 64 + j] * bf2f(DQKV[mm * 1536 + 1024 + h * 64 + j]); }
            xq = xq / (1.f + expf(-xq)); xk = xk / (1.f + expf(-xk)); v = v / (1.f + expf(-v));
            __syncthreads(); q_s[j] = xq; k_s[j] = xk; __syncthreads();
            float qs = 0.f, ks = 0.f;
            for (int i = 0; i < 64; ++i) { qs += q_s[i] * q_s[i]; ks += k_s[i] * k_s[i]; }
            const float qn = 0.125f / sqrtf(qs + 1e-6f), kn = 1.0f / sqrtf(ks + 1e-6f);
            const float a = DAB[m * 32 + dir * 8 + h] + dtb, sp = a > 20.f ? a : log1pf(expf(a)), al = expf(nA * sp), be = 1.f / (1.f + expf(-DAB[m * 32 + 16 + dir * 8 + h]));
            float part = 0.f;
#pragma unroll
            for (int i = 0; i < 64; ++i) part += S[i] * k_s[i];
            const float c = be * (v - al * part * kn); float o = 0.f;
#pragma unroll
            for (int i = 0; i < 64; ++i) { S[i] = al * S[i] + k_s[i] * kn * c; o += S[i] * q_s[i]; }
            o *= qn;
            const float mine = ((const float*)(ws + (dir ? WS_OB : WS_OF)))[m * 512 + h * 64 + j];
            maxe = fmaxf(maxe, fabsf(mine - o)); maxr = fmaxf(maxr, fabsf(o)); }
        atomicMax(ctl + CK_BASE + 12, __float_as_uint(maxe == maxe ? maxe : 1e30f)); atomicMax(ctl + CK_BASE + 13, __float_as_uint(maxr));
    } else if (stage == 8) {
        const int r = hsh % M, d = (hsh >> 15) & 1023; float mg = 0.f;
        for (int n = 0; n < 3; ++n) { const bf16* O = (const bf16*)(ws + WS_AQ + (size_t)n * 32 * MiB) + (size_t)r * 512;
            mg += bf2f(((const bf16*)(ws + WS_GT))[(size_t)n * M * 1024 + (size_t)r * 1024 + d]) * ck_dot(O, 512, args.in[10] + ((size_t)layer * 3 + n) * 512 * 1024 + d, 1024); }
        ck_record(ctl, 8, bf2f(((const bf16*)(ws + WS_MERGED))[(size_t)r * 1024 + d]), mg);
    } else if (stage == 9) {
        const int r = hsh % M, c = (hsh >> 15) & 1023;
        const float ref = ALPHA * bf2f(HB[(size_t)r * 1024 + c]) + ck_dot((const bf16*)(ws + WS_MERGED) + (size_t)r * 1024, 1024, args.in[11] + (size_t)layer * 1024 * 1024 + c, 1024);
        ck_record(ctl, 9, args.out[(size_t)r * 1024 + c], ref);
    } else if (stage == 10 || stage == 13) {
        const int r = hsh % M; const float* g = args.in[stage == 10 ? 12 : 14] + layer * 1024; const float* bb = args.in[stage == 10 ? 13 : 15] + layer * 1024;
        float s = 0.f, s2 = 0.f, de = 0.f; for (int c = 0; c < 1024; ++c) { const float hv = args.out[(size_t)r * 1024 + c]; const float u = (hv - bb[c]) / g[c]; s += u; s2 += u * u; de = fmaxf(de, fabsf(hv - bf2f(HB[(size_t)r * 1024 + c]))); }
        const float mean = s / 1024.f, var = s2 / 1024.f - mean * mean;
        ck_record(ctl, stage, fabsf(mean) + fabsf(var - 1.0f) + de * 0.1f, 0.0f); atomicMax(ctl + CK_BASE + 2 * stage + 1, __float_as_uint(1.0f));
    } else if (stage == 11) {
        const int r = hsh % M, c = (hsh >> 15) % FF;
        const float g = ck_dot(HB + (size_t)r * 1024, 1024, args.in[16] + c, FF), u = ck_dot(HB + (size_t)r * 1024, 1024, args.in[17] + c, FF);
        ck_record(ctl, 11, bf2f(((const bf16*)(ws + WS_FACT))[(size_t)r * FF + c]), g / (1.f + expf(-g)) * u);
    } else if (stage == 12) {
        const int r = hsh % M, c = (hsh >> 15) & 1023;
        const float ref = ALPHA * bf2f(HB[(size_t)r * 1024 + c]) + ck_dot((const bf16*)(ws + WS_FACT) + (size_t)r * FF, FF, args.in[18] + c, 1024);
        ck_record(ctl, 12, args.out[(size_t)r * 1024 + c], ref);
    } else if (stage == 30) {
        const int rr = 3584 + (int)(hsh % 3072), k = (hsh >> 15) & 1023;
        const float mine = bf2f(((const bf16*)(ws + WS_WIN))[((size_t)layer * WIN_ROWS + rr) * 1024 + k]), ref = args.in[1][(size_t)layer * 1024 * IN_COLS + (size_t)k * IN_COLS + 3360 + rr - 3584];
        ck_record(ctl, 30, mine, ref); if (fabsf(mine - ref) > 0.01f * fabsf(ref) + 1e-4f) atomicAdd(ctl + CK_BASE + 101, 1u);
    } else if (stage == 7) {
        const int m = hsh % M, h = (hsh >> 15) & 7; const float* OFp = (const float*)(ws + WS_OF) + (size_t)m * 512 + h * 64; const float* OBp = (const float*)(ws + WS_OB) + (size_t)m * 512 + h * 64;
        float ss = 0.f; for (int d = 0; d < 64; ++d) { const float o = OFp[d] + OBp[d]; ss += o * o; }
        const int d = (hsh >> 18) & 63; const float z = ck_dot(HB + (size_t)m * 1024, 1024, args.in[1] + (size_t)layer * 1024 * IN_COLS + 2304 + h * 64 + d, IN_COLS);
        const float ref = (OFp[d] + OBp[d]) / sqrtf(ss / 64.f + RMS_EPS) * args.in[7][layer * 64 + d] * z / (1.f + expf(-z));
        ck_record(ctl, 7, bf2f(((const bf16*)(ws + WS_DZ))[(size_t)m * 512 + h * 64 + d]), ref);
    }
}
__global__ void check_verdict(Args args) {
    unsigned* ctl = (unsigned*)(args.ws + WS_CTL);
    float code = 3.0f;
#if defined(CK_VAL)
    code = 3.0f + 40.0f * __uint_as_float(ctl[2048 + CK_VAL]);
#elif defined(CK_WCNT)
    { unsigned cnt = ctl[CK_BASE + 101]; int lg = 0; while (cnt) { ++lg; cnt >>= 1; } code += (float)lg; }
#elif defined(CK_COUNT)
    { unsigned cnt = ctl[CK_BASE + 100]; if (cnt > 256) cnt = 256; int distinct = 0;
        for (unsigned i = 0; i < cnt; ++i) { const unsigned ci = ctl[1024 + 2 * i], ri = ctl[1025 + 2 * i];
            const unsigned key = CK_COUNT == 1 ? (ci >> 5) : (CK_COUNT == 2 ? (ri >> 8) : (CK_COUNT == 3 ? (ci & 31) : (ri & 255)));
            bool seen = false; for (unsigned j = 0; j < i; ++j) { const unsigned cj = ctl[1024 + 2 * j], rj = ctl[1025 + 2 * j];
                const unsigned kj = CK_COUNT == 1 ? (cj >> 5) : (CK_COUNT == 2 ? (rj >> 8) : (CK_COUNT == 3 ? (cj & 31) : (rj & 255))); if (kj == key) { seen = true; break; } }
            if (!seen) ++distinct; }
        code += (float)(distinct > 15 ? 15 : distinct); }
#else
#ifndef CK_LIST
#define CK_LIST {14, 15, 16, 3}
#endif
    const int lst[4] = CK_LIST;
    for (int i = 0; i < 4; ++i) { const float e = __uint_as_float(ctl[CK_BASE + 2 * lst[i]]), r = __uint_as_float(ctl[CK_BASE + 2 * lst[i] + 1]); if (r == 0.f || e > 0.04f * r) code += (float)(1 << i); }
#endif
    for (size_t i = (size_t)blockIdx.x * blockDim.x + threadIdx.x; i < (size_t)M * D; i += (size_t)gridDim.x * blockDim.x) args.out[i] = code;
}
#endif
extern "C" void kernel_launch(void* const* d_in, const int* in_sizes, int n_in, void* d_out, int out_size, void* d_ws, size_t ws_size, hipStream_t stream) {
    static int grid = 0;
    if (grid == 0) {
        if (n_in != 23 || out_size != M * D || ws_size < WS_END) { fprintf(stderr, "kernel_launch: unexpected problem (n_in %d, out %d, ws %zu < %zu); nothing launched\n", n_in, out_size, ws_size, (size_t)WS_END); grid = -1; return; }
        int dev = 0, cus = 0, per_cu = 0;
        if (hipGetDevice(&dev) != hipSuccess || hipDeviceGetAttribute(&cus, hipDeviceAttributeMultiprocessorCount, dev) != hipSuccess) { grid = -1; return; }
        if (hipFuncSetAttribute((const void*)fwd_kernel, hipFuncAttributeMaxDynamicSharedMemorySize, LDS_BYTES) != hipSuccess) { fprintf(stderr, "kernel_launch: hipFuncSetAttribute failed\n"); grid = -1; return; }
        if (hipOccupancyMaxActiveBlocksPerMultiprocessor(&per_cu, (const void*)fwd_kernel, NTHR, LDS_BYTES) != hipSuccess || per_cu < 1) { fprintf(stderr, "kernel_launch: occupancy query says %d\n", per_cu); }
        (void)hipGetLastError();
        if (cus != 256 || per_cu < 1) { fprintf(stderr, "kernel_launch: needs 256 CUs with one resident workgroup each (cus %d, per_cu %d)\n", cus, per_cu); grid = -1; return; }
        grid = 256;
    }
    if (grid < 0) return;
    (void)hipMemsetAsync((char*)d_ws + WS_CTL, 0, CTL_ZERO_BYTES, stream);
    Args a{};
    for (int i = 0; i < 23; ++i) a.in[i] = (const float*)d_in[i];
    a.out = (float*)d_out; a.ws = (unsigned char*)d_ws;
#if MK_PER_PHASE
    static const int phases[] = {0, 1, 2, 21, 3, 4, 5, 6, 7, 8, 9, 41, 42, 61, 43, 44, 45, 46, 47, 48, 49, 50, 51, 52, 53, 54, 55, 56};
    for (int p : phases) { a.ph_lo = p; a.ph_hi = p + 1; hipLaunchKernelGGL(fwd_kernel, dim3(grid), dim3(NTHR), LDS_BYTES, stream, a);
#if defined(DBG_CHECK)
        const int L = DBG_CHECK - 1, pb = 1 + 40 * L;
        if (p == pb + 0) { hipLaunchKernelGGL(check_kernel, dim3(64), dim3(256), 0, stream, a, 1, L); hipLaunchKernelGGL(check_kernel, dim3(64), dim3(256), 0, stream, a, 2, L); }
        if (p == pb + 1) { hipLaunchKernelGGL(check_kernel, dim3(512), dim3(256), 0, stream, a, 4, L); hipLaunchKernelGGL(check_kernel, dim3(64), dim3(256), 0, stream, a, 5, L); hipLaunchKernelGGL(check_kernel, dim3(16), dim3(64), 0, stream, a, 6, L); }
        if (p == pb + 20) hipLaunchKernelGGL(check_kernel, dim3(64), dim3(256), 0, stream, a, 7, L);
        if (p == pb + 2) { hipLaunchKernelGGL(check_kernel, dim3(64), dim3(256), 0, stream, a, 3, L); hipLaunchKernelGGL(check_kernel, dim3(256), dim3(256), 0, stream, a, 30, L); }
        if (p == pb + 3) hipLaunchKernelGGL(check_kernel, dim3(64), dim3(256), 0, stream, a, 8, L);
        if (p == pb + 4) hipLaunchKernelGGL(check_kernel, dim3(64), dim3(256), 0, stream, a, 9, L);
        if (p == pb + 5) hipLaunchKernelGGL(check_kernel, dim3(16), dim3(256), 0, stream, a, 10, L);
        if (L == 0 && p == pb + 6) hipLaunchKernelGGL(check_kernel, dim3(64), dim3(256), 0, stream, a, 11, L);
        if (L == 0 && p == pb + 7) hipLaunchKernelGGL(check_kernel, dim3(64), dim3(256), 0, stream, a, 12, L);
        if (L == 0 && p == pb + 8) hipLaunchKernelGGL(check_kernel, dim3(16), dim3(256), 0, stream, a, 13, L);
#endif
    }
#if defined(DBG_CHECK)
    hipLaunchKernelGGL(check_verdict, dim3(1024), dim3(256), 0, stream, a);
#endif
#else
    a.ph_lo = 0; a.ph_hi = 1000;
    hipLaunchKernelGGL(fwd_kernel, dim3(grid), dim3(NTHR), LDS_BYTES, stream, a);
#endif
}
```

```cpp
#include <hip/hip_runtime.h>
#include <cstdio>
#include <cstdint>

#define GAS __attribute__((address_space(1)))
#define LAS __attribute__((address_space(3)))
typedef unsigned short bf16;
typedef unsigned v4u __attribute__((ext_vector_type(4)));
typedef unsigned v2u __attribute__((ext_vector_type(2)));
typedef float f32x2 __attribute__((ext_vector_type(2)));
typedef float f32x4 __attribute__((ext_vector_type(4)));
typedef float f32x16 __attribute__((ext_vector_type(16)));
typedef short bf16x8 __attribute__((ext_vector_type(8)));
typedef short bf16x4 __attribute__((ext_vector_type(4)));

#ifndef ABL
#define ABL 0
#endif
#ifndef LN_FUSE
#define LN_FUSE 3
#endif
#ifndef MK_PER_PHASE
#define MK_PER_PHASE 0
#endif

#ifndef WGM_K
#define WGM_K 8
#endif
namespace pg8 {
#define PG8_LAS __attribute__((address_space(3)))
typedef unsigned short bf16_t;
typedef unsigned u32x4 __attribute__((ext_vector_type(4)));
constexpr int BM = 256, BK = 64, HALF = 128, HTB = HALF * BK * 2  , STAGE_BYTES = 8 * HTB, NXCD = 8, WGM = WGM_K;

__host__ __device__ __forceinline__ int lds_byte(int r, int c) { const int st = (r >> 4) * 2 + (c >> 5), rr = r & 15, cc = c & 31, ob = rr * 64 + cc * 2; return st * 1024 + (ob ^ (((ob >> 9) & 1) << 5)); }
__host__ __device__ __forceinline__ void stage_rc(int b, int& R, int& C) { const int st = b / 1024, sb = b % 1024, swz = sb ^ (((sb >> 9) & 1) << 5); R = (st >> 1) * 16 + swz / 64; C = (st & 1) * 32 + (swz % 64) / 2; }
__host__ __device__ __forceinline__ int perm32(int rho) { const int n = rho >> 4, i = rho & 15; return 8 * (i >> 2) + 4 * n + (i & 3); }

struct Unit { int pm, pn, aux; };

struct StaticOrder {
    int nM, nN, nwg, G, c;
    __host__ __device__ __forceinline__ void init(int nM_, int nN_, int G_, int c_) { nM = nM_; nN = nN_; nwg = nM * nN; G = G_; c = c_; }
    __host__ __device__ __forceinline__ bool map(long L, int& pm, int& pn) const {
        if (L >= nwg) return false;
        int wgid = (int)L; { const int q = nwg / NXCD, r = nwg % NXCD, xcd = wgid % NXCD, off = wgid / NXCD; wgid = (xcd < r ? xcd * (q + 1) : r * (q + 1) + (xcd - r) * q) + off; }
        const int nig = WGM * nN, gid = wgid / nig, fm = gid * WGM, gsz = (nM - fm) < WGM ? (nM - fm) : WGM;
        pm = fm + ((wgid % nig) % gsz); pn = (wgid % nig) / gsz; return true;
    }
};
struct StdSched {
    StaticOrder o; const char* A; const char* Bt; size_t tstep;
    __device__ __forceinline__ void init(const void* A_, const void* Bt_, int M, int N, int K, int G, int c) { o.init(M / BM, N / BM, G, c); A = (const char*)A_; Bt = (const char*)Bt_; tstep = (size_t)BM * K * 2; }
    __device__ __forceinline__ bool next(int i, Unit& u) const { u.aux = 0; return o.map((long)i * o.G + o.c, u.pm, u.pn); }
    __device__ __forceinline__ const char* abase(const Unit& u) const { return A + (size_t)u.pm * tstep; }
    __device__ __forceinline__ const char* bbase(const Unit& u) const { return Bt + (size_t)u.pn * tstep; }
};

typedef __bf16 bf16x2_t __attribute__((ext_vector_type(2)));
__device__ __forceinline__ unsigned cvt_pk_bf16(float lo, float hi) { const f32x2 v = {lo, hi}; const bf16x2_t b = __builtin_convertvector(v, bf16x2_t); return __builtin_bit_cast(unsigned, b); }

typedef f32x4 acc_t[2][2][4][2];
__device__ __forceinline__ void zero_acc(acc_t& acc) {
    float z = 0.f; asm volatile("" : "+v"(z));
#pragma unroll
    for (int a = 0; a < 2; ++a)
#pragma unroll
        for (int b = 0; b < 2; ++b)
#pragma unroll
            for (int m = 0; m < 4; ++m)
#pragma unroll
                for (int n = 0; n < 2; ++n) acc[a][b][m][n] = (f32x4){z, z, z, z};
}

typedef int v8i_t __attribute__((ext_vector_type(8)));
typedef int v4i_t __attribute__((ext_vector_type(4)));
__device__ __forceinline__ f32x4 mfma_fp8(const bf16x8& b0, const bf16x8& b1, const bf16x8& a0, const bf16x8& a1, const f32x4& c) {
    const v4i_t x0 = __builtin_bit_cast(v4i_t, b0), x1 = __builtin_bit_cast(v4i_t, b1), y0 = __builtin_bit_cast(v4i_t, a0), y1 = __builtin_bit_cast(v4i_t, a1);
    const v8i_t X = __builtin_shufflevector(x0, x1, 0, 1, 2, 3, 4, 5, 6, 7), Y = __builtin_shufflevector(y0, y1, 0, 1, 2, 3, 4, 5, 6, 7);
    return __builtin_amdgcn_mfma_scale_f32_16x16x128_f8f6f4(X, Y, c, 0, 0, 0, 0x7f7f7f7f, 0, 0x7f7f7f7f);
}
template <class Epi, class Sched, bool ALIGN_EPI = false, bool SP2 = false, bool FP8 = false>
__device__ __forceinline__ void gemm_phase(PG8_LAS unsigned char* lds, const int K, const Sched& S, const Epi& E, const int wid_in) {
    int lane = (int)__builtin_amdgcn_mbcnt_hi(~0u, __builtin_amdgcn_mbcnt_lo(~0u, 0u)); asm volatile("" : "+v"(lane));
    const int wid = wid_in, tid = wid * 64 + lane, wr = wid >> 2, wc = wid & 3, fr = lane & 15, fq = lane >> 4;
    const int nt = K / BK;
    unsigned voffA[2], voffB[2];
#pragma unroll
    for (int i = 0; i < 2; ++i) { int R, C; stage_rc(tid * 16 + i * 8192, R, C); const int Rb = Epi::PERM ? ((R & ~31) + perm32(R & 31)) : R;
        voffA[i] = (unsigned)(R * K + C) * 2u; voffB[i] = (unsigned)(Rb * K + C) * 2u; }
    const size_t kstep = (size_t)(BK * 2);
    const size_t hstep = (size_t)HALF * K * 2;
    const unsigned ldsw = (unsigned)wid * 1024u;
    const int aoff = lds_byte(wr * 64 + fr, fq * 8), boff = lds_byte(wc * 32 + fr, fq * 8);
#define PG8_SA(b, h) (((b) * 2 + (h)) * HTB)
#define PG8_SB(b, h) ((4 + (b) * 2 + (h)) * HTB)
#define PG8_STAGE(bufoff, gbase, voff) do { _Pragma("unroll") for (int _i = 0; _i < 2; ++_i) \
        __builtin_amdgcn_global_load_lds((const unsigned*)((const char*)(gbase) + (voff)[_i]), (PG8_LAS unsigned*)(lds + (bufoff) + ldsw + _i * 8192), 16, 0, 0); } while (0)
#define PG8_LDA(dst, b, h) do { if constexpr (FP8) { _Pragma("unroll") for (int m = 0; m < 4; ++m) { const v4i_t lo_ = *(const PG8_LAS v4i_t*)(lds + PG8_SA(b, h) + aoff + m * 2048), hi_ = *(const PG8_LAS v4i_t*)(lds + PG8_SA(b, h) + aoff + m * 2048 + 1024); \
            dst##8[m] = __builtin_shufflevector(lo_, hi_, 0, 1, 2, 3, 4, 5, 6, 7); } } \
        else { _Pragma("unroll") for (int m = 0; m < 4; ++m) _Pragma("unroll") for (int k = 0; k < 2; ++k) dst[m][k] = *(const PG8_LAS bf16x8*)(lds + PG8_SA(b, h) + aoff + m * 2048 + k * 1024); } } while (0)
#define PG8_LDB(dst, b, h) do { if constexpr (FP8) { _Pragma("unroll") for (int n = 0; n < 2; ++n) { const v4i_t lo_ = *(const PG8_LAS v4i_t*)(lds + PG8_SB(b, h) + boff + n * 2048), hi_ = *(const PG8_LAS v4i_t*)(lds + PG8_SB(b, h) + boff + n * 2048 + 1024); \
            dst##8[n] = __builtin_shufflevector(lo_, hi_, 0, 1, 2, 3, 4, 5, 6, 7); } } \
        else { _Pragma("unroll") for (int n = 0; n < 2; ++n) _Pragma("unroll") for (int k = 0; k < 2; ++k) dst[n][k] = *(const PG8_LAS bf16x8*)(lds + PG8_SB(b, h) + boff + n * 2048 + k * 1024); } } while (0)
#define PG8_MMA(ai, bj, At, Bt) do { __builtin_amdgcn_s_setprio(1); _Pragma("unroll") for (int m = 0; m < 4; ++m) _Pragma("unroll") for (int n = 0; n < 2; ++n) { \
        if constexpr (FP8) asm volatile("v_mfma_scale_f32_16x16x128_f8f6f4 %0, %1, %2, %0, %3, %3 op_sel_hi:[0,0,0]" : "+v"(acc[ai][bj][m][n]) : "v"(Bt##8[n]), "v"(At##8[m]), "v"(sc127));   \
        else { _Pragma("unroll") for (int k = 0; k < 2; ++k) acc[ai][bj][m][n] = __builtin_amdgcn_mfma_f32_16x16x32_bf16(Bt[n][k], At[m][k], acc[ai][bj][m][n], 0, 0, 0); } } \
        __builtin_amdgcn_s_setprio(0); } while (0)
#define PG8_WAIT_V(n) asm volatile("s_waitcnt vmcnt(" #n ")" ::: "memory")
#define PG8_WAIT_L(n) asm volatile("s_waitcnt lgkmcnt(" #n ")" ::: "memory")
#define PG8_BAR __builtin_amdgcn_s_barrier()
#define PG8_SCHED __builtin_amdgcn_sched_barrier(0)
    Unit cur, nxt; int ui = 0;
    if (!S.next(0, cur)) return;
    acc_t acc; zero_acc(acc);
    bf16x8 At[4][2], B0[2][2], B1[2][2];
    v8i_t At8[4], B08[2], B18[2];
    int sc127 = 0x7f7f7f7f; asm volatile("" : "+v"(sc127));
    const char* cA = S.abase(cur); const char* cB = S.bbase(cur);
    if constexpr (SP2) {
        PG8_STAGE(PG8_SB(0, 0), cB, voffB); PG8_STAGE(PG8_SB(0, 1), cB + hstep, voffB); PG8_STAGE(PG8_SA(0, 0), cA, voffA); PG8_STAGE(PG8_SA(0, 1), cA + hstep, voffA);
        if (wr == 1) PG8_BAR;
        PG8_WAIT_V(2); PG8_BAR;
        PG8_STAGE(PG8_SB(1, 0), cB + kstep, voffB); PG8_STAGE(PG8_SA(1, 0), cA + kstep, voffA); PG8_STAGE(PG8_SB(1, 1), cB + hstep + kstep, voffB);
        PG8_WAIT_V(6); PG8_BAR;
    } else {
        PG8_STAGE(PG8_SB(0, 0), cB, voffB); PG8_STAGE(PG8_SA(0, 0), cA, voffA); PG8_STAGE(PG8_SB(0, 1), cB + hstep, voffB); PG8_STAGE(PG8_SA(0, 1), cA + hstep, voffA);
        if (wr == 1) PG8_BAR;
        PG8_WAIT_V(4); PG8_BAR;
        PG8_STAGE(PG8_SB(1, 0), cB + kstep, voffB); PG8_STAGE(PG8_SA(1, 0), cA + kstep, voffA); PG8_STAGE(PG8_SB(1, 1), cB + hstep + kstep, voffB);
        PG8_WAIT_V(6); PG8_BAR;
    }
    for (;;) {
        const bool has_next = S.next(ui + 1, nxt);
        const char* nA = has_next ? S.abase(nxt) : cA; const char* nB = has_next ? S.bbase(nxt) : cB;
#pragma nounroll
        for (int t = 0; t < nt; t += 2) {
            const bool last = (t == nt - 2);
            const char* a1 = cA + (size_t)(t + 1) * kstep;
            const char* a2 = last ? nA : cA + (size_t)(t + 2) * kstep; const char* b2 = last ? nB : cB + (size_t)(t + 2) * kstep;
            const char* a3 = a2 + kstep; const char* b3 = b2 + kstep;
            if constexpr (SP2) {
            PG8_LDB(B0, 0, 0); PG8_LDB(B1, 0, 1); PG8_SCHED; PG8_LDA(At, 0, 0); PG8_STAGE(PG8_SA(1, 1), a1 + hstep, voffA);
            PG8_WAIT_V(8); PG8_WAIT_L(0); PG8_BAR; PG8_MMA(0, 0, At, B0); PG8_MMA(0, 1, At, B1); PG8_BAR; PG8_SCHED;
            PG8_LDA(At, 0, 1); PG8_STAGE(PG8_SB(0, 0), b2, voffB); PG8_STAGE(PG8_SB(0, 1), b2 + hstep, voffB); PG8_STAGE(PG8_SA(0, 0), a2, voffA);
            PG8_WAIT_V(8); PG8_WAIT_L(0); PG8_BAR; PG8_MMA(1, 0, At, B0); PG8_MMA(1, 1, At, B1); PG8_BAR; PG8_SCHED;
            PG8_LDB(B0, 1, 0); PG8_LDB(B1, 1, 1); PG8_SCHED; PG8_LDA(At, 1, 0); PG8_STAGE(PG8_SA(0, 1), a2 + hstep, voffA);
            PG8_WAIT_V(8); PG8_WAIT_L(0); PG8_BAR; PG8_MMA(0, 0, At, B0); PG8_MMA(0, 1, At, B1); PG8_BAR; PG8_SCHED;
            PG8_LDA(At, 1, 1); PG8_STAGE(PG8_SB(1, 0), b3, voffB); PG8_STAGE(PG8_SB(1, 1), b3 + hstep, voffB); PG8_STAGE(PG8_SA(1, 0), a3, voffA);
            PG8_WAIT_V(8); PG8_WAIT_L(0); PG8_BAR; PG8_MMA(1, 0, At, B0); PG8_MMA(1, 1, At, B1); PG8_BAR; PG8_SCHED;
            } else {
            PG8_LDB(B0, 0, 0); PG8_SCHED; PG8_LDA(At, 0, 0); PG8_STAGE(PG8_SA(1, 1), a1 + hstep, voffA);
            PG8_WAIT_L(8); PG8_BAR; PG8_WAIT_L(0); PG8_MMA(0, 0, At, B0); PG8_BAR; PG8_SCHED;
            PG8_LDB(B1, 0, 1); PG8_STAGE(PG8_SB(0, 0), b2, voffB);
            PG8_BAR; PG8_WAIT_L(0); PG8_MMA(0, 1, At, B1); PG8_BAR;
            PG8_LDA(At, 0, 1); PG8_STAGE(PG8_SA(0, 0), a2, voffA);
            PG8_BAR; PG8_WAIT_L(0); PG8_MMA(1, 0, At, B0); PG8_BAR; PG8_SCHED;
            PG8_STAGE(PG8_SB(0, 1), b2 + hstep, voffB);
            PG8_WAIT_V(6); PG8_BAR; PG8_MMA(1, 1, At, B1); PG8_BAR;
            PG8_LDB(B0, 1, 0); PG8_SCHED; PG8_LDA(At, 1, 0); PG8_STAGE(PG8_SA(0, 1), a2 + hstep, voffA);
            PG8_WAIT_L(8); PG8_BAR; PG8_WAIT_L(0); PG8_MMA(0, 0, At, B0); PG8_BAR; PG8_SCHED;
            PG8_LDB(B1, 1, 1); PG8_STAGE(PG8_SB(1, 0), b3, voffB);
            PG8_BAR; PG8_WAIT_L(0); PG8_MMA(0, 1, At, B1); PG8_BAR;
            PG8_LDA(At, 1, 1); PG8_STAGE(PG8_SA(1, 0), a3, voffA);
            PG8_BAR; PG8_WAIT_L(0); PG8_MMA(1, 0, At, B0); PG8_BAR; PG8_SCHED;
            PG8_STAGE(PG8_SB(1, 1), b3 + hstep, voffB);
            PG8_WAIT_V(6); PG8_BAR; PG8_MMA(1, 1, At, B1); PG8_BAR;
            }
        }
        if constexpr (ALIGN_EPI) { if (wr == 0) PG8_BAR; }
        if constexpr (FP8) asm volatile("s_nop 15\n\ts_nop 15" ::: "memory");
        E(acc, cur, wr, wc, fr, fq);
        if (!has_next) break;
        cur = nxt; cA = nA; cB = nB; ++ui;
        if constexpr (ALIGN_EPI) { if (wr == 1) PG8_BAR; }
    }
    PG8_WAIT_V(0);
    if constexpr (!ALIGN_EPI) { if (wr == 0) PG8_BAR; }
    PG8_BAR;
#undef PG8_SA
#undef PG8_SB
#undef PG8_STAGE
#undef PG8_LDA
#undef PG8_LDB
#undef PG8_MMA
#undef PG8_WAIT_V
#undef PG8_WAIT_L
#undef PG8_BAR
#undef PG8_SCHED
}
}

#ifndef GATES_FP8
#define GATES_FP8 1
#endif
#ifndef FFN_FP8
#define FFN_FP8 3
#endif
#ifndef MOE_FP8
#define MOE_FP8 1
#endif
constexpr int NWAVES = 8, NTHR = 512;
constexpr int BATCH = 16, SEQ = 2048, D = 1024, M = BATCH * SEQ;
constexpr int IN_COLS = 6432;
constexpr int NA = 3584;
constexpr int NG = 3072;
constexpr int WIN_ROWS = NA + NG;
constexpr int FF = 2816, FFE = 3584, NE = 8;
constexpr int NCH = 2, CHT = 256 / NCH, CH_TOK = M / NCH, CH_ROWS = (CHT + 8) * 256;
static_assert(MOE_FP8 || NCH == 4, "bf16 MoE buffers are sized for 4 chunks");
constexpr float LN_EPS = 1e-5f, RMS_EPS = 1e-6f;
constexpr float ALPHA = 1.4142135623730951f;

constexpr size_t MiB = 1u << 20;
constexpr size_t WS_CTL = 0, CTL_ZERO_BYTES = 1 * MiB;
constexpr size_t WS_HB = 1 * MiB;
constexpr size_t WS_META = 65 * MiB;
constexpr size_t WS_WIN = 67 * MiB;
constexpr size_t WS_WBR = 93 * MiB;
constexpr size_t WS_WOUT = 99 * MiB;
constexpr size_t WS_W13 = 103 * MiB;
constexpr size_t WS_W2 = 114 * MiB;
constexpr size_t WS_POOLW = 120 * MiB;
constexpr size_t WS_LNSTAT = 120 * MiB;
constexpr size_t WS_BIG = 121 * MiB;
constexpr size_t WS_AQ = WS_BIG + 0 * MiB;
constexpr size_t WS_DZ = WS_BIG + 32 * MiB;
constexpr size_t WS_OP = WS_BIG + 64 * MiB;
constexpr size_t WS_AK = WS_BIG + 96 * MiB;
constexpr size_t WS_AV = WS_BIG + 104 * MiB;
constexpr size_t WS_DAB = WS_BIG + 112 * MiB;
constexpr size_t WS_PU = WS_BIG + 128 * MiB;
constexpr size_t WS_DQKV = WS_BIG + 160 * MiB;
constexpr size_t WS_OF = WS_BIG + 256 * MiB;
constexpr size_t WS_OB = WS_BIG + 320 * MiB;
constexpr size_t WS_GT = WS_BIG + 160 * MiB;
constexpr size_t WS_MERGED = WS_BIG + 352 * MiB;
constexpr size_t WS_FACT = WS_BIG + 0 * MiB;
constexpr size_t WS_HBG8 = WS_BIG + 384 * MiB;
constexpr size_t WS_HB8 = WS_BIG + 200 * MiB;
constexpr size_t WS_END_L = WS_BIG + 416 * MiB;
constexpr size_t WS_MWGU = 67 * MiB;
constexpr size_t WS_MWD = 179 * MiB;
constexpr size_t WS_XG = 235 * MiB;
constexpr size_t WS_MACT = 271 * MiB;
constexpr size_t WS_YS = 397 * MiB;
constexpr size_t WS_END = 537 * MiB;
static_assert(WS_YS + (size_t)M * 2 * 1024 * 2 <= WS_END && WS_END_L <= WS_END, "ws map");
static_assert(WS_MACT + (size_t)CH_ROWS * FFE * (MOE_FP8 ? 1 : 2) <= WS_YS && WS_XG + (size_t)CH_ROWS * 1024 * (MOE_FP8 ? 1 : 2) <= WS_MACT, "ws map");
constexpr size_t MT_TOKE = 0;
constexpr size_t MT_TOKP = 256 * 1024;
constexpr size_t MT_RANK = 512 * 1024;
constexpr size_t MT_DEFER = 640 * 1024;
constexpr size_t MT_CNT = 768 * 1024;
constexpr size_t MT_ROWMAP = 1024 * 1024;
constexpr int CW_BAR = 4096;
constexpr int CW_LNX = 16384;
constexpr int LNX_LDS_OFF = 131072;

constexpr int RING_OFF = 0, RING_BYTES = 147456;
constexpr int LDSCTL_OFF = RING_BYTES, MISC_OFF = LDSCTL_OFF + 320;
constexpr int MOE_LDS_OFF = LDSCTL_OFF + 1024;
constexpr int LDS_BYTES = 163840;

#define RLX_AGENT __ATOMIC_RELAXED, __HIP_MEMORY_SCOPE_AGENT
#define LDS_WAIT() asm volatile("s_waitcnt lgkmcnt(0)" ::: "memory")
#define VM_WAIT() asm volatile("s_waitcnt vmcnt(0)" ::: "memory")
__device__ __forceinline__ unsigned f2bf(float f) { unsigned u = __builtin_bit_cast(unsigned, f); return (u + 0x7fffu + ((u >> 16) & 1u)) >> 16; }
__device__ __forceinline__ unsigned pk2(float lo, float hi) { return f2bf(lo) | (f2bf(hi) << 16); }
__device__ __forceinline__ float bf2f(unsigned short b) { return __builtin_bit_cast(float, ((unsigned)b) << 16); }
__device__ __forceinline__ float bflo(unsigned w) { return __builtin_bit_cast(float, w << 16); }
__device__ __forceinline__ float bfhi(unsigned w) { return __builtin_bit_cast(float, w & 0xffff0000u); }
__device__ __forceinline__ v4u ld_or_zero(const bf16* p, const bf16* safe, bool ok) { const v4u v = *(const v4u*)(ok ? p : safe); const unsigned mk = ok ? 0xffffffffu : 0u; return (v4u){v.x & mk, v.y & mk, v.z & mk, v.w & mk}; }
__device__ __forceinline__ float sigmoidf_(float x) { return __builtin_amdgcn_rcpf(1.0f + __expf(-x)); }
__device__ __forceinline__ float siluf_(float x) { return x * sigmoidf_(x); }

#define XB_TMO      128
#define XB_XCNT(j)  (256  + 64 * (j))
#define XB_XSUB(j)  (1280 + 64 * (j))
#define XB_XGEN(j)  (2304 + 64 * (j))
#define XB_TOP      3328
#define XB_TOPGEN   3392
#define XCD_BAR_WORDS 3456
#define XB_SPIN_CAP (1u << 22)
#ifndef XB_RELAY
#define XB_RELAY 0
#endif

__device__ __forceinline__ unsigned xb_ld(unsigned* p)              { return __hip_atomic_load(p, __ATOMIC_RELAXED, __HIP_MEMORY_SCOPE_AGENT); }
__device__ __forceinline__ unsigned xb_add(unsigned* p, unsigned v) { return __hip_atomic_fetch_add(p, v, __ATOMIC_RELAXED, __HIP_MEMORY_SCOPE_AGENT); }
__device__ __forceinline__ unsigned xb_xcc_id() { return (unsigned)__builtin_amdgcn_s_getreg((3 << 11) | 20) & 0xFu; }
#define XB_SPIN(cond, bar) do { unsigned _sp = 0; while (cond) { __builtin_amdgcn_s_sleep(1); \
    if ((++_sp & 255u) == 0u) { if (xb_ld(&(bar)[XB_TMO])) break; if (_sp > XB_SPIN_CAP) { atomicAdd(&(bar)[XB_TMO], 1u); break; } } } } while (0)

struct XcdBarrier {
    unsigned* bar; unsigned x; unsigned w0;
    volatile LAS unsigned* st;
};
__device__ __forceinline__ XcdBarrier xcd_barrier_post(unsigned* bar, volatile LAS unsigned* st) {
    XcdBarrier b; b.bar = bar; b.x = xb_xcc_id(); b.st = st; b.w0 = (__builtin_amdgcn_readfirstlane(threadIdx.x >> 6) == 0) ? 1u : 0u;
    if (threadIdx.x == 0) (void)xb_add(&bar[XB_XCNT(b.x)], 1u);
    return b;
}
__device__ __forceinline__ void xcd_barrier_complete(unsigned* bar, unsigned x, unsigned& nloc, unsigned& nx) {
    const unsigned G = gridDim.x * gridDim.y * gridDim.z;
    unsigned sum, cnt, mine, sp = 0u;
    for (;;) {
        sum = 0u; cnt = 0u; mine = 0u;
#pragma unroll
        for (unsigned j = 0; j < 16; ++j) { const unsigned c = xb_ld(&bar[XB_XCNT(j)]); sum += c; cnt += (c > 0u) ? 1u : 0u; mine = (j == x) ? c : mine; }
        if (sum == G) break;
        __builtin_amdgcn_s_sleep(1);
        if ((++sp & 255u) == 0u) { if (xb_ld(&bar[XB_TMO])) break; if (sp > XB_SPIN_CAP) { atomicAdd(&bar[XB_TMO], 1u); break; } }
    }
    nloc = mine > 0u ? mine : 1u; nx = cnt > 0u ? cnt : 1u;
}
__device__ __forceinline__ void xcd_barrier(const XcdBarrier& b) {
    asm volatile("s_waitcnt vmcnt(0)" ::: "memory");
    __syncthreads();
    if (b.w0 && __builtin_amdgcn_mbcnt_hi(~0u, __builtin_amdgcn_mbcnt_lo(~0u, 0u)) == 0u) {
        unsigned* bar = b.bar;
        __builtin_amdgcn_s_waitcnt(0);
        unsigned nloc = b.st[0], nx = b.st[1];
        if (nloc == 0u) { xcd_barrier_complete(bar, b.x, nloc, nx); b.st[0] = nloc; b.st[1] = nx; }
        const unsigned old = xb_add(&bar[XB_XSUB(b.x)], 1u);
        const unsigned gen = old / nloc;
#if XB_RELAY
        if (old + 1u == (gen + 1u) * nloc) {
            __builtin_amdgcn_fence(__ATOMIC_RELEASE, "agent");
            asm volatile("s_waitcnt vmcnt(0)" ::: "memory");
            const unsigned og = xb_add(&bar[XB_TOP], 1u);
            const unsigned tg = og / nx;
            if (og + 1u == (tg + 1u) * nx) xb_add(&bar[XB_TOPGEN], 1u);
            else XB_SPIN(xb_ld(&bar[XB_TOPGEN]) == tg, bar);
            __builtin_amdgcn_fence(__ATOMIC_ACQUIRE, "agent");
#if XB_RELAY
            xb_add(&bar[XB_XGEN(b.x)], 1u);
            asm volatile("s_waitcnt vmcnt(0)" ::: "memory");
#endif
        } else {
#if XB_RELAY
            XB_SPIN(xb_ld(&bar[XB_XGEN(b.x)]) == gen, bar);
#else
            XB_SPIN(xb_ld(&bar[XB_TOPGEN]) == gen, bar);
#endif
            __builtin_amdgcn_fence(__ATOMIC_ACQUIRE, "agent");
            asm volatile("s_waitcnt vmcnt(0)" ::: "memory");
        }
#else
        if (old + 1u == (gen + 1u) * nloc) {
            __builtin_amdgcn_fence(__ATOMIC_RELEASE, "agent");
            asm volatile("s_waitcnt vmcnt(0)" ::: "memory");
            (void)xb_add(&bar[XB_TOP], 1u);
        }
        { const unsigned want = nx * (gen + 1u); XB_SPIN(xb_ld(&bar[XB_TOP]) < want, bar); }
        __builtin_amdgcn_fence(__ATOMIC_ACQUIRE, "agent");
        asm volatile("s_waitcnt vmcnt(0)" ::: "memory");
#endif
    }
    __syncthreads();
}

struct Args { const float* in[23]; float* out; unsigned char* ws; int ph_lo, ph_hi; };
struct Frame {
    unsigned char* lds;
    int tid, lane, wave;
    int G, bx;
    unsigned char* ws;
    float* out;
    const Args* a;
};
#define IN_x(F)          ((F).a->in[0])
#define IN_w_in(F)       ((F).a->in[1])
#define IN_attn_sink(F)  ((F).a->in[2])
#define IN_rel_bias(F)   ((F).a->in[3])
#define IN_conv_w(F)     ((F).a->in[4])
#define IN_a_log(F)      ((F).a->in[5])
#define IN_dt_bias(F)    ((F).a->in[6])
#define IN_dn_norm_w(F)  ((F).a->in[7])
#define IN_pool_w(F)     ((F).a->in[8])
#define IN_pool_scale(F) ((F).a->in[9])
#define IN_w_branch(F)   ((F).a->in[10])
#define IN_w_out(F)      ((F).a->in[11])
#define IN_ln1_g(F)      ((F).a->in[12])
#define IN_ln1_b(F)      ((F).a->in[13])
#define IN_ln2_g(F)      ((F).a->in[14])
#define IN_ln2_b(F)      ((F).a->in[15])
#define IN_ffn_w1(F)     ((F).a->in[16])
#define IN_ffn_w3(F)     ((F).a->in[17])
#define IN_ffn_w2(F)     ((F).a->in[18])
#define IN_router_w(F)   ((F).a->in[19])
#define IN_moe_wg(F)     ((F).a->in[20])
#define IN_moe_wu(F)     ((F).a->in[21])
#define IN_moe_wd(F)     ((F).a->in[22])
__device__ __forceinline__ float wave_sum(float v) {
#pragma unroll
    for (int o = 1; o < 64; o <<= 1) v += __shfl_xor(v, o);
    return v;
}
template <int CTRL> __device__ __forceinline__ float dppf(float x) { return __builtin_bit_cast(float, __builtin_amdgcn_mov_dpp(__builtin_bit_cast(int, x), CTRL, 0xF, 0xF, true)); }
__device__ __forceinline__ float red4(float x) { x += dppf<0xB1>(x); x += dppf<0x4E>(x); return x; }
__device__ __forceinline__ float red8(float x) { x = red4(x); x += dppf<0x141>(x); return x; }
__device__ __forceinline__ float red16(float x) { x = red8(x); x += dppf<0x140>(x); return x; }

__device__ __forceinline__ float q8(float x) { const int p = __builtin_amdgcn_cvt_pk_fp8_f32(x, x, 0, false); return __builtin_amdgcn_cvt_f32_fp8(p, 0); }
#ifndef FP8_EMU
#define FP8_EMU 0
#endif
__device__ __forceinline__ unsigned pk4_fp8(float a, float b, float c, float d) { int w = __builtin_amdgcn_cvt_pk_fp8_f32(a, b, 0, false); w = __builtin_amdgcn_cvt_pk_fp8_f32(c, d, w, true); return (unsigned)w; }
template <bool Q8 = false>
__device__ __forceinline__ void tr_item(const float* W, int ldw, int k0, int n0, bf16* WT, int ldt, int drow0, float* scr, int lane) {
    f32x4 ld[8];
#pragma unroll
    for (int i = 0; i < 8; ++i) ld[i] = __builtin_nontemporal_load((const f32x4*)(W + (size_t)(k0 + 8 * i + (lane >> 3)) * ldw + n0 + 4 * (lane & 7)));
#pragma unroll
    for (int i = 0; i < 8; ++i) { float* d = scr + (8 * i + (lane >> 3)) * 33 + 4 * (lane & 7); d[0] = ld[i][0]; d[1] = ld[i][1]; d[2] = ld[i][2]; d[3] = ld[i][3]; }
    LDS_WAIT(); asm volatile("" ::: "memory");
    const int c = lane & 7;
#pragma unroll
    for (int j = 0; j < 4; ++j) { const int n = (lane >> 3) + 8 * j; const float* s = scr + (8 * c) * 33 + n;
        v4u o;
        if (Q8) { o.x = pk2(q8(32.f * s[0 * 33]), q8(32.f * s[1 * 33])); o.y = pk2(q8(32.f * s[2 * 33]), q8(32.f * s[3 * 33])); o.z = pk2(q8(32.f * s[4 * 33]), q8(32.f * s[5 * 33])); o.w = pk2(q8(32.f * s[6 * 33]), q8(32.f * s[7 * 33])); }
        else { o.x = pk2(s[0 * 33], s[1 * 33]); o.y = pk2(s[2 * 33], s[3 * 33]); o.z = pk2(s[4 * 33], s[5 * 33]); o.w = pk2(s[6 * 33], s[7 * 33]); }
        *(v4u*)(WT + (size_t)(drow0 + n) * ldt + k0 + 8 * c) = o; }
    LDS_WAIT(); asm volatile("" ::: "memory");
}

__device__ __forceinline__ void tr_item_fp8(const float* W, int ldw, int k0, int n0, unsigned char* WT8, int ldt, int drow0, float* scr, int lane) {
    f32x4 ld[8];
#pragma unroll
    for (int i = 0; i < 8; ++i) ld[i] = __builtin_nontemporal_load((const f32x4*)(W + (size_t)(k0 + 8 * i + (lane >> 3)) * ldw + n0 + 4 * (lane & 7)));
#pragma unroll
    for (int i = 0; i < 8; ++i) { float* d = scr + (8 * i + (lane >> 3)) * 33 + 4 * (lane & 7); d[0] = ld[i][0]; d[1] = ld[i][1]; d[2] = ld[i][2]; d[3] = ld[i][3]; }
    LDS_WAIT(); asm volatile("" ::: "memory");
    const int c = lane & 7;
#pragma unroll
    for (int j = 0; j < 4; ++j) { const int n = (lane >> 3) + 8 * j; const float* s = scr + (8 * c) * 33 + n;
        v2u o; o.x = pk4_fp8(32.f * s[0 * 33], 32.f * s[1 * 33], 32.f * s[2 * 33], 32.f * s[3 * 33]); o.y = pk4_fp8(32.f * s[4 * 33], 32.f * s[5 * 33], 32.f * s[6 * 33], 32.f * s[7 * 33]);
        *(v2u*)(WT8 + (size_t)(drow0 + n) * ldt + k0 + 8 * c) = o; }
    LDS_WAIT(); asm volatile("" ::: "memory");
}

struct TrItem { const float* W; int ldw, k0, n0; unsigned char* dst; int ldt, drow, kind; };
__device__ __forceinline__ void tr_load(f32x4 (&ld)[8], const TrItem& t, int lane) {
    if (t.kind == 0) return;
#pragma unroll
    for (int i = 0; i < 8; ++i) ld[i] = __builtin_nontemporal_load((const f32x4*)(t.W + (size_t)(t.k0 + 8 * i + (lane >> 3)) * t.ldw + t.n0 + 4 * (lane & 7)));
}
__device__ __forceinline__ void tr_store(const f32x4 (&ld)[8], const TrItem& t, float* scr, int lane) {
    if (t.kind == 0) return;
#pragma unroll
    for (int i = 0; i < 8; ++i) { float* d = scr + (8 * i + (lane >> 3)) * 33 + 4 * (lane & 7); d[0] = ld[i][0]; d[1] = ld[i][1]; d[2] = ld[i][2]; d[3] = ld[i][3]; }
    LDS_WAIT(); asm volatile("" ::: "memory");
    const int c = lane & 7;
    if (t.kind == 2) {
#pragma unroll
        for (int j = 0; j < 4; ++j) { const int n = (lane >> 3) + 8 * j; const float* s = scr + (8 * c) * 33 + n;
            v2u o; o.x = pk4_fp8(32.f * s[0 * 33], 32.f * s[1 * 33], 32.f * s[2 * 33], 32.f * s[3 * 33]); o.y = pk4_fp8(32.f * s[4 * 33], 32.f * s[5 * 33], 32.f * s[6 * 33], 32.f * s[7 * 33]);
            *(v2u*)(t.dst + (size_t)(t.drow + n) * t.ldt + t.k0 + 8 * c) = o; }
    } else {
#pragma unroll
        for (int j = 0; j < 4; ++j) { const int n = (lane >> 3) + 8 * j; const float* s = scr + (8 * c) * 33 + n;
            v4u o; o.x = pk2(s[0 * 33], s[1 * 33]); o.y = pk2(s[2 * 33], s[3 * 33]); o.z = pk2(s[4 * 33], s[5 * 33]); o.w = pk2(s[6 * 33], s[7 * 33]);
            *(v4u*)((bf16*)t.dst + (size_t)(t.drow + n) * t.ldt + t.k0 + 8 * c) = o; }
    }
    LDS_WAIT(); asm volatile("" ::: "memory");
}
#define TR_PIPELINE(FIRST, COUNT, STRIDE, DEC, scr, lane) do { f32x4 la_[8], lb_[8]; TrItem ta_, tb_; int it_ = (FIRST); \
        if (it_ < (COUNT)) { DEC(it_, ta_); tr_load(la_, ta_, lane); } \
        while (it_ < (COUNT)) { \
            int nx_ = it_ + (STRIDE); if (nx_ < (COUNT)) { DEC(nx_, tb_); tr_load(lb_, tb_, lane); } \
            tr_store(la_, ta_, scr, lane); it_ = nx_; if (it_ >= (COUNT)) break; \
            nx_ = it_ + (STRIDE); if (nx_ < (COUNT)) { DEC(nx_, ta_); tr_load(la_, ta_, lane); } \
            tr_store(lb_, tb_, scr, lane); it_ = nx_; } } while (0)

__device__ __forceinline__ void p0_prologue(Frame& F) {
    float* scr = (float*)(F.lds + F.wave * 16384);
    const int gw = F.bx * NWAVES + F.wave, NGW = F.G * NWAVES;
    constexpr int I_WIN = 16 * 201, I_WBR = 8 * 32, I_WOUT = 16 * 32, I_W1 = 16 * 88, I_W2 = 44 * 32, I_PW = 2 * 4;
    constexpr int NITEMS = 2 * I_WIN + 6 * I_WBR + 2 * I_WOUT + 2 * I_W1 + I_W2 + 8 * I_PW;
    bf16* WIN = (bf16*)(F.ws + WS_WIN); bf16* WBR = (bf16*)(F.ws + WS_WBR); bf16* WOUT = (bf16*)(F.ws + WS_WOUT);
    bf16* W13 = (bf16*)(F.ws + WS_W13); bf16* W2 = (bf16*)(F.ws + WS_W2); bf16* PW = (bf16*)(F.ws + WS_POOLW);
#define P0_DEC(it, t) do { int r = (it); t.kind = 0; \
        if (r < 2 * I_WIN) { const int l = r / I_WIN, q = r % I_WIN, kb = q / 201, n0 = (q % 201) * 32; \
            const int drow = n0 < 2816 ? n0 : (n0 < 2848 ? 3328 + (n0 - 2816) : (n0 < 3360 ? n0 - 32 : 3584 + (n0 - 3360))); \
            t.W = IN_w_in(F) + (size_t)l * 1024 * IN_COLS; t.ldw = IN_COLS; t.k0 = kb * 64; t.n0 = n0; t.ldt = 1024; \
            if (GATES_FP8 && n0 >= 3360) { t.dst = (unsigned char*)(WIN + (size_t)l * WIN_ROWS * 1024 + (size_t)NA * 1024); t.drow = n0 - 3360; t.kind = 2; } \
            else { t.dst = (unsigned char*)(WIN + (size_t)l * WIN_ROWS * 1024); t.drow = drow; t.kind = 1; } } \
        else if ((r -= 2 * I_WIN) < 6 * I_WBR) { const int ln = r / I_WBR, q = r % I_WBR, kb = q / 32, n0 = (q % 32) * 32;        \
            if (ln % 3 != 2) { t.W = IN_w_branch(F) + (size_t)ln * 512 * 1024; t.ldw = 1024; t.k0 = kb * 64; t.n0 = n0; t.dst = (unsigned char*)(WBR + (size_t)ln * 1024 * 512); t.ldt = 512; t.drow = n0; t.kind = 1; } } \
        else if ((r -= 6 * I_WBR) < 2 * I_WOUT) { const int l = r / I_WOUT, q = r % I_WOUT, kb = q / 32, n0 = (q % 32) * 32; \
            t.W = IN_w_out(F) + (size_t)l * 1024 * 1024; t.ldw = 1024; t.k0 = kb * 64; t.n0 = n0; t.dst = (unsigned char*)(WOUT + (size_t)l * 1024 * 1024); t.ldt = 1024; t.drow = n0; t.kind = 1; } \
        else if ((r -= 2 * I_WOUT) < 2 * I_W1) { const int w = r / I_W1, q = r % I_W1, kb = q / 88, n0 = (q % 88) * 32; \
            t.W = w ? IN_ffn_w3(F) : IN_ffn_w1(F); t.ldw = FF; t.k0 = kb * 64; t.n0 = n0; t.dst = (unsigned char*)W13; t.ldt = 1024; t.drow = (n0 >> 7) * 256 + (n0 & 127) + w * 128; t.kind = (FFN_FP8 == 1 || FFN_FP8 == 2) ? 2 : 1; } \
        else if ((r -= 2 * I_W1) < I_W2) { const int kb = r / 32, n0 = (r % 32) * 32; \
            t.W = IN_ffn_w2(F); t.ldw = 1024; t.k0 = kb * 64; t.n0 = n0; t.dst = (unsigned char*)W2; t.ldt = FF; t.drow = n0; t.kind = (FFN_FP8 == 1 || FFN_FP8 == 3) ? 2 : 1; } } while (0)
    (void)PW;
    TR_PIPELINE(gw, NITEMS, NGW, P0_DEC, scr, F.lane);
#undef P0_DEC
    for (int it = gw; it < 2 * 64 * 16; it += NGW) { const int l = it >> 10, cg = (it >> 4) & 63, db = it & 15, g = cg >> 4, c0 = (cg & 15) * 8, d = db * 64 + F.lane;
        const float* pw = IN_pool_w(F) + (((size_t)l * 4 + g) * 128 + c0) * 128; const float* ps = IN_pool_scale(F) + l * 512 + g * 128;
        const float* wb = IN_w_branch(F) + (((size_t)l * 3 + 2) * 512 + g * 128) * 1024 + d;
        for (int i = F.lane; i < 1024; i += 64) { const int j = i >> 7, k = i & 127; scr[k * 8 + j] = pw[j * 128 + k] * ps[k]; }
        LDS_WAIT(); asm volatile("" ::: "memory");
        float acc[8];
#pragma unroll
        for (int j = 0; j < 8; ++j) acc[j] = 0.f;
#pragma nounroll
        for (int kb = 0; kb < 128; kb += 16) {
            float w[16];
#pragma unroll
            for (int u = 0; u < 16; ++u) w[u] = __builtin_nontemporal_load(wb + (size_t)(kb + u) * 1024);
#pragma unroll
            for (int u = 0; u < 16; ++u) { const f32x4 s0 = *(const f32x4*)(scr + (kb + u) * 8), s1 = *(const f32x4*)(scr + (kb + u) * 8 + 4);
                acc[0] += s0[0] * w[u]; acc[1] += s0[1] * w[u]; acc[2] += s0[2] * w[u]; acc[3] += s0[3] * w[u]; acc[4] += s1[0] * w[u]; acc[5] += s1[1] * w[u]; acc[6] += s1[2] * w[u]; acc[7] += s1[3] * w[u]; } }
        LDS_WAIT(); asm volatile("" ::: "memory");
        v4u o; o.x = pk2(acc[0], acc[1]); o.y = pk2(acc[2], acc[3]); o.z = pk2(acc[4], acc[5]); o.w = pk2(acc[6], acc[7]);
        *(v4u*)(WBR + (((size_t)l * 3 + 2) * 1024 + d) * 512 + g * 128 + c0) = o; }
    bf16* HB = (bf16*)(F.ws + WS_HB);
    const size_t gt = (size_t)F.bx * NTHR + F.tid, NT = (size_t)F.G * NTHR;
    const f32x4* xp = (const f32x4*)IN_x(F);
    for (size_t i0 = gt; i0 < (size_t)M * D / 8; i0 += 4 * NT) {
        f32x4 a[4], b[4];
#pragma unroll
        for (int u = 0; u < 4; ++u) { const size_t i = i0 + u * NT; a[u] = __builtin_nontemporal_load(xp + 2 * i); b[u] = __builtin_nontemporal_load(xp + 2 * i + 1); }
#pragma unroll
        for (int u = 0; u < 4; ++u) { const size_t i = i0 + u * NT; v4u o; o.x = pk2(a[u].x, a[u].y); o.y = pk2(a[u].z, a[u].w); o.z = pk2(b[u].x, b[u].y); o.w = pk2(b[u].z, b[u].w); ((v4u*)HB)[i] = o;
            if (GATES_FP8) { v2u o8; o8.x = pk4_fp8(a[u].x, a[u].y, a[u].z, a[u].w); o8.y = pk4_fp8(b[u].x, b[u].y, b[u].z, b[u].w); ((v2u*)(F.ws + WS_HBG8))[i] = o8; } }
    }
}
__device__ __forceinline__ void moe_weight_convert(Frame& F) {
    float* scr = (float*)(F.lds + F.wave * 16384);
    const int gw = F.bx * NWAVES + F.wave, NGW = F.G * NWAVES;
    constexpr int I_GU = 16 * 112, I_D = 56 * 32;
    constexpr int NITEMS = NE * (2 * I_GU + I_D);
    bf16* MWGU = (bf16*)(F.ws + WS_MWGU); bf16* MWD = (bf16*)(F.ws + WS_MWD);
#if MOE_FP8
#define MOE_DEC(it, t) do { int r = (it); \
        if (r < NE * 2 * I_GU) { const int e = r / (2 * I_GU), q2 = r % (2 * I_GU), w = q2 / I_GU, q = q2 % I_GU, kb = q / 112, n0 = (q % 112) * 32; \
            t.W = (w ? IN_moe_wu(F) : IN_moe_wg(F)) + (size_t)e * 1024 * FFE; t.ldw = FFE; t.k0 = kb * 64; t.n0 = n0; t.dst = (unsigned char*)MWGU; t.ldt = 1024; t.drow = e * 2 * FFE + (n0 >> 7) * 256 + (n0 & 127) + w * 128; t.kind = 2; } \
        else { r -= NE * 2 * I_GU; const int e = r / I_D, q = r % I_D, kb = q / 32, n0 = (q % 32) * 32; \
            t.W = IN_moe_wd(F) + (size_t)e * FFE * 1024; t.ldw = 1024; t.k0 = kb * 64; t.n0 = n0; t.dst = (unsigned char*)MWD + (size_t)e * 1024 * FFE; t.ldt = FFE; t.drow = n0; t.kind = 2; } } while (0)
    TR_PIPELINE(gw, NITEMS, NGW, MOE_DEC, scr, F.lane);
#undef MOE_DEC
#else
    for (int it = gw; it < NITEMS; it += NGW) {
        int r = it;
        if (r < NE * 2 * I_GU) { const int e = r / (2 * I_GU), q2 = r % (2 * I_GU), w = q2 / I_GU, q = q2 % I_GU, kb = q / 112, n0 = (q % 112) * 32;
            const int drow = e * 2 * FFE + (n0 >> 7) * 256 + (n0 & 127) + w * 128;
            tr_item<FP8_EMU != 0>((w ? IN_moe_wu(F) : IN_moe_wg(F)) + (size_t)e * 1024 * FFE, FFE, kb * 64, n0, MWGU, 1024, drow, scr, F.lane);
            continue; }
        r -= NE * 2 * I_GU;
        { const int e = r / I_D, q = r % I_D, kb = q / 32, n0 = (q % 32) * 32;
            tr_item<FP8_EMU != 0>(IN_moe_wd(F) + (size_t)e * FFE * 1024, 1024, kb * 64, n0, MWD + (size_t)e * 1024 * FFE, FFE, n0, scr, F.lane); }
    }
#endif
}

using pg8::acc_t; using pg8::Unit; using pg8::cvt_pk_bf16; using pg8::zero_acc;
__device__ __forceinline__ v4u pack8(const f32x4& v0, const f32x4& v1) { v4u w; w.x = cvt_pk_bf16(v0[0], v0[1]); w.y = cvt_pk_bf16(v0[2], v0[3]); w.z = cvt_pk_bf16(v1[0], v1[1]); w.w = cvt_pk_bf16(v1[2], v1[3]); return w; }

struct EpiInA {
    static constexpr bool PERM = true;
    unsigned char* ws;
    __device__ __forceinline__ void operator()(acc_t& acc, const Unit& u, int wr, int wc, int fr, int fq) const {
        const int pn = u.pn; const size_t row0 = (size_t)u.pm * 256 + wr * 64 + fr;
        if (pn == 13) {
            if (wc == 0) { float* dab = (float*)(ws + WS_DAB);
#pragma unroll
                for (int ai = 0; ai < 2; ++ai)
#pragma unroll
                    for (int m = 0; m < 4; ++m) { float* p = dab + (row0 + ai * 128 + m * 16) * 32 + 8 * fq; *(f32x4*)p = acc[ai][0][m][0]; *(f32x4*)(p + 4) = acc[ai][0][m][1]; } }
        } else {
            bf16* b0; bf16* b1; int ldc;
            if (pn < 2) { ldc = 512; b0 = (bf16*)(ws + WS_AQ) + pn * 256; b1 = b0 + 128; }
            else if (pn == 2) { ldc = 128; b0 = (bf16*)(ws + WS_AK); b1 = (bf16*)(ws + WS_AV); }
            else if (pn < 9) { ldc = 1536; b0 = (bf16*)(ws + WS_DQKV) + (pn - 3) * 256; b1 = b0 + 128; }
            else if (pn < 11) { ldc = 512; b0 = (bf16*)(ws + WS_DZ) + (pn - 9) * 256; b1 = b0 + 128; }
            else { ldc = 512; b0 = (bf16*)(ws + WS_PU) + (pn - 11) * 256; b1 = b0 + 128; }
            const int cl = wc * 32 + 8 * fq;
#pragma unroll
            for (int ai = 0; ai < 2; ++ai)
#pragma unroll
                for (int m = 0; m < 4; ++m) { const size_t ro = (row0 + ai * 128 + m * 16) * ldc + cl;
                    *(v4u*)(b0 + ro) = pack8(acc[ai][0][m][0], acc[ai][0][m][1]);
                    *(v4u*)(b1 + ro) = pack8(acc[ai][1][m][0], acc[ai][1][m][1]); }
        }
        zero_acc(acc);
    }
};
struct EpiGates {
    static constexpr bool PERM = true;
    bf16* GT; float asc;
    __device__ __forceinline__ void operator()(acc_t& acc, const Unit& u, int wr, int wc, int fr, int fq) const {
        const size_t row0 = (size_t)u.pm * 256 + wr * 64 + fr;
        bf16* base = GT + (size_t)(u.pn >> 2) * M * 1024 + (u.pn & 3) * 256 + wc * 32 + 8 * fq;
#pragma unroll
        for (int ai = 0; ai < 2; ++ai)
#pragma unroll
            for (int m = 0; m < 4; ++m)
#pragma unroll
                for (int bj = 0; bj < 2; ++bj) { f32x4 v0 = acc[ai][bj][m][0], v1 = acc[ai][bj][m][1];
#pragma unroll
                    for (int j = 0; j < 4; ++j) { v0[j] = sigmoidf_(v0[j] * asc); v1[j] = sigmoidf_(v1[j] * asc); }
                    *(v4u*)(base + (row0 + ai * 128 + m * 16) * 1024 + bj * 128) = pack8(v0, v1); }
        zero_acc(acc);
    }
};
struct BrSched {
    pg8::StaticOrder o; const char *A0, *B0; size_t tstep;
    __device__ __forceinline__ bool next(int i, Unit& u) const { const int t = i / 3; u.aux = i - 3 * t; return o.map((long)t * o.G + o.c, u.pm, u.pn); }
    __device__ __forceinline__ const char* abase(const Unit& u) const { return A0 + (size_t)u.aux * (32 * MiB) + (size_t)u.pm * tstep; }
    __device__ __forceinline__ const char* bbase(const Unit& u) const { return B0 + (size_t)u.aux * (1024 * 512 * 2) + (size_t)u.pn * tstep; }
};
__device__ __forceinline__ void unpack8(const v4u& w, f32x4& a, f32x4& b) { a[0] = bflo(w.x); a[1] = bfhi(w.x); a[2] = bflo(w.y); a[3] = bfhi(w.y); b[0] = bflo(w.z); b[1] = bfhi(w.z); b[2] = bflo(w.w); b[3] = bfhi(w.w); }
#ifndef GNT
#define GNT 1
#endif
struct EpiBranch {
    static constexpr bool PERM = true;
    const bf16* GT; bf16* MG;
    __device__ __forceinline__ void operator()(acc_t& acc, const Unit& u, int wr, int wc, int fr, int fq) const {
        const unsigned eoff = ((unsigned)u.pm * 256u + (unsigned)(wr * 64 + fr)) * 1024u + (unsigned)(u.pn * 256 + wc * 32 + 8 * fq); const int seg = u.aux;
        const char* gn = (const char*)(GT + (size_t)seg * M * 1024);
        const char* gd = (const char*)(GT + (size_t)(seg < 2 ? seg + 1 : 2) * M * 1024);
#pragma unroll
        for (int ai = 0; ai < 2; ++ai)
#pragma unroll
          for (int mh = 0; mh < 2; ++mh) {
            v4u nb[4], db[4];
#pragma unroll
            for (int mm = 0; mm < 2; ++mm)
#pragma unroll
                for (int bj = 0; bj < 2; ++bj) { const int m = 2 * mh + mm; const size_t off = (size_t)((eoff + (unsigned)((ai * 128 + m * 16) * 1024 + bj * 128)) * 2u);
                    nb[mm * 2 + bj] = GNT ? __builtin_nontemporal_load((const v4u*)(gn + off)) : *(const v4u*)(gn + off);
                    if (seg < 2) db[mm * 2 + bj] = *(const v4u*)(gd + off); }
            __builtin_amdgcn_sched_barrier(0);
#pragma unroll
            for (int mm = 0; mm < 2; ++mm)
#pragma unroll
                for (int bj = 0; bj < 2; ++bj) { const int m = 2 * mh + mm; const size_t off = (size_t)((eoff + (unsigned)((ai * 128 + m * 16) * 1024 + bj * 128)) * 2u);
                    f32x4 n0, n1; unpack8(nb[mm * 2 + bj], n0, n1);
                    if (seg < 2) { f32x4 d0, d1; unpack8(db[mm * 2 + bj], d0, d1);
#pragma unroll
                        for (int j = 0; j < 4; ++j) { n0[j] *= __builtin_amdgcn_rcpf(fmaxf(d0[j], 1e-30f)); n1[j] *= __builtin_amdgcn_rcpf(fmaxf(d1[j], 1e-30f)); } }
                    acc[ai][bj][m][0] *= n0; acc[ai][bj][m][1] *= n1;
                    if (seg == 2) *(v4u*)((char*)MG + off) = pack8(acc[ai][bj][m][0], acc[ai][bj][m][1]); }
            __builtin_amdgcn_sched_barrier(0);
          }
        if (seg == 2) zero_acc(acc);
    }
};
struct EpiBranchRMW {
    static constexpr bool PERM = true;
    const bf16* GT; bf16* MG;
    __device__ __forceinline__ void operator()(acc_t& acc, const Unit& u, int wr, int wc, int fr, int fq) const {
        const size_t row0 = (size_t)u.pm * 256 + wr * 64 + fr; const int col = u.pn * 256 + wc * 32 + 8 * fq; const int seg = u.aux;
        const bf16* gn = GT + (size_t)seg * M * 1024;
#pragma unroll
        for (int ai = 0; ai < 2; ++ai)
#pragma unroll
            for (int m = 0; m < 4; ++m)
#pragma unroll
                for (int bj = 0; bj < 2; ++bj) { const size_t off = (row0 + ai * 128 + m * 16) * 1024 + col + bj * 128;
                    f32x4 n0, n1; unpack8(*(const v4u*)(gn + off), n0, n1);
                    f32x4 r0 = acc[ai][bj][m][0] * n0, r1 = acc[ai][bj][m][1] * n1;
                    if (seg > 0) { f32x4 p0, p1; unpack8(*(const v4u*)(MG + off), p0, p1); r0 += p0; r1 += p1; }
                    *(v4u*)(MG + off) = pack8(r0, r1); }
        zero_acc(acc);
    }
};
struct EpiResid {
    static constexpr bool PERM = true;
    bf16* HBp; float ys;
    __device__ __forceinline__ void operator()(acc_t& acc, const Unit& u, int wr, int wc, int fr, int fq) const {
        const size_t row0 = (size_t)u.pm * 256 + wr * 64 + fr; const int col0 = u.pn * 256 + wc * 32 + 8 * fq;
#pragma unroll
        for (int ai = 0; ai < 2; ++ai)
#pragma unroll
            for (int m = 0; m < 4; ++m) { bf16* rp = HBp + (row0 + ai * 128 + m * 16) * 1024 + col0;
#pragma unroll
                for (int bj = 0; bj < 2; ++bj) { f32x4 h0, h1; unpack8(*(const v4u*)(rp + bj * 128), h0, h1);
                    *(v4u*)(rp + bj * 128) = pack8(h0 * ALPHA + acc[ai][bj][m][0] * ys, h1 * ALPHA + acc[ai][bj][m][1] * ys); } }
        zero_acc(acc);
    }
};
template <int use, bool g8, int LNI  >
struct EpiResidLN {
    static constexpr bool PERM = true;
    unsigned char* ws; const Args* a; LAS unsigned char* ldsl; float ys;
    __device__ __forceinline__ void operator()(acc_t& acc, const Unit& u, int wr, int wc, int fr_in, int fq_in) const {
        int fr = fr_in, fq = fq_in; asm volatile("" : "+v"(fr), "+v"(fq));
        const int tid = (wr * 4 + wc) * 64 + fq * 16 + fr;
        LAS float* part = (LAS float*)(ldsl + LNX_LDS_OFF); LAS float* mr = part + 2048;
        const int rloc = wr * 64 + fr; const int col0 = u.pn * 256 + wc * 32 + 8 * fq;
        const unsigned eoff = ((unsigned)u.pm * 256u + (unsigned)rloc) * 1024u + (unsigned)col0;
        const char* hb = (const char*)(ws + WS_HB);
#pragma unroll
        for (int ai = 0; ai < 2; ++ai) {
            v4u rb[8];
#pragma unroll
            for (int m = 0; m < 4; ++m)
#pragma unroll
                for (int bj = 0; bj < 2; ++bj) rb[m * 2 + bj] = *(const v4u*)(hb + (size_t)((eoff + (unsigned)(ai * 128 + m * 16) * 1024u) * 2u + bj * 256u));
            __builtin_amdgcn_sched_barrier(0);
#pragma unroll
            for (int m = 0; m < 4; ++m) { float a = 0.f, q = 0.f;
#pragma unroll
                for (int bj = 0; bj < 2; ++bj) { f32x4 h0, h1; unpack8(rb[m * 2 + bj], h0, h1);
                    const f32x4 z0 = h0 * ALPHA + acc[ai][bj][m][0] * ys, z1 = h1 * ALPHA + acc[ai][bj][m][1] * ys; acc[ai][bj][m][0] = z0; acc[ai][bj][m][1] = z1;
                    a += ((z0[0] + z0[1]) + (z0[2] + z0[3])) + ((z1[0] + z1[1]) + (z1[2] + z1[3]));
                    q += ((z0[0] * z0[0] + z0[1] * z0[1]) + (z0[2] * z0[2] + z0[3] * z0[3])) + ((z1[0] * z1[0] + z1[1] * z1[1]) + (z1[2] * z1[2] + z1[3] * z1[3])); }
                a += __shfl_xor(a, 16); a += __shfl_xor(a, 32); q += __shfl_xor(q, 16); q += __shfl_xor(q, 32);
                if (fq == 0) { LAS float* d = part + (wc * 256 + rloc + ai * 128 + m * 16) * 2; d[0] = a; d[1] = q; } }
            __builtin_amdgcn_sched_barrier(0);
        }
        __syncthreads();
        float S1 = 0.f, S2 = 0.f;
        float* stat = (float*)(ws + WS_LNSTAT) + (size_t)u.pm * 4 * 512;
        if (tid < 256) {
#pragma unroll
            for (int w = 0; w < 4; ++w) { S1 += part[(w * 256 + tid) * 2]; S2 += part[(w * 256 + tid) * 2 + 1]; }
            __hip_atomic_store(stat + (u.pn * 256 + tid) * 2, S1, RLX_AGENT); __hip_atomic_store(stat + (u.pn * 256 + tid) * 2 + 1, S2, RLX_AGENT); }
        asm volatile("s_waitcnt vmcnt(0)" ::: "memory");
        __syncthreads();
        if (tid == 0) { unsigned* flag = (unsigned*)(ws + WS_CTL) + CW_LNX + use * 128 + u.pm;
            (void)__hip_atomic_fetch_add(flag, 1u, RLX_AGENT);
            unsigned sp = 0u; while (__hip_atomic_load(flag, RLX_AGENT) < 4u && ++sp < (1u << 20)) __builtin_amdgcn_s_sleep(1); }
        __syncthreads();
        if (tid < 256) {
#pragma unroll
            for (int p = 1; p < 4; ++p) { const int pn2 = (u.pn + p) & 3; S1 += __hip_atomic_load(stat + (pn2 * 256 + tid) * 2, RLX_AGENT); S2 += __hip_atomic_load(stat + (pn2 * 256 + tid) * 2 + 1, RLX_AGENT); }
            const float mean = S1 * (1.0f / 1024.0f), var = S2 * (1.0f / 1024.0f) - mean * mean;
            mr[tid * 2] = mean; mr[tid * 2 + 1] = __builtin_amdgcn_rsqf((var > 0.f ? var : 0.f) + LN_EPS); }
        __syncthreads();
        asm volatile("" : "+v"(fr), "+v"(fq));
        const int rloc2 = wr * 64 + fr; const int col2 = u.pn * 256 + wc * 32 + 8 * fq;
        const unsigned eoff2 = ((unsigned)u.pm * 256u + (unsigned)rloc2) * 1024u + (unsigned)col2;
        char* hbw = (char*)(ws + WS_HB); unsigned char* h8 = ws + WS_HBG8; const float* gam = a->in[12 + 2 * LNI]; const float* bet = a->in[13 + 2 * LNI];
#pragma unroll
        for (int bj = 0; bj < 2; ++bj) {
            const f32x4 g0 = *(const f32x4*)(gam + col2 + bj * 128), g1 = *(const f32x4*)(gam + col2 + bj * 128 + 4), b0 = *(const f32x4*)(bet + col2 + bj * 128), b1 = *(const f32x4*)(bet + col2 + bj * 128 + 4);
#pragma unroll
            for (int ai = 0; ai < 2; ++ai)
#pragma unroll
                for (int m = 0; m < 4; ++m) { const int rl = rloc2 + ai * 128 + m * 16; const float mean = mr[rl * 2], rstd = mr[rl * 2 + 1];
                    const unsigned eo = eoff2 + (unsigned)(ai * 128 + m * 16) * 1024u + bj * 128u;
                    const f32x4 v0 = (acc[ai][bj][m][0] - mean) * rstd * g0 + b0, v1 = (acc[ai][bj][m][1] - mean) * rstd * g1 + b1;
                    *(v4u*)(hbw + (size_t)(eo * 2u)) = pack8(v0, v1);
                    if (g8) { v2u o; o.x = pk4_fp8(v0[0], v0[1], v0[2], v0[3]); o.y = pk4_fp8(v1[0], v1[1], v1[2], v1[3]); *(v2u*)(h8 + (size_t)eo) = o; } } }
        zero_acc(acc);
    }
};
struct EpiSwiglu {
    static constexpr bool PERM = true;
    bf16* ACT; int ldc; float asc; int q;
    __device__ __forceinline__ void operator()(acc_t& acc, const Unit& u, int wr, int wc, int fr, int fq) const {
        const size_t row0 = (size_t)u.pm * 256 + wr * 64 + fr; const int col = u.aux * 128 + wc * 32 + 8 * fq;
#pragma unroll
        for (int ai = 0; ai < 2; ++ai)
#pragma unroll
            for (int m = 0; m < 4; ++m) { f32x4 v0, v1;
#pragma unroll
                for (int j = 0; j < 4; ++j) { v0[j] = siluf_(acc[ai][0][m][0][j] * asc) * (acc[ai][1][m][0][j] * asc); v1[j] = siluf_(acc[ai][0][m][1][j] * asc) * (acc[ai][1][m][1][j] * asc); if (q) { v0[j] = q8(v0[j]); v1[j] = q8(v1[j]); } }
                *(v4u*)(ACT + (row0 + ai * 128 + m * 16) * ldc + col) = pack8(v0, v1); }
        zero_acc(acc);
    }
};
struct EpiSwiglu8 {
    static constexpr bool PERM = true;
    unsigned char* ACT; int ldc; float asc;
    __device__ __forceinline__ void operator()(acc_t& acc, const Unit& u, int wr, int wc, int fr, int fq) const {
        const size_t row0 = (size_t)u.pm * 256 + wr * 64 + fr; const int col = u.aux * 128 + wc * 32 + 8 * fq;
#pragma unroll
        for (int ai = 0; ai < 2; ++ai)
#pragma unroll
            for (int m = 0; m < 4; ++m) { float v[8];
#pragma unroll
                for (int j = 0; j < 4; ++j) { v[j] = siluf_(acc[ai][0][m][0][j] * asc) * (acc[ai][1][m][0][j] * asc); v[4 + j] = siluf_(acc[ai][0][m][1][j] * asc) * (acc[ai][1][m][1][j] * asc); }
                v2u o; o.x = pk4_fp8(v[0], v[1], v[2], v[3]); o.y = pk4_fp8(v[4], v[5], v[6], v[7]);
                *(v2u*)(ACT + (row0 + ai * 128 + m * 16) * ldc + col) = o;
                __builtin_amdgcn_sched_barrier(0); }
        zero_acc(acc);
    }
};
struct FfnUpSched {
    pg8::StaticOrder o; const char* A; const char* Bt; size_t tstep;
    __device__ __forceinline__ bool next(int i, Unit& u) const { const bool ok = o.map((long)i * o.G + o.c, u.pm, u.pn); u.aux = u.pn; return ok; }
    __device__ __forceinline__ const char* abase(const Unit& u) const { return A + (size_t)u.pm * tstep; }
    __device__ __forceinline__ const char* bbase(const Unit& u) const { return Bt + (size_t)u.pn * tstep; }
};

constexpr int DN_RAW_OFF = 0;
constexpr int DN_XS_OFF = 26624;
constexpr int DN_OB_OFF = DN_XS_OFF + 49152;
constexpr int DN_AB_OFF = DN_OB_OFF + 16384;
constexpr int DN_CW_OFF = DN_AB_OFF + 512;
static_assert(DN_CW_OFF + 3840 <= RING_BYTES, "delta LDS");
__device__ __forceinline__ void delta_seq(Frame& F, int layer, int seq) {
    const int dir = seq >> 7, b = (seq >> 3) & 15, h = seq & 7;
    bf16* raw = (bf16*)(F.lds + DN_RAW_OFF); float* xs = (float*)(F.lds + DN_XS_OFF); float* ob = (float*)(F.lds + DN_OB_OFF);
    float* ab = (float*)(F.lds + DN_AB_OFF); float* cw = (float*)(F.lds + DN_CW_OFF);
    const bf16* DQKV = (const bf16*)(F.ws + WS_DQKV); const float* DAB = (const float*)(F.ws + WS_DAB);
    float* OUT = (float*)(F.ws + (dir ? WS_OB : WS_OF));
    const int tid = F.tid, lane = F.lane, wave = F.wave, p = lane & 7, j = wave * 8 + (lane >> 3);
    __syncthreads();
    for (int i = tid; i < 5 * 192; i += NTHR) { const int jj = i / 192, ch = i % 192; cw[i] = IN_conv_w(F)[((size_t)layer * 5 + jj) * 1536 + (ch >> 6) * 512 + h * 64 + (ch & 63)]; }
    const float nA = -__expf(IN_a_log(F)[layer * 16 + dir * 8 + h]), dtb = IN_dt_bias(F)[layer * 16 + dir * 8 + h];
    float S[8];
#pragma unroll
    for (int i = 0; i < 8; ++i) S[i] = 0.f;
    for (int blk = 0; blk < SEQ / 64; ++blk) {
        const int tb = dir ? (SEQ / 64 - 1 - blk) : blk, t0 = tb * 64;
        __syncthreads();
        for (int idx = tid; idx < 68 * 24; idx += NTHR) { const int r = idx / 24, pc = idx % 24, sec = pc >> 3, c8 = pc & 7, t = t0 - 2 + r;
            const v4u v = ld_or_zero(DQKV + ((size_t)b * SEQ + t) * 1536 + sec * 512 + h * 64 + c8 * 8, DQKV, t >= 0 && t < SEQ);
            *(v4u*)(raw + r * 192 + sec * 64 + c8 * 8) = v; }
        if (tid < 64) { const size_t m = (size_t)b * SEQ + t0 + tid; const float a = DAB[m * 32 + dir * 8 + h], bq = DAB[m * 32 + 16 + dir * 8 + h];
            const float xx = a + dtb; const float sp = xx > 20.f ? xx : log1pf(__expf(xx));
            ab[tid * 2] = __expf(nA * sp); ab[tid * 2 + 1] = sigmoidf_(bq); }
        __syncthreads();
        for (int idx = tid; idx < 64 * 192; idx += NTHR) { const int tt = idx / 192, ch = idx % 192; float x = 0.f;
#pragma unroll
            for (int jj = 0; jj < 5; ++jj) x += cw[jj * 192 + ch] * bf2f(raw[(tt + jj) * 192 + ch]);
            xs[idx] = siluf_(x); }
        __syncthreads();
        { const int row = tid >> 2, part = tid & 3, tt = row >> 1, sec = row & 1; float* xp = xs + tt * 192 + sec * 64 + part * 16; float ss = 0.f; float v[16];
#pragma unroll
            for (int i = 0; i < 16; ++i) { v[i] = xp[i]; ss += v[i] * v[i]; }
            ss = red4(ss);
            const float sc = __builtin_amdgcn_rsqf(ss + 1e-6f) * (sec == 0 ? 0.125f : 1.0f);
#pragma unroll
            for (int i = 0; i < 16; ++i) xp[i] = v[i] * sc; }
        __syncthreads();
        for (int s = 0; s < 64; ++s) {
            const int tt = dir ? 63 - s : s; const float* xr = xs + tt * 192;
            const f32x4 q0 = *(const f32x4*)(xr + 8 * p), q1 = *(const f32x4*)(xr + 8 * p + 4);
            const f32x4 k0 = *(const f32x4*)(xr + 64 + 8 * p), k1 = *(const f32x4*)(xr + 64 + 8 * p + 4);
            const float v = xr[128 + j], al = ab[tt * 2], be = ab[tt * 2 + 1];
            float part = (S[0] * k0[0] + S[1] * k0[1]) + (S[2] * k0[2] + S[3] * k0[3]) + (S[4] * k1[0] + S[5] * k1[1]) + (S[6] * k1[2] + S[7] * k1[3]);
            part = red8(part);
            const float c = be * (v - al * part);
            S[0] = al * S[0] + k0[0] * c; S[1] = al * S[1] + k0[1] * c; S[2] = al * S[2] + k0[2] * c; S[3] = al * S[3] + k0[3] * c;
            S[4] = al * S[4] + k1[0] * c; S[5] = al * S[5] + k1[1] * c; S[6] = al * S[6] + k1[2] * c; S[7] = al * S[7] + k1[3] * c;
            float op = (S[0] * q0[0] + S[1] * q0[1]) + (S[2] * q0[2] + S[3] * q0[3]) + (S[4] * q1[0] + S[5] * q1[1]) + (S[6] * q1[2] + S[7] * q1[3]);
            op = red8(op);
            if (p == 0) ob[tt * 64 + j] = op;
        }
        __syncthreads();
        for (int idx = tid; idx < 64 * 16; idx += NTHR) { const int tt = idx >> 4, c4 = idx & 15;
            *(f32x4*)(OUT + ((size_t)b * SEQ + t0 + tt) * 512 + h * 64 + c4 * 4) = *(const f32x4*)(ob + tt * 64 + c4 * 4); }
    }
}
__device__ __forceinline__ void delta_post(Frame& F, int layer) {
    const bf16* OFp = (const bf16*)(F.ws + WS_OF); const bf16* OBp = (const bf16*)(F.ws + WS_OB); bf16* DZ = (bf16*)(F.ws + WS_DZ);
    const int d4 = (F.lane & 15) * 4; const f32x4 nw = *(const f32x4*)(IN_dn_norm_w(F) + layer * 64 + d4);
    const size_t gq = ((size_t)F.bx * NTHR + F.tid) >> 4, NQ = ((size_t)F.G * NTHR) >> 4;
    for (size_t pr0 = gq; pr0 < (size_t)M * 8; pr0 += 4 * NQ) {
        v2u ofw[4], obw[4], zw[4];
#pragma unroll
        for (int u = 0; u < 4; ++u) { const size_t off = (pr0 + u * NQ) * 64 + d4; ofw[u] = *(const v2u*)(OFp + off); obw[u] = *(const v2u*)(OBp + off); zw[u] = *(const v2u*)(DZ + off); }
#pragma unroll
        for (int u = 0; u < 4; ++u) { const size_t off = (pr0 + u * NQ) * 64 + d4;
            const f32x4 o = (f32x4){bflo(ofw[u].x) + bflo(obw[u].x), bfhi(ofw[u].x) + bfhi(obw[u].x), bflo(ofw[u].y) + bflo(obw[u].y), bfhi(ofw[u].y) + bfhi(obw[u].y)};
            float ss = (o[0] * o[0] + o[1] * o[1]) + (o[2] * o[2] + o[3] * o[3]); ss = red16(ss);
            const float rs = (ABL == 2) ? 0.f : __builtin_amdgcn_rsqf(ss * (1.0f / 64.0f) + RMS_EPS);
            const float z0 = bflo(zw[u].x), z1 = bfhi(zw[u].x), z2 = bflo(zw[u].y), z3 = bfhi(zw[u].y);
            v2u w; w.x = pk2(o[0] * rs * nw[0] * siluf_(z0), o[1] * rs * nw[1] * siluf_(z1)); w.y = pk2(o[2] * rs * nw[2] * siluf_(z2), o[3] * rs * nw[3] * siluf_(z3));
            *(v2u*)(DZ + off) = w; }
    }
}

typedef short v4i16_t __attribute__((ext_vector_type(4)));
constexpr int AT_K_OFF = 0;
constexpr int AT_V_OFF = 46080;
constexpr int AT_BIAS_OFF = 92160;
static_assert(AT_V_OFF + 46080 <= AT_BIAS_OFF && AT_BIAS_OFF + 8320 <= RING_BYTES, "attn LDS");
__device__ __forceinline__ int t5_bucket(int rel) {
    const int n = rel < 0 ? -rel : rel;
    const int large = 8 + (n >= 12) + (n >= 16) + (n >= 23) + (n >= 32) + (n >= 46) + (n >= 64) + (n >= 91);
    return (rel > 0 ? 16 : 0) + (n < 8 ? n : large);
}
__device__ __forceinline__ void attn_bias_setup(Frame& F) {
    float* bl = (float*)(F.lds + AT_BIAS_OFF);
    for (int i = F.tid; i < 8 * 257; i += NTHR) { const int h = i / 257, r = i % 257; bl[h * 260 + r] = IN_rel_bias(F)[t5_bucket(r - 128) * 8 + h] * 1.44269504f; }
}
__device__ __forceinline__ void attn_load(Frame& F, int unit, v4u (&kr)[5], v4u (&vr)[5], bf16x8 (&qn)[4]) {
    const int b = unit >> 6, kvh = (unit >> 5) & 1, q0 = (unit & 31) * 64;
    const bf16* AK = (const bf16*)(F.ws + WS_AK); const bf16* AV = (const bf16*)(F.ws + WS_AV);
    { const int hq = kvh * 4 + (F.wave & 3), qw = q0 + 32 * (F.wave >> 2), qi = F.lane & 31, hl = F.lane >> 5;
        const bf16* qp = (const bf16*)(F.ws + WS_AQ) + ((size_t)b * SEQ + qw + qi) * 512 + hq * 64 + 8 * hl;
#pragma unroll
        for (int s = 0; s < 4; ++s) qn[s] = *(const bf16x8*)(qp + 16 * s); }
#pragma unroll
    for (int it = 0; it < 5; ++it) { const int idx = F.tid + it * NTHR, i = idx >> 3, d8 = idx & 7, kp = q0 - 128 + i; const bool ok = kp >= 0 && kp < SEQ;
        const size_t off = ((size_t)b * SEQ + kp) * 128 + kvh * 64 + d8 * 8;
        kr[it] = ld_or_zero(AK + off, AK, ok); vr[it] = ld_or_zero(AV + off, AV, ok); }
}
__device__ __forceinline__ void attn_store(Frame& F, const v4u (&kr)[5], const v4u (&vr)[5]) {
    bf16* Kl = (bf16*)(F.lds + AT_K_OFF); bf16* Vl = (bf16*)(F.lds + AT_V_OFF);
#pragma unroll
    for (int it = 0; it < 5; ++it) { const int idx = F.tid + it * NTHR, i = idx >> 3, d8 = idx & 7;
        *(v4u*)(Kl + i * 72 + d8 * 8) = kr[it]; *(v4u*)(Vl + i * 72 + d8 * 8) = vr[it]; }
}
__device__ __forceinline__ void attn_compute(Frame& F, int layer, int unit, bf16* OUT, const bf16x8 (&qf)[4]) {
    const int b = unit >> 6, kvh = (unit >> 5) & 1, qb = unit & 31, q0 = qb * 64;
    const bf16* Kl = (const bf16*)(F.lds + AT_K_OFF); const bf16* Vl = (const bf16*)(F.lds + AT_V_OFF); const float* bl = (const float*)(F.lds + AT_BIAS_OFF);
    bf16* AQ = (bf16*)(F.ws + WS_AQ);
    const int lane = F.lane, wave = F.wave;
    const int hq = kvh * 4 + (wave & 3), half = wave >> 2, qw = q0 + 32 * half, qi = lane & 31, hl = lane >> 5;
    const size_t qrow = ((size_t)b * SEQ + qw + qi) * 512 + hq * 64;
    f32x16 o0, o1;
#pragma unroll
    for (int i = 0; i < 16; ++i) { o0[i] = 0.f; o1[i] = 0.f; }
    float mrun = IN_attn_sink(F)[layer * 8 + hq] * 1.44269504f, lrun = hl == 0 ? 1.0f : 0.0f;
    const bool interior = (qb >= 2) && (qb <= 29);
    const float qsc = 0.125f * 1.44269504f;
    const float* bh = bl + hq * 260;
    for (int kt = 0; kt < 9; ++kt) {
        const int kb = 32 * half + 32 * kt;
        f32x16 sc;
#pragma unroll
        for (int i = 0; i < 16; ++i) sc[i] = 0.f;
#pragma unroll
        for (int s = 0; s < 4; ++s) { const bf16x8 a = *(const bf16x8*)(Kl + (kb + qi) * 72 + 16 * s + 8 * hl); sc = __builtin_amdgcn_mfma_f32_32x32x16_bf16(a, qf[s], sc, 0, 0, 0); }
        float mt = -1e30f;
        if (interior && kt >= 1 && kt <= 7) {
            const float* bp = bh + 32 * kt + 4 * hl - qi;
#pragma unroll
            for (int i = 0; i < 16; ++i) { const float sv = sc[i] * qsc + bp[(i & 3) + 8 * (i >> 2)]; sc[i] = sv; mt = fmaxf(mt, sv); }
        } else if (interior) {
            const int rb = 32 * kt + 4 * hl - qi;
#pragma unroll
            for (int i = 0; i < 16; ++i) { const int r = rb + (i & 3) + 8 * (i >> 2); const bool valid = (kt == 0) ? (r >= 0) : (r <= 256); const int ri = (kt == 0) ? (r < 0 ? 0 : r) : (r > 256 ? 256 : r);
                const float sv = valid ? sc[i] * qsc + bh[ri] : -1e30f; sc[i] = sv; mt = fmaxf(mt, sv); }
        } else {
#pragma unroll
            for (int i = 0; i < 16; ++i) { const int krow = (i & 3) + 8 * (i >> 2) + 4 * hl, kp = q0 - 128 + kb + krow, rel = kp - (qw + qi);
                const bool valid = (kp >= 0) && (kp < SEQ) && (rel >= -128) && (rel <= 128);
                const int ri = rel < -128 ? 0 : (rel > 128 ? 256 : rel + 128);
                const float sv = valid ? sc[i] * qsc + bh[ri] : -1e30f; sc[i] = sv; mt = fmaxf(mt, sv); }
        }
        mt = fmaxf(mt, __shfl_xor(mt, 32));
        const float mnew = fmaxf(mrun, mt), corr = __builtin_amdgcn_exp2f(mrun - mnew); mrun = mnew;
        float ls = 0.f;
#pragma unroll
        for (int i = 0; i < 16; ++i) { const float pv = __builtin_amdgcn_exp2f(sc[i] - mnew); sc[i] = pv; ls += pv; }
        lrun = lrun * corr + ls;
#pragma unroll
        for (int i = 0; i < 16; ++i) { o0[i] *= corr; o1[i] *= corr; }
#pragma unroll
        for (int s2 = 0; s2 < 2; ++s2) {
            v4u pw; pw.x = cvt_pk_bf16(sc[8 * s2 + 0], sc[8 * s2 + 1]); pw.y = cvt_pk_bf16(sc[8 * s2 + 2], sc[8 * s2 + 3]); pw.z = cvt_pk_bf16(sc[8 * s2 + 4], sc[8 * s2 + 5]); pw.w = cvt_pk_bf16(sc[8 * s2 + 6], sc[8 * s2 + 7]);
            const bf16x8 pb = __builtin_bit_cast(bf16x8, pw);
            const bf16* v0p = Vl + (size_t)(kb + 16 * s2 + 4 * hl + ((lane & 15) >> 2)) * 72 + 16 * ((lane >> 4) & 1) + 4 * (lane & 3);
            const v4i16_t a0 = __builtin_amdgcn_ds_read_tr16_b64_v4i16((LAS v4i16_t*)v0p), a1 = __builtin_amdgcn_ds_read_tr16_b64_v4i16((LAS v4i16_t*)(v0p + 8 * 72));
            const v4i16_t c0 = __builtin_amdgcn_ds_read_tr16_b64_v4i16((LAS v4i16_t*)(v0p + 32)), c1 = __builtin_amdgcn_ds_read_tr16_b64_v4i16((LAS v4i16_t*)(v0p + 32 + 8 * 72));
            const bf16x8 va = __builtin_shufflevector(a0, a1, 0, 1, 2, 3, 4, 5, 6, 7), vc = __builtin_shufflevector(c0, c1, 0, 1, 2, 3, 4, 5, 6, 7);
            o0 = __builtin_amdgcn_mfma_f32_32x32x16_bf16(va, pb, o0, 0, 0, 0);
            o1 = __builtin_amdgcn_mfma_f32_32x32x16_bf16(vc, pb, o1, 0, 0, 0);
        }
    }
    const float inv = (ABL == 1) ? 0.f : 1.0f / (lrun + __shfl_xor(lrun, 32));
#pragma unroll
    for (int g = 0; g < 4; ++g) {
        v2u w0, w1; w0.x = cvt_pk_bf16(o0[4 * g] * inv, o0[4 * g + 1] * inv); w0.y = cvt_pk_bf16(o0[4 * g + 2] * inv, o0[4 * g + 3] * inv);
        w1.x = cvt_pk_bf16(o1[4 * g] * inv, o1[4 * g + 1] * inv); w1.y = cvt_pk_bf16(o1[4 * g + 2] * inv, o1[4 * g + 3] * inv);
        bf16* OQ = OUT ? OUT : AQ; *(v2u*)(OQ + qrow + 8 * g + 4 * hl) = w0; *(v2u*)(OQ + qrow + 32 + 8 * g + 4 * hl) = w1; }
}

__device__ __forceinline__ void attn_phase(Frame& F, int layer, bf16* OUT) {
    v4u kr[5], vr[5]; bf16x8 qn[4];
    int u = F.bx;
    if (u < 1024) attn_load(F, u, kr, vr, qn);
    for (; u < 1024; u += F.G) {
        __syncthreads();
        attn_store(F, kr, vr);
        bf16x8 qf[4];
#pragma unroll
        for (int s = 0; s < 4; ++s) qf[s] = qn[s];
        __syncthreads();
        if (u + F.G < 1024) attn_load(F, u + F.G, kr, vr, qn);
        attn_compute(F, layer, u, OUT, qf);
    }
}

constexpr int PL_U_OFF = 0;
constexpr int PL_MX_OFF = 49152;
static_assert(PL_MX_OFF + 32768 <= RING_BYTES, "pool LDS");
__device__ __forceinline__ void pool_unit(Frame& F, int layer, int unit) {
    const int b = unit >> 6, t0 = (unit & 63) * 32;
    bf16* U = (bf16*)(F.lds + PL_U_OFF); bf16* MX = (bf16*)(F.lds + PL_MX_OFF);
    const bf16* PU = (const bf16*)(F.ws + WS_PU); bf16* OP = (bf16*)(F.ws + WS_OP);
    const int tid = F.tid;
    __syncthreads();
    for (int idx = tid; idx < 48 * 64; idx += NTHR) { const int r = idx >> 6, c8 = idx & 63, t = t0 - 8 + r;
        const v4u v = ld_or_zero(PU + ((size_t)b * SEQ + t) * 512 + c8 * 8, PU, t >= 0 && t < SEQ);
        *(v4u*)(U + r * 512 + c8 * 8) = v; }
    __syncthreads();
    { const int chp = tid & 255, tt0 = (tid >> 8) * 16, g = chp >> 6, r = 1 << g;
        const unsigned* Uw = (const unsigned*)U + chp;
        float s0 = 0.f, s1 = 0.f;
        for (int d = -r; d <= r; ++d) { const unsigned w = Uw[(8 + tt0 + d) * 256]; s0 += bflo(w); s1 += bfhi(w); }
        for (int i = 0; i < 16; ++i) { const int tt = tt0 + i, t = t0 + tt; const int lo = t - r < 0 ? 0 : t - r, hi = t + r > SEQ - 1 ? SEQ - 1 : t + r;
            const float rc = __builtin_amdgcn_rcpf((float)(hi - lo + 1)); const unsigned c = Uw[(8 + tt) * 256];
            ((unsigned*)MX)[tt * 256 + chp] = (ABL == 3) ? 0u : pk2(s0 * rc - bflo(c), s1 * rc - bfhi(c));
            if (i < 15) { const unsigned a = Uw[(8 + tt + 1 + r) * 256], sb = Uw[(8 + tt - r) * 256]; s0 += bflo(a) - bflo(sb); s1 += bfhi(a) - bfhi(sb); } } }
    __syncthreads();
    for (int idx = tid; idx < 32 * 64; idx += NTHR) { const int tt = idx >> 6, c8 = idx & 63;
        *(v4u*)(OP + ((size_t)b * SEQ + t0 + tt) * 512 + c8 * 8) = *(const v4u*)(MX + tt * 512 + c8 * 8); }
}

constexpr int DC_QN = 0, DC_KN = 9216, DC_KBT = 18432, DC_KDT = 27648, DC_VBT = 36864;
constexpr int DC_ST = 46080, DC_VNT = 55296, DC_T = 64512, DC_QKM = 73728;
constexpr int DC_AF = 82944;
constexpr int DC_AB = 100352;
constexpr int DC_DT1 = 109568;
constexpr int DC_DTS = 112128;
constexpr int DC_OB = 113664;
constexpr int DC_RAW = 55296;
static_assert(DC_RAW + 52224 <= DC_DT1 && DC_OB + 16384 <= RING_BYTES, "delta chunk LDS");
constexpr int DC_CW = LDSCTL_OFF + 2048;
constexpr int DC_VEC = DC_CW + 3840;
static_assert(DC_VEC + 7 * 256 <= LDS_BYTES, "delta chunk LDS (vectors)");
#ifndef DCREP
#define DCREP 0
#endif
__device__ __forceinline__ f32x4 mfma16(const bf16x8& a, const bf16x8& b, const f32x4& c) { return __builtin_amdgcn_mfma_f32_16x16x32_bf16(a, b, c, 0, 0, 0); }
__device__ __forceinline__ bf16x8 ld8(const bf16* p) { return *(const bf16x8*)p; }
__device__ __forceinline__ int tsw(int row, int col) { return row * 72 + ((((col >> 3) ^ (row >> 3)) & 7) << 3) + (col & 7); }
__device__ __forceinline__ int tswc(int row, int chunk) { return row * 72 + (((chunk ^ (row >> 3)) & 7) << 3); }
__device__ __forceinline__ bf16x8 ld44(const bf16* p0, const bf16* p1) { const v2u a = *(const v2u*)p0, b = *(const v2u*)p1; return __builtin_bit_cast(bf16x8, (v4u){a.x, a.y, b.x, b.y}); }
__device__ __forceinline__ void st4(bf16* p, float a, float b, float c, float d) { v2u w; w.x = cvt_pk_bf16(a, b); w.y = cvt_pk_bf16(c, d); *(v2u*)p = w; }

__device__ __forceinline__ void delta_seq_chunked(Frame& F, int layer, int seq) {
    const int dir = seq >> 7, b = (seq >> 3) & 15, h = seq & 7;
    unsigned char* L = F.lds;
    bf16* Qn = (bf16*)(L + DC_QN); bf16* Kn = (bf16*)(L + DC_KN); bf16* KbT = (bf16*)(L + DC_KBT); bf16* KdT = (bf16*)(L + DC_KDT); bf16* VbT = (bf16*)(L + DC_VBT);
    bf16* St = (bf16*)(L + DC_ST); bf16* VnT = (bf16*)(L + DC_VNT); bf16* T = (bf16*)(L + DC_T); bf16* QKm = (bf16*)(L + DC_QKM);
    float* Af = (float*)(L + DC_AF); bf16* Ab = (bf16*)(L + DC_AB); bf16* DT1 = (bf16*)(L + DC_DT1); bf16* DTs = (bf16*)(L + DC_DTS); float* ob = (float*)(L + DC_OB);
    float* raw = (float*)(L + DC_RAW); float* cw = (float*)(L + DC_CW);
    float* Gs = (float*)(L + DC_VEC); float* gam = Gs + 64; float* del = Gs + 128; float* bet = Gs + 192; float* rq = Gs + 256; float* rk = Gs + 320; float* cdp = Gs + 384;
    const bf16* DQKV = (const bf16*)(F.ws + WS_DQKV); const float* DAB = (const float*)(F.ws + WS_DAB);
    float* OUT = (float*)(F.ws + (dir ? WS_OB : WS_OF));
    const int tid0 = F.tid, wave = F.wave; int tid = tid0, lane = tid0 & 63;
    const int tr = wave >> 1, tc0 = 2 * (wave & 1); int l15 = 0, q4 = 0;
    __syncthreads();
    for (int i = tid; i < 5 * 192; i += NTHR) { const int jj = i / 192, ch = i % 192; cw[i] = IN_conv_w(F)[((size_t)layer * 5 + jj) * 1536 + (ch >> 6) * 512 + h * 64 + (ch & 63)]; }
    for (int i = tid; i < 64 * 72 / 2; i += NTHR) { ((unsigned*)St)[i] = 0u; ((unsigned*)T)[i] = 0u; }
    const float nA = -__expf(IN_a_log(F)[layer * 16 + dir * 8 + h]), dtb = IN_dt_bias(F)[layer * 16 + dir * 8 + h];
    f32x4 Sacc[2];
    Sacc[0] = (f32x4){0.f, 0.f, 0.f, 0.f}; Sacc[1] = Sacc[0];
    v4u pre[4]; float pa = 0.f, pb = 0.f;
    { const int t0n = dir ? SEQ - 64 : 0;
#pragma unroll
        for (int it = 0; it < 4; ++it) { const int idx = tid + it * NTHR; const int r = idx / 24, pc = idx % 24, t = t0n - 2 + r;
            pre[it] = ld_or_zero(DQKV + ((size_t)b * SEQ + t) * 1536 + (pc >> 3) * 512 + h * 64 + (pc & 7) * 8, DQKV, idx < 68 * 24 && t >= 0 && t < SEQ); }
        if (wave == 0) { const size_t m = (size_t)b * SEQ + t0n + (dir ? 63 - lane : lane); pa = DAB[m * 32 + dir * 8 + h]; pb = DAB[m * 32 + 16 + dir * 8 + h]; } }
    for (int blk = 0; blk < SEQ / 64; ++blk) {
        const int tb = dir ? (SEQ / 64 - 1 - blk) : blk, t0 = tb * 64;
        tid = tid0; asm volatile("" : "+v"(tid)); lane = tid & 63;
        __syncthreads();
#pragma unroll
        for (int it = 0; it < 4; ++it) { const int idx = tid + it * NTHR; if (idx < 68 * 24) { const int r = idx / 24, pc = idx % 24; float* rp = raw + r * 192 + (pc >> 3) * 64 + (pc & 7) * 8;
                f32x4 lo, hi; unpack8(pre[it], lo, hi); *(f32x4*)rp = lo; *(f32x4*)(rp + 4) = hi; } }
        if (wave == 0) { const float xx = pa + dtb; const float sp = xx > 20.f ? xx : log1pf(__expf(xx));
            float g = nA * sp;
#pragma unroll
            for (int o = 1; o < 64; o <<= 1) { const float u = __shfl_up(g, o); if (lane >= o) g += u; }
            const float gl = __shfl(g, 63);
            Gs[lane] = g; gam[lane] = __expf(g); del[lane] = __expf(gl - g); bet[lane] = sigmoidf_(pb); if (lane == 63) cdp[0] = __expf(g); }
        if (blk + 1 < SEQ / 64) { const int tbn = dir ? (SEQ / 64 - 2 - blk) : blk + 1, t0n = tbn * 64;
#pragma unroll
            for (int it = 0; it < 4; ++it) { const int idx = tid + it * NTHR; const int r = idx / 24, pc = idx % 24, t = t0n - 2 + r;
                pre[it] = ld_or_zero(DQKV + ((size_t)b * SEQ + t) * 1536 + (pc >> 3) * 512 + h * 64 + (pc & 7) * 8, DQKV, idx < 68 * 24 && t >= 0 && t < SEQ); }
            if (wave == 0) { const size_t m = (size_t)b * SEQ + t0n + (dir ? 63 - lane : lane); pa = DAB[m * 32 + dir * 8 + h]; pb = DAB[m * 32 + 16 + dir * 8 + h]; } }
        __syncthreads();
        for (int rep1 = 0; rep1 < (DCREP == 1 ? 2 : 1); ++rep1)
        { const int tt = tid >> 3, d0 = (tid & 7) * 8, s = dir ? 63 - tt : tt;
            float xv[3][8];
#pragma unroll
            for (int sec = 0; sec < 3; ++sec) {
                f32x2 a2[4];
#pragma unroll
                for (int pq = 0; pq < 4; ++pq) a2[pq] = (f32x2){0.f, 0.f};
#pragma unroll
                for (int jj = 0; jj < 5; ++jj) { const float* rp = raw + (tt + jj) * 192 + sec * 64 + d0; const float* cp = cw + jj * 192 + sec * 64 + d0;
                    const f32x4 r0 = *(const f32x4*)rp, r1 = *(const f32x4*)(rp + 4), c0 = *(const f32x4*)cp, c1 = *(const f32x4*)(cp + 4);
                    a2[0] += (f32x2){c0[0], c0[1]} * (f32x2){r0[0], r0[1]}; a2[1] += (f32x2){c0[2], c0[3]} * (f32x2){r0[2], r0[3]};
                    a2[2] += (f32x2){c1[0], c1[1]} * (f32x2){r1[0], r1[1]}; a2[3] += (f32x2){c1[2], c1[3]} * (f32x2){r1[2], r1[3]}; }
#pragma unroll
                for (int e = 0; e < 8; ++e) xv[sec][e] = siluf_(a2[e >> 1][e & 1]);
                __builtin_amdgcn_sched_barrier(0); }
            float sq = 0.f, sk = 0.f;
#pragma unroll
            for (int e = 0; e < 8; ++e) { sq += xv[0][e] * xv[0][e]; sk += xv[1][e] * xv[1][e]; }
            sq = __builtin_amdgcn_rsqf(red8(sq) + 1e-6f) * 0.125f; sk = __builtin_amdgcn_rsqf(red8(sk) + 1e-6f);
            const float be = bet[s], bg = be * gam[s], dl = del[s];
#pragma unroll
            for (int e = 0; e < 8; ++e) { xv[0][e] *= sq; xv[1][e] *= sk; }
            v4u w; w.x = cvt_pk_bf16(xv[0][0], xv[0][1]); w.y = cvt_pk_bf16(xv[0][2], xv[0][3]); w.z = cvt_pk_bf16(xv[0][4], xv[0][5]); w.w = cvt_pk_bf16(xv[0][6], xv[0][7]); *(v4u*)(Qn + s * 72 + d0) = w;
            w.x = cvt_pk_bf16(xv[1][0], xv[1][1]); w.y = cvt_pk_bf16(xv[1][2], xv[1][3]); w.z = cvt_pk_bf16(xv[1][4], xv[1][5]); w.w = cvt_pk_bf16(xv[1][6], xv[1][7]); *(v4u*)(Kn + s * 72 + d0) = w;
#pragma unroll
            for (int e = 0; e < 8; e += 2) { const int o0 = tsw(d0 + e, s), o1 = tsw(d0 + e + 1, s);
                const unsigned wb = cvt_pk_bf16(xv[1][e] * bg, xv[1][e + 1] * bg), wd = cvt_pk_bf16(xv[1][e] * dl, xv[1][e + 1] * dl), wv = cvt_pk_bf16(xv[2][e] * be, xv[2][e + 1] * be);
                KbT[o0] = (bf16)(wb & 0xffffu); KbT[o1] = (bf16)(wb >> 16); KdT[o0] = (bf16)(wd & 0xffffu); KdT[o1] = (bf16)(wd >> 16); VbT[o0] = (bf16)(wv & 0xffffu); VbT[o1] = (bf16)(wv >> 16); } }
        __syncthreads();
        { int lv = lane; asm volatile("" : "+v"(lv)); l15 = lv & 15; q4 = lv >> 4; }
        for (int rep4 = 0; rep4 < (DCREP == 4 ? 2 : 1); ++rep4)
        { const bf16x8 a0 = ld8(Kn + (16 * tr + l15) * 72 + 8 * q4), a1 = ld8(Kn + (16 * tr + l15) * 72 + 32 + 8 * q4);
            float Gj[4];
#pragma unroll
            for (int r = 0; r < 4; ++r) Gj[r] = Gs[16 * tr + 4 * q4 + r];
#pragma unroll
            for (int tcx = 0; tcx < 2; ++tcx) { const int tc = tc0 + tcx, i = 16 * tc + l15, j0 = 16 * tr + 4 * q4;
                f32x4 ckk = (f32x4){0.f, 0.f, 0.f, 0.f}, cqk = ckk;
                if (tc >= tr) {
                    const bf16x8 bk0 = ld8(Kn + i * 72 + 8 * q4), bk1 = ld8(Kn + i * 72 + 32 + 8 * q4), bq0 = ld8(Qn + i * 72 + 8 * q4), bq1 = ld8(Qn + i * 72 + 32 + 8 * q4);
                    ckk = mfma16(a0, bk0, ckk); ckk = mfma16(a1, bk1, ckk); cqk = mfma16(a0, bq0, cqk); cqk = mfma16(a1, bq1, cqk);
                    const float Gi = Gs[i], bi = bet[i];
#pragma unroll
                    for (int r = 0; r < 4; ++r) { const int j = j0 + r; const float dec = __expf(Gi - Gj[r]); ckk[r] = (i > j) ? ckk[r] * dec * bi : 0.f; cqk[r] = (i >= j) ? cqk[r] * dec : 0.f; } }
#pragma unroll
                for (int r = 0; r < 4; ++r) Af[(j0 + r) * 68 + i] = ckk[r];
                st4(QKm + i * 72 + j0, cqk[0], cqk[1], cqk[2], cqk[3]);
                st4(Ab + i * 72 + j0, ckk[0], ckk[1], ckk[2], ckk[3]); } }
        __syncthreads();
        for (int rep5 = 0; rep5 < (DCREP == 5 ? 2 : 1); ++rep5)
        if (wave == 0) { const int b4 = lane >> 4, c = lane & 15; const float* Ar = Af + (16 * b4) * 68 + 16 * b4;
            float t[16];
#pragma unroll
            for (int i = 0; i < 16; ++i) t[i] = (i == c) ? 1.f : 0.f;
#pragma unroll
            for (int j = 0; j < 15; ++j) {
#pragma unroll
                for (int i4 = (j + 1) / 4; i4 < 4; ++i4) { const f32x4 a = *(const f32x4*)(Ar + j * 68 + 4 * i4);
#pragma unroll
                    for (int e = 0; e < 4; ++e) if (4 * i4 + e > j) t[4 * i4 + e] -= a[e] * t[j]; } }
#pragma unroll
            for (int i = 0; i < 16; ++i) T[(16 * b4 + i) * 72 + 16 * b4 + c] = (bf16)f2bf(t[i]);
            { v4u w0, w1; w0.x = cvt_pk_bf16(t[0], t[1]); w0.y = cvt_pk_bf16(t[2], t[3]); w0.z = cvt_pk_bf16(t[4], t[5]); w0.w = cvt_pk_bf16(t[6], t[7]);
                w1.x = cvt_pk_bf16(t[8], t[9]); w1.y = cvt_pk_bf16(t[10], t[11]); w1.z = cvt_pk_bf16(t[12], t[13]); w1.w = cvt_pk_bf16(t[14], t[15]);
                const v4u z = (v4u){0u, 0u, 0u, 0u};
                if ((b4 & 1) == 0) { *(v4u*)(DTs + ((b4 >> 1) * 16 + c) * 24) = w0; *(v4u*)(DTs + ((b4 >> 1) * 16 + c) * 24 + 8) = w1; }
                if (b4 == 0) { *(v4u*)(DT1 + c * 40) = w0; *(v4u*)(DT1 + c * 40 + 8) = w1; }
                if (b4 == 1) { *(v4u*)(DT1 + (16 + c) * 40 + 16) = w0; *(v4u*)(DT1 + (16 + c) * 40 + 24) = w1; *(v4u*)(DT1 + (16 + c) * 40) = z; *(v4u*)(DT1 + (16 + c) * 40 + 8) = z; }
                if (lane < 32) { *(v4u*)(T + lane * 72 + 32) = z; *(v4u*)(T + lane * 72 + 40) = z; *(v4u*)(T + lane * 72 + 48) = z; *(v4u*)(T + lane * 72 + 56) = z; }
                if (lane < 16) { *(v4u*)(T + lane * 72 + 16) = z; *(v4u*)(T + lane * 72 + 24) = z; }
                if (lane >= 32 && lane < 48) { *(v4u*)(T + lane * 72 + 48) = z; *(v4u*)(T + lane * 72 + 56) = z; } }
            LDS_WAIT(); asm volatile("" ::: "memory");
            const int m15 = lane & 15, qq = lane >> 4;
#pragma unroll
            for (int p = 0; p < 2; ++p) { const int b0 = 2 * p, b1 = 2 * p + 1;
                const v4u zz = (v4u){0u, 0u, 0u, 0u};
                v4u av = zz, bv = zz;
                if (qq < 2) { av = *(const v4u*)(Ab + (16 * b1 + m15) * 72 + 16 * b0 + 8 * qq); bv = *(const v4u*)(DTs + (p * 16 + m15) * 24 + 8 * qq); }
                f32x4 X4 = (f32x4){0.f, 0.f, 0.f, 0.f};
                X4 = mfma16(__builtin_bit_cast(bf16x8, av), __builtin_bit_cast(bf16x8, bv), X4);
                v4u xa = zz; xa.x = cvt_pk_bf16(X4[0], X4[1]); xa.y = cvt_pk_bf16(X4[2], X4[3]);
                const v2u dr = *(const v2u*)(T + (16 * b1 + m15) * 72 + 16 * b1 + 4 * qq);
                v4u db = zz; db.x = dr.x; db.y = dr.y;
                f32x4 Z4 = (f32x4){0.f, 0.f, 0.f, 0.f};
                Z4 = mfma16(__builtin_bit_cast(bf16x8, xa), __builtin_bit_cast(bf16x8, db), Z4);
                st4(T + (16 * b1 + m15) * 72 + 16 * b0 + 4 * qq, -Z4[0], -Z4[1], -Z4[2], -Z4[3]);
                if (p == 0) {
#pragma unroll
                    for (int r = 0; r < 4; ++r) DT1[(4 * qq + r) * 40 + 16 + m15] = (bf16)f2bf(-Z4[r]); } }
            LDS_WAIT(); asm volatile("" ::: "memory");
            const int r31 = lane & 31, hh = lane >> 5;
            f32x16 X;
#pragma unroll
            for (int i = 0; i < 16; ++i) X[i] = 0.f;
#pragma unroll
            for (int ks = 0; ks < 2; ++ks) X = __builtin_amdgcn_mfma_f32_32x32x16_bf16(ld8(Ab + (32 + r31) * 72 + 16 * ks + 8 * hh), ld8(DT1 + r31 * 40 + 16 * ks + 8 * hh), X, 0, 0, 0);
            f32x16 Z;
#pragma unroll
            for (int i = 0; i < 16; ++i) Z[i] = 0.f;
#pragma unroll
            for (int ks = 0; ks < 2; ++ks) { v4u pw; pw.x = cvt_pk_bf16(X[8 * ks + 0], X[8 * ks + 1]); pw.y = cvt_pk_bf16(X[8 * ks + 2], X[8 * ks + 3]); pw.z = cvt_pk_bf16(X[8 * ks + 4], X[8 * ks + 5]); pw.w = cvt_pk_bf16(X[8 * ks + 6], X[8 * ks + 7]);
                const bf16* d2 = T + (32 + r31) * 72 + 32 + 16 * ks + 4 * hh;
                Z = __builtin_amdgcn_mfma_f32_32x32x16_bf16(__builtin_bit_cast(bf16x8, pw), ld44(d2, d2 + 8), Z, 0, 0, 0); }
#pragma unroll
            for (int g = 0; g < 4; ++g) st4(T + (32 + r31) * 72 + 8 * g + 4 * hh, -Z[4 * g], -Z[4 * g + 1], -Z[4 * g + 2], -Z[4 * g + 3]); }
        __syncthreads();
        { int lv = lane; asm volatile("" : "+v"(lv)); l15 = lv & 15; q4 = lv >> 4; }
        for (int rep7 = 0; rep7 < (DCREP == 7 ? 2 : 1); ++rep7)
        { const bf16x8 ti0 = ld8(T + (16 * tr + l15) * 72 + 8 * q4), ti1 = ld8(T + (16 * tr + l15) * 72 + 32 + 8 * q4);
            f32x4 wt[4];
#pragma unroll
            for (int dt = 0; dt < 4; ++dt) { wt[dt] = (f32x4){0.f, 0.f, 0.f, 0.f};
                wt[dt] = mfma16(ld8(KbT + tswc(16 * dt + l15, q4)), ti0, wt[dt]); wt[dt] = mfma16(ld8(KbT + tswc(16 * dt + l15, 4 + q4)), ti1, wt[dt]); }
            v4u wa0, wa1;
            wa0.x = cvt_pk_bf16(-wt[0][0], -wt[0][1]); wa0.y = cvt_pk_bf16(-wt[0][2], -wt[0][3]); wa0.z = cvt_pk_bf16(-wt[1][0], -wt[1][1]); wa0.w = cvt_pk_bf16(-wt[1][2], -wt[1][3]);
            wa1.x = cvt_pk_bf16(-wt[2][0], -wt[2][1]); wa1.y = cvt_pk_bf16(-wt[2][2], -wt[2][3]); wa1.z = cvt_pk_bf16(-wt[3][0], -wt[3][1]); wa1.w = cvt_pk_bf16(-wt[3][2], -wt[3][3]);
#pragma unroll
            for (int tcx = 0; tcx < 2; ++tcx) { const int e = 16 * (tc0 + tcx) + l15;
                f32x4 u = (f32x4){0.f, 0.f, 0.f, 0.f};
                u = mfma16(ti0, ld8(VbT + tswc(e, q4)), u); u = mfma16(ti1, ld8(VbT + tswc(e, 4 + q4)), u);
                const bf16* sp = St + e * 72 + 4 * q4;
                u = mfma16(__builtin_bit_cast(bf16x8, wa0), ld44(sp, sp + 16), u); u = mfma16(__builtin_bit_cast(bf16x8, wa1), ld44(sp + 32, sp + 48), u);
                st4(VnT + e * 72 + 16 * tr + 4 * q4, u[0], u[1], u[2], u[3]); } }
        __syncthreads();
        { int lv = lane; asm volatile("" : "+v"(lv)); l15 = lv & 15; q4 = lv >> 4; }
        { const bf16x8 qa0 = ld8(Qn + (16 * tr + l15) * 72 + 8 * q4), qa1 = ld8(Qn + (16 * tr + l15) * 72 + 32 + 8 * q4);
            const bf16x8 ma0 = ld8(QKm + (16 * tr + l15) * 72 + 8 * q4), ma1 = ld8(QKm + (16 * tr + l15) * 72 + 32 + 8 * q4);
            const bf16x8 ka0 = ld8(KdT + tswc(16 * tr + l15, q4)), ka1 = ld8(KdT + tswc(16 * tr + l15, 4 + q4));
            const float cd = cdp[0]; float gi[4];
#pragma unroll
            for (int r = 0; r < 4; ++r) gi[r] = gam[16 * tr + 4 * q4 + r];
#pragma unroll
            for (int tcx = 0; tcx < 2; ++tcx) { const int e = 16 * (tc0 + tcx) + l15;
                const bf16x8 s0 = ld8(St + e * 72 + 8 * q4), s1 = ld8(St + e * 72 + 32 + 8 * q4), n0 = ld8(VnT + e * 72 + 8 * q4), n1 = ld8(VnT + e * 72 + 32 + 8 * q4);
                f32x4 o = (f32x4){0.f, 0.f, 0.f, 0.f};
                o = mfma16(qa0, s0, o); o = mfma16(qa1, s1, o);
#pragma unroll
                for (int r = 0; r < 4; ++r) o[r] *= gi[r];
                o = mfma16(ma0, n0, o); o = mfma16(ma1, n1, o);
#pragma unroll
                for (int r = 0; r < 4; ++r) ob[(16 * tr + 4 * q4 + r) * 64 + e] = o[r];
                Sacc[tcx] = Sacc[tcx] * cd; Sacc[tcx] = mfma16(ka0, n0, Sacc[tcx]); Sacc[tcx] = mfma16(ka1, n1, Sacc[tcx]); } }
        __syncthreads();
#pragma unroll
        for (int tcx = 0; tcx < 2; ++tcx) { const int e = 16 * (tc0 + tcx) + l15; st4(St + e * 72 + 16 * tr + 4 * q4, Sacc[tcx][0], Sacc[tcx][1], Sacc[tcx][2], Sacc[tcx][3]); }
        for (int idx = tid; idx < 64 * 16; idx += NTHR) { const int s = idx >> 4, c4 = idx & 15; const int t = t0 + (dir ? 63 - s : s);
            const f32x4 ov = *(const f32x4*)(ob + s * 64 + c4 * 4); v2u ow; ow.x = cvt_pk_bf16(ov[0], ov[1]); ow.y = cvt_pk_bf16(ov[2], ov[3]);
            *(v2u*)((bf16*)OUT + ((size_t)b * SEQ + t) * 512 + h * 64 + c4 * 4) = ow; }
    }
}

#ifndef DPREP
#define DPREP 0
#endif
constexpr int DP_QN = 0, DP_KD = 18432;
constexpr int DP_KN = 36864, DP_KBT = 46080, DP_VBT = 55296, DP_ST = 64512, DP_VNT = 73728, DP_T = 82944, DP_QKM = 92160, DP_AB = 101376;
constexpr int DP_AF4 = 110592;
constexpr int DP_DT1 = 115712, DP_DTS = 118272;
constexpr int DP_RAW = 119808;
static_assert(DP_RAW + 26112 <= RING_BYTES, "pipelined delta LDS");

__device__ __forceinline__ bf16x8 ldtr8(const bf16* img, int ks, int c, int lane) {
    const int q = lane >> 4, qq = (lane & 15) >> 2, p = lane & 3;
    const bf16* a0 = img + (32 * ks + 8 * q + qq) * 72 + 16 * c + 4 * p;
    const v4i16_t lo = __builtin_amdgcn_ds_read_tr16_b64_v4i16((LAS v4i16_t*)a0), hi = __builtin_amdgcn_ds_read_tr16_b64_v4i16((LAS v4i16_t*)(a0 + 4 * 72));
    return __builtin_shufflevector(lo, hi, 0, 1, 2, 3, 4, 5, 6, 7);
}
typedef __bf16 bf16x2v_t __attribute__((ext_vector_type(2)));
__device__ __forceinline__ float dot2bf(unsigned a, unsigned b, float c) { return __builtin_amdgcn_fdot2_f32_bf16(__builtin_bit_cast(bf16x2v_t, a), __builtin_bit_cast(bf16x2v_t, b), c, false); }
__device__ __forceinline__ void delta_seq_pipe(Frame& F, int layer, int seq) {
    const int dir = seq >> 7, b = (seq >> 3) & 15, h = seq & 7;
    unsigned char* L = F.lds;
    bf16* Qn2 = (bf16*)(L + DP_QN); bf16* Kd2 = (bf16*)(L + DP_KD); bf16* Kn = (bf16*)(L + DP_KN); bf16* KbT = (bf16*)(L + DP_KBT); bf16* VbT = (bf16*)(L + DP_VBT);
    bf16* St = (bf16*)(L + DP_ST); bf16* VnT = (bf16*)(L + DP_VNT); bf16* T = (bf16*)(L + DP_T); bf16* QKm = (bf16*)(L + DP_QKM); bf16* Ab = (bf16*)(L + DP_AB);
    float* Af4 = (float*)(L + DP_AF4); bf16* DT1 = (bf16*)(L + DP_DT1); bf16* DTs = (bf16*)(L + DP_DTS); bf16* raw = (bf16*)(L + DP_RAW);
    float* cw = (float*)(L + DC_CW); float* vec0 = (float*)(L + DC_VEC);
    const bf16* DQKV = (const bf16*)(F.ws + WS_DQKV); const float* DAB = (const float*)(F.ws + WS_DAB);
    bf16* OUT = (bf16*)(F.ws + (dir ? WS_OB : WS_OF));
    const int tid0 = F.tid, wave = F.wave; int tid = tid0, lane = tid0 & 63, l15 = 0, q4 = 0;
    const int tr = wave >> 1, tc0 = 2 * (wave & 1);
    __syncthreads();
    for (int i = tid; i < 5 * 192; i += NTHR) { const int jj = i / 192, ch = i % 192; const unsigned wb = f2bf(IN_conv_w(F)[((size_t)layer * 5 + jj) * 1536 + (ch >> 6) * 512 + h * 64 + (ch & 63)]); ((unsigned*)cw)[i] = (ch & 1) ? (wb << 16) : wb; }
    for (int i = tid; i < 64 * 72 / 2; i += NTHR) ((unsigned*)St)[i] = 0u;
    const float nA = -__expf(IN_a_log(F)[layer * 16 + dir * 8 + h]), dtb = IN_dt_bias(F)[layer * 16 + dir * 8 + h];
    f32x4 Sacc[2];
    Sacc[0] = (f32x4){0.f, 0.f, 0.f, 0.f}; Sacc[1] = Sacc[0];
    v4u pre[4]; float pa = 0.f, pb = 0.f;
    v4u kbw = (v4u){0u, 0u, 0u, 0u}, vbw = kbw;

#define DP_LANE() do { tid = tid0; asm volatile("" : "+v"(tid)); lane = tid & 63; l15 = lane & 15; q4 = lane >> 4; } while (0)
#define DP_T0(NB) ((dir ? (SEQ / 64 - 1 - (NB)) : (NB)) * 64)
#define DP_PREFETCH(NB) do { const int t0n_ = DP_T0(NB); \
        _Pragma("unroll") for (int it = 0; it < 4; ++it) { const int idx = tid + it * NTHR; const int r = idx / 24, pc = idx % 24, t = t0n_ - 2 + r; \
            pre[it] = ld_or_zero(DQKV + ((size_t)b * SEQ + t) * 1536 + (pc >> 3) * 512 + h * 64 + (pc & 7) * 8, DQKV, idx < 68 * 24 && t >= 0 && t < SEQ); } \
        if (wave == 0) { const size_t m_ = (size_t)b * SEQ + t0n_ + (dir ? 63 - lane : lane); pa = DAB[m_ * 32 + dir * 8 + h]; pb = DAB[m_ * 32 + 16 + dir * 8 + h]; } } while (0)
#define DP_S0(NB) do { const int nb_ = (NB); \
        _Pragma("unroll") for (int it = 0; it < 4; ++it) { const int idx = tid + it * NTHR; if (idx < 68 * 24) { const int r = idx / 24, pc = idx % 24; *(v4u*)(raw + r * 192 + (pc >> 3) * 64 + (pc & 7) * 8) = pre[it]; } } \
        if (wave == 0) { float* vd_ = vec0 + (nb_ & 1) * 448; const float xx_ = pa + dtb; const float sp_ = xx_ > 20.f ? xx_ : log1pf(__expf(xx_)); float g_ = nA * sp_; \
            _Pragma("unroll") for (int o_ = 1; o_ < 64; o_ <<= 1) { const float u_ = __shfl_up(g_, o_); if (lane >= o_) g_ += u_; } \
            const float gl_ = __shfl(g_, 63); vd_[lane] = g_; vd_[64 + lane] = __expf(g_); vd_[128 + lane] = __expf(gl_ - g_); vd_[192 + lane] = sigmoidf_(pb); if (lane == 63) vd_[256] = __expf(g_); } \
        if (nb_ + 1 < SEQ / 64) DP_PREFETCH(nb_ + 1); } while (0)
#define DP_S1A(NB) do { const int nb_ = (NB); const float* vd_ = vec0 + (nb_ & 1) * 448; bf16* Qn_ = Qn2 + (nb_ & 1) * 4608; bf16* Kd_ = Kd2 + (nb_ & 1) * 4608; \
        const int tt = tid >> 3, d0 = (tid & 7) * 8, s = dir ? 63 - tt : tt; \
        float xv[3][8]; \
        _Pragma("unroll") for (int sec = 0; sec < 3; ++sec) { float a1[8]; \
            _Pragma("unroll") for (int e = 0; e < 8; ++e) a1[e] = 0.f; \
            _Pragma("unroll") for (int jj = 0; jj < 5; ++jj) { const v4u rw = *(const v4u*)(raw + (tt + jj) * 192 + sec * 64 + d0); const float* cp = cw + jj * 192 + sec * 64 + d0; \
                const v4u c0 = *(const v4u*)cp, c1 = *(const v4u*)(cp + 4); \
                a1[0] = dot2bf(rw.x, c0.x, a1[0]); a1[1] = dot2bf(rw.x, c0.y, a1[1]); a1[2] = dot2bf(rw.y, c0.z, a1[2]); a1[3] = dot2bf(rw.y, c0.w, a1[3]); \
                a1[4] = dot2bf(rw.z, c1.x, a1[4]); a1[5] = dot2bf(rw.z, c1.y, a1[5]); a1[6] = dot2bf(rw.w, c1.z, a1[6]); a1[7] = dot2bf(rw.w, c1.w, a1[7]); } \
            _Pragma("unroll") for (int e = 0; e < 8; ++e) xv[sec][e] = siluf_(a1[e]); \
            __builtin_amdgcn_sched_barrier(0); } \
        float sq = 0.f, sk = 0.f; \
        _Pragma("unroll") for (int e = 0; e < 8; ++e) { sq += xv[0][e] * xv[0][e]; sk += xv[1][e] * xv[1][e]; } \
        sq = __builtin_amdgcn_rsqf(red8(sq) + 1e-6f) * 0.125f; sk = __builtin_amdgcn_rsqf(red8(sk) + 1e-6f); \
        const float be = vd_[192 + s], bg = be * vd_[64 + s], dl = vd_[128 + s]; \
        _Pragma("unroll") for (int e = 0; e < 8; ++e) { xv[0][e] *= sq; xv[1][e] *= sk; } \
        v4u w; w.x = cvt_pk_bf16(xv[0][0], xv[0][1]); w.y = cvt_pk_bf16(xv[0][2], xv[0][3]); w.z = cvt_pk_bf16(xv[0][4], xv[0][5]); w.w = cvt_pk_bf16(xv[0][6], xv[0][7]); *(v4u*)(Qn_ + s * 72 + d0) = w; \
        w.x = cvt_pk_bf16(xv[1][0], xv[1][1]); w.y = cvt_pk_bf16(xv[1][2], xv[1][3]); w.z = cvt_pk_bf16(xv[1][4], xv[1][5]); w.w = cvt_pk_bf16(xv[1][6], xv[1][7]); *(v4u*)(Kn + s * 72 + d0) = w; \
        w.x = cvt_pk_bf16(xv[1][0] * bg, xv[1][1] * bg); w.y = cvt_pk_bf16(xv[1][2] * bg, xv[1][3] * bg); w.z = cvt_pk_bf16(xv[1][4] * bg, xv[1][5] * bg); w.w = cvt_pk_bf16(xv[1][6] * bg, xv[1][7] * bg); kbw = w; \
        w.x = cvt_pk_bf16(xv[1][0] * dl, xv[1][1] * dl); w.y = cvt_pk_bf16(xv[1][2] * dl, xv[1][3] * dl); w.z = cvt_pk_bf16(xv[1][4] * dl, xv[1][5] * dl); w.w = cvt_pk_bf16(xv[1][6] * dl, xv[1][7] * dl); *(v4u*)(Kd_ + s * 72 + d0) = w; \
        w.x = cvt_pk_bf16(xv[2][0] * be, xv[2][1] * be); w.y = cvt_pk_bf16(xv[2][2] * be, xv[2][3] * be); w.z = cvt_pk_bf16(xv[2][4] * be, xv[2][5] * be); w.w = cvt_pk_bf16(xv[2][6] * be, xv[2][7] * be); vbw = w; } while (0)
#define DP_S1B() do { const int tt = tid >> 3, d0 = (tid & 7) * 8, s = dir ? 63 - tt : tt; *(v4u*)(KbT + s * 72 + d0) = kbw; *(v4u*)(VbT + s * 72 + d0) = vbw; } while (0)
#define DP_S4(NB) do { const int nb_ = (NB); const float* vd_ = vec0 + (nb_ & 1) * 448; const bf16* Qn_ = Qn2 + (nb_ & 1) * 4608; \
        const bf16x8 a0 = ld8(Kn + (16 * tr + l15) * 72 + 8 * q4), a1 = ld8(Kn + (16 * tr + l15) * 72 + 32 + 8 * q4); \
        float Gj[4]; \
        _Pragma("unroll") for (int r = 0; r < 4; ++r) Gj[r] = vd_[16 * tr + 4 * q4 + r]; \
        _Pragma("unroll") for (int tcx = 0; tcx < 2; ++tcx) { const int tc = tc0 + tcx, i = 16 * tc + l15, j0 = 16 * tr + 4 * q4; \
            f32x4 ckk = (f32x4){0.f, 0.f, 0.f, 0.f}, cqk = ckk; \
            if (tc >= tr) { \
                const bf16x8 bk0 = ld8(Kn + i * 72 + 8 * q4), bk1 = ld8(Kn + i * 72 + 32 + 8 * q4), bq0 = ld8(Qn_ + i * 72 + 8 * q4), bq1 = ld8(Qn_ + i * 72 + 32 + 8 * q4); \
                ckk = mfma16(a0, bk0, ckk); ckk = mfma16(a1, bk1, ckk); cqk = mfma16(a0, bq0, cqk); cqk = mfma16(a1, bq1, cqk); \
                const float Gi = vd_[i], bi = vd_[192 + i]; \
                _Pragma("unroll") for (int r = 0; r < 4; ++r) { const int j = j0 + r; const float dec = __expf(Gi - Gj[r]); ckk[r] = (i > j) ? ckk[r] * dec * bi : 0.f; cqk[r] = (i >= j) ? cqk[r] * dec : 0.f; } } \
            if (tc == tr) { _Pragma("unroll") for (int r = 0; r < 4; ++r) Af4[tr * 320 + (4 * q4 + r) * 20 + l15] = ckk[r]; } \
            st4(QKm + i * 72 + j0, cqk[0], cqk[1], cqk[2], cqk[3]); \
            st4(Ab + i * 72 + j0, ckk[0], ckk[1], ckk[2], ckk[3]); } } while (0)
#define DP_S5() do { if (wave == 0) { const int b4 = lane >> 4, c = lane & 15; const float* Ar = Af4 + b4 * 320; \
        f32x4 ar[15][4];                                            \
        _Pragma("unroll") for (int j = 0; j < 15; ++j) { _Pragma("unroll") for (int i4 = (j + 1) / 4; i4 < 4; ++i4) ar[j][i4] = *(const f32x4*)(Ar + j * 20 + 4 * i4); } \
        float t[16]; \
        _Pragma("unroll") for (int i = 0; i < 16; ++i) t[i] = (i == c) ? 1.f : 0.f; \
        _Pragma("unroll") for (int j = 0; j < 15; ++j) { \
            _Pragma("unroll") for (int i4 = (j + 1) / 4; i4 < 4; ++i4) { \
                _Pragma("unroll") for (int e = 0; e < 4; ++e) if (4 * i4 + e > j) t[4 * i4 + e] -= ar[j][i4][e] * t[j]; } } \
        _Pragma("unroll") for (int i = 0; i < 16; ++i) T[(16 * b4 + i) * 72 + 16 * b4 + c] = (bf16)f2bf(t[i]); \
        { v4u w0, w1; w0.x = cvt_pk_bf16(t[0], t[1]); w0.y = cvt_pk_bf16(t[2], t[3]); w0.z = cvt_pk_bf16(t[4], t[5]); w0.w = cvt_pk_bf16(t[6], t[7]); \
            w1.x = cvt_pk_bf16(t[8], t[9]); w1.y = cvt_pk_bf16(t[10], t[11]); w1.z = cvt_pk_bf16(t[12], t[13]); w1.w = cvt_pk_bf16(t[14], t[15]); \
            const v4u z = (v4u){0u, 0u, 0u, 0u}; \
            if ((b4 & 1) == 0) { *(v4u*)(DTs + ((b4 >> 1) * 16 + c) * 24) = w0; *(v4u*)(DTs + ((b4 >> 1) * 16 + c) * 24 + 8) = w1; } \
            if (b4 == 0) { *(v4u*)(DT1 + c * 40) = w0; *(v4u*)(DT1 + c * 40 + 8) = w1; } \
            if (b4 == 1) { *(v4u*)(DT1 + (16 + c) * 40 + 16) = w0; *(v4u*)(DT1 + (16 + c) * 40 + 24) = w1; *(v4u*)(DT1 + (16 + c) * 40) = z; *(v4u*)(DT1 + (16 + c) * 40 + 8) = z; } \
            if (lane < 32) { *(v4u*)(T + lane * 72 + 32) = z; *(v4u*)(T + lane * 72 + 40) = z; *(v4u*)(T + lane * 72 + 48) = z; *(v4u*)(T + lane * 72 + 56) = z; } \
            if (lane < 16) { *(v4u*)(T + lane * 72 + 16) = z; *(v4u*)(T + lane * 72 + 24) = z; } \
            if (lane >= 32 && lane < 48) { *(v4u*)(T + lane * 72 + 48) = z; *(v4u*)(T + lane * 72 + 56) = z; } } \
        asm volatile("" ::: "memory");                              \
        const int m15 = lane & 15, qq = lane >> 4; \
        { const v4u zz = (v4u){0u, 0u, 0u, 0u}; v4u av[2], bv[2]; v2u dr[2]; \
            _Pragma("unroll") for (int p = 0; p < 2; ++p) { const int b0 = 2 * p, b1 = 2 * p + 1; av[p] = zz; bv[p] = zz; \
                if (qq < 2) { av[p] = *(const v4u*)(Ab + (16 * b1 + m15) * 72 + 16 * b0 + 8 * qq); bv[p] = *(const v4u*)(DTs + (p * 16 + m15) * 24 + 8 * qq); } \
                dr[p] = *(const v2u*)(T + (16 * b1 + m15) * 72 + 16 * b1 + 4 * qq); } \
            f32x4 Z4[2]; \
            _Pragma("unroll") for (int p = 0; p < 2; ++p) { \
                f32x4 X4 = (f32x4){0.f, 0.f, 0.f, 0.f}; X4 = mfma16(__builtin_bit_cast(bf16x8, av[p]), __builtin_bit_cast(bf16x8, bv[p]), X4); \
                v4u xa = zz; xa.x = cvt_pk_bf16(X4[0], X4[1]); xa.y = cvt_pk_bf16(X4[2], X4[3]); \
                v4u db = zz; db.x = dr[p].x; db.y = dr[p].y; \
                Z4[p] = (f32x4){0.f, 0.f, 0.f, 0.f}; Z4[p] = mfma16(__builtin_bit_cast(bf16x8, xa), __builtin_bit_cast(bf16x8, db), Z4[p]); } \
            _Pragma("unroll") for (int p = 0; p < 2; ++p) { const int b0 = 2 * p, b1 = 2 * p + 1; \
                st4(T + (16 * b1 + m15) * 72 + 16 * b0 + 4 * qq, -Z4[p][0], -Z4[p][1], -Z4[p][2], -Z4[p][3]); \
                if (p == 0) { _Pragma("unroll") for (int r = 0; r < 4; ++r) DT1[(4 * qq + r) * 40 + 16 + m15] = (bf16)f2bf(-Z4[p][r]); } } } \
        asm volatile("" ::: "memory"); \
        const int r31 = lane & 31, hh = lane >> 5; \
        f32x16 X; _Pragma("unroll") for (int i = 0; i < 16; ++i) X[i] = 0.f; \
        _Pragma("unroll") for (int ks = 0; ks < 2; ++ks) X = __builtin_amdgcn_mfma_f32_32x32x16_bf16(ld8(Ab + (32 + r31) * 72 + 16 * ks + 8 * hh), ld8(DT1 + r31 * 40 + 16 * ks + 8 * hh), X, 0, 0, 0); \
        f32x16 Z; _Pragma("unroll") for (int i = 0; i < 16; ++i) Z[i] = 0.f; \
        _Pragma("unroll") for (int ks = 0; ks < 2; ++ks) { v4u pw; pw.x = cvt_pk_bf16(X[8 * ks + 0], X[8 * ks + 1]); pw.y = cvt_pk_bf16(X[8 * ks + 2], X[8 * ks + 3]); pw.z = cvt_pk_bf16(X[8 * ks + 4], X[8 * ks + 5]); pw.w = cvt_pk_bf16(X[8 * ks + 6], X[8 * ks + 7]); \
            const bf16* d2 = T + (32 + r31) * 72 + 32 + 16 * ks + 4 * hh; \
            Z = __builtin_amdgcn_mfma_f32_32x32x16_bf16(__builtin_bit_cast(bf16x8, pw), ld44(d2, d2 + 8), Z, 0, 0, 0); } \
        _Pragma("unroll") for (int g = 0; g < 4; ++g) st4(T + (32 + r31) * 72 + 8 * g + 4 * hh, -Z[4 * g], -Z[4 * g + 1], -Z[4 * g + 2], -Z[4 * g + 3]); } } while (0)
#define DP_S7() do { const bf16x8 ti0 = ld8(T + (16 * tr + l15) * 72 + 8 * q4), ti1 = ld8(T + (16 * tr + l15) * 72 + 32 + 8 * q4); \
        f32x4 wt[4]; \
        _Pragma("unroll") for (int dt = 0; dt < 4; ++dt) { wt[dt] = (f32x4){0.f, 0.f, 0.f, 0.f}; \
            wt[dt] = mfma16(ldtr8(KbT, 0, dt, lane), ti0, wt[dt]); wt[dt] = mfma16(ldtr8(KbT, 1, dt, lane), ti1, wt[dt]); } \
        v4u wa0, wa1; \
        wa0.x = cvt_pk_bf16(-wt[0][0], -wt[0][1]); wa0.y = cvt_pk_bf16(-wt[0][2], -wt[0][3]); wa0.z = cvt_pk_bf16(-wt[1][0], -wt[1][1]); wa0.w = cvt_pk_bf16(-wt[1][2], -wt[1][3]); \
        wa1.x = cvt_pk_bf16(-wt[2][0], -wt[2][1]); wa1.y = cvt_pk_bf16(-wt[2][2], -wt[2][3]); wa1.z = cvt_pk_bf16(-wt[3][0], -wt[3][1]); wa1.w = cvt_pk_bf16(-wt[3][2], -wt[3][3]); \
        _Pragma("unroll") for (int tcx = 0; tcx < 2; ++tcx) { const int e = 16 * (tc0 + tcx) + l15; \
            f32x4 u = (f32x4){0.f, 0.f, 0.f, 0.f}; \
            u = mfma16(ti0, ldtr8(VbT, 0, tc0 + tcx, lane), u); u = mfma16(ti1, ldtr8(VbT, 1, tc0 + tcx, lane), u); \
            const bf16* sp = St + e * 72 + 4 * q4; \
            u = mfma16(__builtin_bit_cast(bf16x8, wa0), ld44(sp, sp + 16), u); u = mfma16(__builtin_bit_cast(bf16x8, wa1), ld44(sp + 32, sp + 48), u); \
            st4(VnT + e * 72 + 16 * tr + 4 * q4, u[0], u[1], u[2], u[3]); } } while (0)
#define DP_S8(NB) do { const int nb_ = (NB); const float* vd_ = vec0 + (nb_ & 1) * 448; const bf16* Qn_ = Qn2 + (nb_ & 1) * 4608; const bf16* Kd_ = Kd2 + (nb_ & 1) * 4608; const int t0_ = DP_T0(nb_); \
        const bf16x8 sa0 = ld8(St + (16 * tr + l15) * 72 + 8 * q4), sa1 = ld8(St + (16 * tr + l15) * 72 + 32 + 8 * q4); \
        const bf16x8 va0 = ld8(VnT + (16 * tr + l15) * 72 + 8 * q4), va1 = ld8(VnT + (16 * tr + l15) * 72 + 32 + 8 * q4); \
        const bf16x8 ka0 = ldtr8(Kd_, 0, tr, lane), ka1 = ldtr8(Kd_, 1, tr, lane); \
        const float cd = vd_[256]; \
        _Pragma("unroll") for (int tcx = 0; tcx < 2; ++tcx) { const int i = 16 * (tc0 + tcx) + l15; \
            f32x4 o = (f32x4){0.f, 0.f, 0.f, 0.f}; \
            o = mfma16(sa0, ld8(Qn_ + i * 72 + 8 * q4), o); o = mfma16(sa1, ld8(Qn_ + i * 72 + 32 + 8 * q4), o); \
            o = o * vd_[64 + i]; \
            o = mfma16(va0, ld8(QKm + i * 72 + 8 * q4), o); o = mfma16(va1, ld8(QKm + i * 72 + 32 + 8 * q4), o); \
            const int t = t0_ + (dir ? 63 - i : i); \
            st4(OUT + ((size_t)b * SEQ + t) * 512 + h * 64 + 16 * tr + 4 * q4, o[0], o[1], o[2], o[3]); \
            const int e = 16 * (tc0 + tcx) + l15; \
            Sacc[tcx] = Sacc[tcx] * cd; Sacc[tcx] = mfma16(ka0, ld8(VnT + e * 72 + 8 * q4), Sacc[tcx]); Sacc[tcx] = mfma16(ka1, ld8(VnT + e * 72 + 32 + 8 * q4), Sacc[tcx]); } } while (0)
#define DP_STW() do { _Pragma("unroll") for (int tcx = 0; tcx < 2; ++tcx) { const int e = 16 * (tc0 + tcx) + l15; st4(St + e * 72 + 16 * tr + 4 * q4, Sacc[tcx][0], Sacc[tcx][1], Sacc[tcx][2], Sacc[tcx][3]); } } while (0)

    constexpr int NCK = SEQ / 64;
    DP_LANE(); DP_PREFETCH(0);
    __syncthreads();
    DP_S0(0);
    __syncthreads();
    DP_S1A(0); DP_S1B();
    __syncthreads();
    DP_LANE(); DP_S4(0); DP_S0(1);
    __syncthreads();
    DP_LANE(); DP_S5(); DP_S1A(1);
    __syncthreads();
#pragma nounroll
    for (int n = 0; n < NCK; ++n) {
        const bool has1 = n + 1 < NCK, has2 = n + 2 < NCK;
        DP_LANE(); DP_S7();
        __syncthreads();
        DP_LANE(); DP_S8(n); if (has1) DP_S1B();
        __syncthreads();
        DP_LANE(); DP_STW(); if (has1) DP_S4(n + 1); if (has2) DP_S0(n + 2);
        __syncthreads();
        DP_LANE(); if (has1) DP_S5(); if (has2) DP_S1A(n + 2);
        __syncthreads();
    }
#undef DP_LANE
#undef DP_T0
#undef DP_PREFETCH
#undef DP_S0
#undef DP_S1A
#undef DP_S1B
#undef DP_S4
#undef DP_S5
#undef DP_S7
#undef DP_S8
#undef DP_STW
}

constexpr int LN_CNT_OFF = LDSCTL_OFF + 512;
template <int MODE, bool W8 = false, bool G8 = false>
__device__ __forceinline__ void ln_phase(Frame& F, const float* gam, const float* bet) {
    float* out = F.out; bf16* HB = (bf16*)(F.ws + WS_HB);
    unsigned* lcnt = (unsigned*)(F.lds + LN_CNT_OFF);
    unsigned* TOKE = (unsigned*)(F.ws + WS_META + MT_TOKE); float* TOKP = (float*)(F.ws + WS_META + MT_TOKP); unsigned short* RANK = (unsigned short*)(F.ws + WS_META + MT_RANK);
    unsigned* CNT = (unsigned*)(F.ws + WS_META + MT_CNT); const bf16* YS = (const bf16*)(F.ws + WS_YS);
    const int lane = F.lane;
    LAS f32x4* RW0 = (LAS f32x4*)((LAS unsigned char*)F.lds); LAS f32x4* RW1 = RW0 + 1024;
    if (MODE == 1) { if (F.tid < 8) lcnt[F.tid] = 0u;
        for (int i = F.tid; i < 1024; i += NTHR) { const int jc = i >> 6, ln = i & 63; const float* rw = IN_router_w(F) + (size_t)(ln * 4 + 256 * (jc >> 2) + (jc & 3)) * 8;
            RW0[i] = *(const f32x4*)rw; RW1[i] = *(const f32x4*)(rw + 4); }
        __syncthreads(); }
    f32x4 gv[4], bv[4];
#pragma unroll
    for (int j = 0; j < 4; ++j) { gv[j] = *(const f32x4*)(gam + lane * 4 + 256 * j); bv[j] = *(const f32x4*)(bet + lane * 4 + 256 * j); }
    v2u nx[2][4];
    { const bf16* h0 = HB + ((size_t)F.bx * 128 + F.wave * 16) * 1024 + lane * 4;
#pragma unroll
        for (int u = 0; u < 2; ++u)
#pragma unroll
            for (int j = 0; j < 4; ++j) nx[u][j] = *(const v2u*)(h0 + u * 1024 + 256 * j); }
    for (int i2 = 0; i2 < 16; i2 += 2) {
      v2u cur[2][4];
#pragma unroll
      for (int u = 0; u < 2; ++u)
#pragma unroll
          for (int j = 0; j < 4; ++j) cur[u][j] = nx[u][j];
      if (i2 + 2 < 16) { const bf16* h0 = HB + ((size_t)F.bx * 128 + F.wave * 16 + i2 + 2) * 1024 + lane * 4;
#pragma unroll
          for (int u = 0; u < 2; ++u)
#pragma unroll
              for (int j = 0; j < 4; ++j) nx[u][j] = *(const v2u*)(h0 + u * 1024 + 256 * j); }
#pragma unroll
      for (int u = 0; u < 2; ++u) {
        const int i = i2 + u;
        const size_t m = (size_t)F.bx * 128 + F.wave * 16 + i;
        float* zr = out + m * 1024 + lane * 4; bf16* hr = HB + m * 1024 + lane * 4;
        f32x4 v[4];
#pragma unroll
        for (int j = 0; j < 4; ++j) v[j] = (f32x4){bflo(cur[u][j].x), bfhi(cur[u][j].x), bflo(cur[u][j].y), bfhi(cur[u][j].y)};
        if (MODE == 2) {
            const float p1 = (ABL == 5) ? 0.f : TOKP[m * 2], p2 = (ABL == 5) ? 0.f : TOKP[m * 2 + 1];
            const bf16* y1 = YS + m * 2048 + lane * 4; const bf16* y2 = y1 + 1024;
#pragma unroll
            for (int j = 0; j < 4; ++j) { const v2u a = *(const v2u*)(y1 + 256 * j), b = *(const v2u*)(y2 + 256 * j);
                v[j][0] = v[j][0] * ALPHA + p1 * bflo(a.x) + p2 * bflo(b.x); v[j][1] = v[j][1] * ALPHA + p1 * bfhi(a.x) + p2 * bfhi(b.x);
                v[j][2] = v[j][2] * ALPHA + p1 * bflo(a.y) + p2 * bflo(b.y); v[j][3] = v[j][3] * ALPHA + p1 * bfhi(a.y) + p2 * bfhi(b.y); }
        }
        float s = 0.f;
#pragma unroll
        for (int j = 0; j < 4; ++j) s += (v[j][0] + v[j][1]) + (v[j][2] + v[j][3]);
        const float mean = wave_sum(s) * (1.0f / 1024.0f);
        float q = 0.f;
#pragma unroll
        for (int j = 0; j < 4; ++j) { v[j] = v[j] - mean; q += (v[j][0] * v[j][0] + v[j][1] * v[j][1]) + (v[j][2] * v[j][2] + v[j][3] * v[j][3]); }
        const float rstd = __builtin_amdgcn_rsqf(wave_sum(q) * (1.0f / 1024.0f) + LN_EPS);
#pragma unroll
        for (int j = 0; j < 4; ++j) { v[j] = v[j] * rstd * gv[j] + bv[j]; if (MODE == 2) *(f32x4*)(zr + 256 * j) = v[j]; }
        if (MODE != 2) {
#pragma unroll
            for (int j = 0; j < 4; ++j) { v2u w; w.x = pk2(v[j][0], v[j][1]); w.y = pk2(v[j][2], v[j][3]); *(v2u*)(hr + 256 * j) = w; }
        }
        if (G8) { unsigned char* h8 = F.ws + WS_HBG8 + m * 1024 + lane * 4;
#pragma unroll
            for (int j = 0; j < 4; ++j) *(unsigned*)(h8 + 256 * j) = pk4_fp8(v[j][0], v[j][1], v[j][2], v[j][3]); }
        if (W8) { unsigned char* h8 = F.ws + WS_HB8 + m * 1024 + lane * 4;
#pragma unroll
            for (int j = 0; j < 4; ++j) *(unsigned*)(h8 + 256 * j) = pk4_fp8(v[j][0], v[j][1], v[j][2], v[j][3]); }
        if (MODE == 1) {
            float lg[8];
#pragma unroll
            for (int e = 0; e < 8; ++e) lg[e] = 0.f;
#pragma unroll
            for (int j = 0; j < 4; ++j)
#pragma unroll
                for (int c = 0; c < 4; ++c) { const f32x4 r0 = RW0[(j * 4 + c) * 64 + lane], r1 = RW1[(j * 4 + c) * 64 + lane]; const float hv = v[j][c];
                    lg[0] += hv * r0[0]; lg[1] += hv * r0[1]; lg[2] += hv * r0[2]; lg[3] += hv * r0[3]; lg[4] += hv * r1[0]; lg[5] += hv * r1[1]; lg[6] += hv * r1[2]; lg[7] += hv * r1[3]; }
#pragma unroll
            for (int e = 0; e < 8; ++e) lg[e] = wave_sum(lg[e]);
            int e1 = 0; float l1 = lg[0];
#pragma unroll
            for (int e = 1; e < 8; ++e) if (lg[e] > l1) { l1 = lg[e]; e1 = e; }
            int e2 = -1; float l2 = -3.0e38f;
#pragma unroll
            for (int e = 0; e < 8; ++e) if (e != e1 && lg[e] > l2) { l2 = lg[e]; e2 = e; }
            if (lane == 0) {
                const float p1 = 1.0f / (1.0f + __expf(l2 - l1));
                TOKE[m] = (unsigned)e1 | ((unsigned)e2 << 8); TOKP[m * 2] = p1; TOKP[m * 2 + 1] = 1.0f - p1; (F.ws + WS_META + MT_DEFER)[m] = 0;
                RANK[m * 2] = (unsigned short)atomicAdd(&lcnt[e1], 1u); RANK[m * 2 + 1] = (unsigned short)atomicAdd(&lcnt[e2], 1u);
            }
        }
      }
    }
    if (MODE == 1) { __syncthreads(); if (F.tid < 8) CNT[F.bx * 8 + F.tid] = lcnt[F.tid]; }
}

constexpr int MT_BASE = 288, MT_TOT = 304, MT_NT = 312, MT_PRE = 320;
constexpr int TAIL_U0 = 512, TAIL_ROW0 = (CHT * (NCH - 1) + TAIL_U0 / 4) * 256;
__device__ __forceinline__ void moe_meta(Frame& F, int ln_wg  ) {
    int* mt = (int*)(F.lds + MOE_LDS_OFF); const unsigned* CNT = (const unsigned*)(F.ws + WS_META + MT_CNT);
    __syncthreads();
    { const int e = F.wave; int tot = 0, pre = 0;
#pragma unroll
        for (int k = 0; k < 4; ++k) { const int w = F.lane + 64 * k; const int v = (int)CNT[w * 8 + e]; tot += v; if (w < ln_wg) pre += v; }
#pragma unroll
        for (int o = 1; o < 64; o <<= 1) { tot += __shfl_xor(tot, o); pre += __shfl_xor(pre, o); }
        if (F.lane == 0) { mt[MT_TOT + e] = tot; mt[MT_PRE + e] = pre; } }
    __syncthreads();
    if (F.tid == 0) { int base = 0;
        for (int e = 0; e < 8; ++e) { mt[MT_BASE + e] = base; const int nt = (mt[MT_TOT + e] + 255) >> 8; for (int t = 0; t < nt; ++t) mt[(base >> 8) + t] = e; base += nt << 8; }
        mt[MT_BASE + 8] = base; mt[MT_NT] = base >> 8; }
    __syncthreads();
}
__device__ __forceinline__ int moe_chunk_tiles(const int* mt, int c) { return c < NCH - 1 ? CHT : mt[MT_NT] - CHT * (NCH - 1); }
__device__ __forceinline__ void moe_gather(Frame& F, int c) {
    if (MK_PER_PHASE || c == 0) moe_meta(F, F.bx);
    const int* mt = (const int*)(F.lds + MOE_LDS_OFF);
    const unsigned* TOKE = (const unsigned*)(F.ws + WS_META + MT_TOKE); const unsigned short* RANK = (const unsigned short*)(F.ws + WS_META + MT_RANK);
    unsigned* ROWMAP = (unsigned*)(F.ws + WS_META + MT_ROWMAP);
    const bf16* HB = (const bf16*)(F.ws + WS_HB); bf16* XG = (bf16*)(F.ws + WS_XG);
    const int lane = F.lane, li = lane & 31; const size_t mbase = (size_t)F.bx * 128 + F.wave * 16;
    int pos; bool mine;
    { const size_t m = mbase + (li >> 1); const int slot = li & 1;
        const int e = (int)((TOKE[m] >> (8 * slot)) & 0xffu);
        pos = mt[MT_BASE + e] + mt[MT_PRE + e] + (int)RANK[m * 2 + slot];
        int cc = pos / (CHT * 256); if (cc > NCH - 1) cc = NCH - 1;
        mine = lane < 32 && cc == c;
        if (mine) { ROWMAP[pos] = (unsigned)(m * 2 + slot); if (c == NCH - 1 && pos >= TAIL_ROW0) (F.ws + WS_META + MT_DEFER)[m] = 1; } }
    unsigned mask = (unsigned)__ballot(mine);
    while (mask) {
        int id[4];
#pragma unroll
        for (int k = 0; k < 4; ++k) { if (mask) { id[k] = __builtin_ctz(mask); mask &= mask - 1u; } else id[k] = -1; }
        v4u a[4], b[4];
#pragma unroll
        for (int k = 0; k < 4; ++k) if (id[k] >= 0) { const bf16* src = HB + (mbase + (id[k] >> 1)) * 1024 + lane * 16; a[k] = *(const v4u*)src; b[k] = *(const v4u*)(src + 8); }
#pragma unroll
        for (int k = 0; k < 4; ++k) if (id[k] >= 0) {
            const size_t lr = (size_t)(__builtin_amdgcn_readlane(pos, id[k]) - CHT * 256 * c);
            if (MOE_FP8) { f32x4 t0, t1, t2, t3; unpack8(a[k], t0, t1); unpack8(b[k], t2, t3);
                v4u o; o.x = pk4_fp8(t0[0], t0[1], t0[2], t0[3]); o.y = pk4_fp8(t1[0], t1[1], t1[2], t1[3]); o.z = pk4_fp8(t2[0], t2[1], t2[2], t2[3]); o.w = pk4_fp8(t3[0], t3[1], t3[2], t3[3]);
                *(v4u*)((unsigned char*)XG + lr * 1024 + lane * 16) = o; }
            else { *(v4u*)(XG + lr * 1024 + lane * 16) = a[k]; *(v4u*)(XG + lr * 1024 + lane * 16 + 8) = b[k]; }
        }
    }
}
template <int PASS>
__device__ __forceinline__ void ln_final(Frame& F, const float* gam, const float* bet, int nskip) {
    float* out = F.out; const bf16* HB = (const bf16*)(F.ws + WS_HB);
    const float* TOKP = (const float*)(F.ws + WS_META + MT_TOKP); const bf16* YS = (const bf16*)(F.ws + WS_YS); const unsigned char* DEFER = F.ws + WS_META + MT_DEFER;
    const int lane = F.lane;
    f32x4 gv[4], bv[4];
#pragma unroll
    for (int j = 0; j < 4; ++j) { gv[j] = *(const f32x4*)(gam + lane * 4 + 256 * j); bv[j] = *(const f32x4*)(bet + lane * 4 + 256 * j); }
    int r0, r1; unsigned long long dmask = 0ull;
    if (PASS == 1) { const int nw = (F.G - nskip) * NWAVES, wv = (F.bx - nskip) * NWAVES + F.wave; r0 = (int)(((long)wv * M) / nw); r1 = (int)(((long)(wv + 1) * M) / nw); }
    else { r0 = F.bx * 128 + F.wave * 16; r1 = r0 + 16; dmask = __ballot(lane < 16 && DEFER[r0 + (lane & 15)] != 0); }
    v2u nx[4], ny1[4], ny2[4]; unsigned nfl = 0u; float np1 = 0.f, np2 = 0.f;
    if (PASS == 1 && r0 < r1) { const bf16* h0 = HB + (size_t)r0 * 1024 + lane * 4; const bf16* y0 = YS + (size_t)r0 * 2048 + lane * 4; nfl = DEFER[r0]; np1 = TOKP[(size_t)r0 * 2]; np2 = TOKP[(size_t)r0 * 2 + 1];
#pragma unroll
        for (int j = 0; j < 4; ++j) { nx[j] = *(const v2u*)(h0 + 256 * j); ny1[j] = *(const v2u*)(y0 + 256 * j); ny2[j] = *(const v2u*)(y0 + 1024 + 256 * j); } }
    for (int m_ = r0; m_ < r1; ++m_) {
        const size_t m = (size_t)m_;
        float* zr = out + m * 1024 + lane * 4; const bf16* hr = HB + m * 1024 + lane * 4;
        const bf16* y1 = YS + m * 2048 + lane * 4; const bf16* y2 = y1 + 1024;
        f32x4 v[4]; v2u ya[4], yb[4]; float p1, p2; bool skip;
        if (PASS == 1) {
#pragma unroll
            for (int j = 0; j < 4; ++j) { v[j] = (f32x4){bflo(nx[j].x), bfhi(nx[j].x), bflo(nx[j].y), bfhi(nx[j].y)}; ya[j] = ny1[j]; yb[j] = ny2[j]; }
            p1 = np1; p2 = np2;
            skip = __builtin_amdgcn_readfirstlane(nfl) != 0u;
            if (m_ + 1 < r1) { nfl = DEFER[m + 1]; np1 = TOKP[m * 2 + 2]; np2 = TOKP[m * 2 + 3];
#pragma unroll
                for (int j = 0; j < 4; ++j) { nx[j] = *(const v2u*)(hr + 1024 + 256 * j); ny1[j] = *(const v2u*)(y1 + 2048 + 256 * j); ny2[j] = *(const v2u*)(y2 + 2048 + 256 * j); } }
        } else {
            skip = ((dmask >> (m_ - r0)) & 1ull) == 0ull;
            if (!skip) { p1 = TOKP[m * 2]; p2 = TOKP[m * 2 + 1];
#pragma unroll
                for (int j = 0; j < 4; ++j) { const v2u w = *(const v2u*)(hr + 256 * j); v[j] = (f32x4){bflo(w.x), bfhi(w.x), bflo(w.y), bfhi(w.y)}; ya[j] = *(const v2u*)(y1 + 256 * j); yb[j] = *(const v2u*)(y2 + 256 * j); } }
        }
        if (skip) continue;
        if (ABL == 5) { p1 = 0.f; p2 = 0.f; }
#pragma unroll
        for (int j = 0; j < 4; ++j) { const v2u a = ya[j], b = yb[j];
            v[j][0] = v[j][0] * ALPHA + p1 * bflo(a.x) + p2 * bflo(b.x); v[j][1] = v[j][1] * ALPHA + p1 * bfhi(a.x) + p2 * bfhi(b.x);
            v[j][2] = v[j][2] * ALPHA + p1 * bflo(a.y) + p2 * bflo(b.y); v[j][3] = v[j][3] * ALPHA + p1 * bfhi(a.y) + p2 * bfhi(b.y); }
        float s = 0.f;
#pragma unroll
        for (int j = 0; j < 4; ++j) s += (v[j][0] + v[j][1]) + (v[j][2] + v[j][3]);
        const float mean = wave_sum(s) * (1.0f / 1024.0f);
        float q = 0.f;
#pragma unroll
        for (int j = 0; j < 4; ++j) { v[j] = v[j] - mean; q += (v[j][0] * v[j][0] + v[j][1] * v[j][1]) + (v[j][2] * v[j][2] + v[j][3] * v[j][3]); }
        const float rstd = __builtin_amdgcn_rsqf(wave_sum(q) * (1.0f / 1024.0f) + LN_EPS);
#pragma unroll
        for (int j = 0; j < 4; ++j) { v[j] = v[j] * rstd * gv[j] + bv[j]; *(f32x4*)(zr + 256 * j) = v[j]; }
    }
}
struct MoeSched {
    int G, c, NJ, nunits, t0; const int* mt; const char* A; const char* B; size_t tsA, tsB; int off = 0;
    __device__ __forceinline__ bool next(int i, Unit& u) const { const int L = i * G + c + off; if (L >= nunits) return false; u.pm = L / NJ; u.aux = L - u.pm * NJ; u.pn = mt[t0 + u.pm] * NJ + u.aux; return true; }
    __device__ __forceinline__ const char* abase(const Unit& u) const { return A + (size_t)u.pm * tsA; }
    __device__ __forceinline__ const char* bbase(const Unit& u) const { return B + (size_t)u.pn * tsB; }
};
struct EpiMoeDown {
    static constexpr bool PERM = true;
    bf16* YS; const unsigned* rowmap; const int* mt; int t0;
    __device__ __forceinline__ void operator()(acc_t& acc, const Unit& u, int wr, int wc, int fr, int fq) const {
        const int tg = t0 + u.pm, e = mt[tg], lim = mt[MT_BASE + e] + mt[MT_TOT + e]; const int row0 = tg * 256 + wr * 64 + fr; const int col = u.aux * 256 + wc * 32 + 8 * fq;
#pragma unroll
        for (int ai = 0; ai < 2; ++ai)
#pragma unroll
            for (int m = 0; m < 4; ++m) { const int r = row0 + ai * 128 + m * 16;
                if (r < lim) { const size_t pr = rowmap[r]; bf16* dst = YS + pr * 1024 + col;
                    const float ds = (FP8_EMU || MOE_FP8) ? (1.0f / 32.0f) : 1.0f;
                    *(v4u*)(dst) = pack8(acc[ai][0][m][0] * ds, acc[ai][0][m][1] * ds); *(v4u*)(dst + 128) = pack8(acc[ai][1][m][0] * ds, acc[ai][1][m][1] * ds); } }
        zero_acc(acc);
    }
};

__global__ void __launch_bounds__(NTHR, 2) fwd_kernel(Args args) {
    extern __shared__ __attribute__((aligned(16))) unsigned char lds[];
    Frame F0;
    F0.lds = lds;
    F0.tid = threadIdx.x; F0.lane = F0.tid & 63; F0.wave = __builtin_amdgcn_readfirstlane(F0.tid >> 6);
    F0.G = gridDim.x; F0.bx = blockIdx.x;
    F0.ws = args.ws; F0.out = args.out;
    F0.a = &args;
    { LAS unsigned char* ldsl0 = (LAS unsigned char*)lds;
    for (int u = F0.tid; u < (LDS_BYTES - LDSCTL_OFF) / 4; u += NTHR) ((LAS unsigned*)(ldsl0 + LDSCTL_OFF))[u] = 0u; }
    __syncthreads();
    unsigned* ctl = (unsigned*)(F0.ws + WS_CTL);
    XcdBarrier bar; bar.bar = ctl + CW_BAR; bar.x = 0; bar.st = nullptr; bar.w0 = 0;
    if (!MK_PER_PHASE) bar = xcd_barrier_post(ctl + CW_BAR, (volatile LAS unsigned*)((LAS unsigned char*)lds + MISC_OFF) + 8);
    const int lo = args.ph_lo, hi = args.ph_hi;
#ifndef PHASE_MASK
#define PHASE_MASK 0xFFFFFFFFu
#endif
#define EN(b) (((PHASE_MASK) >> (b)) & 1u)
#ifndef SP2K
#define SP2K 0
#endif
#ifndef ALN
#define ALN 14
#endif
#ifndef DBL
#define DBL 0
#endif
#define REP(k) for (int rep_ = 0; rep_ < ((DBL) == (k) ? 2 : 1); ++rep_)
#define IN(k) (lo <= (k) && (k) < hi)
#define GRID_BAR() do { if (!MK_PER_PHASE) xcd_barrier(bar); } while (0)
#define PH_BEGIN() Frame P = F0; asm volatile("" : "+s"(P.ws), "+s"(P.out), "+s"(P.G), "+s"(P.bx)); P.lane = (int)__builtin_amdgcn_mbcnt_hi(~0u, __builtin_amdgcn_mbcnt_lo(~0u, 0u)); asm volatile("" : "+v"(P.lane)); P.tid = P.wave * 64 + P.lane; Frame& F = P; LAS unsigned char* ldsl = (LAS unsigned char*)P.lds;

    if (EN(0) && IN(0)) { PH_BEGIN(); REP(100) p0_prologue(F); }
    GRID_BAR();
#if defined(XBAR)
    for (int xb_ = 0; xb_ < XBAR; ++xb_) GRID_BAR();
#endif

#pragma nounroll
    for (int layer = 0; layer < 2; ++layer) {
        const int pb = 1 + 40 * layer;
        if (EN(1) && IN(pb + 0)) { PH_BEGIN(); const bf16* HB = (const bf16*)(F.ws + WS_HB); const bf16* WIN = (const bf16*)(F.ws + WS_WIN) + (size_t)layer * WIN_ROWS * 1024;
            pg8::StdSched S; S.init(HB, WIN, M, NA, 1024, F.G, F.bx);
            EpiInA E{F.ws};
            REP(1) pg8::gemm_phase<EpiInA, pg8::StdSched, (ALN & 8) == 0, true>(ldsl + RING_OFF, 1024, S, E, F.wave);
        }
        GRID_BAR();
        if (EN(2) && IN(pb + 1)) { PH_BEGIN();
#if defined(DELTA_RECURRENT)
            REP(21) for (int s = F.bx; s < 256; s += F.G) delta_seq(F, layer, s);
#else
#if defined(DELTA_NOPIPE)
            REP(21) for (int s = F.bx; s < 256; s += F.G) delta_seq_chunked(F, layer, s);
#else
            REP(21) for (int s = F.bx; s < 256; s += F.G) delta_seq_pipe(F, layer, s);
#endif
#endif
            __syncthreads();
            attn_bias_setup(F);
            if (DBL == 22) attn_phase(F, layer, (bf16*)(F.ws + WS_OP));
            attn_phase(F, layer, nullptr);
            REP(23) for (int u = F.bx; u < 1024; u += F.G) pool_unit(F, layer, u);
        }
        GRID_BAR();
        if (EN(3) && IN(pb + 20)) { PH_BEGIN(); delta_post(F, layer); }
        GRID_BAR();
        if (EN(3) && IN(pb + 2)) { PH_BEGIN(); const bf16* HB = (const bf16*)(F.ws + WS_HB); const bf16* WIN = (const bf16*)(F.ws + WS_WIN) + (size_t)layer * WIN_ROWS * 1024;
#if GATES_FP8
            pg8::StdSched S; S.init(F.ws + WS_HBG8, WIN + (size_t)NA * 1024, M, NG, 512, F.G, F.bx); (void)HB;
            EpiGates E{(bf16*)(F.ws + WS_GT), 1.0f / 32.0f};
            REP(3) pg8::gemm_phase<EpiGates, pg8::StdSched, (ALN & 2) == 0, (SP2K & 2) == 0, true>(ldsl + RING_OFF, 512, S, E, F.wave);
#else
            pg8::StdSched S; S.init(HB, WIN + (size_t)NA * 1024, M, NG, 1024, F.G, F.bx);
            EpiGates E{(bf16*)(F.ws + WS_GT), 1.0f};
            REP(3) pg8::gemm_phase<EpiGates, pg8::StdSched, true, true>(ldsl + RING_OFF, 1024, S, E, F.wave);
#endif
        }
        GRID_BAR();
        if (EN(4) && IN(pb + 3)) { PH_BEGIN();
#if defined(BRSKEW)
            if (F.bx & 1) { for (int i_ = 0; i_ < BRSKEW; ++i_) __builtin_amdgcn_s_sleep(127); }
#endif
            BrSched S; S.o.init(M / 256, 4, F.G, F.bx); S.A0 = (const char*)(F.ws + WS_AQ); static_assert(WS_DZ == WS_AQ + 32 * MiB && WS_OP == WS_AQ + 64 * MiB, "branch planes");
            S.B0 = (const char*)(F.ws + WS_WBR) + (size_t)layer * 3 * 1024 * 512 * 2; S.tstep = (size_t)256 * 512 * 2;
#if defined(BR_RMW)
            EpiBranchRMW E{(const bf16*)(F.ws + WS_GT), (bf16*)(F.ws + WS_MERGED)};
            pg8::gemm_phase<EpiBranchRMW, BrSched, false, true>(ldsl + RING_OFF, 512, S, E, F.wave);
#else
            EpiBranch E{(const bf16*)(F.ws + WS_GT), (bf16*)(F.ws + WS_MERGED)};
            REP(4) pg8::gemm_phase<EpiBranch, BrSched, (ALN & 16) == 0, true>(ldsl + RING_OFF, 512, S, E, F.wave);
#endif
        }
        GRID_BAR();
        if (EN(5) && IN(pb + 4)) { PH_BEGIN();
            pg8::StdSched S; S.init(F.ws + WS_MERGED, (const bf16*)(F.ws + WS_WOUT) + (size_t)layer * 1024 * 1024, M, 1024, 1024, F.G, F.bx);
#if (LN_FUSE & 1)
            if (layer == 0) { EpiResidLN<0, false, 0> E{F.ws, F.a, ldsl, 1.0f};
                pg8::gemm_phase<EpiResidLN<0, false, 0>, pg8::StdSched, true, true>(ldsl + RING_OFF, 1024, S, E, F.wave); }
            else
#endif
            { EpiResid E{(bf16*)(F.ws + WS_HB), 1.0f};
            pg8::gemm_phase<EpiResid, pg8::StdSched, (ALN & 32) == 0, true>(ldsl + RING_OFF, 1024, S, E, F.wave); }
        }
        GRID_BAR();
        if (EN(6) && IN(pb + 5) && !((LN_FUSE & 1) && layer == 0)) { PH_BEGIN();
            if (layer == 0) ln_phase<0, FFN_FP8 == 1 || FFN_FP8 == 2>(F, IN_ln1_g(F), IN_ln1_b(F));
            else { ln_phase<1>(F, IN_ln1_g(F) + 1024, IN_ln1_b(F) + 1024); REP(101) moe_weight_convert(F); }
        }
        if (!((LN_FUSE & 1) && layer == 0)) GRID_BAR();
        if (layer == 0) {
            if (EN(7) && IN(pb + 6)) { PH_BEGIN(); const bf16* HB = (const bf16*)(F.ws + WS_HB);
#if FFN_FP8 == 2
                FfnUpSched S; S.o.init(M / 256, FF / 128, F.G, F.bx); S.A = (const char*)(F.ws + WS_HB8); S.Bt = (const char*)(F.ws + WS_W13); S.tstep = (size_t)256 * 1024; (void)HB;
                EpiSwiglu E{(bf16*)(F.ws + WS_FACT), FF, 1.0f / 32.0f, 0};
                REP(7) pg8::gemm_phase<EpiSwiglu, FfnUpSched, true, true, true>(ldsl + RING_OFF, 512, S, E, F.wave);
#elif FFN_FP8 == 1
                FfnUpSched S; S.o.init(M / 256, FF / 128, F.G, F.bx); S.A = (const char*)(F.ws + WS_HB8); S.Bt = (const char*)(F.ws + WS_W13); S.tstep = (size_t)256 * 1024; (void)HB;
                EpiSwiglu8 E{(unsigned char*)(F.ws + WS_FACT), FF, 1.0f / 32.0f};
                REP(7) pg8::gemm_phase<EpiSwiglu8, FfnUpSched, true, true, true>(ldsl + RING_OFF, 512, S, E, F.wave);
#elif FFN_FP8 == 3
                FfnUpSched S; S.o.init(M / 256, FF / 128, F.G, F.bx); S.A = (const char*)HB; S.Bt = (const char*)(F.ws + WS_W13); S.tstep = (size_t)256 * 1024 * 2;
                EpiSwiglu8 E{(unsigned char*)(F.ws + WS_FACT), FF, 1.0f};
                REP(7) pg8::gemm_phase<EpiSwiglu8, FfnUpSched, (ALN & 4) == 0, true>(ldsl + RING_OFF, 1024, S, E, F.wave);
#else
                FfnUpSched S; S.o.init(M / 256, FF / 128, F.G, F.bx); S.A = (const char*)HB; S.Bt = (const char*)(F.ws + WS_W13); S.tstep = (size_t)256 * 1024 * 2;
                EpiSwiglu E{(bf16*)(F.ws + WS_FACT), FF, 1.0f, 0};
                REP(7) pg8::gemm_phase<EpiSwiglu, FfnUpSched, (ALN & 4) == 0, true>(ldsl + RING_OFF, 1024, S, E, F.wave);
#endif
            }
            GRID_BAR();
            if (EN(8) && IN(pb + 7)) { PH_BEGIN();
#if FFN_FP8 == 1 || FFN_FP8 == 3
                pg8::StdSched S; S.init(F.ws + WS_FACT, F.ws + WS_W2, M, 1024, FF / 2, F.G, F.bx);
#if (LN_FUSE & 2)
                EpiResidLN<1, GATES_FP8 != 0, 1> E{F.ws, F.a, ldsl, (ABL == 4) ? 0.f : (1.0f / 32.0f)};
                pg8::gemm_phase<EpiResidLN<1, GATES_FP8 != 0, 1>, pg8::StdSched, true, true, true>(ldsl + RING_OFF, FF / 2, S, E, F.wave);
#else
                EpiResid E{(bf16*)(F.ws + WS_HB), (ABL == 4) ? 0.f : (1.0f / 32.0f)};
                pg8::gemm_phase<EpiResid, pg8::StdSched, true, true, true>(ldsl + RING_OFF, FF / 2, S, E, F.wave);
#endif
#else
                pg8::StdSched S; S.init(F.ws + WS_FACT, F.ws + WS_W2, M, 1024, FF, F.G, F.bx);
                EpiResid E{(bf16*)(F.ws + WS_HB), (ABL == 4) ? 0.f : 1.0f};
                pg8::gemm_phase<EpiResid, pg8::StdSched, (ALN & 64) == 0, true>(ldsl + RING_OFF, FF, S, E, F.wave);
#endif
            }
            GRID_BAR();
#if !((LN_FUSE & 2) && (FFN_FP8 == 1 || FFN_FP8 == 3))
            if (EN(9) && IN(pb + 8)) { PH_BEGIN(); ln_phase<0, false, GATES_FP8 != 0>(F, IN_ln2_g(F), IN_ln2_b(F)); }
            GRID_BAR();
#endif
        } else {
            if (EN(10) && IN(pb + 6)) { PH_BEGIN(); moe_gather(F, 0); }
            GRID_BAR();
#pragma nounroll
            for (int c = 0; c < NCH; ++c) {
                if (EN(11) && IN(pb + 7 + 2 * c)) { PH_BEGIN(); const int* mt = (const int*)(F.lds + MOE_LDS_OFF);
                    if (MK_PER_PHASE) moe_meta(F, -1);
                    MoeSched S; S.G = F.G; S.c = F.bx; S.NJ = FFE / 128; S.t0 = CHT * c; S.nunits = moe_chunk_tiles(mt, c) * S.NJ; S.mt = mt; S.A = (const char*)(F.ws + WS_XG); S.B = (const char*)(F.ws + WS_MWGU);
                    S.tsA = (size_t)256 * 1024 * (MOE_FP8 ? 1 : 2); S.tsB = S.tsA;
#if MOE_FP8
                    EpiSwiglu8 E{(unsigned char*)(F.ws + WS_MACT), FFE, 1.0f / 32.0f};
                    REP(11) pg8::gemm_phase<EpiSwiglu8, MoeSched, (ALN & 1) == 0, (SP2K & 1) == 0, true>(ldsl + RING_OFF, 512, S, E, F.wave);
#else
                    EpiSwiglu E{(bf16*)(F.ws + WS_MACT), FFE, FP8_EMU ? (1.0f / 32.0f) : 1.0f, FP8_EMU};
                    REP(11) pg8::gemm_phase<EpiSwiglu, MoeSched, true, true>(ldsl + RING_OFF, 1024, S, E, F.wave);
#endif
                }
                GRID_BAR();
                if (EN(12) && IN(pb + 8 + 2 * c)) { PH_BEGIN(); const int* mt = (const int*)(F.lds + MOE_LDS_OFF);
                    if (MK_PER_PHASE) moe_meta(F, -1);
                    MoeSched S; S.G = F.G; S.c = F.bx; S.NJ = 4; S.t0 = CHT * c; S.nunits = moe_chunk_tiles(mt, c) * 4; if (c == NCH - 1 && S.nunits > TAIL_U0) S.nunits = TAIL_U0; S.mt = mt; S.A = (const char*)(F.ws + WS_MACT); S.B = (const char*)(F.ws + WS_MWD);
                    S.tsA = (size_t)256 * FFE * (MOE_FP8 ? 1 : 2); S.tsB = S.tsA;
                    EpiMoeDown E{(bf16*)(F.ws + WS_YS), (const unsigned*)(F.ws + WS_META + MT_ROWMAP), mt, CHT * c};
#if MOE_FP8
                    REP(12) pg8::gemm_phase<EpiMoeDown, MoeSched, (ALN & 128) == 0, (SP2K & 4) == 0, true>(ldsl + RING_OFF, FFE / 2, S, E, F.wave);
#else
                    REP(12) pg8::gemm_phase<EpiMoeDown, MoeSched, true, true>(ldsl + RING_OFF, FFE, S, E, F.wave);
#endif
                }
                if (EN(12) && IN(pb + 8 + 2 * c) && c + 1 < NCH) { PH_BEGIN(); moe_gather(F, c + 1); }
                GRID_BAR();
            }
            if (EN(13) && IN(pb + 13)) { PH_BEGIN(); const int* mt = (const int*)(F.lds + MOE_LDS_OFF);
                if (MK_PER_PHASE) moe_meta(F, -1);
                const int total = moe_chunk_tiles(mt, NCH - 1) * 4, ntail = total > TAIL_U0 ? total - TAIL_U0 : 0;
                if (F.bx < ntail) {
                    MoeSched S; S.G = F.G; S.c = F.bx; S.NJ = 4; S.t0 = CHT * (NCH - 1); S.nunits = total; S.off = TAIL_U0; S.mt = mt; S.A = (const char*)(F.ws + WS_MACT); S.B = (const char*)(F.ws + WS_MWD);
                    S.tsA = (size_t)256 * FFE * (MOE_FP8 ? 1 : 2); S.tsB = S.tsA;
                    EpiMoeDown E{(bf16*)(F.ws + WS_YS), (const unsigned*)(F.ws + WS_META + MT_ROWMAP), mt, CHT * (NCH - 1)};
#if MOE_FP8
                    pg8::gemm_phase<EpiMoeDown, MoeSched, true, true, true>(ldsl + RING_OFF, FFE / 2, S, E, F.wave);
#else
                    pg8::gemm_phase<EpiMoeDown, MoeSched, true, true>(ldsl + RING_OFF, FFE, S, E, F.wave);
#endif
                } else ln_final<1>(F, IN_ln2_g(F) + 1024, IN_ln2_b(F) + 1024, ntail);
            }
            GRID_BAR();
            if (EN(13) && IN(pb + 15)) { PH_BEGIN(); ln_final<2>(F, IN_ln2_g(F) + 1024, IN_ln2_b(F) + 1024, 0); }
        }
    }
#undef IN
#undef GRID_BAR
}


#if defined(DBG_CHECK)
constexpr int CK_BASE = 512;
__device__ __forceinline__ unsigned ck_hash(unsigned x) { x ^= x >> 16; x *= 0x7feb352du; x ^= x >> 15; x *= 0x846ca68bu; x ^= x >> 16; return x; }
__device__ __forceinline__ void ck_record(unsigned* ctl, int stage, float mine, float ref) {
    const float e = fabsf(mine - ref), r = fabsf(ref);
    atomicMax(ctl + CK_BASE + 2 * stage, __float_as_uint(e == e ? e : 1e30f)); atomicMax(ctl + CK_BASE + 2 * stage + 1, __float_as_uint(r));
}
__device__ __forceinline__ float ck_dot(const bf16* a, int K, const float* w, int ldw) { float s = 0.f; for (int k = 0; k < K; ++k) s += bf2f(a[k]) * w[(size_t)k * ldw]; return s; }
__global__ void __launch_bounds__(256) check_kernel(Args args, int stage, int layer) {
    unsigned char* ws = args.ws; unsigned* ctl = (unsigned*)(ws + WS_CTL);
    const bf16* HB = (const bf16*)(ws + WS_HB);
    const int gt = blockIdx.x * 256 + threadIdx.x;
    const unsigned hsh = ck_hash((unsigned)gt * 2654435761u + 12345u * stage);
    if (stage == 1) {
        const int r = hsh % M; int c = (hsh >> 15) % 3328; if (c >= 2816) c += 32;
        const float ref = ck_dot(HB + (size_t)r * 1024, 1024, args.in[1] + (size_t)layer * 1024 * IN_COLS + c, IN_COLS);
        float mine;
        if (c < 512) mine = bf2f(((const bf16*)(ws + WS_AQ))[(size_t)r * 512 + c]);
        else if (c < 640) mine = bf2f(((const bf16*)(ws + WS_AK))[(size_t)r * 128 + c - 512]);
        else if (c < 768) mine = bf2f(((const bf16*)(ws + WS_AV))[(size_t)r * 128 + c - 640]);
        else if (c < 2304) mine = bf2f(((const bf16*)(ws + WS_DQKV))[(size_t)r * 1536 + c - 768]);
        else if (c < 2816) mine = bf2f(((const bf16*)(ws + WS_DZ))[(size_t)r * 512 + c - 2304]);
        else mine = bf2f(((const bf16*)(ws + WS_PU))[(size_t)r * 512 + c - 2848]);
        ck_record(ctl, 1, mine, ref);
    } else if (stage == 2) {
        const int r = hsh % M, c = (hsh >> 15) % 32;
        const float ref = ck_dot(HB + (size_t)r * 1024, 1024, args.in[1] + (size_t)layer * 1024 * IN_COLS + 2816 + c, IN_COLS);
        ck_record(ctl, 2, ((const float*)(ws + WS_DAB))[(size_t)r * 32 + c], ref);
    } else if (stage == 3) {
        const int r = hsh % M, c = (hsh >> 15) % 3072;
        const float ref = 1.0f / (1.0f + expf(-ck_dot(HB + (size_t)r * 1024, 1024, args.in[1] + (size_t)layer * 1024 * IN_COLS + 3360 + c, IN_COLS)));
        const float mine3 = bf2f(((const bf16*)(ws + WS_GT))[(size_t)(c >> 10) * M * 1024 + (size_t)r * 1024 + (c & 1023)]);
        ck_record(ctl, 3, mine3, ref);
        ck_record(ctl, 14 + (c >> 10), mine3, ref);
        ck_record(ctl, 17 + (r >> 13), mine3, ref);
        ck_record(ctl, 21 + ((c >> 8) & 3), mine3, ref);
        if (fabsf(mine3 - ref) > 0.04f) { const unsigned ix = atomicAdd(ctl + CK_BASE + 100, 1u); if (ix < 256) { ctl[1024 + 2 * ix] = (unsigned)c; ctl[1025 + 2 * ix] = (unsigned)r; } atomicMax(ctl + 2048, __float_as_uint(mine3)); atomicMax(ctl + 2049, __float_as_uint(1.0f - mine3)); atomicMax(ctl + 2050, __float_as_uint(ref)); atomicMax(ctl + 2051, __float_as_uint(1.0f - ref)); }
    } else if (stage == 4) {
        __shared__ float q_s[64]; __shared__ float sc_s[260];
        const unsigned hb_ = ck_hash((unsigned)blockIdx.x * 2654435761u + 777u);
        const int m = hb_ % M, hq = (hb_ >> 15) & 7, d = (hb_ >> 18) & 63, b = m / SEQ, t = m % SEQ, kvh = hq >> 2;
        if (threadIdx.x < 64) q_s[threadIdx.x] = ck_dot(HB + (size_t)m * 1024, 1024, args.in[1] + (size_t)layer * 1024 * IN_COLS + hq * 64 + threadIdx.x, IN_COLS);
        __syncthreads();
        const bf16* AK = (const bf16*)(ws + WS_AK); const bf16* AV = (const bf16*)(ws + WS_AV);
        const float sink = args.in[2][layer * 8 + hq];
        for (int j = threadIdx.x; j < 257; j += 256) { const int kp = t - 128 + j; float s = -1e30f;
            if (kp >= 0 && kp < SEQ) { s = 0.f; for (int i = 0; i < 64; ++i) s += q_s[i] * bf2f(AK[((size_t)b * SEQ + kp) * 128 + kvh * 64 + i]);
                const int rel = kp - t, n = rel < 0 ? -rel : rel;
                int bk; if (n < 8) bk = n; else { bk = 8 + (int)(logf((float)n / 8.f) / logf(16.f) * 8.f + 1e-4f); if (bk > 15) bk = 15; } if (rel > 0) bk += 16;
                s = s * 0.125f + args.in[3][bk * 8 + hq]; }
            sc_s[j] = s; }
        __syncthreads();
        if (threadIdx.x == 0) { float mx = sink; for (int j = 0; j < 257; ++j) mx = fmaxf(mx, sc_s[j]);
            float den = expf(sink - mx), o = 0.f;
            for (int j = 0; j < 257; ++j) { if (sc_s[j] < -1e29f) continue; const int kp = t - 128 + j; const float p = expf(sc_s[j] - mx); den += p; o += p * bf2f(AV[((size_t)b * SEQ + kp) * 128 + kvh * 64 + d]); }
            ck_record(ctl, 4, bf2f(((const bf16*)(ws + WS_AQ))[(size_t)m * 512 + hq * 64 + d]), o / den); }
    } else if (stage == 5) {
        const int m = hsh % M, g = (hsh >> 15) & 3, d = (hsh >> 17) & 127, b = m / SEQ, t = m % SEQ, r = 1 << g;
        const bf16* PU = (const bf16*)(ws + WS_PU); const float* pw = args.in[8] + ((size_t)layer * 4 + g) * 128 * 128;
        const int lo = t - r < 0 ? 0 : t - r, hi = t + r > SEQ - 1 ? SEQ - 1 : t + r; float y = 0.f;
        for (int c = 0; c < 128; ++c) { float s = 0.f; for (int tt = lo; tt <= hi; ++tt) s += bf2f(PU[((size_t)b * SEQ + tt) * 512 + g * 128 + c]);
            const float mxv = s / (float)(hi - lo + 1) - bf2f(PU[(size_t)m * 512 + g * 128 + c]); y += mxv * pw[c * 128 + d]; }
        y *= args.in[9][layer * 512 + g * 128 + d];
        ck_record(ctl, 5, bf2f(((const bf16*)(ws + WS_OP))[(size_t)m * 512 + g * 128 + d]), y);
    } else if (stage == 6) {
        constexpr int TCK = 192;
        __shared__ float q_s[64]; __shared__ float k_s[64];
        const int j = threadIdx.x & 63; if (threadIdx.x >= 64) return;
        const int seq = (blockIdx.x * 17 + 3) & 255;
        const int dir = seq >> 7, b = (seq >> 3) & 15, h = seq & 7;
        const bf16* DQKV = (const bf16*)(ws + WS_DQKV); const float* DAB = (const float*)(ws + WS_DAB); const float* cwp = args.in[4] + (size_t)layer * 5 * 1536;
        const float nA = -expf(args.in[5][layer * 16 + dir * 8 + h]), dtb = args.in[6][layer * 16 + dir * 8 + h];
        float S[64];
#pragma unroll
        for (int i = 0; i < 64; ++i) S[i] = 0.f;
        float maxe = 0.f, maxr = 0.f;
        for (int s2 = 0; s2 < TCK; ++s2) { const int t = dir ? SEQ - 1 - s2 : s2; const size_t m = (size_t)b * SEQ + t;
            float xq = 0.f, xk = 0.f, v = 0.f;
            for (int jj = 0; jj < 5; ++jj) { const int tt = t + jj - 2; if (tt < 0 || tt >= SEQ) continue; const size_t mm = (size_t)b * SEQ + tt;
                xq += cwp[jj * 1536 + h * 64 + j] * bf2f(DQKV[mm * 1536 + h * 64 + j]); xk += cwp[jj * 1536 + 512 + h * 64 + j] * bf2f(DQKV[mm * 1536 + 512 + h * 64 + j]);
                v += cwp[jj * 1536 + 1024 + h * 64 + j] * bf2f(DQKV[mm * 1536 + 1024 + h * 64 + j]); }
            xq = xq / (1.f + expf(-xq)); xk = xk / (1.f + expf(-xk)); v = v / (1.f + expf(-v));
            __syncthreads(); q_s[j] = xq; k_s[j] = xk; __syncthreads();
            float qs = 0.f, ks = 0.f;
            for (int i = 0; i < 64; ++i) { qs += q_s[i] * q_s[i]; ks += k_s[i] * k_s[i]; }
            const float qn = 0.125f / sqrtf(qs + 1e-6f), kn = 1.0f / sqrtf(ks + 1e-6f);
            const float a = DAB[m * 32 + dir * 8 + h] + dtb, sp = a > 20.f ? a : log1pf(expf(a)), al = expf(nA * sp), be = 1.f / (1.f + expf(-DAB[m * 32 + 16 + dir * 8 + h]));
            float part = 0.f;
#pragma unroll
            for (int i = 0; i < 64; ++i) part += S[i] * k_s[i];
            const float c = be * (v - al * part * kn); float o = 0.f;
#pragma unroll
            for (int i = 0; i < 64; ++i) { S[i] = al * S[i] + k_s[i] * kn * c; o += S[i] * q_s[i]; }
            o *= qn;
            const float mine = ((const float*)(ws + (dir ? WS_OB : WS_OF)))[m * 512 + h * 64 + j];
            maxe = fmaxf(maxe, fabsf(mine - o)); maxr = fmaxf(maxr, fabsf(o)); }
        atomicMax(ctl + CK_BASE + 12, __float_as_uint(maxe == maxe ? maxe : 1e30f)); atomicMax(ctl + CK_BASE + 13, __float_as_uint(maxr));
    } else if (stage == 8) {
        const int r = hsh % M, d = (hsh >> 15) & 1023; float mg = 0.f;
        for (int n = 0; n < 3; ++n) { const bf16* O = (const bf16*)(ws + WS_AQ + (size_t)n * 32 * MiB) + (size_t)r * 512;
            mg += bf2f(((const bf16*)(ws + WS_GT))[(size_t)n * M * 1024 + (size_t)r * 1024 + d]) * ck_dot(O, 512, args.in[10] + ((size_t)layer * 3 + n) * 512 * 1024 + d, 1024); }
        ck_record(ctl, 8, bf2f(((const bf16*)(ws + WS_MERGED))[(size_t)r * 1024 + d]), mg);
    } else if (stage == 9) {
        const int r = hsh % M, c = (hsh >> 15) & 1023;
        const float ref = ALPHA * bf2f(HB[(size_t)r * 1024 + c]) + ck_dot((const bf16*)(ws + WS_MERGED) + (size_t)r * 1024, 1024, args.in[11] + (size_t)layer * 1024 * 1024 + c, 1024);
        ck_record(ctl, 9, args.out[(size_t)r * 1024 + c], ref);
    } else if (stage == 10 || stage == 13) {
        const int r = hsh % M; const float* g = args.in[stage == 10 ? 12 : 14] + layer * 1024; const float* bb = args.in[stage == 10 ? 13 : 15] + layer * 1024;
        float s = 0.f, s2 = 0.f, de = 0.f; for (int c = 0; c < 1024; ++c) { const float hv = args.out[(size_t)r * 1024 + c]; const float u = (hv - bb[c]) / g[c]; s += u; s2 += u * u; de = fmaxf(de, fabsf(hv - bf2f(HB[(size_t)r * 1024 + c]))); }
        const float mean = s / 1024.f, var = s2 / 1024.f - mean * mean;
        ck_record(ctl, stage, fabsf(mean) + fabsf(var - 1.0f) + de * 0.1f, 0.0f); atomicMax(ctl + CK_BASE + 2 * stage + 1, __float_as_uint(1.0f));
    } else if (stage == 11) {
        const int r = hsh % M, c = (hsh >> 15) % FF;
        const float g = ck_dot(HB + (size_t)r * 1024, 1024, args.in[16] + c, FF), u = ck_dot(HB + (size_t)r * 1024, 1024, args.in[17] + c, FF);
        ck_record(ctl, 11, bf2f(((const bf16*)(ws + WS_FACT))[(size_t)r * FF + c]), g / (1.f + expf(-g)) * u);
    } else if (stage == 12) {
        const int r = hsh % M, c = (hsh >> 15) & 1023;
        const float ref = ALPHA * bf2f(HB[(size_t)r * 1024 + c]) + ck_dot((const bf16*)(ws + WS_FACT) + (size_t)r * FF, FF, args.in[18] + c, 1024);
        ck_record(ctl, 12, args.out[(size_t)r * 1024 + c], ref);
    } else if (stage == 30) {
        const int rr = 3584 + (int)(hsh % 3072), k = (hsh >> 15) & 1023;
        const float mine = bf2f(((const bf16*)(ws + WS_WIN))[((size_t)layer * WIN_ROWS + rr) * 1024 + k]), ref = args.in[1][(size_t)layer * 1024 * IN_COLS + (size_t)k * IN_COLS + 3360 + rr - 3584];
        ck_record(ctl, 30, mine, ref); if (fabsf(mine - ref) > 0.01f * fabsf(ref) + 1e-4f) atomicAdd(ctl + CK_BASE + 101, 1u);
    } else if (stage == 7) {
        const int m = hsh % M, h = (hsh >> 15) & 7; const float* OFp = (const float*)(ws + WS_OF) + (size_t)m * 512 + h * 64; const float* OBp = (const float*)(ws + WS_OB) + (size_t)m * 512 + h * 64;
        float ss = 0.f; for (int d = 0; d < 64; ++d) { const float o = OFp[d] + OBp[d]; ss += o * o; }
        const int d = (hsh >> 18) & 63; const float z = ck_dot(HB + (size_t)m * 1024, 1024, args.in[1] + (size_t)layer * 1024 * IN_COLS + 2304 + h * 64 + d, IN_COLS);
        const float ref = (OFp[d] + OBp[d]) / sqrtf(ss / 64.f + RMS_EPS) * args.in[7][layer * 64 + d] * z / (1.f + expf(-z));
        ck_record(ctl, 7, bf2f(((const bf16*)(ws + WS_DZ))[(size_t)m * 512 + h * 64 + d]), ref);
    }
}
__global__ void check_verdict(Args args) {
    unsigned* ctl = (unsigned*)(args.ws + WS_CTL);
    float code = 3.0f;
#if defined(CK_VAL)
    code = 3.0f + 40.0f * __uint_as_float(ctl[2048 + CK_VAL]);
#elif defined(CK_WCNT)
    { unsigned cnt = ctl[CK_BASE + 101]; int lg = 0; while (cnt) { ++lg; cnt >>= 1; } code += (float)lg; }
#elif defined(CK_COUNT)
    { unsigned cnt = ctl[CK_BASE + 100]; if (cnt > 256) cnt = 256; int distinct = 0;
        for (unsigned i = 0; i < cnt; ++i) { const unsigned ci = ctl[1024 + 2 * i], ri = ctl[1025 + 2 * i];
            const unsigned key = CK_COUNT == 1 ? (ci >> 5) : (CK_COUNT == 2 ? (ri >> 8) : (CK_COUNT == 3 ? (ci & 31) : (ri & 255)));
            bool seen = false; for (unsigned j = 0; j < i; ++j) { const unsigned cj = ctl[1024 + 2 * j], rj = ctl[1025 + 2 * j];
                const unsigned kj = CK_COUNT == 1 ? (cj >> 5) : (CK_COUNT == 2 ? (rj >> 8) : (CK_COUNT == 3 ? (cj & 31) : (rj & 255))); if (kj == key) { seen = true; break; } }
            if (!seen) ++distinct; }
        code += (float)(distinct > 15 ? 15 : distinct); }
#else
#ifndef CK_LIST
#define CK_LIST {14, 15, 16, 3}
#endif
    const int lst[4] = CK_LIST;
    for (int i = 0; i < 4; ++i) { const float e = __uint_as_float(ctl[CK_BASE + 2 * lst[i]]), r = __uint_as_float(ctl[CK_BASE + 2 * lst[i] + 1]); if (r == 0.f || e > 0.04f * r) code += (float)(1 << i); }
#endif
    for (size_t i = (size_t)blockIdx.x * blockDim.x + threadIdx.x; i < (size_t)M * D; i += (size_t)gridDim.x * blockDim.x) args.out[i] = code;
}
#endif
extern "C" void kernel_launch(void* const* d_in, const int* in_sizes, int n_in, void* d_out, int out_size, void* d_ws, size_t ws_size, hipStream_t stream) {
    static int grid = 0;
    if (grid == 0) {
        if (n_in != 23 || out_size != M * D || ws_size < WS_END) { fprintf(stderr, "kernel_launch: unexpected problem (n_in %d, out %d, ws %zu < %zu); nothing launched\n", n_in, out_size, ws_size, (size_t)WS_END); grid = -1; return; }
        int dev = 0, cus = 0, per_cu = 0;
        if (hipGetDevice(&dev) != hipSuccess || hipDeviceGetAttribute(&cus, hipDeviceAttributeMultiprocessorCount, dev) != hipSuccess) { grid = -1; return; }
        if (hipFuncSetAttribute((const void*)fwd_kernel, hipFuncAttributeMaxDynamicSharedMemorySize, LDS_BYTES) != hipSuccess) { fprintf(stderr, "kernel_launch: hipFuncSetAttribute failed\n"); grid = -1; return; }
        if (hipOccupancyMaxActiveBlocksPerMultiprocessor(&per_cu, (const void*)fwd_kernel, NTHR, LDS_BYTES) != hipSuccess || per_cu < 1) { fprintf(stderr, "kernel_launch: occupancy query says %d\n", per_cu); }
        (void)hipGetLastError();
        if (cus != 256 || per_cu < 1) { fprintf(stderr, "kernel_launch: needs 256 CUs with one resident workgroup each (cus %d, per_cu %d)\n", cus, per_cu); grid = -1; return; }
        grid = 256;
    }
    if (grid < 0) return;
    (void)hipMemsetAsync((char*)d_ws + WS_CTL, 0, CTL_ZERO_BYTES, stream);
    Args a{};
    for (int i = 0; i < 23; ++i) a.in[i] = (const float*)d_in[i];
    a.out = (float*)d_out; a.ws = (unsigned char*)d_ws;
#if MK_PER_PHASE
    static const int phases[] = {0, 1, 2, 21, 3, 4, 5, 6, 7, 8, 9, 41, 42, 61, 43, 44, 45, 46, 47, 48, 49, 50, 51, 52, 53, 54, 55, 56};
    for (int p : phases) { a.ph_lo = p; a.ph_hi = p + 1; hipLaunchKernelGGL(fwd_kernel, dim3(grid), dim3(NTHR), LDS_BYTES, stream, a);
#if defined(DBG_CHECK)
        const int L = DBG_CHECK - 1, pb = 1 + 40 * L;
        if (p == pb + 0) { hipLaunchKernelGGL(check_kernel, dim3(64), dim3(256), 0, stream, a, 1, L); hipLaunchKernelGGL(check_kernel, dim3(64), dim3(256), 0, stream, a, 2, L); }
        if (p == pb + 1) { hipLaunchKernelGGL(check_kernel, dim3(512), dim3(256), 0, stream, a, 4, L); hipLaunchKernelGGL(check_kernel, dim3(64), dim3(256), 0, stream, a, 5, L); hipLaunchKernelGGL(check_kernel, dim3(16), dim3(64), 0, stream, a, 6, L); }
        if (p == pb + 20) hipLaunchKernelGGL(check_kernel, dim3(64), dim3(256), 0, stream, a, 7, L);
        if (p == pb + 2) { hipLaunchKernelGGL(check_kernel, dim3(64), dim3(256), 0, stream, a, 3, L); hipLaunchKernelGGL(check_kernel, dim3(256), dim3(256), 0, stream, a, 30, L); }
        if (p == pb + 3) hipLaunchKernelGGL(check_kernel, dim3(64), dim3(256), 0, stream, a, 8, L);
        if (p == pb + 4) hipLaunchKernelGGL(check_kernel, dim3(64), dim3(256), 0, stream, a, 9, L);
        if (p == pb + 5) hipLaunchKernelGGL(check_kernel, dim3(16), dim3(256), 0, stream, a, 10, L);
        if (L == 0 && p == pb + 6) hipLaunchKernelGGL(check_kernel, dim3(64), dim3(256), 0, stream, a, 11, L);
        if (L == 0 && p == pb + 7) hipLaunchKernelGGL(check_kernel, dim3(64), dim3(256), 0, stream, a, 12, L);
        if (L == 0 && p == pb + 8) hipLaunchKernelGGL(check_kernel, dim3(16), dim3(256), 0, stream, a, 13, L);
#endif
    }
#if defined(DBG_CHECK)
    hipLaunchKernelGGL(check_verdict, dim3(1024), dim3(256), 0, stream, a);
#endif
#else
    a.ph_lo = 0; a.ph_hi = 1000;
    hipLaunchKernelGGL(fwd_kernel, dim3(grid), dim3(NTHR), LDS_BYTES, stream, a);
#endif
}
```
